# Optimizing an MI355X kernel written in HIP

```python
import math
import jax, jax.numpy as jnp
from jax import lax
import numpy as np

D_MODEL = 1024
BATCH = 8
SEQ = 2048
DEPTH = 2

GRID_W = 64
CTX_LEN = 256
HEAD_DIM = 64
ROPE_FREQS_PER_AXIS = HEAD_DIM // 4
ROPE_BASE = 10000.0
EPS = 1e-6
FNET_GROUPS = 8
FNET_GROUP_DIM = 64
FNET_WIDTH = FNET_GROUPS * FNET_GROUP_DIM
RET_HEADS = 4
RET_QK_DIM = HEAD_DIM
RET_V_DIM = 2 * HEAD_DIM
RET_CHUNK = 128
DIFF_HEADS = 4
DIFF_QK_DIM = HEAD_DIM
DIFF_V_DIM = 2 * HEAD_DIM
Q_BLOCK = 128
N_BRANCHES = 3
N_EXPERTS = 16
EC_FACTOR = 2
EXPERT_HIDDEN = 2 * D_MODEL
N_MOD = 6
IN_WIDTHS = (FNET_WIDTH,
             RET_HEADS * RET_QK_DIM, RET_HEADS * RET_QK_DIM, RET_HEADS * RET_V_DIM, RET_HEADS * RET_V_DIM,
             DIFF_HEADS * 2 * DIFF_QK_DIM, DIFF_HEADS * 2 * DIFF_QK_DIM, DIFF_HEADS * DIFF_V_DIM,
             N_BRANCHES * D_MODEL)
IN_WIDTH = sum(IN_WIDTHS)
IN_SPLITS = tuple(int(s) for s in np.cumsum(IN_WIDTHS)[:-1])

kernel_name = 'hybrid_fnet_retention_diffattn_ecmoe_dit'


def rms_norm(x, gain=None):
    xf = x.astype(jnp.float32)
    y = xf * lax.rsqrt(jnp.mean(xf * xf, axis=-1, keepdims=True) + EPS)
    if gain is not None:
        y = y * gain.astype(jnp.float32)
    return y.astype(x.dtype)


def head_layer_norm(o):
    mu = jnp.mean(o, axis=-1, keepdims=True)
    var = jnp.mean(jnp.square(o - mu), axis=-1, keepdims=True)
    return (o - mu) * lax.rsqrt(var + EPS)


def modulation(cvec, w_mod, b_mod):
    m = jax.nn.silu(cvec) @ w_mod + b_mod
    return jnp.split(m[..., None, :], N_MOD, axis=-1)


def adaln(h, shift, scale):
    return h * (1.0 + scale) + shift


def axial_rope(rows):
    row = jnp.repeat(jnp.arange(rows, dtype=jnp.float32), GRID_W)
    col = jnp.tile(jnp.arange(GRID_W, dtype=jnp.float32), rows)
    inv = ROPE_BASE ** (-jnp.arange(ROPE_FREQS_PER_AXIS, dtype=jnp.float32) / ROPE_FREQS_PER_AXIS)
    ang = jnp.concatenate([row[:, None] * inv, col[:, None] * inv], axis=-1)
    return jnp.cos(ang), jnp.sin(ang)


def apply_rope(x, cos, sin):
    shape = (cos.shape[0],) + (1,) * (x.ndim - 3) + (cos.shape[-1],)
    c = cos.reshape(shape).astype(x.dtype)
    s = sin.reshape(shape).astype(x.dtype)
    x1, x2 = jnp.split(x, 2, axis=-1)
    return jnp.concatenate([x1 * c - x2 * s, x2 * c + x1 * s], axis=-1)


def mixer_inputs(h, w_in, q_gain, k_gain, rope):
    B, N, _ = h.shape
    fo, rq, rk, rv, rg, dq, dk, dv, gates = jnp.split(h @ w_in, IN_SPLITS, axis=-1)
    rq = rq.reshape(B, N, RET_HEADS, RET_QK_DIM) * (RET_QK_DIM ** -0.5)
    rk = rk.reshape(B, N, RET_HEADS, RET_QK_DIM)
    rv = rv.reshape(B, N, RET_HEADS, RET_V_DIM)
    dq = rms_norm(dq.reshape(B, N, DIFF_HEADS, 2, DIFF_QK_DIM), q_gain)
    dk = rms_norm(dk.reshape(B, N, DIFF_HEADS, 2, DIFF_QK_DIM), k_gain)
    dv = dv.reshape(B, N, DIFF_HEADS, DIFF_V_DIM)
    if rope is not None:
        cos, sin = rope
        rq, rk = apply_rope(rq, cos, sin), apply_rope(rk, cos, sin)
        dq, dk = apply_rope(dq, cos, sin), apply_rope(dk, cos, sin)
    return fo, (rq, rk, rv, rg), (dq, dk, dv), gates


def fourier_mix(u):
    B, N, _ = u.shape
    g = u.reshape(B, N, FNET_GROUPS, FNET_GROUP_DIM).astype(jnp.float32)
    f = jnp.fft.fft2(g, axes=(1, 3), norm='ortho').real
    return f.reshape(B, N, FNET_WIDTH).astype(u.dtype)


def retention_scan(q, k, v, log_gamma, state0, include_diag):
    B, N, H, _ = q.shape
    dv = v.shape[-1]
    n_chunks = N // RET_CHUNK

    def to_chunks(t):
        return t.astype(jnp.float32).reshape(B, n_chunks, RET_CHUNK, H, t.shape[-1]).transpose(1, 0, 3, 2, 4)

    qc, kc, vc = to_chunks(q), to_chunks(k), to_chunks(v)
    lg = log_gamma.astype(jnp.float32)
    pos = jnp.arange(RET_CHUNK, dtype=jnp.float32)
    rel = pos[:, None] - pos[None, :]
    keep = (rel >= 0) if include_diag else (rel > 0)
    intra_decay = jnp.where(keep, jnp.exp(lg[:, None, None] * jnp.maximum(rel, 0.0)), 0.0)
    q_decay = jnp.exp(lg[:, None] * (pos + 1.0))[..., None]
    k_decay = jnp.exp(lg[:, None] * (RET_CHUNK - 1.0 - pos))[..., None]
    chunk_decay = jnp.exp(lg * RET_CHUNK)[:, None, None]

    def step(state, blk):
        qb, kb, vb = blk
        scores = jnp.einsum('bhid,bhjd->bhij', qb, kb) * intra_decay
        out = (jnp.einsum('bhij,bhje->bhie', scores, vb)
               + jnp.einsum('bhid,bhde->bhie', qb * q_decay, state))
        state = state * chunk_decay + jnp.einsum('bhjd,bhje->bhde', kb * k_decay, vb)
        return state, out

    state, out = lax.scan(step, state0.astype(jnp.float32), (qc, kc, vc))
    return out.transpose(1, 0, 3, 2, 4).reshape(B, N, H, dv), state


def bidirectional_retention(q, k, v, decays, state_f, state_b):
    out_f, s_f = retention_scan(q, k, v, decays[0], state_f, True)
    out_b, s_b = retention_scan(q[:, ::-1], k[:, ::-1], v[:, ::-1], decays[1], state_b, False)
    return out_f + out_b[:, ::-1], s_f, s_b


def retention_final_states(k, v, decays):
    N = k.shape[1]
    pos = jnp.arange(N, dtype=jnp.float32)
    lg = decays.astype(jnp.float32)
    w_f = jnp.exp(lg[0][None, :] * (N - 1.0 - pos)[:, None])
    w_b = jnp.exp(lg[1][None, :] * pos[:, None])
    kf, vf = k.astype(jnp.float32), v.astype(jnp.float32)
    s_f = jnp.einsum('nh,bnhd,bnhe->bhde', w_f, kf, vf)
    s_b = jnp.einsum('nh,bnhd,bnhe->bhde', w_b, kf, vf)
    return s_f, s_b


def retention_output(o, rg):
    B, N = o.shape[:2]
    return head_layer_norm(o).reshape(B, N, -1).astype(rg.dtype) * jax.nn.silu(rg)


def diff_attention_block(q, k, v, lam):
    s = jnp.einsum('bqhcd,bkhcd->bhcqk', q, k).astype(jnp.float32) * (DIFF_QK_DIM ** -0.5)
    p = jax.nn.softmax(s, axis=-1)
    a = p[:, :, 0] - lam * p[:, :, 1]
    return jnp.einsum('bhqk,bkhe->bqhe', a.astype(v.dtype), v)


def blockwise_diff_attention(q, k, v, lam):
    B, N = q.shape[:2]
    nq = N // Q_BLOCK
    qb = jnp.moveaxis(q.reshape((B, nq, Q_BLOCK) + q.shape[2:]), 1, 0)
    out = lax.map(lambda blk: diff_attention_block(blk, k, v, lam), qb)
    return jnp.moveaxis(out, 0, 1).reshape(B, N, DIFF_HEADS, DIFF_V_DIM)


def diff_output(o, lam_init):
    B, N = o.shape[:2]
    return (rms_norm(o) * (1.0 - lam_init)).reshape(B, N, -1)


def merge_branches(fo, ro, do, gate_logits, w_fo, w_ro, w_do, w_o):
    g_f, g_r, g_d = jnp.split(jax.nn.sigmoid(gate_logits), N_BRANCHES, axis=-1)
    return (g_f * (fo @ w_fo) + g_r * (ro @ w_ro) + g_d * (do @ w_do)) @ w_o


def expert_choice_moe(h, w_router, w_gate, w_up, w_down):
    B, N, D = h.shape
    cap = EC_FACTOR * N // N_EXPERTS
    aff = jax.nn.softmax((h @ w_router).astype(jnp.float32), axis=-1)
    top_w, top_idx = lax.top_k(jnp.swapaxes(aff, 1, 2), cap)
    xs = jax.vmap(lambda hb, ib: hb[ib])(h, top_idx)
    hid = jax.nn.silu(jnp.einsum('becd,edf->becf', xs, w_gate)) * jnp.einsum('becd,edf->becf', xs, w_up)
    ye = jnp.einsum('becf,efd->becd', hid, w_down) * top_w[..., None].astype(h.dtype)
    return jax.vmap(lambda ib, yb: jnp.zeros((N, D), yb.dtype).at[ib.reshape(-1)].add(yb.reshape(-1, D)))(top_idx, ye)


def setup_inputs(seed: int = 0) -> dict:
    key = jax.random.key(seed)
    ks = jax.random.split(key, 24)

    def normal(k, shape, scale):
        return jax.random.normal(k, shape, jnp.float32) * scale

    base_decay = jnp.asarray(np.log(1.0 - 2.0 ** (-5.0 - np.arange(RET_HEADS))), jnp.float32)
    mix_width = FNET_WIDTH
    return {
        'x': normal(ks[0], (BATCH, SEQ, D_MODEL), 1.0),
        'c': normal(ks[1], (BATCH, D_MODEL), 1.0),
        'ctx': normal(ks[2], (BATCH, CTX_LEN, D_MODEL), 1.0),
        'c_ctx': normal(ks[3], (D_MODEL,), 1.0),
        'w_mod': normal(ks[4], (DEPTH, D_MODEL, N_MOD * D_MODEL), 0.5 * D_MODEL ** -0.5),
        'b_mod': normal(ks[5], (DEPTH, N_MOD * D_MODEL), 0.02),
        'g_attn': 1.0 + normal(ks[6], (DEPTH, D_MODEL), 0.02),
        'g_ffn': 1.0 + normal(ks[7], (DEPTH, D_MODEL), 0.02),
        'w_in': normal(ks[8], (DEPTH, D_MODEL, IN_WIDTH), D_MODEL ** -0.5),
        'ret_decay': base_decay * (1.0 + normal(ks[9], (DEPTH, 2, RET_HEADS), 0.05)),
        'diff_qn': 1.0 + normal(ks[10], (DEPTH, DIFF_QK_DIM), 0.02),
        'diff_kn': 1.0 + normal(ks[11], (DEPTH, DIFF_QK_DIM), 0.02),
        'diff_lambda': normal(ks[12], (DEPTH, 4, DIFF_QK_DIM), 0.1),
        'w_fnet_o': normal(ks[13], (DEPTH, mix_width, D_MODEL), mix_width ** -0.5),
        'w_ret_o': normal(ks[14], (DEPTH, RET_HEADS * RET_V_DIM, D_MODEL), (RET_HEADS * RET_V_DIM) ** -0.5),
        'w_diff_o': normal(ks[15], (DEPTH, DIFF_HEADS * DIFF_V_DIM, D_MODEL), (DIFF_HEADS * DIFF_V_DIM) ** -0.5),
        'w_out': normal(ks[16], (DEPTH, D_MODEL, D_MODEL), D_MODEL ** -0.5),
        'w_router': normal(ks[17], (DEPTH, D_MODEL, N_EXPERTS), D_MODEL ** -0.5),
        'w_exp_gate': normal(ks[18], (DEPTH, N_EXPERTS, D_MODEL, EXPERT_HIDDEN), D_MODEL ** -0.5),
        'w_exp_up': normal(ks[19], (DEPTH, N_EXPERTS, D_MODEL, EXPERT_HIDDEN), D_MODEL ** -0.5),
        'w_exp_down': normal(ks[20], (DEPTH, N_EXPERTS, EXPERT_HIDDEN, D_MODEL), EXPERT_HIDDEN ** -0.5),
    }


def reference(x, c, ctx, c_ctx, w_mod, b_mod, g_attn, g_ffn, w_in, ret_decay, diff_qn, diff_kn, diff_lambda,
              w_fnet_o, w_ret_o, w_diff_o, w_out, w_router, w_exp_gate, w_exp_up, w_exp_down):
    B, N, _ = x.shape
    ROWS = N // GRID_W
    rope = axial_rope(ROWS)
    xc = ctx
    zero_state = jnp.zeros((B, RET_HEADS, RET_QK_DIM, RET_V_DIM), jnp.float32)
    for layer in range(DEPTH):
        last = layer == DEPTH - 1
        lam_init = 0.8 - 0.6 * math.exp(-0.3 * layer)
        lq1, lk1, lq2, lk2 = diff_lambda[layer].astype(jnp.float32)
        lam = jnp.exp(jnp.sum(lq1 * lk1)) - jnp.exp(jnp.sum(lq2 * lk2)) + lam_init
        mx = modulation(c, w_mod[layer], b_mod[layer])
        mc = modulation(c_ctx, w_mod[layer], b_mod[layer])
        decays = ret_decay[layer]
        branch_w = (w_fnet_o[layer], w_ret_o[layer], w_diff_o[layer], w_out[layer])
        moe_w = (w_router[layer], w_exp_gate[layer], w_exp_up[layer], w_exp_down[layer])

        hc = adaln(rms_norm(xc, g_attn[layer]), mc[0], mc[1])
        fc, (rqc, rkc, rvc, rgc), (dqc, dkc, dvc), gates_c = mixer_inputs(hc, w_in[layer], diff_qn[layer], diff_kn[layer], None)
        if last:
            s_f, s_b = retention_final_states(rkc, rvc, decays)
        else:
            ro_c, s_f, s_b = bidirectional_retention(rqc, rkc, rvc, decays, zero_state, zero_state)
            do_c = diff_attention_block(dqc, dkc, dvc, lam)
            mix_c = merge_branches(fourier_mix(fc), retention_output(ro_c, rgc), diff_output(do_c, lam_init), gates_c, *branch_w)
            xc_next = xc + mc[2] * mix_c
            h2c = adaln(rms_norm(xc_next, g_ffn[layer]), mc[3], mc[4])
            xc_next = xc_next + mc[5] * expert_choice_moe(h2c, *moe_w)

        h = adaln(rms_norm(x, g_attn[layer]), mx[0], mx[1])
        f, (rq, rk, rv, rg), (dq, dk, dv), gates = mixer_inputs(h, w_in[layer], diff_qn[layer], diff_kn[layer], rope)
        ro, _, _ = bidirectional_retention(rq, rk, rv, decays, s_f, s_b)
        k_all = jnp.concatenate([dk, dkc], axis=1)
        v_all = jnp.concatenate([dv, dvc], axis=1)
        do = blockwise_diff_attention(dq, k_all, v_all, lam)
        mix = merge_branches(fourier_mix(f), retention_output(ro, rg), diff_output(do, lam_init), gates, *branch_w)
        x = x + mx[2] * mix
        h2 = adaln(rms_norm(x, g_ffn[layer]), mx[3], mx[4])
        x = x + mx[5] * expert_choice_moe(h2, *moe_w)
        if not last:
            xc = xc_next
    return x
```

```cpp
#include <hip/hip_runtime.h>
#include <cstdio>
#include <cstdint>

#ifndef MK_MULTI_LAUNCH
#define MK_MULTI_LAUNCH 0
#endif

#define GAS __attribute__((address_space(1)))
#define LAS __attribute__((address_space(3)))
typedef unsigned short bf16;
typedef short bf16x8 __attribute__((ext_vector_type(8)));
typedef short s16x4 __attribute__((ext_vector_type(4)));
typedef float f32x4 __attribute__((ext_vector_type(4)));
typedef float f32x16 __attribute__((ext_vector_type(16)));
typedef unsigned u32x4 __attribute__((ext_vector_type(4)));
typedef unsigned u32x2 __attribute__((ext_vector_type(2)));
typedef float f32x2_t __attribute__((ext_vector_type(2)));
typedef __bf16 bf16x2_t __attribute__((ext_vector_type(2)));

constexpr int D = 1024, NB = 8, SEQ = 2048, CTX = 256, DEPTH = 2, GRIDW = 64;
constexpr int TC = NB * CTX, TL = NB * SEQ, TA = TC + TL;
constexpr int NPROJ = 6144;
constexpr int C_RQ = 0, C_RK = 256, C_RV = 512, C_RG = 1024, C_DQ = 1536, C_DK = 2048, C_DV = 2560, C_GATE = 3072;
constexpr int INW = 6656;
constexpr int NE = 16, EH = 2048;
constexpr float EPS = 1e-6f;
constexpr float LOG2E = 1.4426950408889634f;

constexpr size_t al(size_t x) { return (x + 0xFFFFFull) & ~0xFFFFFull; }
constexpr size_t WS_CTL = 0, CTL_BYTES = 1u << 20;
constexpr size_t WS_MOD = WS_CTL + CTL_BYTES;
constexpr size_t WS_ROPE = WS_MOD + al((size_t)DEPTH * 9 * 6 * D * 4);
constexpr size_t WS_AFF = WS_ROPE + al((size_t)2 * SEQ * 32 * 4);
constexpr size_t WS_INV = WS_AFF + al((size_t)TA * 16 * 4);
constexpr size_t WS_TOPW = WS_INV + al((size_t)TA * 16 * 4);
constexpr size_t WS_WIN = WS_TOPW + al((size_t)36864 * 4);
constexpr size_t WIN_L = (size_t)7168 * 1024 * 2;
constexpr size_t WS_WFO = WS_WIN + al(2 * WIN_L);
constexpr size_t WMG_ONE = (size_t)1024 * 512 * 2;
constexpr size_t WS_WOUT = WS_WFO + al(6 * WMG_ONE);
constexpr size_t WOUT_L = (size_t)1024 * 1024 * 2;
constexpr size_t WS_WGU = WS_WOUT + al(2 * WOUT_L);
constexpr size_t WGU_E = (size_t)4096 * 1024 * 2;
constexpr size_t WS_WD = WS_WGU + al(16 * WGU_E);
constexpr size_t WD_E = (size_t)1024 * 2048 * 2;
constexpr size_t WS_DFTL = WS_WD + al(16 * WD_E);
constexpr size_t WS_DFTC = WS_DFTL + al((size_t)2048 * 4096 * 2);
constexpr size_t WS_XR = WS_DFTC + al((size_t)256 * 512 * 2);
constexpr size_t WS_HB = WS_XR + al((size_t)TA * D * 4);
constexpr size_t WS_PROJ = WS_HB + al((size_t)TA * D * 2);
constexpr size_t WS_GT = WS_PROJ + al((size_t)TA * NPROJ * 2);
constexpr size_t WS_GTC = WS_GT + al((size_t)4096 * 4096 * 2);
constexpr size_t WS_FO = WS_GTC + al((size_t)4096 * 512 * 2);
constexpr size_t MIX_ONE = (size_t)TA * 512 * 2;
constexpr size_t WS_MIXB = WS_FO + al(3 * MIX_ONE);
constexpr size_t WS_XS = WS_MIXB + al((size_t)TA * D * 2);
constexpr size_t WS_END = WS_XS + al((size_t)36864 * D * 2);
constexpr size_t WS_HID = WS_PROJ;
constexpr size_t WS_YE = WS_XS;
static_assert((size_t)36864 * EH * 2 <= (size_t)TA * NPROJ * 2, "HID overlays PROJ");
static_assert(WS_END <= (size_t)1024 * 1024 * 1024, "workspace map must fit 1 GiB");

constexpr int CW_BAR = 4096;
constexpr int CW_QUEUE = 16384;

constexpr int RING_BYTES = 131072;
constexpr int LDSCTL_OFF = RING_BYTES, MISC_OFF = LDSCTL_OFF + 320;
constexpr int LDS_BYTES = 147456;

#define RLX_AGENT __ATOMIC_RELAXED, __HIP_MEMORY_SCOPE_AGENT
#define LDS_WAIT() asm volatile("s_waitcnt lgkmcnt(0)" ::: "memory")
#define VM_WAIT() asm volatile("s_waitcnt vmcnt(0)" ::: "memory")
__device__ __forceinline__ unsigned f2bf(float f) { unsigned u = __builtin_bit_cast(unsigned, f); return (u + 0x7fffu + ((u >> 16) & 1u)) >> 16; }
__device__ __forceinline__ unsigned pk2(float lo, float hi) { f32x2_t v = {lo, hi}; bf16x2_t b = __builtin_convertvector(v, bf16x2_t); return __builtin_bit_cast(unsigned, b); }
__device__ __forceinline__ float bflo(unsigned w) { return __builtin_bit_cast(float, w << 16); }
__device__ __forceinline__ float bfhi(unsigned w) { return __builtin_bit_cast(float, w & 0xffff0000u); }
__device__ __forceinline__ float bf2f(bf16 h) { return __builtin_bit_cast(float, (unsigned)h << 16); }
__device__ __forceinline__ float wave_sum(float v) {
#pragma unroll
    for (int o = 1; o < 64; o <<= 1) v += __shfl_xor(v, o);
    return v;
}
__device__ __forceinline__ float sigmoidf_(float x) { return __builtin_amdgcn_rcpf(1.0f + __builtin_amdgcn_exp2f(-x * LOG2E)); }
__device__ __forceinline__ float siluf_(float x) { return x * sigmoidf_(x); }

namespace pg8 {
constexpr int BM = 256, BK = 64, HALF = 128, HTB = HALF * BK * 2, STAGE_BYTES = 8 * HTB, NXCD = 8, WGM = 8;
__host__ __device__ __forceinline__ int lds_byte(int r, int c) { const int st = (r >> 4) * 2 + (c >> 5), rr = r & 15, cc = c & 31, ob = rr * 64 + cc * 2; return st * 1024 + (ob ^ (((ob >> 9) & 1) << 5)); }
__host__ __device__ __forceinline__ void stage_rc(int b, int& R, int& C) { const int st = b / 1024, sb = b % 1024, swz = sb ^ (((sb >> 9) & 1) << 5); R = (st >> 1) * 16 + swz / 64; C = (st & 1) * 32 + (swz % 64) / 2; }
__host__ __device__ __forceinline__ int perm32(int rho) { const int n = rho >> 4, i = rho & 15; return 8 * (i >> 2) + 4 * n + (i & 3); }

struct Unit { int pm, pn, tag; const char* A; const char* B; };

__device__ __forceinline__ bool grid_order(long L, int nM, int nN, int& pm, int& pn) {
    const int nwg = nM * nN; if (L >= nwg) return false;
    int wgid = (int)L; { const int q = nwg / NXCD, r = nwg % NXCD, xcd = wgid % NXCD, off = wgid / NXCD; wgid = (xcd < r ? xcd * (q + 1) : r * (q + 1) + (xcd - r) * q) + off; }
    const int nig = WGM * nN, gid = wgid / nig, fm = gid * WGM, gsz = (nM - fm) < WGM ? (nM - fm) : WGM;
    pm = fm + ((wgid % nig) % gsz); pn = (wgid % nig) / gsz; return true;
}

typedef f32x4 Acc[2][2][4][2];
__device__ __forceinline__ void zero_acc(Acc& acc) {
#pragma unroll
    for (int a = 0; a < 2; ++a)
#pragma unroll
        for (int b = 0; b < 2; ++b)
#pragma unroll
            for (int m = 0; m < 4; ++m)
#pragma unroll
                for (int n = 0; n < 2; ++n) acc[a][b][m][n] = (f32x4){0.f, 0.f, 0.f, 0.f};
}

template <class Epi, class Sched>
__device__ __forceinline__ void gemm_phase(LAS unsigned char* lds, const int tid, const int K, const Sched& S, const Epi& E) {
    const int wid = __builtin_amdgcn_readfirstlane(tid >> 6), lane = tid & 63, wr = wid >> 2, wc = wid & 3, fr = lane & 15, fq = lane >> 4;
    const int nt = K / BK;
    unsigned voffA[2], voffB[2];
#pragma unroll
    for (int i = 0; i < 2; ++i) { int R, C; stage_rc(tid * 16 + i * 8192, R, C); const int Rb = Epi::PERM ? ((R & ~31) + perm32(R & 31)) : R;
        voffA[i] = (unsigned)(R * K + C) * 2u; voffB[i] = (unsigned)(Rb * K + C) * 2u; }
    const size_t kstep = (size_t)(BK * 2);
    const size_t hstep = (size_t)HALF * K * 2;
    const unsigned ldsw = (unsigned)wid * 1024u;
    const int aoff = lds_byte(wr * 64 + fr, fq * 8), boff = lds_byte(wc * 32 + fr, fq * 8);
#define PG8_SA(b, h) (((b) * 2 + (h)) * HTB)
#define PG8_SB(b, h) ((4 + (b) * 2 + (h)) * HTB)
#define PG8_STAGE(bufoff, gbase, voff) do { _Pragma("unroll") for (int _i = 0; _i < 2; ++_i) \
        __builtin_amdgcn_global_load_lds((const unsigned*)((const char*)(gbase) + (voff)[_i]), (LAS unsigned*)(lds + (bufoff) + ldsw + _i * 8192), 16, 0, 0); } while (0)
#define PG8_LDA(dst, b, h) do { _Pragma("unroll") for (int m = 0; m < 4; ++m) _Pragma("unroll") for (int k = 0; k < 2; ++k) dst[m][k] = *(const LAS bf16x8*)(lds + PG8_SA(b, h) + aoff + m * 2048 + k * 1024); } while (0)
#define PG8_LDB(dst, b, h) do { _Pragma("unroll") for (int n = 0; n < 2; ++n) _Pragma("unroll") for (int k = 0; k < 2; ++k) dst[n][k] = *(const LAS bf16x8*)(lds + PG8_SB(b, h) + boff + n * 2048 + k * 1024); } while (0)
#define PG8_MMA(ai, bj, At, Bt) do { __builtin_amdgcn_s_setprio(1); _Pragma("unroll") for (int m = 0; m < 4; ++m) _Pragma("unroll") for (int n = 0; n < 2; ++n) _Pragma("unroll") for (int k = 0; k < 2; ++k) \
        acc[ai][bj][m][n] = __builtin_amdgcn_mfma_f32_16x16x32_bf16(Bt[n][k], At[m][k], acc[ai][bj][m][n], 0, 0, 0); __builtin_amdgcn_s_setprio(0); } while (0)
#define PG8_WAIT_V(n) asm volatile("s_waitcnt vmcnt(" #n ")" ::: "memory")
#define PG8_WAIT_L(n) asm volatile("s_waitcnt lgkmcnt(" #n ")" ::: "memory")
#define PG8_BAR __builtin_amdgcn_s_barrier()
#define PG8_SCHED __builtin_amdgcn_sched_barrier(0)
    Unit cur, nxt; int ui = 0;
    if (!S.next(0, cur)) return;
    Acc acc; zero_acc(acc);
    bf16x8 At[4][2], B0[2][2], B1[2][2];
    const char* cA = cur.A; const char* cB = cur.B;
    PG8_STAGE(PG8_SB(0, 0), cB, voffB); PG8_STAGE(PG8_SB(0, 1), cB + hstep, voffB); PG8_STAGE(PG8_SA(0, 0), cA, voffA); PG8_STAGE(PG8_SA(0, 1), cA + hstep, voffA);
    if (wr == 1) PG8_BAR;
    PG8_WAIT_V(2); PG8_BAR;
    PG8_STAGE(PG8_SB(1, 0), cB + kstep, voffB); PG8_STAGE(PG8_SA(1, 0), cA + kstep, voffA); PG8_STAGE(PG8_SB(1, 1), cB + hstep + kstep, voffB);
    PG8_WAIT_V(6); PG8_BAR;
    for (;;) {
        const bool has_next = S.next(ui + 1, nxt);
        const char* nA = has_next ? nxt.A : cA; const char* nB = has_next ? nxt.B : cB;
        for (int t = 0; t < nt; t += 2) {
            const bool last = (t == nt - 2);
            const char* a1 = cA + (size_t)(t + 1) * kstep;
            const char* a2 = last ? nA : cA + (size_t)(t + 2) * kstep; const char* b2 = last ? nB : cB + (size_t)(t + 2) * kstep;
            const char* a3 = a2 + kstep; const char* b3 = b2 + kstep;
            PG8_LDB(B0, 0, 0); PG8_LDB(B1, 0, 1); PG8_SCHED; PG8_LDA(At, 0, 0); PG8_STAGE(PG8_SA(1, 1), a1 + hstep, voffA);
            PG8_WAIT_V(8); PG8_WAIT_L(0); PG8_BAR; PG8_MMA(0, 0, At, B0); PG8_MMA(0, 1, At, B1); PG8_BAR; PG8_SCHED;
            PG8_LDA(At, 0, 1); PG8_STAGE(PG8_SB(0, 0), b2, voffB); PG8_STAGE(PG8_SB(0, 1), b2 + hstep, voffB); PG8_STAGE(PG8_SA(0, 0), a2, voffA);
            PG8_WAIT_V(8); PG8_WAIT_L(0); PG8_BAR; PG8_MMA(1, 0, At, B0); PG8_MMA(1, 1, At, B1); PG8_BAR; PG8_SCHED;
            PG8_LDB(B0, 1, 0); PG8_LDB(B1, 1, 1); PG8_SCHED; PG8_LDA(At, 1, 0); PG8_STAGE(PG8_SA(0, 1), a2 + hstep, voffA);
            PG8_WAIT_V(8); PG8_WAIT_L(0); PG8_BAR; PG8_MMA(0, 0, At, B0); PG8_MMA(0, 1, At, B1); PG8_BAR; PG8_SCHED;
            PG8_LDA(At, 1, 1); PG8_STAGE(PG8_SB(1, 0), b3, voffB); PG8_STAGE(PG8_SB(1, 1), b3 + hstep, voffB); PG8_STAGE(PG8_SA(1, 0), a3, voffA);
            PG8_WAIT_V(8); PG8_WAIT_L(0); PG8_BAR; PG8_MMA(1, 0, At, B0); PG8_MMA(1, 1, At, B1); PG8_BAR; PG8_SCHED;
        }
        if (wr == 0) PG8_BAR;
        E(acc, cur, wr, wc, fr, fq);
        if (!has_next) break;
        cur = nxt; cA = nA; cB = nB; ++ui;
        if (wr == 1) PG8_BAR;
    }
    PG8_WAIT_V(0);
    PG8_BAR;
#undef PG8_SA
#undef PG8_SB
#undef PG8_STAGE
#undef PG8_LDA
#undef PG8_LDB
#undef PG8_MMA
#undef PG8_WAIT_V
#undef PG8_WAIT_L
#undef PG8_BAR
#undef PG8_SCHED
}
}

#define XB_TMO      128
#define XB_XCNT(j)  (256  + 64 * (j))
#define XB_XSUB(j)  (1280 + 64 * (j))
#define XB_XGEN(j)  (2304 + 64 * (j))
#define XB_TOP      3328
#define XB_TOPGEN   3392
#define XCD_BAR_WORDS 3456
#define XB_SPIN_CAP (1u << 22)
__device__ __forceinline__ unsigned xb_ld(unsigned* p)              { return __hip_atomic_load(p, __ATOMIC_RELAXED, __HIP_MEMORY_SCOPE_AGENT); }
__device__ __forceinline__ unsigned xb_add(unsigned* p, unsigned v) { return __hip_atomic_fetch_add(p, v, __ATOMIC_RELAXED, __HIP_MEMORY_SCOPE_AGENT); }
__device__ __forceinline__ unsigned xb_xcc_id() { return (unsigned)__builtin_amdgcn_s_getreg((3 << 11) | 20) & 0xFu; }
#define XB_SPIN(cond, bar) do { unsigned _sp = 0; while (cond) { __builtin_amdgcn_s_sleep(1); \
    if ((++_sp & 255u) == 0u) { if (xb_ld(&(bar)[XB_TMO])) break; if (_sp > XB_SPIN_CAP) { atomicAdd(&(bar)[XB_TMO], 1u); break; } } } } while (0)
struct XcdBarrier { unsigned* bar; unsigned x; volatile LAS unsigned* st; };
__device__ __forceinline__ XcdBarrier xcd_barrier_post(unsigned* bar, volatile LAS unsigned* st) {
    XcdBarrier b; b.bar = bar; b.x = xb_xcc_id(); b.st = st;
    if (threadIdx.x == 0) (void)xb_add(&bar[XB_XCNT(b.x)], 1u);
    return b;
}
__device__ __forceinline__ void xcd_barrier_complete(unsigned* bar, unsigned x, unsigned& nloc, unsigned& nx) {
    const unsigned G = gridDim.x * gridDim.y * gridDim.z;
    unsigned sum, cnt, mine, sp = 0u;
    for (;;) {
        sum = 0u; cnt = 0u; mine = 0u;
#pragma unroll
        for (unsigned j = 0; j < 16; ++j) { const unsigned c = xb_ld(&bar[XB_XCNT(j)]); sum += c; cnt += (c > 0u) ? 1u : 0u; mine = (j == x) ? c : mine; }
        if (sum == G) break;
        __builtin_amdgcn_s_sleep(1);
        if ((++sp & 255u) == 0u) { if (xb_ld(&bar[XB_TMO])) break; if (sp > XB_SPIN_CAP) { atomicAdd(&bar[XB_TMO], 1u); break; } }
    }
    nloc = mine > 0u ? mine : 1u; nx = cnt > 0u ? cnt : 1u;
}
__device__ __forceinline__ void xcd_barrier(const XcdBarrier& b) {
    asm volatile("s_waitcnt vmcnt(0)" ::: "memory");
    __syncthreads();
    if (threadIdx.x == 0) {
        unsigned* bar = b.bar;
        __builtin_amdgcn_s_waitcnt(0);
        unsigned nloc = b.st[0], nx = b.st[1];
        if (nloc == 0u) { xcd_barrier_complete(bar, b.x, nloc, nx); b.st[0] = nloc; b.st[1] = nx; }
        const unsigned old = xb_add(&bar[XB_XSUB(b.x)], 1u);
        const unsigned gen = old / nloc;
        if (old + 1u == (gen + 1u) * nloc) {
            __builtin_amdgcn_fence(__ATOMIC_RELEASE, "agent");
            asm volatile("s_waitcnt vmcnt(0)" ::: "memory");
            const unsigned og = xb_add(&bar[XB_TOP], 1u);
            const unsigned tg = og / nx;
            if (og + 1u == (tg + 1u) * nx) xb_add(&bar[XB_TOPGEN], 1u);
            else XB_SPIN(xb_ld(&bar[XB_TOPGEN]) == tg, bar);
            __builtin_amdgcn_fence(__ATOMIC_ACQUIRE, "agent");
            xb_add(&bar[XB_XGEN(b.x)], 1u);
            asm volatile("s_waitcnt vmcnt(0)" ::: "memory");
        } else {
            XB_SPIN(xb_ld(&bar[XB_XGEN(b.x)]) == gen, bar);
            __builtin_amdgcn_fence(__ATOMIC_ACQUIRE, "agent");
            asm volatile("s_waitcnt vmcnt(0)" ::: "memory");
        }
    }
    __syncthreads();
}

struct Args { const float* in[21]; float* out; unsigned char* ws; int ph_lo, ph_hi; };
struct Frame {
    LAS unsigned char* lds; volatile LAS unsigned* MISC; unsigned* ctl;
    int tid, lane, wave, vcu, G;
    const void __attribute__((address_space(4)))* karg; float* out; unsigned char* ws;
};
__device__ __forceinline__ const float* inp(const Frame& F, int i) { return ((const float* const __attribute__((address_space(4)))*)F.karg)[i]; }
#define IN_X 0
#define IN_C 1
#define IN_CTX 2
#define IN_CCTX 3
#define IN_WMOD 4
#define IN_BMOD 5
#define IN_GATTN 6
#define IN_GFFN 7
#define IN_WIN 8
#define IN_RDEC 9
#define IN_QN 10
#define IN_KN 11
#define IN_LAMBDA 12
#define IN_WFO 13
#define IN_WRO 14
#define IN_WDO 15
#define IN_WOUT 16
#define IN_WROUTER 17
#define IN_WEG 18
#define IN_WEU 19
#define IN_WED 20

__device__ __forceinline__ int vec_of_row(int r) { return r < TC ? 8 : (r - TC) / SEQ; }
__device__ __forceinline__ const float* mod_ptr(const Frame& F, int layer, int v, int i) { return (const float*)(F.ws + WS_MOD) + ((size_t)(layer * 9 + v) * 6 + i) * D; }
__device__ __forceinline__ float lam_init_of(int layer) { return layer == 0 ? 0.2f : 0.8f - 0.6f * 0.74081822068171788f; }
__device__ __forceinline__ float lam_of(const Frame& F, int layer) {
    const float* L = inp(F, IN_LAMBDA) + (size_t)layer * 4 * 64; float s1 = 0.f, s2 = 0.f;
    for (int i = 0; i < 64; ++i) { s1 += L[i] * L[64 + i]; s2 += L[128 + i] * L[192 + i]; }
    return __expf(s1) - __expf(s2) + lam_init_of(layer);
}

__device__ __forceinline__ void transpose_item(const float* W, int ldw, int K, int k0, int n0src, bf16* WT, int dst_row0, LAS float* scr, int lane) {
#pragma unroll 8
    for (int i = 0; i < 32; ++i) { const int kk = 2 * i + (lane >> 5); scr[kk * 33 + (lane & 31)] = W[(size_t)(k0 + kk) * ldw + n0src + (lane & 31)]; }
    LDS_WAIT(); asm volatile("" ::: "memory");
    const int c = lane & 7;
#pragma unroll
    for (int j = 0; j < 4; ++j) { const int n = (lane >> 3) + 8 * j; const LAS float* s = scr + (8 * c) * 33 + n;
        u32x4 o; o.x = pk2(s[0 * 33], s[1 * 33]); o.y = pk2(s[2 * 33], s[3 * 33]); o.z = pk2(s[4 * 33], s[5 * 33]); o.w = pk2(s[6 * 33], s[7 * 33]);
        *(u32x4*)(WT + (size_t)(dst_row0 + n) * K + k0 + 8 * c) = o; }
    LDS_WAIT(); asm volatile("" ::: "memory");
}
template <class RowMap>
__device__ __forceinline__ void transpose_matrix(Frame& F, const float* W, int ldw, int csrc, int K, int N, bf16* WT, RowMap map, int& item_base) {
    LAS float* scr = (LAS float*)(F.lds + F.wave * 16384);
    const int gw = F.vcu * 8 + F.wave, NGW = F.G * 8;
    const int nblk = N / 32, nitems = (K / 64) * nblk;
    int start = (gw - item_base % NGW + NGW) % NGW;
    for (int it = start; it < nitems; it += NGW) { const int kb = it / nblk, nb = it % nblk; transpose_item(W, ldw, K, 64 * kb, csrc + 32 * nb, WT, map(32 * nb), scr, F.lane); }
    item_base += nitems;
}
struct MapId { int off; __device__ int operator()(int n) const { return off + n; } };
struct MapGU { int up; __device__ int operator()(int n) const { return (n >> 7) * 256 + up * 128 + (n & 127); } };

__device__ __forceinline__ void convert_expert_weights(Frame& F, int layer) {
    int base = 0;
    for (int e = 0; e < NE; ++e) {
        const float* wg = inp(F, IN_WEG) + ((size_t)layer * NE + e) * D * EH; const float* wu = inp(F, IN_WEU) + ((size_t)layer * NE + e) * D * EH; const float* wd = inp(F, IN_WED) + ((size_t)layer * NE + e) * EH * D;
        bf16* gu = (bf16*)(F.ws + WS_WGU + e * WGU_E); bf16* dn = (bf16*)(F.ws + WS_WD + e * WD_E);
        transpose_matrix(F, wg, EH, 0, D, EH, gu, MapGU{0}, base);
        transpose_matrix(F, wu, EH, 0, D, EH, gu, MapGU{1}, base);
        transpose_matrix(F, wd, D, 0, EH, D, dn, MapId{0}, base);
    }
}

__device__ __forceinline__ void phase_prologue(Frame& F) {
    const int tid = F.tid;
    {
        LAS float* sc = (LAS float*)F.lds;
        LAS float* red = sc + 9 * 1024;
        for (int i = tid; i < 9 * 1024; i += 512) { const int v = i >> 10, k = i & 1023; const float c = v < 8 ? inp(F, IN_C)[v * D + k] : inp(F, IN_CCTX)[k]; sc[i] = siluf_(c); }
        __syncthreads();
        for (int item = F.vcu; item < DEPTH * 96; item += F.G) {
            const int layer = item / 96, cb = item % 96, col = cb * 64 + (tid & 63), kg = tid >> 6;
            const float* w = inp(F, IN_WMOD) + (size_t)layer * D * 6144 + col;
            float a[9];
#pragma unroll
            for (int v = 0; v < 9; ++v) a[v] = 0.f;
#pragma unroll 4
            for (int kk = 0; kk < 128; ++kk) { const int k = kg * 128 + kk; const float wv = w[(size_t)k * 6144];
#pragma unroll
                for (int v = 0; v < 9; ++v) a[v] += sc[v * 1024 + k] * wv; }
#pragma unroll
            for (int v = 0; v < 9; ++v) red[(kg * 64 + (tid & 63)) * 9 + v] = a[v];
            __syncthreads();
            for (int o = tid; o < 64 * 9; o += 512) { const int cc = o / 9, v = o % 9; float s = 0.f;
                for (int g = 0; g < 8; ++g) s += red[(g * 64 + cc) * 9 + v];
                const int colo = cb * 64 + cc;
                ((float*)(F.ws + WS_MOD))[(size_t)(layer * 9 + v) * 6144 + colo] = s + inp(F, IN_BMOD)[layer * 6144 + colo]; }
            __syncthreads();
        }
    }
    {
        const int gt = F.vcu * 512 + tid, NT = F.G * 512;
        float* rc = (float*)(F.ws + WS_ROPE); float* rs = rc + SEQ * 32;
        for (int i = gt; i < SEQ * 32; i += NT) { const int pos = i >> 5, f = i & 31; const float inv = powf(10000.0f, -(float)(f & 15) / 16.0f);
            const float p = (f < 16) ? (float)(pos / GRIDW) : (float)(pos % GRIDW); const float ang = p * inv; rc[i] = cosf(ang); rs[i] = sinf(ang); }
        LAS float* ct = (LAS float*)F.lds;
        __syncthreads();
        for (int m = tid; m < 2048; m += 512) ct[m] = (float)cos(6.283185307179586476925 * (double)m / 2048.0);
        __syncthreads();
        bf16* dl = (bf16*)(F.ws + WS_DFTL); const float sl = 0.022097086912079608f;
        for (int i = gt; i < 2048 * 2048; i += NT) {
            const int k = i >> 11, n = i & 2047, m = (k * n) & 2047; const float c = ct[m], s = ct[(m - 512) & 2047];
            dl[(size_t)k * 4096 + n] = (bf16)f2bf(c * sl); dl[(size_t)k * 4096 + 2048 + n] = (bf16)f2bf(-s * sl); }
        bf16* dc = (bf16*)(F.ws + WS_DFTC);
        for (int i = gt; i < 256 * 256; i += NT) { const int k = i >> 8, n = i & 255, m = ((k * n) & 255) * 8; const float c = ct[m], s = ct[(m - 512) & 2047];
            dc[(size_t)k * 512 + n] = (bf16)f2bf(c * 0.0625f); dc[(size_t)k * 512 + 256 + n] = (bf16)f2bf(-s * 0.0625f); }
        for (int layer = 0; layer < DEPTH; ++layer) {
            const float* win = inp(F, IN_WIN) + (size_t)layer * D * INW; bf16* wt = (bf16*)(F.ws + WS_WIN + layer * WIN_L) + (size_t)6144 * 1024;
            for (int i = gt; i < 1024 * 1024; i += NT) { const int k = i & 1023, no = i >> 10, part = no >> 9, g = (no >> 6) & 7, cp = no & 63;
                const float* src = win + (size_t)k * INW + g * 64; float s = 0.f;
                for (int c = 0; c < 64; ++c) { const int m = ((c * cp) & 63) * 32; const float t = part == 0 ? ct[m] : ct[(m - 512) & 2047]; s += src[c] * t; }
                wt[(size_t)no * 1024 + k] = (bf16)f2bf(s * 0.125f); }
        }
        __syncthreads();
    }
    {
        int base = 0;
        for (int layer = 0; layer < DEPTH; ++layer) {
            transpose_matrix(F, inp(F, IN_WIN) + (size_t)layer * D * INW, INW, 512, D, NPROJ, (bf16*)(F.ws + WS_WIN + layer * WIN_L), MapId{0}, base);
            transpose_matrix(F, inp(F, IN_WFO) + (size_t)layer * 512 * D, D, 0, 512, D, (bf16*)(F.ws + WS_WFO + (layer * 3 + 0) * WMG_ONE), MapId{0}, base);
            transpose_matrix(F, inp(F, IN_WRO) + (size_t)layer * 512 * D, D, 0, 512, D, (bf16*)(F.ws + WS_WFO + (layer * 3 + 1) * WMG_ONE), MapId{0}, base);
            transpose_matrix(F, inp(F, IN_WDO) + (size_t)layer * 512 * D, D, 0, 512, D, (bf16*)(F.ws + WS_WFO + (layer * 3 + 2) * WMG_ONE), MapId{0}, base);
            transpose_matrix(F, inp(F, IN_WOUT) + (size_t)layer * D * D, D, 0, D, D, (bf16*)(F.ws + WS_WOUT + layer * WOUT_L), MapId{0}, base);
        }
    }
    convert_expert_weights(F, 0);
}

__device__ __forceinline__ void phase_norm(Frame& F, int layer) {
    const int gw = F.vcu * 8 + F.wave, NGW = F.G * 8, lane = F.lane;
    const bool fin = layer == DEPTH; const int r_lo = (layer >= DEPTH - 1) ? (fin ? TC : 0) : 0;
    float* XR = (float*)(F.ws + WS_XR); const int* INV = (const int*)(F.ws + WS_INV); const bf16* YE = (const bf16*)(F.ws + WS_YE); bf16* HB = (bf16*)(F.ws + WS_HB);
    for (int r = r_lo + gw; r < TA; r += NGW) {
        const int v = vec_of_row(r);
        f32x4 x[4];
        if (layer == 0) { const float* src = r < TC ? inp(F, IN_CTX) + (size_t)r * D : inp(F, IN_X) + (size_t)(r - TC) * D;
#pragma unroll
            for (int j = 0; j < 4; ++j) x[j] = *(const f32x4*)(src + 4 * lane + 256 * j);
        } else {
            const float* src = XR + (size_t)r * D;
#pragma unroll
            for (int j = 0; j < 4; ++j) x[j] = *(const f32x4*)(src + 4 * lane + 256 * j);
            if (!(layer == DEPTH - 1 + 1 && false)) {
                const bool has_moe = !(layer == 1 && r < TC && false);
                if (has_moe) {
                    f32x4 s[4];
#pragma unroll
                    for (int j = 0; j < 4; ++j) s[j] = (f32x4){0.f, 0.f, 0.f, 0.f};
                    const int* inv = INV + (size_t)r * 16;
                    for (int e = 0; e < NE; ++e) { const int slot = __builtin_amdgcn_readfirstlane(inv[e]);
                        if (slot >= 0) { const bf16* y = YE + (size_t)slot * D;
#pragma unroll
                            for (int j = 0; j < 4; ++j) { const u32x2 w = *(const u32x2*)(y + 4 * lane + 256 * j); s[j] += (f32x4){bflo(w.x), bfhi(w.x), bflo(w.y), bfhi(w.y)}; } } }
                    const float* m5 = mod_ptr(F, layer - 1, v, 5);
#pragma unroll
                    for (int j = 0; j < 4; ++j) x[j] += *(const f32x4*)(m5 + 4 * lane + 256 * j) * s[j];
                }
            }
        }
        if (fin) {
#pragma unroll
            for (int j = 0; j < 4; ++j) *(f32x4*)(F.out + (size_t)(r - TC) * D + 4 * lane + 256 * j) = x[j];
            continue;
        }
        if (layer > 0) {
#pragma unroll
            for (int j = 0; j < 4; ++j) *(f32x4*)(XR + (size_t)r * D + 4 * lane + 256 * j) = x[j];
        }
        float ss = 0.f;
#pragma unroll
        for (int j = 0; j < 4; ++j) ss += (x[j].x * x[j].x + x[j].y * x[j].y) + (x[j].z * x[j].z + x[j].w * x[j].w);
        const float rinv = 1.0f / sqrtf(wave_sum(ss) * (1.0f / D) + EPS);
        const float* g = inp(F, IN_GATTN) + (size_t)layer * D; const float* sh = mod_ptr(F, layer, v, 0); const float* scl = mod_ptr(F, layer, v, 1);
#pragma unroll
        for (int j = 0; j < 4; ++j) { const int k = 4 * lane + 256 * j; const f32x4 gv = *(const f32x4*)(g + k), sv = *(const f32x4*)(sh + k), cv = *(const f32x4*)(scl + k);
            const f32x4 y = (x[j] * rinv * gv) * (cv + 1.0f) + sv;
            u32x2 w; w.x = pk2(y.x, y.y); w.y = pk2(y.z, y.w); *(u32x2*)(HB + (size_t)r * D + k) = w; }
    }
}

using pg8::Unit; using pg8::Acc;
struct SchedGrid {
    int nM, nN, G, c; const char* A; const char* B; size_t a_tile, b_tile; int pm_per_group; size_t b_group;
    __device__ __forceinline__ bool next(int i, Unit& u) const {
        int pm, pn; if (c < 0 || !pg8::grid_order((long)i * G + c, nM, nN, pm, pn)) return false;
        u.pm = pm; u.pn = pn; u.tag = 0; u.A = A + (size_t)pm * a_tile; u.B = B + (size_t)pn * b_tile + (pm_per_group ? (size_t)(pm / pm_per_group) * b_group : 0); return true; }
};
struct SchedMerge {
    int nM, nN, G, c; const char* A; const char* B; size_t a_seg, b_seg, a_tile, b_tile;
    __device__ __forceinline__ bool next(int i, Unit& u) const {
        const int t = i / 3, seg = i - 3 * t; int pm, pn; if (!pg8::grid_order((long)t * G + c, nM, nN, pm, pn)) return false;
        u.pm = pm; u.pn = pn; u.tag = seg; u.A = A + (size_t)seg * a_seg + (size_t)pm * a_tile; u.B = B + (size_t)seg * b_seg + (size_t)pn * b_tile; return true; }
};

struct EpiBf16 {
    static constexpr bool PERM = true;
    bf16* C; int ldc;
    __device__ __forceinline__ void operator()(Acc& acc, const Unit& u, int wr, int wc, int fr, int fq) const {
        const int row0 = u.pm * 256 + wr * 64 + fr, col0 = u.pn * 256 + wc * 32 + 8 * fq;
#pragma unroll
        for (int ai = 0; ai < 2; ++ai)
#pragma unroll
            for (int m = 0; m < 4; ++m) { bf16* rowp = C + (size_t)(row0 + ai * 128 + m * 16) * ldc + col0;
#pragma unroll
                for (int bj = 0; bj < 2; ++bj) { const f32x4 v0 = acc[ai][bj][m][0], v1 = acc[ai][bj][m][1];
                    u32x4 w; w.x = pk2(v0[0], v0[1]); w.y = pk2(v0[2], v0[3]); w.z = pk2(v1[0], v1[1]); w.w = pk2(v1[2], v1[3]);
                    *(u32x4*)(rowp + bj * 128) = w; } }
        pg8::zero_acc(acc);
    }
};
struct EpiGT {
    static constexpr bool PERM = true;
    bf16* GT; bf16* GTC;
    __device__ __forceinline__ void operator()(Acc& acc, const Unit& u, int wr, int wc, int fr, int fq) const {
        const int tok0 = u.pn * 256;
        bf16* base; int pitch, nseq, n0;
        if (tok0 < TC) { const int b = tok0 / CTX; base = GTC + (size_t)b * 512 * 512; pitch = 512; nseq = CTX; n0 = tok0 - b * CTX; }
        else { const int t = tok0 - TC, b = t / SEQ; base = GT + (size_t)b * 512 * 4096; pitch = 4096; nseq = SEQ; n0 = t - b * SEQ; }
        const int crow0 = u.pm * 256 + wr * 64 + fr, ccol0 = wc * 32 + 8 * fq;
#pragma unroll
        for (int ai = 0; ai < 2; ++ai)
#pragma unroll
            for (int m = 0; m < 4; ++m) { const int c = crow0 + ai * 128 + m * 16, part = c >> 9, ch = c & 511;
                bf16* rowp = base + (size_t)ch * pitch + part * nseq + n0 + ccol0;
#pragma unroll
                for (int bj = 0; bj < 2; ++bj) { const f32x4 v0 = acc[ai][bj][m][0], v1 = acc[ai][bj][m][1];
                    u32x4 w; w.x = pk2(v0[0], v0[1]); w.y = pk2(v0[2], v0[3]); w.z = pk2(v1[0], v1[1]); w.w = pk2(v1[2], v1[3]);
                    *(u32x4*)(rowp + bj * 128) = w; } }
        pg8::zero_acc(acc);
    }
};
struct EpiDFT {
    static constexpr bool PERM = true;
    bf16* FO; int nseq; int row_base0;
    __device__ __forceinline__ void operator()(Acc& acc, const Unit& u, int wr, int wc, int fr, int fq) const {
        const int k0 = u.pm * 256 + wr * 64 + fr, b = (u.pn * 256) >> 9, ch0 = ((u.pn * 256) & 511) + wc * 32 + 8 * fq;
        bf16* base = FO + (size_t)(row_base0 + b * nseq + k0) * 512 + ch0;
#pragma unroll
        for (int ai = 0; ai < 2; ++ai)
#pragma unroll
            for (int m = 0; m < 4; ++m) { bf16* rowp = base + (size_t)(ai * 128 + m * 16) * 512;
#pragma unroll
                for (int bj = 0; bj < 2; ++bj) { const f32x4 v0 = acc[ai][bj][m][0], v1 = acc[ai][bj][m][1];
                    u32x4 w; w.x = pk2(v0[0], v0[1]); w.y = pk2(v0[2], v0[3]); w.z = pk2(v1[0], v1[1]); w.w = pk2(v1[2], v1[3]);
                    *(u32x4*)(rowp + bj * 128) = w; } }
        pg8::zero_acc(acc);
    }
};
struct EpiMerge {
    static constexpr bool PERM = true;
    const bf16* PROJ; bf16* MIXB; int row_off;
    __device__ __forceinline__ void operator()(Acc& acc, const Unit& u, int wr, int wc, int fr, int fq) const {
        const int row0 = row_off + u.pm * 256 + wr * 64 + fr, col0 = u.pn * 256 + wc * 32 + 8 * fq, seg = u.tag;
#pragma unroll
        for (int ai = 0; ai < 2; ++ai)
#pragma unroll
            for (int m = 0; m < 4; ++m) { const size_t row = (size_t)(row0 + ai * 128 + m * 16);
#pragma unroll
                for (int bj = 0; bj < 2; ++bj) { const int col = col0 + bj * 128;
                    const u32x4 ga = *(const u32x4*)(PROJ + row * NPROJ + C_GATE + seg * 1024 + col);
                    float f[8];
                    if (seg < 2) { const u32x4 gb = *(const u32x4*)(PROJ + row * NPROJ + C_GATE + (seg + 1) * 1024 + col);
#pragma unroll
                        for (int q = 0; q < 4; ++q) { const float a0 = bflo(ga[q]), a1 = bfhi(ga[q]), b0 = bflo(gb[q]), b1 = bfhi(gb[q]);
                            f[2 * q] = (1.0f + __builtin_amdgcn_exp2f(-b0 * LOG2E)) * __builtin_amdgcn_rcpf(1.0f + __builtin_amdgcn_exp2f(-a0 * LOG2E));
                            f[2 * q + 1] = (1.0f + __builtin_amdgcn_exp2f(-b1 * LOG2E)) * __builtin_amdgcn_rcpf(1.0f + __builtin_amdgcn_exp2f(-a1 * LOG2E)); }
                    } else {
#pragma unroll
                        for (int q = 0; q < 4; ++q) { f[2 * q] = sigmoidf_(bflo(ga[q])); f[2 * q + 1] = sigmoidf_(bfhi(ga[q])); }
                    }
                    f32x4 v0 = acc[ai][bj][m][0], v1 = acc[ai][bj][m][1];
                    v0 = v0 * (f32x4){f[0], f[1], f[2], f[3]}; v1 = v1 * (f32x4){f[4], f[5], f[6], f[7]};
                    if (seg < 2) { acc[ai][bj][m][0] = v0; acc[ai][bj][m][1] = v1; }
                    else { u32x4 w; w.x = pk2(v0[0], v0[1]); w.y = pk2(v0[2], v0[3]); w.z = pk2(v1[0], v1[1]); w.w = pk2(v1[2], v1[3]);
                        *(u32x4*)(MIXB + row * D + col) = w; acc[ai][bj][m][0] = (f32x4){0.f, 0.f, 0.f, 0.f}; acc[ai][bj][m][1] = (f32x4){0.f, 0.f, 0.f, 0.f}; } }
                asm volatile("" ::: "memory"); }
    }
};
struct EpiOut {
    static constexpr bool PERM = false;
    const float* base_ctx; const float* base_lat; float* XR; const float* mod2; int row_off;
    __device__ __forceinline__ void operator()(Acc& acc, const Unit& u, int wr, int wc, int fr, int fq) const {
        const int row0 = row_off + u.pm * 256 + wr * 64 + fr, col0 = u.pn * 256 + wc * 32 + 4 * fq;
        const int v = vec_of_row(row_off + u.pm * 256);
        f32x4 mv[2][2];
#pragma unroll
        for (int bj = 0; bj < 2; ++bj)
#pragma unroll
            for (int n = 0; n < 2; ++n) mv[bj][n] = *(const f32x4*)(mod2 + (size_t)v * 6144 + col0 + bj * 128 + n * 16);
#pragma unroll
        for (int ai = 0; ai < 2; ++ai)
#pragma unroll
            for (int m = 0; m < 4; ++m) { const int row = row0 + ai * 128 + m * 16;
                const float* bp = row < TC ? base_ctx + (size_t)row * D : base_lat + (size_t)(row - TC) * D; float* op = XR + (size_t)row * D;
#pragma unroll
                for (int bj = 0; bj < 2; ++bj)
#pragma unroll
                    for (int n = 0; n < 2; ++n) { const int c = col0 + bj * 128 + n * 16; *(f32x4*)(op + c) = *(const f32x4*)(bp + c) + mv[bj][n] * acc[ai][bj][m][n]; } }
        pg8::zero_acc(acc);
    }
};
struct EpiGU {
    static constexpr bool PERM = true;
    bf16* HID;
    __device__ __forceinline__ void operator()(Acc& acc, const Unit& u, int wr, int wc, int fr, int fq) const {
        const int row0 = u.pm * 256 + wr * 64 + fr, col0 = u.pn * 128 + wc * 32 + 8 * fq;
#pragma unroll
        for (int ai = 0; ai < 2; ++ai)
#pragma unroll
            for (int m = 0; m < 4; ++m) { float h[8];
#pragma unroll
                for (int n = 0; n < 2; ++n)
#pragma unroll
                    for (int j = 0; j < 4; ++j) { const float g = acc[ai][0][m][n][j], up = acc[ai][1][m][n][j]; h[4 * n + j] = siluf_(g) * up; }
                u32x4 w; w.x = pk2(h[0], h[1]); w.y = pk2(h[2], h[3]); w.z = pk2(h[4], h[5]); w.w = pk2(h[6], h[7]);
                *(u32x4*)(HID + (size_t)(row0 + ai * 128 + m * 16) * EH + col0) = w; }
        pg8::zero_acc(acc);
    }
};
struct EpiDown {
    static constexpr bool PERM = true;
    bf16* YE; const float* topw;
    __device__ __forceinline__ void operator()(Acc& acc, const Unit& u, int wr, int wc, int fr, int fq) const {
        const int row0 = u.pm * 256 + wr * 64 + fr, col0 = u.pn * 256 + wc * 32 + 8 * fq;
#pragma unroll
        for (int ai = 0; ai < 2; ++ai)
#pragma unroll
            for (int m = 0; m < 4; ++m) { const int row = row0 + ai * 128 + m * 16; const float tw = topw[row];
#pragma unroll
                for (int bj = 0; bj < 2; ++bj) { const f32x4 v0 = acc[ai][bj][m][0] * tw, v1 = acc[ai][bj][m][1] * tw;
                    u32x4 w; w.x = pk2(v0[0], v0[1]); w.y = pk2(v0[2], v0[3]); w.z = pk2(v1[0], v1[1]); w.w = pk2(v1[2], v1[3]);
                    *(u32x4*)(YE + (size_t)row * D + col0 + bj * 128) = w; } }
        pg8::zero_acc(acc);
    }
};

__device__ __forceinline__ void phase_inproj(Frame& F, int layer) {
    const char* HB = (const char*)(F.ws + WS_HB); const char* WT = (const char*)(F.ws + WS_WIN + layer * WIN_L);
    {
        SchedGrid S{TA / 256, NPROJ / 256, F.G, (int)blockIdx.x, HB, WT, (size_t)256 * D * 2, (size_t)256 * D * 2, 0, 0};
        EpiBf16 E{(bf16*)(F.ws + WS_PROJ), NPROJ};
        pg8::gemm_phase(F.lds, F.tid, D, S, E);
    }
    {
        SchedGrid S{4, TA / 256, F.G, (int)blockIdx.x, WT + (size_t)6144 * D * 2, HB, (size_t)256 * D * 2, (size_t)256 * D * 2, 0, 0};
        EpiGT E{(bf16*)(F.ws + WS_GT), (bf16*)(F.ws + WS_GTC)};
        pg8::gemm_phase(F.lds, F.tid, D, S, E);
    }
}

__device__ __forceinline__ void phase_rope(Frame& F, int layer) {
    const int gw = F.vcu * 8 + F.wave, NGW = F.G * 8, lane = F.lane, s = lane & 15, vq = lane >> 4;
    bf16* PROJ = (bf16*)(F.ws + WS_PROJ); const float* rc = (const float*)(F.ws + WS_ROPE); const float* rs = rc + SEQ * 32;
    const float qg0 = inp(F, IN_QN)[layer * 64 + 2 * s], qg1 = inp(F, IN_QN)[layer * 64 + 2 * s + 1], qg2 = inp(F, IN_QN)[layer * 64 + 32 + 2 * s], qg3 = inp(F, IN_QN)[layer * 64 + 33 + 2 * s];
    const float kg0 = inp(F, IN_KN)[layer * 64 + 2 * s], kg1 = inp(F, IN_KN)[layer * 64 + 2 * s + 1], kg2 = inp(F, IN_KN)[layer * 64 + 32 + 2 * s], kg3 = inp(F, IN_KN)[layer * 64 + 33 + 2 * s];
    for (int r = gw; r < TA; r += NGW) {
        const bool lat = r >= TC; const int pos = lat ? (r - TC) % SEQ : 0;
        float c0 = 1.f, c1 = 1.f, s0 = 0.f, s1 = 0.f;
        if (lat) { c0 = rc[pos * 32 + 2 * s]; c1 = rc[pos * 32 + 2 * s + 1]; s0 = rs[pos * 32 + 2 * s]; s1 = rs[pos * 32 + 2 * s + 1]; }
#pragma unroll
        for (int pass = 0; pass < 6; ++pass) {
            const int vi = pass * 4 + vq;
            const int col = vi < 4 ? C_RQ + vi * 64 : vi < 8 ? C_RK + (vi - 4) * 64 : vi < 16 ? C_DQ + (vi - 8) * 64 : C_DK + (vi - 16) * 64;
            bf16* p = PROJ + (size_t)r * NPROJ + col;
            const unsigned wa = *(const unsigned*)(p + 2 * s), wb = *(const unsigned*)(p + 32 + 2 * s);
            float a0 = bflo(wa), a1 = bfhi(wa), b0 = bflo(wb), b1 = bfhi(wb);
            if (vi >= 8) {
                float ss = a0 * a0 + a1 * a1 + b0 * b0 + b1 * b1;
                ss += __shfl_xor(ss, 1); ss += __shfl_xor(ss, 2); ss += __shfl_xor(ss, 4); ss += __shfl_xor(ss, 8);
                const float rinv = 1.0f / sqrtf(ss * (1.0f / 64.0f) + EPS);
                if (vi < 16) { a0 *= rinv * qg0; a1 *= rinv * qg1; b0 *= rinv * qg2; b1 *= rinv * qg3; }
                else { a0 *= rinv * kg0; a1 *= rinv * kg1; b0 *= rinv * kg2; b1 *= rinv * kg3; }
            } else if (vi < 4) { a0 *= 0.125f; a1 *= 0.125f; b0 *= 0.125f; b1 *= 0.125f; }
            float o0 = a0 * c0 - b0 * s0, o1 = a1 * c1 - b1 * s1, o2 = b0 * c0 + a0 * s0, o3 = b1 * c1 + a1 * s1;
            if (vi >= 8 && vi < 16) { const float k = 0.125f * LOG2E; o0 *= k; o1 *= k; o2 *= k; o3 *= k; }
            *(unsigned*)(p + 2 * s) = pk2(o0, o1); *(unsigned*)(p + 32 + 2 * s) = pk2(o2, o3);
        }
    }
}

namespace att {
constexpr int KPITCH = 144, VPITCH = 320, KC_BYTES = 64 * KPITCH, V_BYTES = 64 * VPITCH, BUF_BYTES = 2 * KC_BYTES + V_BYTES;
constexpr int SCR_OFF = 2 * BUF_BYTES;
constexpr int QW_OFF = SCR_OFF + 8 * 256;
__device__ __forceinline__ int crow(int r, int hi) { return (r & 3) + 8 * (r >> 2) + 4 * hi; }
__device__ __forceinline__ s16x4 vtr(const LAS unsigned char* p) { typedef short v4i16_t __attribute__((ext_vector_type(4))); return __builtin_bit_cast(s16x4, __builtin_amdgcn_ds_read_tr16_b64_v4i16((LAS v4i16_t*)p)); }

struct UnitDesc {
    int mode;
    int qrow0;
    int qpos0;
    int h;
    int krowA, ntA;
    int krowB, ntB;
    int kindB;
    int nseq;
    int outrow0;
    float lgf, lgb;
    float lam, scale_out;
};

__device__ __forceinline__ void unit(const Frame& F, const UnitDesc& u) {
    LAS unsigned char* lds = F.lds;
    const int tid = F.tid, lane = F.lane, wid = F.wave, r32 = lane & 31, hi = lane >> 5;
    const bf16* PROJ = (const bf16*)(F.ws + WS_PROJ);
    const bool diff = u.mode == 0;
    const int comp = diff ? (wid >> 2) : 0;
    const int qoff = diff ? 32 * (wid & 3) : 32 * wid;
    const int kcol = diff ? C_DK + u.h * 128 : C_RK + u.h * 64, vcol = diff ? C_DV + u.h * 128 : C_RV + u.h * 128;
    const int qcol = diff ? C_DQ + u.h * 128 + comp * 64 : C_RQ + u.h * 64;
    const int NT = u.ntA + u.ntB;
    bf16x8 qf[4];
    { const bf16* qp = PROJ + (size_t)(u.qrow0 + qoff + r32) * NPROJ + qcol + 8 * hi;
#pragma unroll
      for (int s = 0; s < 4; ++s) qf[s] = *(const bf16x8*)(qp + 16 * s); }
    f32x16 o[4];
#pragma unroll
    for (int d = 0; d < 4; ++d) o[d] = (f32x16){};
    float lsum = 0.f;
    u32x4 kreg[2], vreg[2];
    auto tile_row = [&](int t) { return t < u.ntA ? u.krowA + 64 * t : u.krowB + 64 * (t - u.ntA); };
    auto load_tile = [&](int t) {
        const int row0 = tile_row(t);
#pragma unroll
        for (int i = 0; i < 2; ++i) { const int cid = tid + 512 * i, key = cid >> 4, c16 = cid & 15;
            vreg[i] = *(const u32x4*)(PROJ + (size_t)(row0 + key) * NPROJ + vcol + c16 * 8);
            if (diff) kreg[i] = *(const u32x4*)(PROJ + (size_t)(row0 + key) * NPROJ + kcol + c16 * 8); }
        if (!diff) { const int key = tid >> 3, c8 = tid & 7; kreg[0] = *(const u32x4*)(PROJ + (size_t)(row0 + key) * NPROJ + kcol + c8 * 8); }
    };
    auto store_tile = [&](int buf) {
        LAS unsigned char* b = lds + buf * BUF_BYTES;
#pragma unroll
        for (int i = 0; i < 2; ++i) { const int cid = tid + 512 * i, key = cid >> 4, c16 = cid & 15;
            *(LAS u32x4*)(b + 2 * KC_BYTES + key * VPITCH + c16 * 16) = vreg[i];
            if (diff) *(LAS u32x4*)(b + (c16 >> 3) * KC_BYTES + key * KPITCH + (c16 & 7) * 16) = kreg[i]; }
        if (!diff) { const int key = tid >> 3, c8 = tid & 7; *(LAS u32x4*)(b + key * KPITCH + c8 * 16) = kreg[0]; }
    };
    load_tile(0); store_tile(0);
    __syncthreads();
    const int qpos = u.qpos0 + qoff + r32;
    for (int t = 0; t < NT; ++t) {
        if (t + 1 < NT) load_tile(t + 1);
        const LAS unsigned char* b = lds + (t & 1) * BUF_BYTES;
        const LAS unsigned char* kb = b + comp * KC_BYTES + r32 * KPITCH + hi * 16;
        u32x4 pw[4];
        const bool segB = t >= u.ntA; const int j0 = 64 * (segB ? t - u.ntA : t);
#pragma unroll
        for (int kh = 0; kh < 2; ++kh) {
            f32x16 sc = (f32x16){};
#pragma unroll
            for (int s = 0; s < 4; ++s) { const bf16x8 kf = *(const LAS bf16x8*)(kb + kh * 32 * KPITCH + s * 32); sc = __builtin_amdgcn_mfma_f32_32x32x16_bf16(kf, qf[s], sc, 0, 0, 0); }
            if (diff) {
#pragma unroll
                for (int r = 0; r < 16; ++r) sc[r] = __builtin_amdgcn_exp2f(sc[r]);
                float a = 0.f;
#pragma unroll
                for (int r = 0; r < 16; ++r) a += sc[r];
                lsum += a;
            } else if (!segB || u.kindB == 0) {
#pragma unroll
                for (int r = 0; r < 16; ++r) { const int d = qpos - (j0 + 32 * kh + crow(r, hi)); sc[r] *= __builtin_amdgcn_exp2f((float)d * (d >= 0 ? u.lgf : -u.lgb)); }
            } else {
#pragma unroll
                for (int r = 0; r < 16; ++r) { const int na = j0 + 32 * kh + crow(r, hi);
                    sc[r] *= __builtin_amdgcn_exp2f((float)(qpos + CTX - na) * u.lgf) + __builtin_amdgcn_exp2f((float)(u.nseq - qpos + na) * u.lgb); }
            }
            pw[2 * kh] = (u32x4){pk2(sc[0], sc[1]), pk2(sc[2], sc[3]), pk2(sc[4], sc[5]), pk2(sc[6], sc[7])};
            pw[2 * kh + 1] = (u32x4){pk2(sc[8], sc[9]), pk2(sc[10], sc[11]), pk2(sc[12], sc[13]), pk2(sc[14], sc[15])};
            __builtin_amdgcn_sched_barrier(0);
        }
        const LAS unsigned char* vb = b + 2 * KC_BYTES + (4 * hi + ((lane & 15) >> 2)) * VPITCH + ((lane >> 4) & 1) * 32 + (lane & 3) * 8;
        __builtin_amdgcn_sched_barrier(0);
#pragma unroll
        for (int dvb = 0; dvb < 4; ++dvb) {
#pragma unroll
            for (int ks = 0; ks < 4; ++ks) {
                const s16x4 lo = vtr(vb + ks * 16 * VPITCH + dvb * 64), hi4 = vtr(vb + ks * 16 * VPITCH + 8 * VPITCH + dvb * 64);
                const bf16x8 vf = (bf16x8){lo[0], lo[1], lo[2], lo[3], hi4[0], hi4[1], hi4[2], hi4[3]};
                o[dvb] = __builtin_amdgcn_mfma_f32_32x32x16_bf16(__builtin_bit_cast(bf16x8, pw[ks]), vf, o[dvb], 0, 0, 0);
            }
            __builtin_amdgcn_sched_barrier(0);
        }
        if (t + 1 < NT) store_tile((t + 1) & 1);
        __syncthreads();
    }
    LAS float* wsf = (LAS float*)(lds + SCR_OFF) + wid * 64;
    int lz = lane; asm volatile("" : "+v"(lz));
    const int r32e = lz & 31, hie = lz >> 5;
    if (diff) {
        lsum += __shfl_xor(lsum, 32);
        if (hie == 0) wsf[r32e] = 1.0f / lsum;
        LDS_WAIT();
        float rl[16];
#pragma unroll
        for (int r = 0; r < 16; ++r) rl[r] = wsf[crow(r, hie)];
        LAS float* XC = (LAS float*)lds;
        if (comp == 1) {
#pragma unroll
            for (int r = 0; r < 16; ++r) { const int q = qoff + crow(r, hie);
#pragma unroll
                for (int d = 0; d < 4; ++d) XC[q * 128 + 32 * d + r32e] = o[d][r] * rl[r] * u.lam; }
        }
        __syncthreads();
        if (comp == 0) {
            float ss[16];
#pragma unroll
            for (int r = 0; r < 16; ++r) { const int q = qoff + crow(r, hie); float a = 0.f;
#pragma unroll
                for (int d = 0; d < 4; ++d) { const float v = o[d][r] * rl[r] - XC[q * 128 + 32 * d + r32e]; o[d][r] = v; a += v * v; }
                ss[r] = a; }
#pragma unroll
            for (int r = 0; r < 16; ++r) { float a = ss[r]; a += __shfl_xor(a, 1); a += __shfl_xor(a, 2); a += __shfl_xor(a, 4); a += __shfl_xor(a, 8); a += __shfl_xor(a, 16);
                ss[r] = u.scale_out / sqrtf(a * (1.0f / 128.0f) + EPS); }
            bf16* DO = (bf16*)(F.ws + WS_FO + 2 * MIX_ONE);
#pragma unroll
            for (int r = 0; r < 16; ++r) { bf16* op = DO + (size_t)(u.outrow0 + qoff + crow(r, hie)) * 512 + u.h * 128 + r32e;
#pragma unroll
                for (int d = 0; d < 4; ++d) op[32 * d] = (bf16)f2bf(o[d][r] * ss[r]); }
        }
    } else {
        bf16* RO = (bf16*)(F.ws + WS_FO + 1 * MIX_ONE);
#pragma unroll
        for (int r = 0; r < 16; ++r) {
            float a = (o[0][r] + o[1][r]) + (o[2][r] + o[3][r]);
            a += __shfl_xor(a, 1); a += __shfl_xor(a, 2); a += __shfl_xor(a, 4); a += __shfl_xor(a, 8); a += __shfl_xor(a, 16);
            const float mu = a * (1.0f / 128.0f); float q = 0.f;
#pragma unroll
            for (int d = 0; d < 4; ++d) { const float v = o[d][r] - mu; o[d][r] = v; q += v * v; }
            q += __shfl_xor(q, 1); q += __shfl_xor(q, 2); q += __shfl_xor(q, 4); q += __shfl_xor(q, 8); q += __shfl_xor(q, 16);
            const float rstd = 1.0f / sqrtf(q * (1.0f / 128.0f) + EPS);
            const size_t row = (size_t)(u.outrow0 + qoff + crow(r, hie));
            const bf16* gp = PROJ + row * NPROJ + C_RG + u.h * 128 + r32e; bf16* op = RO + row * 512 + u.h * 128 + r32e;
#pragma unroll
            for (int d = 0; d < 4; ++d) { const float g = bf2f(gp[32 * d]); op[32 * d] = (bf16)f2bf(o[d][r] * rstd * siluf_(g)); }
        }
    }
    __syncthreads();
}
}

constexpr int NDFT_CU = 64;

__device__ __forceinline__ void phase_mixers(Frame& F, int layer) {
    const bool last = layer == DEPTH - 1;
#if !defined(ONLY_SUB) || ONLY_SUB == 1
    if ((int)blockIdx.x < NDFT_CU && F.G > NDFT_CU) {
        {
            SchedGrid S{SEQ / 256, 4096 / 256, NDFT_CU, (int)blockIdx.x, (const char*)(F.ws + WS_DFTL), (const char*)(F.ws + WS_GT), (size_t)256 * 4096 * 2, (size_t)256 * 4096 * 2, 0, 0};
            EpiDFT E{(bf16*)(F.ws + WS_FO), SEQ, TC};
            pg8::gemm_phase(F.lds, F.tid, 4096, S, E);
        }
        if (!last) {
            SchedGrid S{1, 4096 / 256, NDFT_CU, (int)blockIdx.x, (const char*)(F.ws + WS_DFTC), (const char*)(F.ws + WS_GTC), (size_t)256 * 512 * 2, (size_t)256 * 512 * 2, 0, 0};
            EpiDFT E{(bf16*)(F.ws + WS_FO), CTX, 0};
            pg8::gemm_phase(F.lds, F.tid, 512, S, E);
        }
        return;
    }
#endif
#if defined(ONLY_SUB) && ONLY_SUB == 1
    return;
#endif
    const int nunits = last ? 768 : 864;
    const float lam = lam_of(F, layer), so = 1.0f - lam_init_of(layer);
    unsigned* qctr = F.ctl + CW_QUEUE + 64 * layer;
    volatile LAS unsigned* qw = (volatile LAS unsigned*)(F.lds + att::QW_OFF);
    const bool solo = F.G <= NDFT_CU;
    (void)solo;
    for (;;) {
        if (F.tid == 0) *qw = __hip_atomic_fetch_add(qctr, 1u, RLX_AGENT);
        __syncthreads();
        const int i = (int)*qw;
        __syncthreads();
        if (i >= nunits) break;
        att::UnitDesc u{};
        u.lam = lam; u.scale_out = so;
        if (i < 512) { const int b = i >> 6, h = (i >> 4) & 3, qb = i & 15; u.mode = 0; u.h = h; u.qrow0 = TC + b * SEQ + qb * 128; u.qpos0 = qb * 128; u.krowA = TC + b * SEQ; u.ntA = 32; u.krowB = b * CTX; u.ntB = 4; }
        else if (i < 768) { const int j = i - 512, b = j >> 5, h = (j >> 3) & 3, qb = j & 7; u.mode = 1; u.h = h; u.qrow0 = TC + b * SEQ + qb * 256; u.qpos0 = qb * 256; u.krowA = TC + b * SEQ; u.ntA = 32; u.krowB = b * CTX; u.ntB = 4; u.kindB = 1; u.nseq = SEQ; }
        else if (i < 832) { const int j = i - 768, b = j >> 3, h = (j >> 1) & 3, qb = j & 1; u.mode = 0; u.h = h; u.qrow0 = b * CTX + qb * 128; u.qpos0 = qb * 128; u.krowA = b * CTX; u.ntA = 4; u.krowB = 0; u.ntB = 0; }
        else { const int j = i - 832, b = j >> 2, h = j & 3; u.mode = 1; u.h = h; u.qrow0 = b * CTX; u.qpos0 = 0; u.krowA = b * CTX; u.ntA = 4; u.krowB = 0; u.ntB = 0; u.kindB = 0; u.nseq = CTX; }
        u.outrow0 = u.qrow0;
        if (u.mode == 1) { u.lgf = inp(F, IN_RDEC)[(layer * 2 + 0) * 4 + u.h] * LOG2E; u.lgb = inp(F, IN_RDEC)[(layer * 2 + 1) * 4 + u.h] * LOG2E; }
        att::unit(F, u);
    }
}

__device__ __forceinline__ void phase_merge(Frame& F, int layer) {
    const int row_off = layer == DEPTH - 1 ? TC : 0, M = TA - row_off;
    SchedMerge S{M / 256, D / 256, F.G, (int)blockIdx.x, (const char*)(F.ws + WS_FO) + (size_t)row_off * 512 * 2, (const char*)(F.ws + WS_WFO + (size_t)layer * 3 * WMG_ONE), MIX_ONE, WMG_ONE, (size_t)256 * 512 * 2, (size_t)256 * 512 * 2};
    EpiMerge E{(const bf16*)(F.ws + WS_PROJ), (bf16*)(F.ws + WS_MIXB), row_off};
    pg8::gemm_phase(F.lds, F.tid, 512, S, E);
}
__device__ __forceinline__ void phase_outproj(Frame& F, int layer) {
    const int row_off = layer == DEPTH - 1 ? TC : 0, M = TA - row_off;
    SchedGrid S{M / 256, D / 256, F.G, (int)blockIdx.x, (const char*)(F.ws + WS_MIXB) + (size_t)row_off * D * 2, (const char*)(F.ws + WS_WOUT + layer * WOUT_L), (size_t)256 * D * 2, (size_t)256 * D * 2, 0, 0};
    const float* XR = (const float*)(F.ws + WS_XR);
    EpiOut E{layer == 0 ? inp(F, IN_CTX) : XR, layer == 0 ? inp(F, IN_X) : XR + (size_t)TC * D, (float*)(F.ws + WS_XR), (const float*)(F.ws + WS_MOD) + (size_t)layer * 9 * 6144 + 2 * 1024, row_off};
    pg8::gemm_phase(F.lds, F.tid, D, S, E);
}

__device__ __forceinline__ void phase_norm2(Frame& F, int layer) {
    const int gw = F.vcu * 8 + F.wave, NGW = F.G * 8, lane = F.lane, tid = F.tid;
    LAS float* wr_t = (LAS float*)F.lds;
    const float* wrt = inp(F, IN_WROUTER) + (size_t)layer * D * NE;
    for (int i = tid; i < D * NE; i += 512) { const int k = i >> 4, e = i & 15; wr_t[e * 1024 + k] = wrt[i]; }
    __syncthreads();
    const int r_lo = layer == DEPTH - 1 ? TC : 0;
    const float* XR = (const float*)(F.ws + WS_XR); bf16* HB = (bf16*)(F.ws + WS_HB); float* AFF = (float*)(F.ws + WS_AFF);
    for (int r = r_lo + gw; r < TA; r += NGW) {
        const int v = vec_of_row(r);
        f32x4 x[4];
#pragma unroll
        for (int j = 0; j < 4; ++j) x[j] = *(const f32x4*)(XR + (size_t)r * D + 4 * lane + 256 * j);
        float ss = 0.f;
#pragma unroll
        for (int j = 0; j < 4; ++j) ss += (x[j].x * x[j].x + x[j].y * x[j].y) + (x[j].z * x[j].z + x[j].w * x[j].w);
        const float rinv = 1.0f / sqrtf(wave_sum(ss) * (1.0f / D) + EPS);
        const float* g = inp(F, IN_GFFN) + (size_t)layer * D; const float* sh = mod_ptr(F, layer, v, 3); const float* scl = mod_ptr(F, layer, v, 4);
#pragma unroll
        for (int j = 0; j < 4; ++j) { const int k = 4 * lane + 256 * j; const f32x4 gv = *(const f32x4*)(g + k), sv = *(const f32x4*)(sh + k), cv = *(const f32x4*)(scl + k);
            x[j] = (x[j] * rinv * gv) * (cv + 1.0f) + sv;
            u32x2 w; w.x = pk2(x[j].x, x[j].y); w.y = pk2(x[j].z, x[j].w); *(u32x2*)(HB + (size_t)r * D + k) = w; }
        float mine = 0.f;
#pragma unroll 2
        for (int e = 0; e < 16; ++e) { float a = 0.f;
#pragma unroll
            for (int j = 0; j < 4; ++j) { const f32x4 w = *(const LAS f32x4*)(wr_t + e * 1024 + 4 * lane + 256 * j); a += (x[j].x * w.x + x[j].y * w.y) + (x[j].z * w.z + x[j].w * w.w); }
            a = wave_sum(a); mine = (lane == e) ? a : mine; }
        float mx = mine;
        mx = fmaxf(mx, __shfl_xor(mx, 1)); mx = fmaxf(mx, __shfl_xor(mx, 2)); mx = fmaxf(mx, __shfl_xor(mx, 4)); mx = fmaxf(mx, __shfl_xor(mx, 8));
        const float ex = __expf(mine - mx); float den = ex;
        den += __shfl_xor(den, 1); den += __shfl_xor(den, 2); den += __shfl_xor(den, 4); den += __shfl_xor(den, 8);
        if (lane < 16) AFF[(size_t)r * 16 + lane] = ex / den;
    }
    __syncthreads();
}

__device__ __forceinline__ void phase_topk(Frame& F, int layer) {
    const bool last = layer == DEPTH - 1; const int tid = F.tid, lane = F.lane;
    const int RPE = last ? 2048 : 2304, lat_off = last ? 0 : 256;
    LAS float* vals = (LAS float*)F.lds;
    LAS int* sel = (LAS int*)(F.lds + 8192);
    const float* AFF = (const float*)(F.ws + WS_AFF); int* INV = (int*)(F.ws + WS_INV); float* TOPW = (float*)(F.ws + WS_TOPW);
    const bf16* HB = (const bf16*)(F.ws + WS_HB); bf16* XS = (bf16*)(F.ws + WS_XS);
    const int nitems = last ? 256 : 384;
    for (int item = F.vcu; item < nitems; item += F.G) {
        int n, C, tokrow0, e, slot0, el0, nel;
        if (item < 256) { const int be = item >> 1, half = item & 1, b = be >> 4; e = be & 15; n = SEQ; C = 256; tokrow0 = TC + b * SEQ; slot0 = e * RPE + lat_off + b * 256; el0 = half * 1024; nel = 1024; }
        else { const int be = item - 256, b = be >> 4; e = be & 15; n = CTX; C = 32; tokrow0 = b * CTX; slot0 = e * RPE + b * 32; el0 = 0; nel = 256; }
        for (int k = tid; k < n; k += 512) vals[k] = AFF[(size_t)(tokrow0 + k) * 16 + e];
        __syncthreads();
        const int i0 = el0 + tid, i1 = i0 + 512; const bool act0 = tid < nel, act1 = (tid + 512) < nel;
        const float v0 = act0 ? vals[i0] : 0.f, v1 = act1 ? vals[i1] : 0.f;
        int c0 = 0, c1 = 0;
        for (int j4 = 0; j4 < n / 4; ++j4) { const f32x4 a = *(const LAS f32x4*)(vals + 4 * j4);
#pragma unroll
            for (int q = 0; q < 4; ++q) { const int j = 4 * j4 + q; const float aj = a[q];
                c0 += (aj > v0 || (aj == v0 && j < i0)) ? 1 : 0; c1 += (aj > v1 || (aj == v1 && j < i1)) ? 1 : 0; } }
        if (act0) { const int R = c0 < C ? slot0 + c0 : -1; sel[tid] = R; INV[(size_t)(tokrow0 + i0) * 16 + e] = R; if (R >= 0) TOPW[R] = v0; }
        if (act1) { const int R = c1 < C ? slot0 + c1 : -1; sel[tid + 512] = R; INV[(size_t)(tokrow0 + i1) * 16 + e] = R; if (R >= 0) TOPW[R] = v1; }
        __syncthreads();
        for (int li = F.wave; li < nel; li += 8) { const int R = sel[li];
            if (R >= 0) { const u32x4* src = (const u32x4*)(HB + (size_t)(tokrow0 + el0 + li) * D); u32x4* dst = (u32x4*)(XS + (size_t)R * D);
                const u32x4 a = src[lane], bq = src[lane + 64]; dst[lane] = a; dst[lane + 64] = bq; } }
        __syncthreads();
    }
}

__device__ __forceinline__ void phase_gateup(Frame& F, int layer) {
    const int RPE = layer == DEPTH - 1 ? 2048 : 2304;
    SchedGrid S{NE * RPE / 256, 4096 / 256, F.G, (int)blockIdx.x, (const char*)(F.ws + WS_XS), (const char*)(F.ws + WS_WGU), (size_t)256 * D * 2, (size_t)256 * D * 2, RPE / 256, WGU_E};
    EpiGU E{(bf16*)(F.ws + WS_HID)};
    pg8::gemm_phase(F.lds, F.tid, D, S, E);
}
__device__ __forceinline__ void phase_down(Frame& F, int layer) {
    const int RPE = layer == DEPTH - 1 ? 2048 : 2304;
    SchedGrid S{NE * RPE / 256, D / 256, F.G, (int)blockIdx.x, (const char*)(F.ws + WS_HID), (const char*)(F.ws + WS_WD), (size_t)256 * EH * 2, (size_t)256 * EH * 2, RPE / 256, WD_E};
    EpiDown E{(bf16*)(F.ws + WS_YE), (const float*)(F.ws + WS_TOPW)};
    pg8::gemm_phase(F.lds, F.tid, EH, S, E);
}

constexpr int NPHASE = 1 + 10 * DEPTH + 1;
__global__ void __launch_bounds__(512, 2) mk_fwd(Args args) {
    extern __shared__ __attribute__((aligned(16))) unsigned char lds_raw[];
    Frame F;
    F.lds = (LAS unsigned char*)lds_raw; F.MISC = (volatile LAS unsigned*)(F.lds + MISC_OFF);
    F.tid = threadIdx.x; F.lane = F.tid & 63; F.wave = __builtin_amdgcn_readfirstlane(F.tid >> 6);
    F.G = gridDim.x; { const int bx = blockIdx.x; F.vcu = (F.G % 8 == 0) ? (bx % 8) * (F.G / 8) + bx / 8 : bx; }
    F.ws = args.ws; F.ctl = (unsigned*)(args.ws + WS_CTL); F.out = args.out;
    for (int u = F.tid; u < (LDS_BYTES - LDSCTL_OFF) / 4; u += 512) ((LAS unsigned*)(F.lds + LDSCTL_OFF))[u] = 0u;
    __syncthreads();
    XcdBarrier bar; bar.bar = F.ctl + CW_BAR; bar.x = 0; bar.st = nullptr;
    const bool multi = (args.ph_hi - args.ph_lo) > 1;
    if (multi) bar = xcd_barrier_post(F.ctl + CW_BAR, F.MISC + 8);
    for (int ph = args.ph_lo; ph < args.ph_hi; ++ph) {
        { unsigned long long w = (unsigned long long)args.ws; asm volatile("" : "+s"(w)); F.ws = (unsigned char*)w; F.ctl = (unsigned*)(F.ws + WS_CTL); }
        { unsigned long long kp = (unsigned long long)__builtin_amdgcn_kernarg_segment_ptr(); asm volatile("" : "+s"(kp)); F.karg = (const void __attribute__((address_space(4)))*)kp; }
        { int l = (int)__builtin_amdgcn_mbcnt_hi(~0u, __builtin_amdgcn_mbcnt_lo(~0u, 0u)); asm volatile("" : "+v"(l)); F.lane = l; F.tid = F.wave * 64 + l; }
#ifdef ONLY_PHASE
        if (ph == 0) { if (ONLY_PHASE == 10) phase_prologue(F); }
        else if (ph == NPHASE - 1) { if (ONLY_PHASE == 0) phase_norm(F, DEPTH); }
#else
        if (ph == 0) phase_prologue(F);
        else if (ph == NPHASE - 1) phase_norm(F, DEPTH);
#endif
        else {
            const int layer = (ph - 1) / 10, k = (ph - 1) % 10;
#ifdef ONLY_PHASE
            if (k != ONLY_PHASE) continue;
#endif
            switch (k) {
                case 0: phase_norm(F, layer); if (layer > 0) convert_expert_weights(F, layer); break;
                case 1: phase_inproj(F, layer); break;
                case 2: phase_rope(F, layer); break;
                case 3: phase_mixers(F, layer); break;
                case 4: phase_merge(F, layer); break;
                case 5: phase_outproj(F, layer); break;
                case 6: phase_norm2(F, layer); break;
                case 7: phase_topk(F, layer); break;
                case 8: phase_gateup(F, layer); break;
                default: phase_down(F, layer); break;
            }
        }
        if (ph + 1 < args.ph_hi) xcd_barrier(bar);
    }
}

extern "C" void kernel_launch(void* const* d_in, const int* in_sizes, int n_in, void* d_out, int out_size, void* d_ws, size_t ws_size, hipStream_t stream) {
    static int grid = 0;
    if (grid == 0) {
        if (n_in != 21 || out_size != TL * D || ws_size < WS_END) { fprintf(stderr, "kernel_launch: unexpected shapes (n_in %d, out %d, ws %zu need %zu)\n", n_in, out_size, ws_size, (size_t)WS_END); grid = -1; return; }
        int dev = 0, cus = 0, per_cu = 0;
        if (hipGetDevice(&dev) != hipSuccess || hipDeviceGetAttribute(&cus, hipDeviceAttributeMultiprocessorCount, dev) != hipSuccess) { grid = -1; return; }
        if (hipFuncSetAttribute((const void*)mk_fwd, hipFuncAttributeMaxDynamicSharedMemorySize, LDS_BYTES) != hipSuccess) { fprintf(stderr, "kernel_launch: hipFuncSetAttribute failed\n"); grid = -1; return; }
        if (hipOccupancyMaxActiveBlocksPerMultiprocessor(&per_cu, (const void*)mk_fwd, 512, LDS_BYTES) != hipSuccess || per_cu < 1) { fprintf(stderr, "kernel_launch: occupancy query says %d\n", per_cu); per_cu = 1; }
        (void)hipGetLastError();
        grid = cus * (per_cu >= 1 ? 1 : 1);
        if (grid % 8 != 0 || grid <= NDFT_CU) fprintf(stderr, "kernel_launch: unusual grid %d\n", grid);
    }
    if (grid < 0) return;
    (void)hipMemsetAsync((char*)d_ws + WS_CTL, 0, CTL_BYTES, stream);
    Args a{};
    for (int i = 0; i < 21; ++i) a.in[i] = (const float*)d_in[i];
    a.out = (float*)d_out; a.ws = (unsigned char*)d_ws;
#if MK_MULTI_LAUNCH
    for (int ph = 0; ph < NPHASE; ++ph) { a.ph_lo = ph; a.ph_hi = ph + 1; hipLaunchKernelGGL(mk_fwd, dim3(grid), dim3(512), LDS_BYTES, stream, a); }
#else
    a.ph_lo = 0; a.ph_hi = NPHASE;
    void* kargs[] = {&a};
    hipError_t e = hipLaunchCooperativeKernel((const void*)mk_fwd, dim3(grid), dim3(512), kargs, LDS_BYTES, stream);
    if (e != hipSuccess) fprintf(stderr, "kernel_launch: cooperative launch failed: %s (grid %d)\n", hipGetErrorString(e), grid);
#endif
}
```

```cpp
#include <hip/hip_runtime.h>
#include <cstdio>
#include <cstdint>

#ifndef PROBE_MASK
#define PROBE_MASK 0
#endif
#ifndef MK_MULTI_LAUNCH
#define MK_MULTI_LAUNCH 0
#endif

#define GAS __attribute__((address_space(1)))
#define LAS __attribute__((address_space(3)))
typedef unsigned short bf16;
typedef short bf16x8 __attribute__((ext_vector_type(8)));
typedef short s16x4 __attribute__((ext_vector_type(4)));
typedef float f32x4 __attribute__((ext_vector_type(4)));
typedef float f32x16 __attribute__((ext_vector_type(16)));
typedef unsigned u32x4 __attribute__((ext_vector_type(4)));
typedef unsigned u32x2 __attribute__((ext_vector_type(2)));
typedef float f32x2_t __attribute__((ext_vector_type(2)));
typedef __bf16 bf16x2_t __attribute__((ext_vector_type(2)));

constexpr int D = 1024, NB = 8, SEQ = 2048, CTX = 256, DEPTH = 2, GRIDW = 64;
constexpr int TC = NB * CTX, TL = NB * SEQ, TA = TC + TL;
constexpr int NPROJ = 6144;
constexpr int C_RQ = 0, C_RK = 256, C_RV = 512, C_RG = 1024, C_DQ = 1536, C_DK = 2048, C_DV = 2560, C_GATE = 3072;
constexpr int INW = 6656;
constexpr int NE = 16, EH = 2048;
constexpr float EPS = 1e-6f;
constexpr float LOG2E = 1.4426950408889634f;

constexpr size_t al(size_t x) { return (x + 0xFFFFFull) & ~0xFFFFFull; }
constexpr size_t WS_CTL = 0, CTL_BYTES = 1u << 20;
constexpr size_t WS_MOD = WS_CTL + CTL_BYTES;
constexpr size_t WS_ROPE = WS_MOD + al((size_t)DEPTH * 9 * 6 * D * 4);
constexpr size_t WS_AFF = WS_ROPE + al((size_t)2 * SEQ * 32 * 4);
constexpr size_t WS_INV = WS_AFF + al((size_t)TA * 16 * 4);
constexpr size_t WS_TOPW = WS_INV + al((size_t)TA * 16 * 4);
constexpr size_t WS_WIN = WS_TOPW + al((size_t)36864 * 4);
constexpr size_t WIN_L = (size_t)7168 * 1024 * 2;
constexpr size_t WS_WFO = WS_WIN + al(2 * WIN_L);
constexpr size_t WMG_ONE = (size_t)1024 * 512 * 2;
constexpr size_t WS_WOUT = WS_WFO + al(6 * WMG_ONE);
constexpr size_t WOUT_L = (size_t)1024 * 1024 * 2;
constexpr size_t WS_WGU = WS_WOUT + al(2 * WOUT_L);
constexpr size_t WGU_E = (size_t)4096 * 1024 * 2;
constexpr size_t WS_WD = WS_WGU + al(16 * WGU_E);
constexpr size_t WD_E = (size_t)1024 * 2048 * 2;
constexpr size_t WS_DFTL = WS_WD + al(16 * WD_E);
constexpr size_t WS_DFTC = WS_DFTL + al((size_t)2048 * 4096 * 2);
constexpr size_t WS_XR = WS_DFTC + al((size_t)256 * 512 * 2);
constexpr size_t WS_HB = WS_XR + al((size_t)TA * D * 4);
constexpr size_t WS_PROJ = WS_HB + al((size_t)TA * D * 2);
constexpr size_t WS_GT = WS_PROJ + al((size_t)TA * NPROJ * 2);
constexpr size_t WS_GTC = WS_GT + al((size_t)4096 * 4096 * 2);
constexpr size_t WS_FO = WS_GTC + al((size_t)4096 * 512 * 2);
constexpr size_t MIX_ONE = (size_t)TA * 512 * 2;
constexpr size_t WS_MIXB = WS_FO + al(3 * MIX_ONE);
constexpr size_t WS_XS = WS_MIXB + al((size_t)TA * D * 2);
constexpr size_t WS_END = WS_XS + al((size_t)36864 * D * 2);
constexpr size_t WS_HID = WS_PROJ;
constexpr size_t WS_YE = WS_XS;
static_assert((size_t)36864 * EH * 2 <= (size_t)TA * NPROJ * 2, "HID overlays PROJ");
static_assert(WS_END <= (size_t)1024 * 1024 * 1024, "workspace map must fit 1 GiB");

constexpr int CW_BAR = 4096;
constexpr int CW_QUEUE = 16384;

constexpr int RING_BYTES = 131072;
constexpr int LDSCTL_OFF = RING_BYTES, MISC_OFF = LDSCTL_OFF + 320;
constexpr int LDS_BYTES = 147456;

#define RLX_AGENT __ATOMIC_RELAXED, __HIP_MEMORY_SCOPE_AGENT
#define LDS_WAIT() asm volatile("s_waitcnt lgkmcnt(0)" ::: "memory")
#define VM_WAIT() asm volatile("s_waitcnt vmcnt(0)" ::: "memory")
__device__ __forceinline__ unsigned f2bf(float f) { unsigned u = __builtin_bit_cast(unsigned, f); return (u + 0x7fffu + ((u >> 16) & 1u)) >> 16; }
__device__ __forceinline__ unsigned pk2(float lo, float hi) { f32x2_t v = {lo, hi}; bf16x2_t b = __builtin_convertvector(v, bf16x2_t); return __builtin_bit_cast(unsigned, b); }
__device__ __forceinline__ float bflo(unsigned w) { return __builtin_bit_cast(float, w << 16); }
__device__ __forceinline__ float bfhi(unsigned w) { return __builtin_bit_cast(float, w & 0xffff0000u); }
__device__ __forceinline__ float bf2f(bf16 h) { return __builtin_bit_cast(float, (unsigned)h << 16); }
__device__ __forceinline__ float wave_sum(float v) {
#pragma unroll
    for (int o = 1; o < 64; o <<= 1) v += __shfl_xor(v, o);
    return v;
}
__device__ __forceinline__ float sigmoidf_(float x) { return __builtin_amdgcn_rcpf(1.0f + __builtin_amdgcn_exp2f(-x * LOG2E)); }
__device__ __forceinline__ float siluf_(float x) { return x * sigmoidf_(x); }

namespace pg8 {
constexpr int BM = 256, BK = 64, HALF = 128, HTB = HALF * BK * 2, STAGE_BYTES = 8 * HTB, NXCD = 8, WGM = 8;
__host__ __device__ __forceinline__ int lds_byte(int r, int c) { const int st = (r >> 4) * 2 + (c >> 5), rr = r & 15, cc = c & 31, ob = rr * 64 + cc * 2; return st * 1024 + (ob ^ (((ob >> 9) & 1) << 5)); }
__host__ __device__ __forceinline__ void stage_rc(int b, int& R, int& C) { const int st = b / 1024, sb = b % 1024, swz = sb ^ (((sb >> 9) & 1) << 5); R = (st >> 1) * 16 + swz / 64; C = (st & 1) * 32 + (swz % 64) / 2; }
__host__ __device__ __forceinline__ int perm32(int rho) { const int n = rho >> 4, i = rho & 15; return 8 * (i >> 2) + 4 * n + (i & 3); }

struct Unit { int pm, pn, tag; const char* A; const char* B; };

__device__ __forceinline__ bool grid_order(long L, int nM, int nN, int& pm, int& pn) {
    const int nwg = nM * nN; if (L >= nwg) return false;
    int wgid = (int)L; { const int q = nwg / NXCD, r = nwg % NXCD, xcd = wgid % NXCD, off = wgid / NXCD; wgid = (xcd < r ? xcd * (q + 1) : r * (q + 1) + (xcd - r) * q) + off; }
    const int nig = WGM * nN, gid = wgid / nig, fm = gid * WGM, gsz = (nM - fm) < WGM ? (nM - fm) : WGM;
    pm = fm + ((wgid % nig) % gsz); pn = (wgid % nig) / gsz; return true;
}

typedef f32x4 Acc[2][2][4][2];
__device__ __forceinline__ void zero_acc(Acc& acc) {
#pragma unroll
    for (int a = 0; a < 2; ++a)
#pragma unroll
        for (int b = 0; b < 2; ++b)
#pragma unroll
            for (int m = 0; m < 4; ++m)
#pragma unroll
                for (int n = 0; n < 2; ++n) acc[a][b][m][n] = (f32x4){0.f, 0.f, 0.f, 0.f};
}

template <class Epi, class Sched>
__device__ __forceinline__ void gemm_phase(LAS unsigned char* lds, const int tid, const int K, const Sched& S, const Epi& E) {
    const int wid = __builtin_amdgcn_readfirstlane(tid >> 6), lane = tid & 63, wr = wid >> 2, wc = wid & 3, fr = lane & 15, fq = lane >> 4;
    const int nt = K / BK;
    unsigned voffA[2], voffB[2];
#pragma unroll
    for (int i = 0; i < 2; ++i) { int R, C; stage_rc(tid * 16 + i * 8192, R, C); const int Rb = Epi::PERM ? ((R & ~31) + perm32(R & 31)) : R;
        voffA[i] = (unsigned)(R * K + C) * 2u; voffB[i] = (unsigned)(Rb * K + C) * 2u; }
    const size_t kstep = (size_t)(BK * 2);
    const size_t hstep = (size_t)HALF * K * 2;
    const unsigned ldsw = (unsigned)wid * 1024u;
    const int aoff = lds_byte(wr * 64 + fr, fq * 8), boff = lds_byte(wc * 32 + fr, fq * 8);
#define PG8_SA(b, h) (((b) * 2 + (h)) * HTB)
#define PG8_SB(b, h) ((4 + (b) * 2 + (h)) * HTB)
#define PG8_STAGE(bufoff, gbase, voff) do { _Pragma("unroll") for (int _i = 0; _i < 2; ++_i) \
        __builtin_amdgcn_global_load_lds((const unsigned*)((const char*)(gbase) + (voff)[_i]), (LAS unsigned*)(lds + (bufoff) + ldsw + _i * 8192), 16, 0, 0); } while (0)
#define PG8_LDA(dst, b, h) do { _Pragma("unroll") for (int m = 0; m < 4; ++m) _Pragma("unroll") for (int k = 0; k < 2; ++k) dst[m][k] = *(const LAS bf16x8*)(lds + PG8_SA(b, h) + aoff + m * 2048 + k * 1024); } while (0)
#define PG8_LDB(dst, b, h) do { _Pragma("unroll") for (int n = 0; n < 2; ++n) _Pragma("unroll") for (int k = 0; k < 2; ++k) dst[n][k] = *(const LAS bf16x8*)(lds + PG8_SB(b, h) + boff + n * 2048 + k * 1024); } while (0)
#define PG8_MMA(ai, bj, At, Bt) do { __builtin_amdgcn_s_setprio(1); _Pragma("unroll") for (int m = 0; m < 4; ++m) _Pragma("unroll") for (int n = 0; n < 2; ++n) _Pragma("unroll") for (int k = 0; k < 2; ++k) \
        acc[ai][bj][m][n] = __builtin_amdgcn_mfma_f32_16x16x32_bf16(Bt[n][k], At[m][k], acc[ai][bj][m][n], 0, 0, 0); __builtin_amdgcn_s_setprio(0); } while (0)
#define PG8_WAIT_V(n) asm volatile("s_waitcnt vmcnt(" #n ")" ::: "memory")
#define PG8_WAIT_L(n) asm volatile("s_waitcnt lgkmcnt(" #n ")" ::: "memory")
#define PG8_BAR __builtin_amdgcn_s_barrier()
#define PG8_SCHED __builtin_amdgcn_sched_barrier(0)
    Unit cur, nxt; int ui = 0;
    if (!S.next(0, cur)) return;
    Acc acc; zero_acc(acc);
    bf16x8 At[4][2], B0[2][2], B1[2][2];
    const char* cA = cur.A; const char* cB = cur.B;
    PG8_STAGE(PG8_SB(0, 0), cB, voffB); PG8_STAGE(PG8_SB(0, 1), cB + hstep, voffB); PG8_STAGE(PG8_SA(0, 0), cA, voffA); PG8_STAGE(PG8_SA(0, 1), cA + hstep, voffA);
    if (wr == 1) PG8_BAR;
    PG8_WAIT_V(2); PG8_BAR;
    PG8_STAGE(PG8_SB(1, 0), cB + kstep, voffB); PG8_STAGE(PG8_SA(1, 0), cA + kstep, voffA); PG8_STAGE(PG8_SB(1, 1), cB + hstep + kstep, voffB);
    PG8_WAIT_V(6); PG8_BAR;
    for (;;) {
        const bool has_next = S.next(ui + 1, nxt);
        const char* nA = has_next ? nxt.A : cA; const char* nB = has_next ? nxt.B : cB;
        for (int t = 0; t < nt; t += 2) {
            const bool last = (t == nt - 2);
            const char* a1 = cA + (size_t)(t + 1) * kstep;
            const char* a2 = last ? nA : cA + (size_t)(t + 2) * kstep; const char* b2 = last ? nB : cB + (size_t)(t + 2) * kstep;
            const char* a3 = a2 + kstep; const char* b3 = b2 + kstep;
            PG8_LDB(B0, 0, 0); PG8_LDB(B1, 0, 1); PG8_SCHED; PG8_LDA(At, 0, 0); PG8_STAGE(PG8_SA(1, 1), a1 + hstep, voffA);
            PG8_WAIT_V(8); PG8_WAIT_L(0); PG8_BAR; PG8_MMA(0, 0, At, B0); PG8_MMA(0, 1, At, B1); PG8_BAR; PG8_SCHED;
            PG8_LDA(At, 0, 1); PG8_STAGE(PG8_SB(0, 0), b2, voffB); PG8_STAGE(PG8_SB(0, 1), b2 + hstep, voffB); PG8_STAGE(PG8_SA(0, 0), a2, voffA);
            PG8_WAIT_V(8); PG8_WAIT_L(0); PG8_BAR; PG8_MMA(1, 0, At, B0); PG8_MMA(1, 1, At, B1); PG8_BAR; PG8_SCHED;
            PG8_LDB(B0, 1, 0); PG8_LDB(B1, 1, 1); PG8_SCHED; PG8_LDA(At, 1, 0); PG8_STAGE(PG8_SA(0, 1), a2 + hstep, voffA);
            PG8_WAIT_V(8); PG8_WAIT_L(0); PG8_BAR; PG8_MMA(0, 0, At, B0); PG8_MMA(0, 1, At, B1); PG8_BAR; PG8_SCHED;
            PG8_LDA(At, 1, 1); PG8_STAGE(PG8_SB(1, 0), b3, voffB); PG8_STAGE(PG8_SB(1, 1), b3 + hstep, voffB); PG8_STAGE(PG8_SA(1, 0), a3, voffA);
            PG8_WAIT_V(8); PG8_WAIT_L(0); PG8_BAR; PG8_MMA(1, 0, At, B0); PG8_MMA(1, 1, At, B1); PG8_BAR; PG8_SCHED;
        }
        if (wr == 0) PG8_BAR;
        E(acc, cur, wr, wc, fr, fq);
        if (!has_next) break;
        cur = nxt; cA = nA; cB = nB; ++ui;
        if (wr == 1) PG8_BAR;
    }
    PG8_WAIT_V(0);
    PG8_BAR;
#undef PG8_SA
#undef PG8_SB
#undef PG8_STAGE
#undef PG8_LDA
#undef PG8_LDB
#undef PG8_MMA
#undef PG8_WAIT_V
#undef PG8_WAIT_L
#undef PG8_BAR
#undef PG8_SCHED
}
}

#define XB_TMO      128
#define XB_XCNT(j)  (256  + 64 * (j))
#define XB_XSUB(j)  (1280 + 64 * (j))
#define XB_XGEN(j)  (2304 + 64 * (j))
#define XB_TOP      3328
#define XB_TOPGEN   3392
#define XCD_BAR_WORDS 3456
#define XB_SPIN_CAP (1u << 22)
__device__ __forceinline__ unsigned xb_ld(unsigned* p)              { return __hip_atomic_load(p, __ATOMIC_RELAXED, __HIP_MEMORY_SCOPE_AGENT); }
__device__ __forceinline__ unsigned xb_add(unsigned* p, unsigned v) { return __hip_atomic_fetch_add(p, v, __ATOMIC_RELAXED, __HIP_MEMORY_SCOPE_AGENT); }
__device__ __forceinline__ unsigned xb_xcc_id() { return (unsigned)__builtin_amdgcn_s_getreg((3 << 11) | 20) & 0xFu; }
#define XB_SPIN(cond, bar) do { unsigned _sp = 0; while (cond) { __builtin_amdgcn_s_sleep(1); \
    if ((++_sp & 255u) == 0u) { if (xb_ld(&(bar)[XB_TMO])) break; if (_sp > XB_SPIN_CAP) { atomicAdd(&(bar)[XB_TMO], 1u); break; } } } } while (0)
struct XcdBarrier { unsigned* bar; unsigned x; volatile LAS unsigned* st; };
__device__ __forceinline__ XcdBarrier xcd_barrier_post(unsigned* bar, volatile LAS unsigned* st) {
    XcdBarrier b; b.bar = bar; b.x = xb_xcc_id(); b.st = st;
    if (threadIdx.x == 0) (void)xb_add(&bar[XB_XCNT(b.x)], 1u);
    return b;
}
__device__ __forceinline__ void xcd_barrier_complete(unsigned* bar, unsigned x, unsigned& nloc, unsigned& nx) {
    const unsigned G = gridDim.x * gridDim.y * gridDim.z;
    unsigned sum, cnt, mine, sp = 0u;
    for (;;) {
        sum = 0u; cnt = 0u; mine = 0u;
#pragma unroll
        for (unsigned j = 0; j < 16; ++j) { const unsigned c = xb_ld(&bar[XB_XCNT(j)]); sum += c; cnt += (c > 0u) ? 1u : 0u; mine = (j == x) ? c : mine; }
        if (sum == G) break;
        __builtin_amdgcn_s_sleep(1);
        if ((++sp & 255u) == 0u) { if (xb_ld(&bar[XB_TMO])) break; if (sp > XB_SPIN_CAP) { atomicAdd(&bar[XB_TMO], 1u); break; } }
    }
    nloc = mine > 0u ? mine : 1u; nx = cnt > 0u ? cnt : 1u;
}
__device__ __forceinline__ void xcd_barrier(const XcdBarrier& b) {
    asm volatile("s_waitcnt vmcnt(0)" ::: "memory");
    __syncthreads();
    if (threadIdx.x == 0) {
        unsigned* bar = b.bar;
        __builtin_amdgcn_s_waitcnt(0);
        unsigned nloc = b.st[0], nx = b.st[1];
        if (nloc == 0u) { xcd_barrier_complete(bar, b.x, nloc, nx); b.st[0] = nloc; b.st[1] = nx; }
        const unsigned old = xb_add(&bar[XB_XSUB(b.x)], 1u);
        const unsigned gen = old / nloc;
        if (old + 1u == (gen + 1u) * nloc) {
            __builtin_amdgcn_fence(__ATOMIC_RELEASE, "agent");
            asm volatile("s_waitcnt vmcnt(0)" ::: "memory");
            const unsigned og = xb_add(&bar[XB_TOP], 1u);
            const unsigned tg = og / nx;
            if (og + 1u == (tg + 1u) * nx) xb_add(&bar[XB_TOPGEN], 1u);
            else XB_SPIN(xb_ld(&bar[XB_TOPGEN]) == tg, bar);
            __builtin_amdgcn_fence(__ATOMIC_ACQUIRE, "agent");
            xb_add(&bar[XB_XGEN(b.x)], 1u);
            asm volatile("s_waitcnt vmcnt(0)" ::: "memory");
        } else {
            XB_SPIN(xb_ld(&bar[XB_XGEN(b.x)]) == gen, bar);
            __builtin_amdgcn_fence(__ATOMIC_ACQUIRE, "agent");
            asm volatile("s_waitcnt vmcnt(0)" ::: "memory");
        }
    }
    __syncthreads();
}

struct Args { const float* in[21]; float* out; unsigned char* ws; int ph_lo, ph_hi; };
struct Frame {
    LAS unsigned char* lds; volatile LAS unsigned* MISC; unsigned* ctl;
    int tid, lane, wave, vcu, G;
    const void __attribute__((address_space(4)))* karg; float* out; unsigned char* ws;
};
__device__ __forceinline__ const float* inp(const Frame& F, int i) { return ((const float* const __attribute__((address_space(4)))*)F.karg)[i]; }
#define IN_X 0
#define IN_C 1
#define IN_CTX 2
#define IN_CCTX 3
#define IN_WMOD 4
#define IN_BMOD 5
#define IN_GATTN 6
#define IN_GFFN 7
#define IN_WIN 8
#define IN_RDEC 9
#define IN_QN 10
#define IN_KN 11
#define IN_LAMBDA 12
#define IN_WFO 13
#define IN_WRO 14
#define IN_WDO 15
#define IN_WOUT 16
#define IN_WROUTER 17
#define IN_WEG 18
#define IN_WEU 19
#define IN_WED 20

__device__ __forceinline__ int vec_of_row(int r) { return r < TC ? 8 : (r - TC) / SEQ; }
__device__ __forceinline__ const float* mod_ptr(const Frame& F, int layer, int v, int i) { return (const float*)(F.ws + WS_MOD) + ((size_t)(layer * 9 + v) * 6 + i) * D; }
__device__ __forceinline__ float lam_init_of(int layer) { return layer == 0 ? 0.2f : 0.8f - 0.6f * 0.74081822068171788f; }
__device__ __forceinline__ float lam_of(const Frame& F, int layer) {
    const float* L = inp(F, IN_LAMBDA) + (size_t)layer * 4 * 64; float s1 = 0.f, s2 = 0.f;
    for (int i = 0; i < 64; ++i) { s1 += L[i] * L[64 + i]; s2 += L[128 + i] * L[192 + i]; }
    return __expf(s1) - __expf(s2) + lam_init_of(layer);
}

__device__ __forceinline__ void transpose_item(const float* W, int ldw, int K, int k0, int n0src, bf16* WT, int dst_row0, LAS float* scr, int lane) {
#pragma unroll 8
    for (int i = 0; i < 32; ++i) { const int kk = 2 * i + (lane >> 5); scr[kk * 33 + (lane & 31)] = W[(size_t)(k0 + kk) * ldw + n0src + (lane & 31)]; }
    LDS_WAIT(); asm volatile("" ::: "memory");
    const int c = lane & 7;
#pragma unroll
    for (int j = 0; j < 4; ++j) { const int n = (lane >> 3) + 8 * j; const LAS float* s = scr + (8 * c) * 33 + n;
        u32x4 o; o.x = pk2(s[0 * 33], s[1 * 33]); o.y = pk2(s[2 * 33], s[3 * 33]); o.z = pk2(s[4 * 33], s[5 * 33]); o.w = pk2(s[6 * 33], s[7 * 33]);
        *(u32x4*)(WT + (size_t)(dst_row0 + n) * K + k0 + 8 * c) = o; }
    LDS_WAIT(); asm volatile("" ::: "memory");
}
template <class RowMap>
__device__ __forceinline__ void transpose_matrix(Frame& F, const float* W, int ldw, int csrc, int K, int N, bf16* WT, RowMap map, int& item_base) {
    LAS float* scr = (LAS float*)(F.lds + F.wave * 16384);
    const int gw = F.vcu * 8 + F.wave, NGW = F.G * 8;
    const int nblk = N / 32, nitems = (K / 64) * nblk;
    int start = (gw - item_base % NGW + NGW) % NGW;
    for (int it = start; it < nitems; it += NGW) { const int kb = it / nblk, nb = it % nblk; transpose_item(W, ldw, K, 64 * kb, csrc + 32 * nb, WT, map(32 * nb), scr, F.lane); }
    item_base += nitems;
}
struct MapId { int off; __device__ int operator()(int n) const { return off + n; } };
struct MapGU { int up; __device__ int operator()(int n) const { return (n >> 7) * 256 + up * 128 + (n & 127); } };

__device__ __forceinline__ void convert_expert_weights(Frame& F, int layer) {
    int base = 0;
    for (int e = 0; e < NE; ++e) {
        const float* wg = inp(F, IN_WEG) + ((size_t)layer * NE + e) * D * EH; const float* wu = inp(F, IN_WEU) + ((size_t)layer * NE + e) * D * EH; const float* wd = inp(F, IN_WED) + ((size_t)layer * NE + e) * EH * D;
        bf16* gu = (bf16*)(F.ws + WS_WGU + e * WGU_E); bf16* dn = (bf16*)(F.ws + WS_WD + e * WD_E);
        transpose_matrix(F, wg, EH, 0, D, EH, gu, MapGU{0}, base);
        transpose_matrix(F, wu, EH, 0, D, EH, gu, MapGU{1}, base);
        transpose_matrix(F, wd, D, 0, EH, D, dn, MapId{0}, base);
    }
}

__device__ __forceinline__ void phase_prologue(Frame& F) {
    const int tid = F.tid;
    {
        LAS float* sc = (LAS float*)F.lds;
        LAS float* red = sc + 9 * 1024;
        for (int i = tid; i < 9 * 1024; i += 512) { const int v = i >> 10, k = i & 1023; const float c = v < 8 ? inp(F, IN_C)[v * D + k] : inp(F, IN_CCTX)[k]; sc[i] = siluf_(c); }
        __syncthreads();
        for (int item = F.vcu; item < DEPTH * 96; item += F.G) {
            const int layer = item / 96, cb = item % 96, col = cb * 64 + (tid & 63), kg = tid >> 6;
            const float* w = inp(F, IN_WMOD) + (size_t)layer * D * 6144 + col;
            float a[9];
#pragma unroll
            for (int v = 0; v < 9; ++v) a[v] = 0.f;
#pragma unroll 4
            for (int kk = 0; kk < 128; ++kk) { const int k = kg * 128 + kk; const float wv = w[(size_t)k * 6144];
#pragma unroll
                for (int v = 0; v < 9; ++v) a[v] += sc[v * 1024 + k] * wv; }
#pragma unroll
            for (int v = 0; v < 9; ++v) red[(kg * 64 + (tid & 63)) * 9 + v] = a[v];
            __syncthreads();
            for (int o = tid; o < 64 * 9; o += 512) { const int cc = o / 9, v = o % 9; float s = 0.f;
                for (int g = 0; g < 8; ++g) s += red[(g * 64 + cc) * 9 + v];
                const int colo = cb * 64 + cc;
                ((float*)(F.ws + WS_MOD))[(size_t)(layer * 9 + v) * 6144 + colo] = s + inp(F, IN_BMOD)[layer * 6144 + colo]; }
            __syncthreads();
        }
    }
    {
        const int gt = F.vcu * 512 + tid, NT = F.G * 512;
        float* rc = (float*)(F.ws + WS_ROPE); float* rs = rc + SEQ * 32;
        for (int i = gt; i < SEQ * 32; i += NT) { const int pos = i >> 5, f = i & 31; const float inv = __builtin_amdgcn_exp2f(-(float)(f & 15) * (13.287712379549449f / 16.0f));
            const float p = (f < 16) ? (float)(pos / GRIDW) : (float)(pos % GRIDW); const float ang = p * inv; rc[i] = __builtin_amdgcn_cosf(ang * 0.15915494309189535f); rs[i] = __builtin_amdgcn_sinf(ang * 0.15915494309189535f); }
        LAS float* ct = (LAS float*)F.lds;
        __syncthreads();
        for (int m = tid; m < 2048; m += 512) ct[m] = __builtin_amdgcn_cosf((float)m * (1.0f / 2048.0f));
        __syncthreads();
        bf16* dl = (bf16*)(F.ws + WS_DFTL); const float sl = 0.022097086912079608f;
        for (int i = gt; i < 2048 * 2048; i += NT) {
            const int k = i >> 11, n = i & 2047, m = (k * n) & 2047; const float c = ct[m], s = ct[(m - 512) & 2047];
            dl[(size_t)k * 4096 + n] = (bf16)f2bf(c * sl); dl[(size_t)k * 4096 + 2048 + n] = (bf16)f2bf(-s * sl); }
        bf16* dc = (bf16*)(F.ws + WS_DFTC);
        for (int i = gt; i < 256 * 256; i += NT) { const int k = i >> 8, n = i & 255, m = ((k * n) & 255) * 8; const float c = ct[m], s = ct[(m - 512) & 2047];
            dc[(size_t)k * 512 + n] = (bf16)f2bf(c * 0.0625f); dc[(size_t)k * 512 + 256 + n] = (bf16)f2bf(-s * 0.0625f); }
        for (int layer = 0; layer < DEPTH; ++layer) {
            const float* win = inp(F, IN_WIN) + (size_t)layer * D * INW; bf16* wt = (bf16*)(F.ws + WS_WIN + layer * WIN_L) + (size_t)6144 * 1024;
            for (int i = gt; i < 1024 * 1024; i += NT) { const int k = i & 1023, no = i >> 10, part = no >> 9, g = (no >> 6) & 7, cp = no & 63;
                const float* src = win + (size_t)k * INW + g * 64; float s = 0.f;
                for (int c = 0; c < 64; ++c) { const int m = ((c * cp) & 63) * 32; const float t = part == 0 ? ct[m] : ct[(m - 512) & 2047]; s += src[c] * t; }
                wt[(size_t)no * 1024 + k] = (bf16)f2bf(s * 0.125f); }
        }
        __syncthreads();
    }
    {
        int base = 0;
        for (int layer = 0; layer < DEPTH; ++layer) {
            transpose_matrix(F, inp(F, IN_WIN) + (size_t)layer * D * INW, INW, 512, D, NPROJ, (bf16*)(F.ws + WS_WIN + layer * WIN_L), MapId{0}, base);
            transpose_matrix(F, inp(F, IN_WFO) + (size_t)layer * 512 * D, D, 0, 512, D, (bf16*)(F.ws + WS_WFO + (layer * 3 + 0) * WMG_ONE), MapId{0}, base);
            transpose_matrix(F, inp(F, IN_WRO) + (size_t)layer * 512 * D, D, 0, 512, D, (bf16*)(F.ws + WS_WFO + (layer * 3 + 1) * WMG_ONE), MapId{0}, base);
            transpose_matrix(F, inp(F, IN_WDO) + (size_t)layer * 512 * D, D, 0, 512, D, (bf16*)(F.ws + WS_WFO + (layer * 3 + 2) * WMG_ONE), MapId{0}, base);
            transpose_matrix(F, inp(F, IN_WOUT) + (size_t)layer * D * D, D, 0, D, D, (bf16*)(F.ws + WS_WOUT + layer * WOUT_L), MapId{0}, base);
        }
    }
    convert_expert_weights(F, 0);
}

__device__ __forceinline__ void phase_norm(Frame& F, int layer) {
    const int gw = F.vcu * 8 + F.wave, NGW = F.G * 8, lane = F.lane;
    const bool fin = layer == DEPTH; const int r_lo = (layer >= DEPTH - 1) ? (fin ? TC : 0) : 0;
    float* XR = (float*)(F.ws + WS_XR); const int* INV = (const int*)(F.ws + WS_INV); const bf16* YE = (const bf16*)(F.ws + WS_YE); bf16* HB = (bf16*)(F.ws + WS_HB);
    for (int r = r_lo + gw; r < TA; r += NGW) {
        const int v = vec_of_row(r);
        f32x4 x[4];
        if (layer == 0) { const float* src = r < TC ? inp(F, IN_CTX) + (size_t)r * D : inp(F, IN_X) + (size_t)(r - TC) * D;
#pragma unroll
            for (int j = 0; j < 4; ++j) x[j] = *(const f32x4*)(src + 4 * lane + 256 * j);
        } else {
            const float* src = XR + (size_t)r * D;
#pragma unroll
            for (int j = 0; j < 4; ++j) x[j] = *(const f32x4*)(src + 4 * lane + 256 * j);
            if (!(layer == DEPTH - 1 + 1 && false)) {
                const bool has_moe = !(layer == 1 && r < TC && false);
                if (has_moe) {
                    f32x4 s[4];
#pragma unroll
                    for (int j = 0; j < 4; ++j) s[j] = (f32x4){0.f, 0.f, 0.f, 0.f};
                    const int* inv = INV + (size_t)r * 16;
                    for (int e = 0; e < NE; ++e) { const int slot = __builtin_amdgcn_readfirstlane(inv[e]);
                        if (slot >= 0) { const bf16* y = YE + (size_t)slot * D;
#pragma unroll
                            for (int j = 0; j < 4; ++j) { const u32x2 w = *(const u32x2*)(y + 4 * lane + 256 * j); s[j] += (f32x4){bflo(w.x), bfhi(w.x), bflo(w.y), bfhi(w.y)}; } } }
                    const float* m5 = mod_ptr(F, layer - 1, v, 5);
#pragma unroll
                    for (int j = 0; j < 4; ++j) x[j] += *(const f32x4*)(m5 + 4 * lane + 256 * j) * s[j];
                }
            }
        }
        if (fin) {
#pragma unroll
            for (int j = 0; j < 4; ++j) *(f32x4*)(F.out + (size_t)(r - TC) * D + 4 * lane + 256 * j) = x[j];
            continue;
        }
        if (layer > 0) {
#pragma unroll
            for (int j = 0; j < 4; ++j) *(f32x4*)(XR + (size_t)r * D + 4 * lane + 256 * j) = x[j];
        }
        float ss = 0.f;
#pragma unroll
        for (int j = 0; j < 4; ++j) ss += (x[j].x * x[j].x + x[j].y * x[j].y) + (x[j].z * x[j].z + x[j].w * x[j].w);
        const float rinv = __builtin_amdgcn_rsqf(wave_sum(ss) * (1.0f / D) + EPS);
        const float* g = inp(F, IN_GATTN) + (size_t)layer * D; const float* sh = mod_ptr(F, layer, v, 0); const float* scl = mod_ptr(F, layer, v, 1);
#pragma unroll
        for (int j = 0; j < 4; ++j) { const int k = 4 * lane + 256 * j; const f32x4 gv = *(const f32x4*)(g + k), sv = *(const f32x4*)(sh + k), cv = *(const f32x4*)(scl + k);
            const f32x4 y = (x[j] * rinv * gv) * (cv + 1.0f) + sv;
            u32x2 w; w.x = pk2(y.x, y.y); w.y = pk2(y.z, y.w); *(u32x2*)(HB + (size_t)r * D + k) = w; }
    }
}

using pg8::Unit; using pg8::Acc;
struct SchedGrid {
    int nM, nN, G, c; const char* A; const char* B; size_t a_tile, b_tile; int pm_per_group; size_t b_group;
    __device__ __forceinline__ bool next(int i, Unit& u) const {
        int pm, pn; if (c < 0 || !pg8::grid_order((long)i * G + c, nM, nN, pm, pn)) return false;
        u.pm = pm; u.pn = pn; u.tag = 0; u.A = A + (size_t)pm * a_tile; u.B = B + (size_t)pn * b_tile + (pm_per_group ? (size_t)(pm / pm_per_group) * b_group : 0); return true; }
};
struct SchedMerge {
    int nM, nN, G, c; const char* A; const char* B; size_t a_seg, b_seg, a_tile, b_tile;
    __device__ __forceinline__ bool next(int i, Unit& u) const {
        const int t = i / 3, seg = i - 3 * t; int pm, pn; if (!pg8::grid_order((long)t * G + c, nM, nN, pm, pn)) return false;
        u.pm = pm; u.pn = pn; u.tag = seg; u.A = A + (size_t)seg * a_seg + (size_t)pm * a_tile; u.B = B + (size_t)seg * b_seg + (size_t)pn * b_tile; return true; }
};

struct EpiBf16 {
    static constexpr bool PERM = true;
    bf16* C; int ldc;
    __device__ __forceinline__ void operator()(Acc& acc, const Unit& u, int wr, int wc, int fr, int fq) const {
        const int row0 = u.pm * 256 + wr * 64 + fr, col0 = u.pn * 256 + wc * 32 + 8 * fq;
#pragma unroll
        for (int ai = 0; ai < 2; ++ai)
#pragma unroll
            for (int m = 0; m < 4; ++m) { bf16* rowp = C + (size_t)(row0 + ai * 128 + m * 16) * ldc + col0;
#pragma unroll
                for (int bj = 0; bj < 2; ++bj) { const f32x4 v0 = acc[ai][bj][m][0], v1 = acc[ai][bj][m][1];
                    u32x4 w; w.x = pk2(v0[0], v0[1]); w.y = pk2(v0[2], v0[3]); w.z = pk2(v1[0], v1[1]); w.w = pk2(v1[2], v1[3]);
                    *(u32x4*)(rowp + bj * 128) = w; } }
        pg8::zero_acc(acc);
    }
};
struct EpiGT {
    static constexpr bool PERM = true;
    bf16* GT; bf16* GTC;
    __device__ __forceinline__ void operator()(Acc& acc, const Unit& u, int wr, int wc, int fr, int fq) const {
        const int tok0 = u.pn * 256;
        bf16* base; int pitch, nseq, n0;
        if (tok0 < TC) { const int b = tok0 / CTX; base = GTC + (size_t)b * 512 * 512; pitch = 512; nseq = CTX; n0 = tok0 - b * CTX; }
        else { const int t = tok0 - TC, b = t / SEQ; base = GT + (size_t)b * 512 * 4096; pitch = 4096; nseq = SEQ; n0 = t - b * SEQ; }
        const int crow0 = u.pm * 256 + wr * 64 + fr, ccol0 = wc * 32 + 8 * fq;
#pragma unroll
        for (int ai = 0; ai < 2; ++ai)
#pragma unroll
            for (int m = 0; m < 4; ++m) { const int c = crow0 + ai * 128 + m * 16, part = c >> 9, ch = c & 511;
                bf16* rowp = base + (size_t)ch * pitch + part * nseq + n0 + ccol0;
#pragma unroll
                for (int bj = 0; bj < 2; ++bj) { const f32x4 v0 = acc[ai][bj][m][0], v1 = acc[ai][bj][m][1];
                    u32x4 w; w.x = pk2(v0[0], v0[1]); w.y = pk2(v0[2], v0[3]); w.z = pk2(v1[0], v1[1]); w.w = pk2(v1[2], v1[3]);
                    *(u32x4*)(rowp + bj * 128) = w; } }
        pg8::zero_acc(acc);
    }
};
struct EpiDFT {
    static constexpr bool PERM = true;
    bf16* FO; int nseq; int row_base0;
    __device__ __forceinline__ void operator()(Acc& acc, const Unit& u, int wr, int wc, int fr, int fq) const {
        const int k0 = u.pm * 256 + wr * 64 + fr, b = (u.pn * 256) >> 9, ch0 = ((u.pn * 256) & 511) + wc * 32 + 8 * fq;
        bf16* base = FO + (size_t)(row_base0 + b * nseq + k0) * 512 + ch0;
#pragma unroll
        for (int ai = 0; ai < 2; ++ai)
#pragma unroll
            for (int m = 0; m < 4; ++m) { bf16* rowp = base + (size_t)(ai * 128 + m * 16) * 512;
#pragma unroll
                for (int bj = 0; bj < 2; ++bj) { const f32x4 v0 = acc[ai][bj][m][0], v1 = acc[ai][bj][m][1];
                    u32x4 w; w.x = pk2(v0[0], v0[1]); w.y = pk2(v0[2], v0[3]); w.z = pk2(v1[0], v1[1]); w.w = pk2(v1[2], v1[3]);
                    *(u32x4*)(rowp + bj * 128) = w; } }
        pg8::zero_acc(acc);
    }
};
struct EpiMerge {
    static constexpr bool PERM = true;
    const bf16* PROJ; bf16* MIXB; int row_off;
    __device__ __forceinline__ void operator()(Acc& acc, const Unit& u, int wr, int wc, int fr, int fq) const {
        const int row0 = row_off + u.pm * 256 + wr * 64 + fr, col0 = u.pn * 256 + wc * 32 + 8 * fq, seg = u.tag;
#pragma unroll
        for (int ai = 0; ai < 2; ++ai)
#pragma unroll
            for (int m = 0; m < 4; ++m) { const size_t row = (size_t)(row0 + ai * 128 + m * 16);
#pragma unroll
                for (int bj = 0; bj < 2; ++bj) { const int col = col0 + bj * 128;
                    const u32x4 ga = *(const u32x4*)(PROJ + row * NPROJ + C_GATE + seg * 1024 + col);
                    float f[8];
                    if (seg < 2) { const u32x4 gb = *(const u32x4*)(PROJ + row * NPROJ + C_GATE + (seg + 1) * 1024 + col);
#pragma unroll
                        for (int q = 0; q < 4; ++q) { const float a0 = bflo(ga[q]), a1 = bfhi(ga[q]), b0 = bflo(gb[q]), b1 = bfhi(gb[q]);
                            f[2 * q] = (1.0f + __builtin_amdgcn_exp2f(-b0 * LOG2E)) * __builtin_amdgcn_rcpf(1.0f + __builtin_amdgcn_exp2f(-a0 * LOG2E));
                            f[2 * q + 1] = (1.0f + __builtin_amdgcn_exp2f(-b1 * LOG2E)) * __builtin_amdgcn_rcpf(1.0f + __builtin_amdgcn_exp2f(-a1 * LOG2E)); }
                    } else {
#pragma unroll
                        for (int q = 0; q < 4; ++q) { f[2 * q] = sigmoidf_(bflo(ga[q])); f[2 * q + 1] = sigmoidf_(bfhi(ga[q])); }
                    }
                    f32x4 v0 = acc[ai][bj][m][0], v1 = acc[ai][bj][m][1];
                    v0 = v0 * (f32x4){f[0], f[1], f[2], f[3]}; v1 = v1 * (f32x4){f[4], f[5], f[6], f[7]};
                    if (seg < 2) { acc[ai][bj][m][0] = v0; acc[ai][bj][m][1] = v1; }
                    else { u32x4 w; w.x = pk2(v0[0], v0[1]); w.y = pk2(v0[2], v0[3]); w.z = pk2(v1[0], v1[1]); w.w = pk2(v1[2], v1[3]);
                        *(u32x4*)(MIXB + row * D + col) = w; acc[ai][bj][m][0] = (f32x4){0.f, 0.f, 0.f, 0.f}; acc[ai][bj][m][1] = (f32x4){0.f, 0.f, 0.f, 0.f}; } }
                asm volatile("" ::: "memory"); }
    }
};
struct EpiOut {
    static constexpr bool PERM = false;
    const float* base_ctx; const float* base_lat; float* XR; const float* mod2; int row_off;
    __device__ __forceinline__ void operator()(Acc& acc, const Unit& u, int wr, int wc, int fr, int fq) const {
        const int row0 = row_off + u.pm * 256 + wr * 64 + fr, col0 = u.pn * 256 + wc * 32 + 4 * fq;
        const int v = vec_of_row(row_off + u.pm * 256);
        f32x4 mv[2][2];
#pragma unroll
        for (int bj = 0; bj < 2; ++bj)
#pragma unroll
            for (int n = 0; n < 2; ++n) mv[bj][n] = *(const f32x4*)(mod2 + (size_t)v * 6144 + col0 + bj * 128 + n * 16);
#pragma unroll
        for (int ai = 0; ai < 2; ++ai)
#pragma unroll
            for (int m = 0; m < 4; ++m) { const int row = row0 + ai * 128 + m * 16;
                const float* bp = row < TC ? base_ctx + (size_t)row * D : base_lat + (size_t)(row - TC) * D; float* op = XR + (size_t)row * D;
#pragma unroll
                for (int bj = 0; bj < 2; ++bj)
#pragma unroll
                    for (int n = 0; n < 2; ++n) { const int c = col0 + bj * 128 + n * 16; *(f32x4*)(op + c) = *(const f32x4*)(bp + c) + mv[bj][n] * acc[ai][bj][m][n]; } }
        pg8::zero_acc(acc);
    }
};
struct EpiGU {
    static constexpr bool PERM = true;
    bf16* HID;
    __device__ __forceinline__ void operator()(Acc& acc, const Unit& u, int wr, int wc, int fr, int fq) const {
        const int row0 = u.pm * 256 + wr * 64 + fr, col0 = u.pn * 128 + wc * 32 + 8 * fq;
#pragma unroll
        for (int ai = 0; ai < 2; ++ai)
#pragma unroll
            for (int m = 0; m < 4; ++m) { float h[8];
#pragma unroll
                for (int n = 0; n < 2; ++n)
#pragma unroll
                    for (int j = 0; j < 4; ++j) { const float g = acc[ai][0][m][n][j], up = acc[ai][1][m][n][j]; h[4 * n + j] = siluf_(g) * up; }
                u32x4 w; w.x = pk2(h[0], h[1]); w.y = pk2(h[2], h[3]); w.z = pk2(h[4], h[5]); w.w = pk2(h[6], h[7]);
                *(u32x4*)(HID + (size_t)(row0 + ai * 128 + m * 16) * EH + col0) = w; }
        pg8::zero_acc(acc);
    }
};
struct EpiDown {
    static constexpr bool PERM = true;
    bf16* YE; const float* topw;
    __device__ __forceinline__ void operator()(Acc& acc, const Unit& u, int wr, int wc, int fr, int fq) const {
        const int row0 = u.pm * 256 + wr * 64 + fr, col0 = u.pn * 256 + wc * 32 + 8 * fq;
#pragma unroll
        for (int ai = 0; ai < 2; ++ai)
#pragma unroll
            for (int m = 0; m < 4; ++m) { const int row = row0 + ai * 128 + m * 16; const float tw = topw[row];
#pragma unroll
                for (int bj = 0; bj < 2; ++bj) { const f32x4 v0 = acc[ai][bj][m][0] * tw, v1 = acc[ai][bj][m][1] * tw;
                    u32x4 w; w.x = pk2(v0[0], v0[1]); w.y = pk2(v0[2], v0[3]); w.z = pk2(v1[0], v1[1]); w.w = pk2(v1[2], v1[3]);
                    *(u32x4*)(YE + (size_t)row * D + col0 + bj * 128) = w; } }
        pg8::zero_acc(acc);
    }
};

__device__ __forceinline__ void phase_inproj(Frame& F, int layer) {
    const char* HB = (const char*)(F.ws + WS_HB); const char* WT = (const char*)(F.ws + WS_WIN + layer * WIN_L);
    {
        SchedGrid S{TA / 256, NPROJ / 256, F.G, (int)blockIdx.x, HB, WT, (size_t)256 * D * 2, (size_t)256 * D * 2, 0, 0};
        EpiBf16 E{(bf16*)(F.ws + WS_PROJ), NPROJ};
        pg8::gemm_phase(F.lds, F.tid, D, S, E);
    }
    {
        SchedGrid S{4, TA / 256, F.G, (int)blockIdx.x, WT + (size_t)6144 * D * 2, HB, (size_t)256 * D * 2, (size_t)256 * D * 2, 0, 0};
        EpiGT E{(bf16*)(F.ws + WS_GT), (bf16*)(F.ws + WS_GTC)};
        pg8::gemm_phase(F.lds, F.tid, D, S, E);
    }
}

__device__ __forceinline__ void phase_rope(Frame& F, int layer) {
    const int gw = F.vcu * 8 + F.wave, NGW = F.G * 8, lane = F.lane, s = lane & 15, vq = lane >> 4;
    bf16* PROJ = (bf16*)(F.ws + WS_PROJ); const float* rc = (const float*)(F.ws + WS_ROPE); const float* rs = rc + SEQ * 32;
    const float qg0 = inp(F, IN_QN)[layer * 64 + 2 * s], qg1 = inp(F, IN_QN)[layer * 64 + 2 * s + 1], qg2 = inp(F, IN_QN)[layer * 64 + 32 + 2 * s], qg3 = inp(F, IN_QN)[layer * 64 + 33 + 2 * s];
    const float kg0 = inp(F, IN_KN)[layer * 64 + 2 * s], kg1 = inp(F, IN_KN)[layer * 64 + 2 * s + 1], kg2 = inp(F, IN_KN)[layer * 64 + 32 + 2 * s], kg3 = inp(F, IN_KN)[layer * 64 + 33 + 2 * s];
    for (int r = gw; r < TA; r += NGW) {
        const bool lat = r >= TC; const int pos = lat ? (r - TC) % SEQ : 0;
        float c0 = 1.f, c1 = 1.f, s0 = 0.f, s1 = 0.f;
        if (lat) { c0 = rc[pos * 32 + 2 * s]; c1 = rc[pos * 32 + 2 * s + 1]; s0 = rs[pos * 32 + 2 * s]; s1 = rs[pos * 32 + 2 * s + 1]; }
#pragma unroll
        for (int pass = 0; pass < 6; ++pass) {
            const int vi = pass * 4 + vq;
            const int col = vi < 4 ? C_RQ + vi * 64 : vi < 8 ? C_RK + (vi - 4) * 64 : vi < 16 ? C_DQ + (vi - 8) * 64 : C_DK + (vi - 16) * 64;
            bf16* p = PROJ + (size_t)r * NPROJ + col;
            const unsigned wa = *(const unsigned*)(p + 2 * s), wb = *(const unsigned*)(p + 32 + 2 * s);
            float a0 = bflo(wa), a1 = bfhi(wa), b0 = bflo(wb), b1 = bfhi(wb);
            if (vi >= 8) {
                float ss = a0 * a0 + a1 * a1 + b0 * b0 + b1 * b1;
                ss += __shfl_xor(ss, 1); ss += __shfl_xor(ss, 2); ss += __shfl_xor(ss, 4); ss += __shfl_xor(ss, 8);
                const float rinv = __builtin_amdgcn_rsqf(ss * (1.0f / 64.0f) + EPS);
                if (vi < 16) { a0 *= rinv * qg0; a1 *= rinv * qg1; b0 *= rinv * qg2; b1 *= rinv * qg3; }
                else { a0 *= rinv * kg0; a1 *= rinv * kg1; b0 *= rinv * kg2; b1 *= rinv * kg3; }
            } else if (vi < 4) { a0 *= 0.125f; a1 *= 0.125f; b0 *= 0.125f; b1 *= 0.125f; }
            float o0 = a0 * c0 - b0 * s0, o1 = a1 * c1 - b1 * s1, o2 = b0 * c0 + a0 * s0, o3 = b1 * c1 + a1 * s1;
            if (vi >= 8 && vi < 16) { const float k = 0.125f * LOG2E; o0 *= k; o1 *= k; o2 *= k; o3 *= k; }
            *(unsigned*)(p + 2 * s) = pk2(o0, o1); *(unsigned*)(p + 32 + 2 * s) = pk2(o2, o3);
        }
    }
}

namespace att {
constexpr int KPITCH = 144, VPITCH = 320, KC_BYTES = 64 * KPITCH, V_BYTES = 64 * VPITCH, BUF_BYTES = 2 * KC_BYTES + V_BYTES;
constexpr int SCR_OFF = 2 * BUF_BYTES;
constexpr int QW_OFF = SCR_OFF + 8 * 256;
__device__ __forceinline__ int crow(int r, int hi) { return (r & 3) + 8 * (r >> 2) + 4 * hi; }
__device__ __forceinline__ s16x4 vtr(const LAS unsigned char* p) { typedef short v4i16_t __attribute__((ext_vector_type(4))); return __builtin_bit_cast(s16x4, __builtin_amdgcn_ds_read_tr16_b64_v4i16((LAS v4i16_t*)p)); }

struct UnitDesc {
    int mode;
    int qrow0;
    int qpos0;
    int h;
    int krowA, ntA;
    int krowB, ntB;
    int kindB;
    int nseq;
    int outrow0;
    float lgf, lgb;
    float lam, scale_out;
};

__device__ __forceinline__ void unit(const Frame& F, const UnitDesc& u) {
    LAS unsigned char* lds = F.lds;
    const int tid = F.tid, lane = F.lane, wid = F.wave, r32 = lane & 31, hi = lane >> 5;
    const bf16* PROJ = (const bf16*)(F.ws + WS_PROJ);
    const bool diff = u.mode == 0;
    const int comp = diff ? (wid >> 2) : 0;
    const int qoff = diff ? 32 * (wid & 3) : 32 * wid;
    const int kcol = diff ? C_DK + u.h * 128 : C_RK + u.h * 64, vcol = diff ? C_DV + u.h * 128 : C_RV + u.h * 128;
    const int qcol = diff ? C_DQ + u.h * 128 + comp * 64 : C_RQ + u.h * 64;
    const int NT = u.ntA + u.ntB;
    bf16x8 qf[4];
    { const bf16* qp = PROJ + (size_t)(u.qrow0 + qoff + r32) * NPROJ + qcol + 8 * hi;
#pragma unroll
      for (int s = 0; s < 4; ++s) qf[s] = *(const bf16x8*)(qp + 16 * s); }
    f32x16 o[4];
#pragma unroll
    for (int d = 0; d < 4; ++d) o[d] = (f32x16){};
    float lsum = 0.f;
    u32x4 kreg[2], vreg[2];
    auto tile_row = [&](int t) { return t < u.ntA ? u.krowA + 64 * t : u.krowB + 64 * (t - u.ntA); };
    auto load_tile = [&](int t) {
        const int row0 = tile_row(t);
#pragma unroll
        for (int i = 0; i < 2; ++i) { const int cid = tid + 512 * i, key = cid >> 4, c16 = cid & 15;
            vreg[i] = *(const u32x4*)(PROJ + (size_t)(row0 + key) * NPROJ + vcol + c16 * 8);
            if (diff) kreg[i] = *(const u32x4*)(PROJ + (size_t)(row0 + key) * NPROJ + kcol + c16 * 8); }
        if (!diff) { const int key = tid >> 3, c8 = tid & 7; kreg[0] = *(const u32x4*)(PROJ + (size_t)(row0 + key) * NPROJ + kcol + c8 * 8); }
    };
    auto store_tile = [&](int buf) {
        LAS unsigned char* b = lds + buf * BUF_BYTES;
#pragma unroll
        for (int i = 0; i < 2; ++i) { const int cid = tid + 512 * i, key = cid >> 4, c16 = cid & 15;
            *(LAS u32x4*)(b + 2 * KC_BYTES + key * VPITCH + c16 * 16) = vreg[i];
            if (diff) *(LAS u32x4*)(b + (c16 >> 3) * KC_BYTES + key * KPITCH + (c16 & 7) * 16) = kreg[i]; }
        if (!diff) { const int key = tid >> 3, c8 = tid & 7; *(LAS u32x4*)(b + key * KPITCH + c8 * 16) = kreg[0]; }
    };
    load_tile(0); store_tile(0);
    __syncthreads();
    const int qpos = u.qpos0 + qoff + r32;
    for (int t = 0; t < NT; ++t) {
        if (t + 1 < NT) load_tile(t + 1);
        const LAS unsigned char* b = lds + (t & 1) * BUF_BYTES;
        const LAS unsigned char* kb = b + comp * KC_BYTES + r32 * KPITCH + hi * 16;
        u32x4 pw[4];
        const bool segB = t >= u.ntA; const int j0 = 64 * (segB ? t - u.ntA : t);
#pragma unroll
        for (int kh = 0; kh < 2; ++kh) {
            f32x16 sc = (f32x16){};
#pragma unroll
            for (int s = 0; s < 4; ++s) { const bf16x8 kf = *(const LAS bf16x8*)(kb + kh * 32 * KPITCH + s * 32); sc = __builtin_amdgcn_mfma_f32_32x32x16_bf16(kf, qf[s], sc, 0, 0, 0); }
            if (diff) {
#pragma unroll
                for (int r = 0; r < 16; ++r) sc[r] = __builtin_amdgcn_exp2f(sc[r]);
                float a = 0.f;
#pragma unroll
                for (int r = 0; r < 16; ++r) a += sc[r];
                lsum += a;
            } else if (!segB || u.kindB == 0) {
#pragma unroll
                for (int r = 0; r < 16; ++r) { const int d = qpos - (j0 + 32 * kh + crow(r, hi)); sc[r] *= __builtin_amdgcn_exp2f((float)d * (d >= 0 ? u.lgf : -u.lgb)); }
            } else {
#pragma unroll
                for (int r = 0; r < 16; ++r) { const int na = j0 + 32 * kh + crow(r, hi);
                    sc[r] *= __builtin_amdgcn_exp2f((float)(qpos + CTX - na) * u.lgf) + __builtin_amdgcn_exp2f((float)(u.nseq - qpos + na) * u.lgb); }
            }
            pw[2 * kh] = (u32x4){pk2(sc[0], sc[1]), pk2(sc[2], sc[3]), pk2(sc[4], sc[5]), pk2(sc[6], sc[7])};
            pw[2 * kh + 1] = (u32x4){pk2(sc[8], sc[9]), pk2(sc[10], sc[11]), pk2(sc[12], sc[13]), pk2(sc[14], sc[15])};
            __builtin_amdgcn_sched_barrier(0);
        }
        const LAS unsigned char* vb = b + 2 * KC_BYTES + (4 * hi + ((lane & 15) >> 2)) * VPITCH + ((lane >> 4) & 1) * 32 + (lane & 3) * 8;
        __builtin_amdgcn_sched_barrier(0);
#pragma unroll
        for (int dvb = 0; dvb < 4; ++dvb) {
#pragma unroll
            for (int ks = 0; ks < 4; ++ks) {
                const s16x4 lo = vtr(vb + ks * 16 * VPITCH + dvb * 64), hi4 = vtr(vb + ks * 16 * VPITCH + 8 * VPITCH + dvb * 64);
                const bf16x8 vf = (bf16x8){lo[0], lo[1], lo[2], lo[3], hi4[0], hi4[1], hi4[2], hi4[3]};
                o[dvb] = __builtin_amdgcn_mfma_f32_32x32x16_bf16(__builtin_bit_cast(bf16x8, pw[ks]), vf, o[dvb], 0, 0, 0);
            }
            __builtin_amdgcn_sched_barrier(0);
        }
        if (t + 1 < NT) store_tile((t + 1) & 1);
        __syncthreads();
    }
    LAS float* wsf = (LAS float*)(lds + SCR_OFF) + wid * 64;
    int lz = lane; asm volatile("" : "+v"(lz));
    const int r32e = lz & 31, hie = lz >> 5;
    if (diff) {
        lsum += __shfl_xor(lsum, 32);
        if (hie == 0) wsf[r32e] = __builtin_amdgcn_rcpf(lsum);
        LDS_WAIT();
        float rl[16];
#pragma unroll
        for (int r = 0; r < 16; ++r) rl[r] = wsf[crow(r, hie)];
        LAS float* XC = (LAS float*)lds;
        if (comp == 1) {
#pragma unroll
            for (int r = 0; r < 16; ++r) { const int q = qoff + crow(r, hie);
#pragma unroll
                for (int d = 0; d < 4; ++d) XC[q * 128 + 32 * d + r32e] = o[d][r] * rl[r] * u.lam; }
        }
        __syncthreads();
        if (comp == 0) {
            float ss[16];
#pragma unroll
            for (int r = 0; r < 16; ++r) { const int q = qoff + crow(r, hie); float a = 0.f;
#pragma unroll
                for (int d = 0; d < 4; ++d) { const float v = o[d][r] * rl[r] - XC[q * 128 + 32 * d + r32e]; o[d][r] = v; a += v * v; }
                ss[r] = a; }
#pragma unroll
            for (int r = 0; r < 16; ++r) { float a = ss[r]; a += __shfl_xor(a, 1); a += __shfl_xor(a, 2); a += __shfl_xor(a, 4); a += __shfl_xor(a, 8); a += __shfl_xor(a, 16);
                ss[r] = u.scale_out * __builtin_amdgcn_rsqf(a * (1.0f / 128.0f) + EPS); }
            bf16* DO = (bf16*)(F.ws + WS_FO + 2 * MIX_ONE);
#pragma unroll
            for (int r = 0; r < 16; ++r) { bf16* op = DO + (size_t)(u.outrow0 + qoff + crow(r, hie)) * 512 + u.h * 128 + r32e;
#pragma unroll
                for (int d = 0; d < 4; ++d) op[32 * d] = (bf16)f2bf(o[d][r] * ss[r]); }
        }
    } else {
        bf16* RO = (bf16*)(F.ws + WS_FO + 1 * MIX_ONE);
#pragma unroll
        for (int r = 0; r < 16; ++r) {
            float a = (o[0][r] + o[1][r]) + (o[2][r] + o[3][r]);
            a += __shfl_xor(a, 1); a += __shfl_xor(a, 2); a += __shfl_xor(a, 4); a += __shfl_xor(a, 8); a += __shfl_xor(a, 16);
            const float mu = a * (1.0f / 128.0f); float q = 0.f;
#pragma unroll
            for (int d = 0; d < 4; ++d) { const float v = o[d][r] - mu; o[d][r] = v; q += v * v; }
            q += __shfl_xor(q, 1); q += __shfl_xor(q, 2); q += __shfl_xor(q, 4); q += __shfl_xor(q, 8); q += __shfl_xor(q, 16);
            const float rstd = __builtin_amdgcn_rsqf(q * (1.0f / 128.0f) + EPS);
            const size_t row = (size_t)(u.outrow0 + qoff + crow(r, hie));
            const bf16* gp = PROJ + row * NPROJ + C_RG + u.h * 128 + r32e; bf16* op = RO + row * 512 + u.h * 128 + r32e;
#pragma unroll
            for (int d = 0; d < 4; ++d) { const float g = bf2f(gp[32 * d]); op[32 * d] = (bf16)f2bf(o[d][r] * rstd * siluf_(g)); }
        }
    }
    __syncthreads();
}
}

constexpr int NDFT_CU = 64;

__device__ __forceinline__ void phase_mixers(Frame& F, int layer, int rep) {
    const bool last = layer == DEPTH - 1;
#if !defined(ONLY_SUB) || ONLY_SUB == 1
    if ((int)blockIdx.x < NDFT_CU && F.G > NDFT_CU) {
        {
            SchedGrid S{SEQ / 256, 4096 / 256, NDFT_CU, (int)blockIdx.x, (const char*)(F.ws + WS_DFTL), (const char*)(F.ws + WS_GT), (size_t)256 * 4096 * 2, (size_t)256 * 4096 * 2, 0, 0};
            EpiDFT E{(bf16*)(F.ws + WS_FO), SEQ, TC};
            pg8::gemm_phase(F.lds, F.tid, 4096, S, E);
        }
        if (!last) {
            SchedGrid S{1, 4096 / 256, NDFT_CU, (int)blockIdx.x, (const char*)(F.ws + WS_DFTC), (const char*)(F.ws + WS_GTC), (size_t)256 * 512 * 2, (size_t)256 * 512 * 2, 0, 0};
            EpiDFT E{(bf16*)(F.ws + WS_FO), CTX, 0};
            pg8::gemm_phase(F.lds, F.tid, 512, S, E);
        }
        return;
    }
#endif
#if defined(ONLY_SUB) && ONLY_SUB == 1
    return;
#endif
    const int nunits = last ? 768 : 864;
    const float lam = lam_of(F, layer), so = 1.0f - lam_init_of(layer);
    unsigned* qctr = F.ctl + CW_QUEUE + 64 * (layer + 2 * rep);
    volatile LAS unsigned* qw = (volatile LAS unsigned*)(F.lds + att::QW_OFF);
    const bool solo = F.G <= NDFT_CU;
    (void)solo;
    for (;;) {
        if (F.tid == 0) *qw = __hip_atomic_fetch_add(qctr, 1u, RLX_AGENT);
        __syncthreads();
        const int i = (int)*qw;
        __syncthreads();
        if (i >= nunits) break;
        att::UnitDesc u{};
        u.lam = lam; u.scale_out = so;
        if (i < 512) { const int b = i >> 6, h = (i >> 4) & 3, qb = i & 15; u.mode = 0; u.h = h; u.qrow0 = TC + b * SEQ + qb * 128; u.qpos0 = qb * 128; u.krowA = TC + b * SEQ; u.ntA = 32; u.krowB = b * CTX; u.ntB = 4; }
        else if (i < 768) { const int j = i - 512, b = j >> 5, h = (j >> 3) & 3, qb = j & 7; u.mode = 1; u.h = h; u.qrow0 = TC + b * SEQ + qb * 256; u.qpos0 = qb * 256; u.krowA = TC + b * SEQ; u.ntA = 32; u.krowB = b * CTX; u.ntB = 4; u.kindB = 1; u.nseq = SEQ; }
        else if (i < 832) { const int j = i - 768, b = j >> 3, h = (j >> 1) & 3, qb = j & 1; u.mode = 0; u.h = h; u.qrow0 = b * CTX + qb * 128; u.qpos0 = qb * 128; u.krowA = b * CTX; u.ntA = 4; u.krowB = 0; u.ntB = 0; }
        else { const int j = i - 832, b = j >> 2, h = j & 3; u.mode = 1; u.h = h; u.qrow0 = b * CTX; u.qpos0 = 0; u.krowA = b * CTX; u.ntA = 4; u.krowB = 0; u.ntB = 0; u.kindB = 0; u.nseq = CTX; }
        u.outrow0 = u.qrow0;
        if (u.mode == 1) { u.lgf = inp(F, IN_RDEC)[(layer * 2 + 0) * 4 + u.h] * LOG2E; u.lgb = inp(F, IN_RDEC)[(layer * 2 + 1) * 4 + u.h] * LOG2E; }
        att::unit(F, u);
    }
}

__device__ __forceinline__ void phase_merge(Frame& F, int layer) {
    const int row_off = layer == DEPTH - 1 ? TC : 0, M = TA - row_off;
    SchedMerge S{M / 256, D / 256, F.G, (int)blockIdx.x, (const char*)(F.ws + WS_FO) + (size_t)row_off * 512 * 2, (const char*)(F.ws + WS_WFO + (size_t)layer * 3 * WMG_ONE), MIX_ONE, WMG_ONE, (size_t)256 * 512 * 2, (size_t)256 * 512 * 2};
    EpiMerge E{(const bf16*)(F.ws + WS_PROJ), (bf16*)(F.ws + WS_MIXB), row_off};
    pg8::gemm_phase(F.lds, F.tid, 512, S, E);
}
__device__ __forceinline__ void phase_outproj(Frame& F, int layer) {
    const int row_off = layer == DEPTH - 1 ? TC : 0, M = TA - row_off;
    SchedGrid S{M / 256, D / 256, F.G, (int)blockIdx.x, (const char*)(F.ws + WS_MIXB) + (size_t)row_off * D * 2, (const char*)(F.ws + WS_WOUT + layer * WOUT_L), (size_t)256 * D * 2, (size_t)256 * D * 2, 0, 0};
    const float* XR = (const float*)(F.ws + WS_XR);
    EpiOut E{layer == 0 ? inp(F, IN_CTX) : XR, layer == 0 ? inp(F, IN_X) : XR + (size_t)TC * D, (float*)(F.ws + WS_XR), (const float*)(F.ws + WS_MOD) + (size_t)layer * 9 * 6144 + 2 * 1024, row_off};
    pg8::gemm_phase(F.lds, F.tid, D, S, E);
}

__device__ __forceinline__ void phase_norm2(Frame& F, int layer) {
    const int gw = F.vcu * 8 + F.wave, NGW = F.G * 8, lane = F.lane, tid = F.tid;
    LAS float* wr_t = (LAS float*)F.lds;
    const float* wrt = inp(F, IN_WROUTER) + (size_t)layer * D * NE;
    for (int i = tid; i < D * NE; i += 512) { const int k = i >> 4, e = i & 15; wr_t[e * 1024 + k] = wrt[i]; }
    __syncthreads();
    const int r_lo = layer == DEPTH - 1 ? TC : 0;
    const float* XR = (const float*)(F.ws + WS_XR); bf16* HB = (bf16*)(F.ws + WS_HB); float* AFF = (float*)(F.ws + WS_AFF);
    for (int r = r_lo + gw; r < TA; r += NGW) {
        const int v = vec_of_row(r);
        f32x4 x[4];
#pragma unroll
        for (int j = 0; j < 4; ++j) x[j] = *(const f32x4*)(XR + (size_t)r * D + 4 * lane + 256 * j);
        float ss = 0.f;
#pragma unroll
        for (int j = 0; j < 4; ++j) ss += (x[j].x * x[j].x + x[j].y * x[j].y) + (x[j].z * x[j].z + x[j].w * x[j].w);
        const float rinv = __builtin_amdgcn_rsqf(wave_sum(ss) * (1.0f / D) + EPS);
        const float* g = inp(F, IN_GFFN) + (size_t)layer * D; const float* sh = mod_ptr(F, layer, v, 3); const float* scl = mod_ptr(F, layer, v, 4);
#pragma unroll
        for (int j = 0; j < 4; ++j) { const int k = 4 * lane + 256 * j; const f32x4 gv = *(const f32x4*)(g + k), sv = *(const f32x4*)(sh + k), cv = *(const f32x4*)(scl + k);
            x[j] = (x[j] * rinv * gv) * (cv + 1.0f) + sv;
            u32x2 w; w.x = pk2(x[j].x, x[j].y); w.y = pk2(x[j].z, x[j].w); *(u32x2*)(HB + (size_t)r * D + k) = w; }
        float mine = 0.f;
#pragma unroll 2
        for (int e = 0; e < 16; ++e) { float a = 0.f;
#pragma unroll
            for (int j = 0; j < 4; ++j) { const f32x4 w = *(const LAS f32x4*)(wr_t + e * 1024 + 4 * lane + 256 * j); a += (x[j].x * w.x + x[j].y * w.y) + (x[j].z * w.z + x[j].w * w.w); }
            a = wave_sum(a); mine = (lane == e) ? a : mine; }
        float mx = mine;
        mx = fmaxf(mx, __shfl_xor(mx, 1)); mx = fmaxf(mx, __shfl_xor(mx, 2)); mx = fmaxf(mx, __shfl_xor(mx, 4)); mx = fmaxf(mx, __shfl_xor(mx, 8));
        const float ex = __expf(mine - mx); float den = ex;
        den += __shfl_xor(den, 1); den += __shfl_xor(den, 2); den += __shfl_xor(den, 4); den += __shfl_xor(den, 8);
        if (lane < 16) AFF[(size_t)r * 16 + lane] = ex * __builtin_amdgcn_rcpf(den);
    }
    __syncthreads();
}

__device__ __forceinline__ void phase_topk(Frame& F, int layer) {
    const bool last = layer == DEPTH - 1; const int tid = F.tid, lane = F.lane;
    const int RPE = last ? 2048 : 2304, lat_off = last ? 0 : 256;
    LAS float* vals = (LAS float*)F.lds;
    LAS int* sel = (LAS int*)(F.lds + 8192);
    const float* AFF = (const float*)(F.ws + WS_AFF); int* INV = (int*)(F.ws + WS_INV); float* TOPW = (float*)(F.ws + WS_TOPW);
    const bf16* HB = (const bf16*)(F.ws + WS_HB); bf16* XS = (bf16*)(F.ws + WS_XS);
    const int nitems = last ? 256 : 384;
    for (int item = F.vcu; item < nitems; item += F.G) {
        int n, C, tokrow0, e, slot0, el0, nel;
        if (item < 256) { const int be = item >> 1, half = item & 1, b = be >> 4; e = be & 15; n = SEQ; C = 256; tokrow0 = TC + b * SEQ; slot0 = e * RPE + lat_off + b * 256; el0 = half * 1024; nel = 1024; }
        else { const int be = item - 256, b = be >> 4; e = be & 15; n = CTX; C = 32; tokrow0 = b * CTX; slot0 = e * RPE + b * 32; el0 = 0; nel = 256; }
        for (int k = tid; k < n; k += 512) vals[k] = AFF[(size_t)(tokrow0 + k) * 16 + e];
        __syncthreads();
        const int i0 = el0 + tid, i1 = i0 + 512; const bool act0 = tid < nel, act1 = (tid + 512) < nel;
        const float v0 = act0 ? vals[i0] : 0.f, v1 = act1 ? vals[i1] : 0.f;
        int c0 = 0, c1 = 0;
        for (int j4 = 0; j4 < n / 4; ++j4) { const f32x4 a = *(const LAS f32x4*)(vals + 4 * j4);
#pragma unroll
            for (int q = 0; q < 4; ++q) { const int j = 4 * j4 + q; const float aj = a[q];
                c0 += (aj > v0 || (aj == v0 && j < i0)) ? 1 : 0; c1 += (aj > v1 || (aj == v1 && j < i1)) ? 1 : 0; } }
        if (act0) { const int R = c0 < C ? slot0 + c0 : -1; sel[tid] = R; INV[(size_t)(tokrow0 + i0) * 16 + e] = R; if (R >= 0) TOPW[R] = v0; }
        if (act1) { const int R = c1 < C ? slot0 + c1 : -1; sel[tid + 512] = R; INV[(size_t)(tokrow0 + i1) * 16 + e] = R; if (R >= 0) TOPW[R] = v1; }
        __syncthreads();
        for (int li = F.wave; li < nel; li += 8) { const int R = sel[li];
            if (R >= 0) { const u32x4* src = (const u32x4*)(HB + (size_t)(tokrow0 + el0 + li) * D); u32x4* dst = (u32x4*)(XS + (size_t)R * D);
                const u32x4 a = src[lane], bq = src[lane + 64]; dst[lane] = a; dst[lane + 64] = bq; } }
        __syncthreads();
    }
}

__device__ __forceinline__ void phase_gateup(Frame& F, int layer) {
    const int RPE = layer == DEPTH - 1 ? 2048 : 2304;
    SchedGrid S{NE * RPE / 256, 4096 / 256, F.G, (int)blockIdx.x, (const char*)(F.ws + WS_XS), (const char*)(F.ws + WS_WGU), (size_t)256 * D * 2, (size_t)256 * D * 2, RPE / 256, WGU_E};
    EpiGU E{(bf16*)(F.ws + WS_HID)};
    pg8::gemm_phase(F.lds, F.tid, D, S, E);
}
__device__ __forceinline__ void phase_down(Frame& F, int layer) {
    const int RPE = layer == DEPTH - 1 ? 2048 : 2304;
    SchedGrid S{NE * RPE / 256, D / 256, F.G, (int)blockIdx.x, (const char*)(F.ws + WS_HID), (const char*)(F.ws + WS_WD), (size_t)256 * EH * 2, (size_t)256 * EH * 2, RPE / 256, WD_E};
    EpiDown E{(bf16*)(F.ws + WS_YE), (const float*)(F.ws + WS_TOPW)};
    pg8::gemm_phase(F.lds, F.tid, EH, S, E);
}

constexpr int NPHASE = 1 + 10 * DEPTH + 1;
__global__ void __launch_bounds__(512, 2) mk_fwd(Args args) {
    extern __shared__ __attribute__((aligned(16))) unsigned char lds_raw[];
    Frame F;
    F.lds = (LAS unsigned char*)lds_raw; F.MISC = (volatile LAS unsigned*)(F.lds + MISC_OFF);
    F.tid = threadIdx.x; F.lane = F.tid & 63; F.wave = __builtin_amdgcn_readfirstlane(F.tid >> 6);
    F.G = gridDim.x; { const int bx = blockIdx.x; F.vcu = (F.G % 8 == 0) ? (bx % 8) * (F.G / 8) + bx / 8 : bx; }
    F.ws = args.ws; F.ctl = (unsigned*)(args.ws + WS_CTL); F.out = args.out;
    for (int u = F.tid; u < (LDS_BYTES - LDSCTL_OFF) / 4; u += 512) ((LAS unsigned*)(F.lds + LDSCTL_OFF))[u] = 0u;
    __syncthreads();
    XcdBarrier bar; bar.bar = F.ctl + CW_BAR; bar.x = 0; bar.st = nullptr;
    const bool multi = (args.ph_hi - args.ph_lo) > 1;
    if (multi) bar = xcd_barrier_post(F.ctl + CW_BAR, F.MISC + 8);
    for (int ph = args.ph_lo; ph < args.ph_hi; ++ph) {
        const int layer = (ph - 1) / 10, k = (ph == 0) ? 10 : (ph == NPHASE - 1) ? 12 : (ph - 1) % 10;
        int reps = 1 + ((PROBE_MASK >> k) & 1);
        if (k == 0 && layer > 0 && (PROBE_MASK & 2048)) reps = 2;
        for (int rep = 0; rep < reps; ++rep) {
            { unsigned long long w = (unsigned long long)args.ws; asm volatile("" : "+s"(w)); F.ws = (unsigned char*)w; F.ctl = (unsigned*)(F.ws + WS_CTL); }
            { unsigned long long kp = (unsigned long long)__builtin_amdgcn_kernarg_segment_ptr(); asm volatile("" : "+s"(kp)); F.karg = (const void __attribute__((address_space(4)))*)kp; }
            { int l = (int)__builtin_amdgcn_mbcnt_hi(~0u, __builtin_amdgcn_mbcnt_lo(~0u, 0u)); asm volatile("" : "+v"(l)); F.lane = l; F.tid = F.wave * 64 + l; }
#ifdef ONLY_PHASE
            if (k != ONLY_PHASE) continue;
#endif
            switch (k) {
                case 10: phase_prologue(F); break;
                case 12: phase_norm(F, DEPTH); break;
                case 0: if (rep == 0) phase_norm(F, layer); if (layer > 0) convert_expert_weights(F, layer); break;
                case 1: phase_inproj(F, layer); break;
                case 2: if (rep == 0) phase_rope(F, layer); break;
                case 3: phase_mixers(F, layer, rep); break;
                case 4: phase_merge(F, layer); break;
                case 5: if (rep == 0) phase_outproj(F, layer); break;
                case 6: phase_norm2(F, layer); break;
                case 7: phase_topk(F, layer); break;
                case 8: phase_gateup(F, layer); break;
                default: phase_down(F, layer); break;
            }
            if (rep + 1 < reps || ph + 1 < args.ph_hi) xcd_barrier(bar);
        }
    }
}

extern "C" void kernel_launch(void* const* d_in, const int* in_sizes, int n_in, void* d_out, int out_size, void* d_ws, size_t ws_size, hipStream_t stream) {
    static int grid = 0;
    if (grid == 0) {
        if (n_in != 21 || out_size != TL * D || ws_size < WS_END) { fprintf(stderr, "kernel_launch: unexpected shapes (n_in %d, out %d, ws %zu need %zu)\n", n_in, out_size, ws_size, (size_t)WS_END); grid = -1; return; }
        int dev = 0, cus = 0, per_cu = 0;
        if (hipGetDevice(&dev) != hipSuccess || hipDeviceGetAttribute(&cus, hipDeviceAttributeMultiprocessorCount, dev) != hipSuccess) { grid = -1; return; }
        if (hipFuncSetAttribute((const void*)mk_fwd, hipFuncAttributeMaxDynamicSharedMemorySize, LDS_BYTES) != hipSuccess) { fprintf(stderr, "kernel_launch: hipFuncSetAttribute failed\n"); grid = -1; return; }
        if (hipOccupancyMaxActiveBlocksPerMultiprocessor(&per_cu, (const void*)mk_fwd, 512, LDS_BYTES) != hipSuccess || per_cu < 1) { fprintf(stderr, "kernel_launch: occupancy query says %d\n", per_cu); per_cu = 1; }
        (void)hipGetLastError();
        grid = cus * (per_cu >= 1 ? 1 : 1);
        if (grid % 8 != 0 || grid <= NDFT_CU) fprintf(stderr, "kernel_launch: unusual grid %d\n", grid);
    }
    if (grid < 0) return;
    (void)hipMemsetAsync((char*)d_ws + WS_CTL, 0, CTL_BYTES, stream);
    Args a{};
    for (int i = 0; i < 21; ++i) a.in[i] = (const float*)d_in[i];
    a.out = (float*)d_out; a.ws = (unsigned char*)d_ws;
#if MK_MULTI_LAUNCH
    for (int ph = 0; ph < NPHASE; ++ph) { a.ph_lo = ph; a.ph_hi = ph + 1; hipLaunchKernelGGL(mk_fwd, dim3(grid), dim3(512), LDS_BYTES, stream, a); }
#else
    a.ph_lo = 0; a.ph_hi = NPHASE;
    void* kargs[] = {&a};
    hipError_t e = hipLaunchCooperativeKernel((const void*)mk_fwd, dim3(grid), dim3(512), kargs, LDS_BYTES, stream);
    if (e != hipSuccess) fprintf(stderr, "kernel_launch: cooperative launch failed: %s (grid %d)\n", hipGetErrorString(e), grid);
#endif
}
```

```cpp
#include <hip/hip_runtime.h>
#include <cstdio>
#include <cstdint>

#ifndef PROBE_MASK
#define PROBE_MASK 0
#endif
#ifndef MK_MULTI_LAUNCH
#define MK_MULTI_LAUNCH 0
#endif

#define GAS __attribute__((address_space(1)))
#define LAS __attribute__((address_space(3)))
typedef unsigned short bf16;
typedef short bf16x8 __attribute__((ext_vector_type(8)));
typedef short s16x4 __attribute__((ext_vector_type(4)));
typedef float f32x4 __attribute__((ext_vector_type(4)));
typedef float f32x16 __attribute__((ext_vector_type(16)));
typedef unsigned u32x4 __attribute__((ext_vector_type(4)));
typedef unsigned u32x2 __attribute__((ext_vector_type(2)));
typedef float f32x2_t __attribute__((ext_vector_type(2)));
typedef __bf16 bf16x2_t __attribute__((ext_vector_type(2)));

constexpr int D = 1024, NB = 8, SEQ = 2048, CTX = 256, DEPTH = 2, GRIDW = 64;
constexpr int TC = NB * CTX, TL = NB * SEQ, TA = TC + TL;
constexpr int NPROJ = 6144;
constexpr int C_RQ = 0, C_RK = 256, C_RV = 512, C_RG = 1024, C_DQ = 1536, C_DK = 2048, C_DV = 2560, C_GATE = 3072;
constexpr int INW = 6656;
constexpr int NE = 16, EH = 2048;
constexpr float EPS = 1e-6f;
constexpr float LOG2E = 1.4426950408889634f;

constexpr size_t al(size_t x) { return (x + 0xFFFFFull) & ~0xFFFFFull; }
constexpr size_t WS_CTL = 0, CTL_BYTES = 1u << 20;
constexpr size_t WS_MOD = WS_CTL + CTL_BYTES;
constexpr size_t WS_ROPE = WS_MOD + al((size_t)DEPTH * 9 * 6 * D * 4);
constexpr size_t WS_AFF = WS_ROPE + al((size_t)2 * SEQ * 32 * 4);
constexpr size_t WS_INV = WS_AFF + al((size_t)TA * 16 * 4);
constexpr size_t WS_TOPW = WS_INV + al((size_t)TA * 16 * 4);
constexpr size_t WS_WIN = WS_TOPW + al((size_t)36864 * 4);
constexpr size_t WIN_L = (size_t)7168 * 1024 * 2;
constexpr size_t WS_WFO = WS_WIN + al(2 * WIN_L);
constexpr size_t WMG_ONE = (size_t)1024 * 512 * 2;
constexpr size_t WS_WOUT = WS_WFO + al(6 * WMG_ONE);
constexpr size_t WOUT_L = (size_t)1024 * 1024 * 2;
constexpr size_t WS_WGU = WS_WOUT + al(2 * WOUT_L);
constexpr size_t WGU_E = (size_t)4096 * 1024 * 2;
constexpr size_t WS_WD = WS_WGU + al(16 * WGU_E);
constexpr size_t WD_E = (size_t)1024 * 2048 * 2;
constexpr size_t WS_DFTL = WS_WD + al(16 * WD_E);
constexpr size_t WS_DFTC = WS_DFTL + al((size_t)2048 * 4096 * 2);
constexpr size_t WS_XR = WS_DFTC + al((size_t)256 * 512 * 2);
constexpr size_t WS_HB = WS_XR + al((size_t)TA * D * 4);
constexpr size_t WS_PROJ = WS_HB + al((size_t)TA * D * 2);
constexpr size_t WS_GT = WS_PROJ + al((size_t)TA * NPROJ * 2);
constexpr size_t WS_GTC = WS_GT + al((size_t)4096 * 4096 * 2);
constexpr size_t WS_FO = WS_GTC + al((size_t)4096 * 512 * 2);
constexpr size_t MIX_ONE = (size_t)TA * 512 * 2;
constexpr size_t WS_MIXB = WS_FO + al(3 * MIX_ONE);
constexpr size_t WS_XS = WS_MIXB + al((size_t)TA * D * 2);
constexpr size_t WS_END = WS_XS + al((size_t)36864 * D * 2);
constexpr size_t WS_HID = WS_PROJ;
constexpr size_t WS_YE = WS_XS;
static_assert((size_t)36864 * EH * 2 <= (size_t)TA * NPROJ * 2, "HID overlays PROJ");
static_assert(WS_END <= (size_t)1024 * 1024 * 1024, "workspace map must fit 1 GiB");

constexpr int CW_BAR = 4096;
constexpr int CW_QUEUE = 16384;

constexpr int RING_BYTES = 131072;
constexpr int LDSCTL_OFF = RING_BYTES, MISC_OFF = LDSCTL_OFF + 320;
constexpr int LDS_BYTES = 147456;

#define RLX_AGENT __ATOMIC_RELAXED, __HIP_MEMORY_SCOPE_AGENT
#define LDS_WAIT() asm volatile("s_waitcnt lgkmcnt(0)" ::: "memory")
#define VM_WAIT() asm volatile("s_waitcnt vmcnt(0)" ::: "memory")
__device__ __forceinline__ unsigned f2bf(float f) { unsigned u = __builtin_bit_cast(unsigned, f); return (u + 0x7fffu + ((u >> 16) & 1u)) >> 16; }
__device__ __forceinline__ unsigned pk2(float lo, float hi) { f32x2_t v = {lo, hi}; bf16x2_t b = __builtin_convertvector(v, bf16x2_t); return __builtin_bit_cast(unsigned, b); }
__device__ __forceinline__ float bflo(unsigned w) { return __builtin_bit_cast(float, w << 16); }
__device__ __forceinline__ float bfhi(unsigned w) { return __builtin_bit_cast(float, w & 0xffff0000u); }
__device__ __forceinline__ float bf2f(bf16 h) { return __builtin_bit_cast(float, (unsigned)h << 16); }
__device__ __forceinline__ float wave_sum(float v) {
#pragma unroll
    for (int o = 1; o < 64; o <<= 1) v += __shfl_xor(v, o);
    return v;
}
__device__ __forceinline__ float sigmoidf_(float x) { return __builtin_amdgcn_rcpf(1.0f + __builtin_amdgcn_exp2f(-x * LOG2E)); }
__device__ __forceinline__ float siluf_(float x) { return x * sigmoidf_(x); }

namespace pg8 {
constexpr int BM = 256, BK = 64, HALF = 128, HTB = HALF * BK * 2, STAGE_BYTES = 8 * HTB, NXCD = 8, WGM = 8;
__host__ __device__ __forceinline__ int lds_byte(int r, int c) { const int st = (r >> 4) * 2 + (c >> 5), rr = r & 15, cc = c & 31, ob = rr * 64 + cc * 2; return st * 1024 + (ob ^ (((ob >> 9) & 1) << 5)); }
__host__ __device__ __forceinline__ void stage_rc(int b, int& R, int& C) { const int st = b / 1024, sb = b % 1024, swz = sb ^ (((sb >> 9) & 1) << 5); R = (st >> 1) * 16 + swz / 64; C = (st & 1) * 32 + (swz % 64) / 2; }
__host__ __device__ __forceinline__ int perm32(int rho) { const int n = rho >> 4, i = rho & 15; return 8 * (i >> 2) + 4 * n + (i & 3); }

struct Unit { int pm, pn, tag; const char* A; const char* B; };

__device__ __forceinline__ bool grid_order(long L, int nM, int nN, int& pm, int& pn) {
    const int nwg = nM * nN; if (L >= nwg) return false;
    int wgid = (int)L; { const int q = nwg / NXCD, r = nwg % NXCD, xcd = wgid % NXCD, off = wgid / NXCD; wgid = (xcd < r ? xcd * (q + 1) : r * (q + 1) + (xcd - r) * q) + off; }
    const int nig = WGM * nN, gid = wgid / nig, fm = gid * WGM, gsz = (nM - fm) < WGM ? (nM - fm) : WGM;
    pm = fm + ((wgid % nig) % gsz); pn = (wgid % nig) / gsz; return true;
}

typedef f32x4 Acc[2][2][4][2];
__device__ __forceinline__ void zero_acc(Acc& acc) {
#pragma unroll
    for (int a = 0; a < 2; ++a)
#pragma unroll
        for (int b = 0; b < 2; ++b)
#pragma unroll
            for (int m = 0; m < 4; ++m)
#pragma unroll
                for (int n = 0; n < 2; ++n) acc[a][b][m][n] = (f32x4){0.f, 0.f, 0.f, 0.f};
}

template <class Epi, class Sched>
__device__ __forceinline__ void gemm_phase(LAS unsigned char* lds, const int tid, const int K, const Sched& S, const Epi& E) {
    const int wid = __builtin_amdgcn_readfirstlane(tid >> 6), lane = tid & 63, wr = wid >> 2, wc = wid & 3, fr = lane & 15, fq = lane >> 4;
    const int nt = K / BK;
    unsigned voffA[2], voffB[2];
#pragma unroll
    for (int i = 0; i < 2; ++i) { int R, C; stage_rc(tid * 16 + i * 8192, R, C); const int Rb = Epi::PERM ? ((R & ~31) + perm32(R & 31)) : R;
        voffA[i] = (unsigned)(R * K + C) * 2u; voffB[i] = (unsigned)(Rb * K + C) * 2u; }
    const size_t kstep = (size_t)(BK * 2);
    const size_t hstep = (size_t)HALF * K * 2;
    const unsigned ldsw = (unsigned)wid * 1024u;
    const int aoff = lds_byte(wr * 64 + fr, fq * 8), boff = lds_byte(wc * 32 + fr, fq * 8);
#define PG8_SA(b, h) (((b) * 2 + (h)) * HTB)
#define PG8_SB(b, h) ((4 + (b) * 2 + (h)) * HTB)
#define PG8_STAGE(bufoff, gbase, voff) do { _Pragma("unroll") for (int _i = 0; _i < 2; ++_i) \
        __builtin_amdgcn_global_load_lds((const unsigned*)((const char*)(gbase) + (voff)[_i]), (LAS unsigned*)(lds + (bufoff) + ldsw + _i * 8192), 16, 0, 0); } while (0)
#define PG8_LDA(dst, b, h) do { _Pragma("unroll") for (int m = 0; m < 4; ++m) _Pragma("unroll") for (int k = 0; k < 2; ++k) dst[m][k] = *(const LAS bf16x8*)(lds + PG8_SA(b, h) + aoff + m * 2048 + k * 1024); } while (0)
#define PG8_LDB(dst, b, h) do { _Pragma("unroll") for (int n = 0; n < 2; ++n) _Pragma("unroll") for (int k = 0; k < 2; ++k) dst[n][k] = *(const LAS bf16x8*)(lds + PG8_SB(b, h) + boff + n * 2048 + k * 1024); } while (0)
#define PG8_MMA(ai, bj, At, Bt) do { __builtin_amdgcn_s_setprio(1); _Pragma("unroll") for (int m = 0; m < 4; ++m) _Pragma("unroll") for (int n = 0; n < 2; ++n) _Pragma("unroll") for (int k = 0; k < 2; ++k) \
        acc[ai][bj][m][n] = __builtin_amdgcn_mfma_f32_16x16x32_bf16(Bt[n][k], At[m][k], acc[ai][bj][m][n], 0, 0, 0); __builtin_amdgcn_s_setprio(0); } while (0)
#define PG8_WAIT_V(n) asm volatile("s_waitcnt vmcnt(" #n ")" ::: "memory")
#define PG8_WAIT_L(n) asm volatile("s_waitcnt lgkmcnt(" #n ")" ::: "memory")
#define PG8_BAR __builtin_amdgcn_s_barrier()
#define PG8_SCHED __builtin_amdgcn_sched_barrier(0)
    Unit cur, nxt; int ui = 0;
    if (!S.next(0, cur)) return;
    Acc acc; zero_acc(acc);
    bf16x8 At[4][2], B0[2][2], B1[2][2];
    const char* cA = cur.A; const char* cB = cur.B;
    PG8_STAGE(PG8_SB(0, 0), cB, voffB); PG8_STAGE(PG8_SB(0, 1), cB + hstep, voffB); PG8_STAGE(PG8_SA(0, 0), cA, voffA); PG8_STAGE(PG8_SA(0, 1), cA + hstep, voffA);
    if (wr == 1) PG8_BAR;
    PG8_WAIT_V(2); PG8_BAR;
    PG8_STAGE(PG8_SB(1, 0), cB + kstep, voffB); PG8_STAGE(PG8_SA(1, 0), cA + kstep, voffA); PG8_STAGE(PG8_SB(1, 1), cB + hstep + kstep, voffB);
    PG8_WAIT_V(6); PG8_BAR;
    for (;;) {
        const bool has_next = S.next(ui + 1, nxt);
        const char* nA = has_next ? nxt.A : cA; const char* nB = has_next ? nxt.B : cB;
        for (int t = 0; t < nt; t += 2) {
            const bool last = (t == nt - 2);
            const char* a1 = cA + (size_t)(t + 1) * kstep;
            const char* a2 = last ? nA : cA + (size_t)(t + 2) * kstep; const char* b2 = last ? nB : cB + (size_t)(t + 2) * kstep;
            const char* a3 = a2 + kstep; const char* b3 = b2 + kstep;
            PG8_LDB(B0, 0, 0); PG8_LDB(B1, 0, 1); PG8_SCHED; PG8_LDA(At, 0, 0); PG8_STAGE(PG8_SA(1, 1), a1 + hstep, voffA);
            PG8_WAIT_V(8); PG8_WAIT_L(0); PG8_BAR; PG8_MMA(0, 0, At, B0); PG8_MMA(0, 1, At, B1); PG8_BAR; PG8_SCHED;
            PG8_LDA(At, 0, 1); PG8_STAGE(PG8_SB(0, 0), b2, voffB); PG8_STAGE(PG8_SB(0, 1), b2 + hstep, voffB); PG8_STAGE(PG8_SA(0, 0), a2, voffA);
            PG8_WAIT_V(8); PG8_WAIT_L(0); PG8_BAR; PG8_MMA(1, 0, At, B0); PG8_MMA(1, 1, At, B1); PG8_BAR; PG8_SCHED;
            PG8_LDB(B0, 1, 0); PG8_LDB(B1, 1, 1); PG8_SCHED; PG8_LDA(At, 1, 0); PG8_STAGE(PG8_SA(0, 1), a2 + hstep, voffA);
            PG8_WAIT_V(8); PG8_WAIT_L(0); PG8_BAR; PG8_MMA(0, 0, At, B0); PG8_MMA(0, 1, At, B1); PG8_BAR; PG8_SCHED;
            PG8_LDA(At, 1, 1); PG8_STAGE(PG8_SB(1, 0), b3, voffB); PG8_STAGE(PG8_SB(1, 1), b3 + hstep, voffB); PG8_STAGE(PG8_SA(1, 0), a3, voffA);
            PG8_WAIT_V(8); PG8_WAIT_L(0); PG8_BAR; PG8_MMA(1, 0, At, B0); PG8_MMA(1, 1, At, B1); PG8_BAR; PG8_SCHED;
        }
        if (wr == 0) PG8_BAR;
        E(acc, cur, wr, wc, fr, fq);
        if (!has_next) break;
        cur = nxt; cA = nA; cB = nB; ++ui;
        if (wr == 1) PG8_BAR;
    }
    PG8_WAIT_V(0);
    PG8_BAR;
#undef PG8_SA
#undef PG8_SB
#undef PG8_STAGE
#undef PG8_LDA
#undef PG8_LDB
#undef PG8_MMA
#undef PG8_WAIT_V
#undef PG8_WAIT_L
#undef PG8_BAR
#undef PG8_SCHED
}
}

#define XB_TMO      128
#define XB_XCNT(j)  (256  + 64 * (j))
#define XB_XSUB(j)  (1280 + 64 * (j))
#define XB_XGEN(j)  (2304 + 64 * (j))
#define XB_TOP      3328
#define XB_TOPGEN   3392
#define XCD_BAR_WORDS 3456
#define XB_SPIN_CAP (1u << 22)
__device__ __forceinline__ unsigned xb_ld(unsigned* p)              { return __hip_atomic_load(p, __ATOMIC_RELAXED, __HIP_MEMORY_SCOPE_AGENT); }
__device__ __forceinline__ unsigned xb_add(unsigned* p, unsigned v) { return __hip_atomic_fetch_add(p, v, __ATOMIC_RELAXED, __HIP_MEMORY_SCOPE_AGENT); }
__device__ __forceinline__ unsigned xb_xcc_id() { return (unsigned)__builtin_amdgcn_s_getreg((3 << 11) | 20) & 0xFu; }
#define XB_SPIN(cond, bar) do { unsigned _sp = 0; while (cond) { __builtin_amdgcn_s_sleep(1); \
    if ((++_sp & 255u) == 0u) { if (xb_ld(&(bar)[XB_TMO])) break; if (_sp > XB_SPIN_CAP) { atomicAdd(&(bar)[XB_TMO], 1u); break; } } } } while (0)
struct XcdBarrier { unsigned* bar; unsigned x; volatile LAS unsigned* st; };
__device__ __forceinline__ XcdBarrier xcd_barrier_post(unsigned* bar, volatile LAS unsigned* st) {
    XcdBarrier b; b.bar = bar; b.x = xb_xcc_id(); b.st = st;
    if (threadIdx.x == 0) (void)xb_add(&bar[XB_XCNT(b.x)], 1u);
    return b;
}
__device__ __forceinline__ void xcd_barrier_complete(unsigned* bar, unsigned x, unsigned& nloc, unsigned& nx) {
    const unsigned G = gridDim.x * gridDim.y * gridDim.z;
    unsigned sum, cnt, mine, sp = 0u;
    for (;;) {
        sum = 0u; cnt = 0u; mine = 0u;
#pragma unroll
        for (unsigned j = 0; j < 16; ++j) { const unsigned c = xb_ld(&bar[XB_XCNT(j)]); sum += c; cnt += (c > 0u) ? 1u : 0u; mine = (j == x) ? c : mine; }
        if (sum == G) break;
        __builtin_amdgcn_s_sleep(1);
        if ((++sp & 255u) == 0u) { if (xb_ld(&bar[XB_TMO])) break; if (sp > XB_SPIN_CAP) { atomicAdd(&bar[XB_TMO], 1u); break; } }
    }
    nloc = mine > 0u ? mine : 1u; nx = cnt > 0u ? cnt : 1u;
}
__device__ __forceinline__ void xcd_barrier(const XcdBarrier& b) {
    asm volatile("s_waitcnt vmcnt(0)" ::: "memory");
    __syncthreads();
    if (threadIdx.x == 0) {
        unsigned* bar = b.bar;
        __builtin_amdgcn_s_waitcnt(0);
        unsigned nloc = b.st[0], nx = b.st[1];
        if (nloc == 0u) { xcd_barrier_complete(bar, b.x, nloc, nx); b.st[0] = nloc; b.st[1] = nx; }
        const unsigned old = xb_add(&bar[XB_XSUB(b.x)], 1u);
        const unsigned gen = old / nloc;
        if (old + 1u == (gen + 1u) * nloc) {
            __builtin_amdgcn_fence(__ATOMIC_RELEASE, "agent");
            asm volatile("s_waitcnt vmcnt(0)" ::: "memory");
            const unsigned og = xb_add(&bar[XB_TOP], 1u);
            const unsigned tg = og / nx;
            if (og + 1u == (tg + 1u) * nx) xb_add(&bar[XB_TOPGEN], 1u);
            else XB_SPIN(xb_ld(&bar[XB_TOPGEN]) == tg, bar);
            __builtin_amdgcn_fence(__ATOMIC_ACQUIRE, "agent");
            xb_add(&bar[XB_XGEN(b.x)], 1u);
            asm volatile("s_waitcnt vmcnt(0)" ::: "memory");
        } else {
            XB_SPIN(xb_ld(&bar[XB_XGEN(b.x)]) == gen, bar);
            __builtin_amdgcn_fence(__ATOMIC_ACQUIRE, "agent");
            asm volatile("s_waitcnt vmcnt(0)" ::: "memory");
        }
    }
    __syncthreads();
}

struct Args { const float* in[21]; float* out; unsigned char* ws; int ph_lo, ph_hi; };
struct Frame {
    LAS unsigned char* lds; volatile LAS unsigned* MISC; unsigned* ctl;
    int tid, lane, wave, vcu, G;
    const void __attribute__((address_space(4)))* karg; float* out; unsigned char* ws;
};
__device__ __forceinline__ const float* inp(const Frame& F, int i) { return ((const float* const __attribute__((address_space(4)))*)F.karg)[i]; }
#define IN_X 0
#define IN_C 1
#define IN_CTX 2
#define IN_CCTX 3
#define IN_WMOD 4
#define IN_BMOD 5
#define IN_GATTN 6
#define IN_GFFN 7
#define IN_WIN 8
#define IN_RDEC 9
#define IN_QN 10
#define IN_KN 11
#define IN_LAMBDA 12
#define IN_WFO 13
#define IN_WRO 14
#define IN_WDO 15
#define IN_WOUT 16
#define IN_WROUTER 17
#define IN_WEG 18
#define IN_WEU 19
#define IN_WED 20

__device__ __forceinline__ int vec_of_row(int r) { return r < TC ? 8 : (r - TC) / SEQ; }
__device__ __forceinline__ const float* mod_ptr(const Frame& F, int layer, int v, int i) { return (const float*)(F.ws + WS_MOD) + ((size_t)(layer * 9 + v) * 6 + i) * D; }
__device__ __forceinline__ float lam_init_of(int layer) { return layer == 0 ? 0.2f : 0.8f - 0.6f * 0.74081822068171788f; }
__device__ __forceinline__ float lam_of(const Frame& F, int layer) {
    const float* L = inp(F, IN_LAMBDA) + (size_t)layer * 4 * 64; float s1 = 0.f, s2 = 0.f;
    for (int i = 0; i < 64; ++i) { s1 += L[i] * L[64 + i]; s2 += L[128 + i] * L[192 + i]; }
    return __expf(s1) - __expf(s2) + lam_init_of(layer);
}

__device__ __forceinline__ void transpose_item(const float* W, int ldw, int K, int k0, int n0src, bf16* WT, int dst_row0, LAS float* scr, int lane) {
#pragma unroll 8
    for (int i = 0; i < 32; ++i) { const int kk = 2 * i + (lane >> 5); scr[kk * 33 + (lane & 31)] = W[(size_t)(k0 + kk) * ldw + n0src + (lane & 31)]; }
    LDS_WAIT(); asm volatile("" ::: "memory");
    const int c = lane & 7;
#pragma unroll
    for (int j = 0; j < 4; ++j) { const int n = (lane >> 3) + 8 * j; const LAS float* s = scr + (8 * c) * 33 + n;
        u32x4 o; o.x = pk2(s[0 * 33], s[1 * 33]); o.y = pk2(s[2 * 33], s[3 * 33]); o.z = pk2(s[4 * 33], s[5 * 33]); o.w = pk2(s[6 * 33], s[7 * 33]);
        *(u32x4*)(WT + (size_t)(dst_row0 + n) * K + k0 + 8 * c) = o; }
    LDS_WAIT(); asm volatile("" ::: "memory");
}
template <class RowMap>
__device__ __forceinline__ void transpose_matrix(Frame& F, const float* W, int ldw, int csrc, int K, int N, bf16* WT, RowMap map, int& item_base) {
    LAS float* scr = (LAS float*)(F.lds + F.wave * 16384);
    const int gw = F.vcu * 8 + F.wave, NGW = F.G * 8;
    const int nblk = N / 32, nitems = (K / 64) * nblk;
    int start = (gw - item_base % NGW + NGW) % NGW;
    for (int it = start; it < nitems; it += NGW) { const int kb = it / nblk, nb = it % nblk; transpose_item(W, ldw, K, 64 * kb, csrc + 32 * nb, WT, map(32 * nb), scr, F.lane); }
    item_base += nitems;
}
struct MapId { int off; __device__ int operator()(int n) const { return off + n; } };
struct MapGU { int up; __device__ int operator()(int n) const { return (n >> 7) * 256 + up * 128 + (n & 127); } };

__device__ __forceinline__ void convert_expert_weights(Frame& F, int layer) {
    int base = 0;
    for (int e = 0; e < NE; ++e) {
        const float* wg = inp(F, IN_WEG) + ((size_t)layer * NE + e) * D * EH; const float* wu = inp(F, IN_WEU) + ((size_t)layer * NE + e) * D * EH; const float* wd = inp(F, IN_WED) + ((size_t)layer * NE + e) * EH * D;
        bf16* gu = (bf16*)(F.ws + WS_WGU + e * WGU_E); bf16* dn = (bf16*)(F.ws + WS_WD + e * WD_E);
        transpose_matrix(F, wg, EH, 0, D, EH, gu, MapGU{0}, base);
        transpose_matrix(F, wu, EH, 0, D, EH, gu, MapGU{1}, base);
        transpose_matrix(F, wd, D, 0, EH, D, dn, MapId{0}, base);
    }
}

__device__ __forceinline__ void phase_prologue(Frame& F) {
    const int tid = F.tid;
    {
        LAS float* sc = (LAS float*)F.lds;
        LAS float* red = sc + 9 * 1024;
        for (int i = tid; i < 9 * 1024; i += 512) { const int v = i >> 10, k = i & 1023; const float c = v < 8 ? inp(F, IN_C)[v * D + k] : inp(F, IN_CCTX)[k]; sc[i] = siluf_(c); }
        __syncthreads();
        for (int item = F.vcu; item < DEPTH * 96; item += F.G) {
            const int layer = item / 96, cb = item % 96, col = cb * 64 + (tid & 63), kg = tid >> 6;
            const float* w = inp(F, IN_WMOD) + (size_t)layer * D * 6144 + col;
            float a[9];
#pragma unroll
            for (int v = 0; v < 9; ++v) a[v] = 0.f;
#pragma unroll 4
            for (int kk = 0; kk < 128; ++kk) { const int k = kg * 128 + kk; const float wv = w[(size_t)k * 6144];
#pragma unroll
                for (int v = 0; v < 9; ++v) a[v] += sc[v * 1024 + k] * wv; }
#pragma unroll
            for (int v = 0; v < 9; ++v) red[(kg * 64 + (tid & 63)) * 9 + v] = a[v];
            __syncthreads();
            for (int o = tid; o < 64 * 9; o += 512) { const int cc = o / 9, v = o % 9; float s = 0.f;
                for (int g = 0; g < 8; ++g) s += red[(g * 64 + cc) * 9 + v];
                const int colo = cb * 64 + cc;
                ((float*)(F.ws + WS_MOD))[(size_t)(layer * 9 + v) * 6144 + colo] = s + inp(F, IN_BMOD)[layer * 6144 + colo]; }
            __syncthreads();
        }
    }
    {
        const int gt = F.vcu * 512 + tid, NT = F.G * 512;
        float* rc = (float*)(F.ws + WS_ROPE); float* rs = rc + SEQ * 32;
        for (int i = gt; i < SEQ * 32; i += NT) { const int pos = i >> 5, f = i & 31; const float inv = __builtin_amdgcn_exp2f(-(float)(f & 15) * (13.287712379549449f / 16.0f));
            const float p = (f < 16) ? (float)(pos / GRIDW) : (float)(pos % GRIDW); const float ang = p * inv; rc[i] = __builtin_amdgcn_cosf(ang * 0.15915494309189535f); rs[i] = __builtin_amdgcn_sinf(ang * 0.15915494309189535f); }
        LAS float* ct = (LAS float*)F.lds;
        __syncthreads();
        for (int m = tid; m < 2048; m += 512) ct[m] = __builtin_amdgcn_cosf((float)m * (1.0f / 2048.0f));
        __syncthreads();
        bf16* dl = (bf16*)(F.ws + WS_DFTL); const float sl = 0.022097086912079608f;
        for (int i = gt; i < 2048 * 2048; i += NT) {
            const int k = i >> 11, n = i & 2047, m = (k * n) & 2047; const float c = ct[m], s = ct[(m - 512) & 2047];
            dl[(size_t)k * 4096 + n] = (bf16)f2bf(c * sl); dl[(size_t)k * 4096 + 2048 + n] = (bf16)f2bf(-s * sl); }
        bf16* dc = (bf16*)(F.ws + WS_DFTC);
        for (int i = gt; i < 256 * 256; i += NT) { const int k = i >> 8, n = i & 255, m = ((k * n) & 255) * 8; const float c = ct[m], s = ct[(m - 512) & 2047];
            dc[(size_t)k * 512 + n] = (bf16)f2bf(c * 0.0625f); dc[(size_t)k * 512 + 256 + n] = (bf16)f2bf(-s * 0.0625f); }
        for (int layer = 0; layer < DEPTH; ++layer) {
            const float* win = inp(F, IN_WIN) + (size_t)layer * D * INW; bf16* wt = (bf16*)(F.ws + WS_WIN + layer * WIN_L) + (size_t)6144 * 1024;
            for (int i = gt; i < 1024 * 1024; i += NT) { const int k = i & 1023, no = i >> 10, part = no >> 9, g = (no >> 6) & 7, cp = no & 63;
                const float* src = win + (size_t)k * INW + g * 64; float s = 0.f;
                for (int c = 0; c < 64; ++c) { const int m = ((c * cp) & 63) * 32; const float t = part == 0 ? ct[m] : ct[(m - 512) & 2047]; s += src[c] * t; }
                wt[(size_t)no * 1024 + k] = (bf16)f2bf(s * 0.125f); }
        }
        __syncthreads();
    }
    {
        int base = 0;
        for (int layer = 0; layer < DEPTH; ++layer) {
            transpose_matrix(F, inp(F, IN_WIN) + (size_t)layer * D * INW, INW, 512, D, NPROJ, (bf16*)(F.ws + WS_WIN + layer * WIN_L), MapId{0}, base);
            transpose_matrix(F, inp(F, IN_WFO) + (size_t)layer * 512 * D, D, 0, 512, D, (bf16*)(F.ws + WS_WFO + (layer * 3 + 0) * WMG_ONE), MapId{0}, base);
            transpose_matrix(F, inp(F, IN_WRO) + (size_t)layer * 512 * D, D, 0, 512, D, (bf16*)(F.ws + WS_WFO + (layer * 3 + 1) * WMG_ONE), MapId{0}, base);
            transpose_matrix(F, inp(F, IN_WDO) + (size_t)layer * 512 * D, D, 0, 512, D, (bf16*)(F.ws + WS_WFO + (layer * 3 + 2) * WMG_ONE), MapId{0}, base);
            transpose_matrix(F, inp(F, IN_WOUT) + (size_t)layer * D * D, D, 0, D, D, (bf16*)(F.ws + WS_WOUT + layer * WOUT_L), MapId{0}, base);
        }
    }
    convert_expert_weights(F, 0);
}

__device__ __forceinline__ void phase_norm(Frame& F, int layer) {
    const int gw = F.vcu * 8 + F.wave, NGW = F.G * 8, lane = F.lane;
    const bool fin = layer == DEPTH; const int r_lo = (layer >= DEPTH - 1) ? (fin ? TC : 0) : 0;
    float* XR = (float*)(F.ws + WS_XR); const int* INV = (const int*)(F.ws + WS_INV); const bf16* YE = (const bf16*)(F.ws + WS_YE); bf16* HB = (bf16*)(F.ws + WS_HB);
    for (int r = r_lo + gw; r < TA; r += NGW) {
        const int v = vec_of_row(r);
        f32x4 x[4];
        if (layer == 0) { const float* src = r < TC ? inp(F, IN_CTX) + (size_t)r * D : inp(F, IN_X) + (size_t)(r - TC) * D;
#pragma unroll
            for (int j = 0; j < 4; ++j) x[j] = *(const f32x4*)(src + 4 * lane + 256 * j);
        } else {
            const float* src = XR + (size_t)r * D;
#pragma unroll
            for (int j = 0; j < 4; ++j) x[j] = *(const f32x4*)(src + 4 * lane + 256 * j);
            if (!(layer == DEPTH - 1 + 1 && false)) {
                const bool has_moe = !(layer == 1 && r < TC && false);
                if (has_moe) {
                    f32x4 s[4];
#pragma unroll
                    for (int j = 0; j < 4; ++j) s[j] = (f32x4){0.f, 0.f, 0.f, 0.f};
                    const int* inv = INV + (size_t)r * 16;
                    for (int e = 0; e < NE; ++e) { const int slot = __builtin_amdgcn_readfirstlane(inv[e]);
                        if (slot >= 0) { const bf16* y = YE + (size_t)slot * D;
#pragma unroll
                            for (int j = 0; j < 4; ++j) { const u32x2 w = *(const u32x2*)(y + 4 * lane + 256 * j); s[j] += (f32x4){bflo(w.x), bfhi(w.x), bflo(w.y), bfhi(w.y)}; } } }
                    const float* m5 = mod_ptr(F, layer - 1, v, 5);
#pragma unroll
                    for (int j = 0; j < 4; ++j) x[j] += *(const f32x4*)(m5 + 4 * lane + 256 * j) * s[j];
                }
            }
        }
        if (fin) {
#pragma unroll
            for (int j = 0; j < 4; ++j) *(f32x4*)(F.out + (size_t)(r - TC) * D + 4 * lane + 256 * j) = x[j];
            continue;
        }
        if (layer > 0) {
#pragma unroll
            for (int j = 0; j < 4; ++j) *(f32x4*)(XR + (size_t)r * D + 4 * lane + 256 * j) = x[j];
        }
        float ss = 0.f;
#pragma unroll
        for (int j = 0; j < 4; ++j) ss += (x[j].x * x[j].x + x[j].y * x[j].y) + (x[j].z * x[j].z + x[j].w * x[j].w);
        const float rinv = __builtin_amdgcn_rsqf(wave_sum(ss) * (1.0f / D) + EPS);
        const float* g = inp(F, IN_GATTN) + (size_t)layer * D; const float* sh = mod_ptr(F, layer, v, 0); const float* scl = mod_ptr(F, layer, v, 1);
#pragma unroll
        for (int j = 0; j < 4; ++j) { const int k = 4 * lane + 256 * j; const f32x4 gv = *(const f32x4*)(g + k), sv = *(const f32x4*)(sh + k), cv = *(const f32x4*)(scl + k);
            const f32x4 y = (x[j] * rinv * gv) * (cv + 1.0f) + sv;
            u32x2 w; w.x = pk2(y.x, y.y); w.y = pk2(y.z, y.w); *(u32x2*)(HB + (size_t)r * D + k) = w; }
    }
}

using pg8::Unit; using pg8::Acc;
struct SchedGrid {
    int nM, nN, G, c; const char* A; const char* B; size_t a_tile, b_tile; int pm_per_group; size_t b_group;
    __device__ __forceinline__ bool next(int i, Unit& u) const {
        int pm, pn; if (c < 0 || !pg8::grid_order((long)i * G + c, nM, nN, pm, pn)) return false;
        u.pm = pm; u.pn = pn; u.tag = 0; u.A = A + (size_t)pm * a_tile; u.B = B + (size_t)pn * b_tile + (pm_per_group ? (size_t)(pm / pm_per_group) * b_group : 0); return true; }
};
struct SchedMerge {
    int nM, nN, G, c; const char* A; const char* B; size_t a_seg, b_seg, a_tile, b_tile;
    __device__ __forceinline__ bool next(int i, Unit& u) const {
        const int t = i / 3, seg = i - 3 * t; int pm, pn; if (!pg8::grid_order((long)t * G + c, nM, nN, pm, pn)) return false;
        u.pm = pm; u.pn = pn; u.tag = seg; u.A = A + (size_t)seg * a_seg + (size_t)pm * a_tile; u.B = B + (size_t)seg * b_seg + (size_t)pn * b_tile; return true; }
};

struct EpiBf16 {
    static constexpr bool PERM = true;
    bf16* C; int ldc;
    __device__ __forceinline__ void operator()(Acc& acc, const Unit& u, int wr, int wc, int fr, int fq) const {
        const int row0 = u.pm * 256 + wr * 64 + fr, col0 = u.pn * 256 + wc * 32 + 8 * fq;
#pragma unroll
        for (int ai = 0; ai < 2; ++ai)
#pragma unroll
            for (int m = 0; m < 4; ++m) { bf16* rowp = C + (size_t)(row0 + ai * 128 + m * 16) * ldc + col0;
#pragma unroll
                for (int bj = 0; bj < 2; ++bj) { const f32x4 v0 = acc[ai][bj][m][0], v1 = acc[ai][bj][m][1];
                    u32x4 w; w.x = pk2(v0[0], v0[1]); w.y = pk2(v0[2], v0[3]); w.z = pk2(v1[0], v1[1]); w.w = pk2(v1[2], v1[3]);
                    *(u32x4*)(rowp + bj * 128) = w; } }
        pg8::zero_acc(acc);
    }
};
struct EpiGT {
    static constexpr bool PERM = true;
    bf16* GT; bf16* GTC;
    __device__ __forceinline__ void operator()(Acc& acc, const Unit& u, int wr, int wc, int fr, int fq) const {
        const int tok0 = u.pn * 256;
        bf16* base; int pitch, nseq, n0;
        if (tok0 < TC) { const int b = tok0 / CTX; base = GTC + (size_t)b * 512 * 512; pitch = 512; nseq = CTX; n0 = tok0 - b * CTX; }
        else { const int t = tok0 - TC, b = t / SEQ; base = GT + (size_t)b * 512 * 4096; pitch = 4096; nseq = SEQ; n0 = t - b * SEQ; }
        const int crow0 = u.pm * 256 + wr * 64 + fr, ccol0 = wc * 32 + 8 * fq;
#pragma unroll
        for (int ai = 0; ai < 2; ++ai)
#pragma unroll
            for (int m = 0; m < 4; ++m) { const int c = crow0 + ai * 128 + m * 16, part = c >> 9, ch = c & 511;
                bf16* rowp = base + (size_t)ch * pitch + part * nseq + n0 + ccol0;
#pragma unroll
                for (int bj = 0; bj < 2; ++bj) { const f32x4 v0 = acc[ai][bj][m][0], v1 = acc[ai][bj][m][1];
                    u32x4 w; w.x = pk2(v0[0], v0[1]); w.y = pk2(v0[2], v0[3]); w.z = pk2(v1[0], v1[1]); w.w = pk2(v1[2], v1[3]);
                    *(u32x4*)(rowp + bj * 128) = w; } }
        pg8::zero_acc(acc);
    }
};
struct EpiDFT {
    static constexpr bool PERM = true;
    bf16* FO; int nseq; int row_base0;
    __device__ __forceinline__ void operator()(Acc& acc, const Unit& u, int wr, int wc, int fr, int fq) const {
        const int k0 = u.pm * 256 + wr * 64 + fr, b = (u.pn * 256) >> 9, ch0 = ((u.pn * 256) & 511) + wc * 32 + 8 * fq;
        bf16* base = FO + (size_t)(row_base0 + b * nseq + k0) * 512 + ch0;
#pragma unroll
        for (int ai = 0; ai < 2; ++ai)
#pragma unroll
            for (int m = 0; m < 4; ++m) { bf16* rowp = base + (size_t)(ai * 128 + m * 16) * 512;
#pragma unroll
                for (int bj = 0; bj < 2; ++bj) { const f32x4 v0 = acc[ai][bj][m][0], v1 = acc[ai][bj][m][1];
                    u32x4 w; w.x = pk2(v0[0], v0[1]); w.y = pk2(v0[2], v0[3]); w.z = pk2(v1[0], v1[1]); w.w = pk2(v1[2], v1[3]);
                    *(u32x4*)(rowp + bj * 128) = w; } }
        pg8::zero_acc(acc);
    }
};
struct EpiMerge {
    static constexpr bool PERM = true;
    const bf16* PROJ; bf16* MIXB; int row_off;
    __device__ __forceinline__ void operator()(Acc& acc, const Unit& u, int wr, int wc, int fr, int fq) const {
        const int row0 = row_off + u.pm * 256 + wr * 64 + fr, col0 = u.pn * 256 + wc * 32 + 8 * fq, seg = u.tag;
#pragma unroll
        for (int ai = 0; ai < 2; ++ai)
#pragma unroll
            for (int m = 0; m < 4; ++m) { const size_t row = (size_t)(row0 + ai * 128 + m * 16);
#pragma unroll
                for (int bj = 0; bj < 2; ++bj) { const int col = col0 + bj * 128;
                    const u32x4 ga = *(const u32x4*)(PROJ + row * NPROJ + C_GATE + seg * 1024 + col);
                    float f[8];
                    if (seg < 2) { const u32x4 gb = *(const u32x4*)(PROJ + row * NPROJ + C_GATE + (seg + 1) * 1024 + col);
#pragma unroll
                        for (int q = 0; q < 4; ++q) { const float a0 = bflo(ga[q]), a1 = bfhi(ga[q]), b0 = bflo(gb[q]), b1 = bfhi(gb[q]);
                            f[2 * q] = (1.0f + __builtin_amdgcn_exp2f(-b0 * LOG2E)) * __builtin_amdgcn_rcpf(1.0f + __builtin_amdgcn_exp2f(-a0 * LOG2E));
                            f[2 * q + 1] = (1.0f + __builtin_amdgcn_exp2f(-b1 * LOG2E)) * __builtin_amdgcn_rcpf(1.0f + __builtin_amdgcn_exp2f(-a1 * LOG2E)); }
                    } else {
#pragma unroll
                        for (int q = 0; q < 4; ++q) { f[2 * q] = sigmoidf_(bflo(ga[q])); f[2 * q + 1] = sigmoidf_(bfhi(ga[q])); }
                    }
                    f32x4 v0 = acc[ai][bj][m][0], v1 = acc[ai][bj][m][1];
                    v0 = v0 * (f32x4){f[0], f[1], f[2], f[3]}; v1 = v1 * (f32x4){f[4], f[5], f[6], f[7]};
                    if (seg < 2) { acc[ai][bj][m][0] = v0; acc[ai][bj][m][1] = v1; }
                    else { u32x4 w; w.x = pk2(v0[0], v0[1]); w.y = pk2(v0[2], v0[3]); w.z = pk2(v1[0], v1[1]); w.w = pk2(v1[2], v1[3]);
                        *(u32x4*)(MIXB + row * D + col) = w; acc[ai][bj][m][0] = (f32x4){0.f, 0.f, 0.f, 0.f}; acc[ai][bj][m][1] = (f32x4){0.f, 0.f, 0.f, 0.f}; } }
                asm volatile("" ::: "memory"); }
    }
};
struct EpiOut {
    static constexpr bool PERM = false;
    const float* base_ctx; const float* base_lat; float* XR; const float* mod2; int row_off;
    __device__ __forceinline__ void operator()(Acc& acc, const Unit& u, int wr, int wc, int fr, int fq) const {
        const int row0 = row_off + u.pm * 256 + wr * 64 + fr, col0 = u.pn * 256 + wc * 32 + 4 * fq;
        const int v = vec_of_row(row_off + u.pm * 256);
        f32x4 mv[2][2];
#pragma unroll
        for (int bj = 0; bj < 2; ++bj)
#pragma unroll
            for (int n = 0; n < 2; ++n) mv[bj][n] = *(const f32x4*)(mod2 + (size_t)v * 6144 + col0 + bj * 128 + n * 16);
#pragma unroll
        for (int ai = 0; ai < 2; ++ai)
#pragma unroll
            for (int m = 0; m < 4; ++m) { const int row = row0 + ai * 128 + m * 16;
                const float* bp = row < TC ? base_ctx + (size_t)row * D : base_lat + (size_t)(row - TC) * D; float* op = XR + (size_t)row * D;
#pragma unroll
                for (int bj = 0; bj < 2; ++bj)
#pragma unroll
                    for (int n = 0; n < 2; ++n) { const int c = col0 + bj * 128 + n * 16; *(f32x4*)(op + c) = *(const f32x4*)(bp + c) + mv[bj][n] * acc[ai][bj][m][n]; } }
        pg8::zero_acc(acc);
    }
};
struct EpiGU {
    static constexpr bool PERM = true;
    bf16* HID;
    __device__ __forceinline__ void operator()(Acc& acc, const Unit& u, int wr, int wc, int fr, int fq) const {
        const int row0 = u.pm * 256 + wr * 64 + fr, col0 = u.pn * 128 + wc * 32 + 8 * fq;
#pragma unroll
        for (int ai = 0; ai < 2; ++ai)
#pragma unroll
            for (int m = 0; m < 4; ++m) { float h[8];
#pragma unroll
                for (int n = 0; n < 2; ++n)
#pragma unroll
                    for (int j = 0; j < 4; ++j) { const float g = acc[ai][0][m][n][j], up = acc[ai][1][m][n][j]; h[4 * n + j] = siluf_(g) * up; }
                u32x4 w; w.x = pk2(h[0], h[1]); w.y = pk2(h[2], h[3]); w.z = pk2(h[4], h[5]); w.w = pk2(h[6], h[7]);
                *(u32x4*)(HID + (size_t)(row0 + ai * 128 + m * 16) * EH + col0) = w; }
        pg8::zero_acc(acc);
    }
};
struct EpiDown {
    static constexpr bool PERM = true;
    bf16* YE; const float* topw;
    __device__ __forceinline__ void operator()(Acc& acc, const Unit& u, int wr, int wc, int fr, int fq) const {
        const int row0 = u.pm * 256 + wr * 64 + fr, col0 = u.pn * 256 + wc * 32 + 8 * fq;
#pragma unroll
        for (int ai = 0; ai < 2; ++ai)
#pragma unroll
            for (int m = 0; m < 4; ++m) { const int row = row0 + ai * 128 + m * 16; const float tw = topw[row];
#pragma unroll
                for (int bj = 0; bj < 2; ++bj) { const f32x4 v0 = acc[ai][bj][m][0] * tw, v1 = acc[ai][bj][m][1] * tw;
                    u32x4 w; w.x = pk2(v0[0], v0[1]); w.y = pk2(v0[2], v0[3]); w.z = pk2(v1[0], v1[1]); w.w = pk2(v1[2], v1[3]);
                    *(u32x4*)(YE + (size_t)row * D + col0 + bj * 128) = w; } }
        pg8::zero_acc(acc);
    }
};

__device__ __forceinline__ void phase_inproj(Frame& F, int layer) {
    const char* HB = (const char*)(F.ws + WS_HB); const char* WT = (const char*)(F.ws + WS_WIN + layer * WIN_L);
    {
        SchedGrid S{TA / 256, NPROJ / 256, F.G, (int)blockIdx.x, HB, WT, (size_t)256 * D * 2, (size_t)256 * D * 2, 0, 0};
        EpiBf16 E{(bf16*)(F.ws + WS_PROJ), NPROJ};
        pg8::gemm_phase(F.lds, F.tid, D, S, E);
    }
    {
        SchedGrid S{4, TA / 256, F.G, (int)blockIdx.x, WT + (size_t)6144 * D * 2, HB, (size_t)256 * D * 2, (size_t)256 * D * 2, 0, 0};
        EpiGT E{(bf16*)(F.ws + WS_GT), (bf16*)(F.ws + WS_GTC)};
        pg8::gemm_phase(F.lds, F.tid, D, S, E);
    }
}

__device__ __forceinline__ void phase_rope(Frame& F, int layer) {
    const int gw = F.vcu * 8 + F.wave, NGW = F.G * 8, lane = F.lane, s = lane & 15, vq = lane >> 4;
    bf16* PROJ = (bf16*)(F.ws + WS_PROJ); const float* rc = (const float*)(F.ws + WS_ROPE); const float* rs = rc + SEQ * 32;
    const float qg0 = inp(F, IN_QN)[layer * 64 + 2 * s], qg1 = inp(F, IN_QN)[layer * 64 + 2 * s + 1], qg2 = inp(F, IN_QN)[layer * 64 + 32 + 2 * s], qg3 = inp(F, IN_QN)[layer * 64 + 33 + 2 * s];
    const float kg0 = inp(F, IN_KN)[layer * 64 + 2 * s], kg1 = inp(F, IN_KN)[layer * 64 + 2 * s + 1], kg2 = inp(F, IN_KN)[layer * 64 + 32 + 2 * s], kg3 = inp(F, IN_KN)[layer * 64 + 33 + 2 * s];
    for (int r = gw; r < TA; r += NGW) {
        const bool lat = r >= TC; const int pos = lat ? (r - TC) % SEQ : 0;
        float c0 = 1.f, c1 = 1.f, s0 = 0.f, s1 = 0.f;
        if (lat) { c0 = rc[pos * 32 + 2 * s]; c1 = rc[pos * 32 + 2 * s + 1]; s0 = rs[pos * 32 + 2 * s]; s1 = rs[pos * 32 + 2 * s + 1]; }
#pragma unroll
        for (int pass = 0; pass < 6; ++pass) {
            const int vi = pass * 4 + vq;
            const int col = vi < 4 ? C_RQ + vi * 64 : vi < 8 ? C_RK + (vi - 4) * 64 : vi < 16 ? C_DQ + (vi - 8) * 64 : C_DK + (vi - 16) * 64;
            bf16* p = PROJ + (size_t)r * NPROJ + col;
            const unsigned wa = *(const unsigned*)(p + 2 * s), wb = *(const unsigned*)(p + 32 + 2 * s);
            float a0 = bflo(wa), a1 = bfhi(wa), b0 = bflo(wb), b1 = bfhi(wb);
            if (vi >= 8) {
                float ss = a0 * a0 + a1 * a1 + b0 * b0 + b1 * b1;
                ss += __shfl_xor(ss, 1); ss += __shfl_xor(ss, 2); ss += __shfl_xor(ss, 4); ss += __shfl_xor(ss, 8);
                const float rinv = __builtin_amdgcn_rsqf(ss * (1.0f / 64.0f) + EPS);
                if (vi < 16) { a0 *= rinv * qg0; a1 *= rinv * qg1; b0 *= rinv * qg2; b1 *= rinv * qg3; }
                else { a0 *= rinv * kg0; a1 *= rinv * kg1; b0 *= rinv * kg2; b1 *= rinv * kg3; }
            } else if (vi < 4) { a0 *= 0.125f; a1 *= 0.125f; b0 *= 0.125f; b1 *= 0.125f; }
            float o0 = a0 * c0 - b0 * s0, o1 = a1 * c1 - b1 * s1, o2 = b0 * c0 + a0 * s0, o3 = b1 * c1 + a1 * s1;
            if (vi >= 8 && vi < 16) { const float k = 0.125f * LOG2E; o0 *= k; o1 *= k; o2 *= k; o3 *= k; }
            *(unsigned*)(p + 2 * s) = pk2(o0, o1); *(unsigned*)(p + 32 + 2 * s) = pk2(o2, o3);
        }
    }
}

namespace att {
constexpr int KPITCH = 144, VPITCH = 320, KC_BYTES = 64 * KPITCH, V_BYTES = 64 * VPITCH, BUF_BYTES = 2 * KC_BYTES + V_BYTES;
constexpr int SCR_OFF = 2 * BUF_BYTES;
constexpr int QW_OFF = SCR_OFF + 8 * 256;
__device__ __forceinline__ int crow(int r, int hi) { return (r & 3) + 8 * (r >> 2) + 4 * hi; }
__device__ __forceinline__ s16x4 vtr(const LAS unsigned char* p) { typedef short v4i16_t __attribute__((ext_vector_type(4))); return __builtin_bit_cast(s16x4, __builtin_amdgcn_ds_read_tr16_b64_v4i16((LAS v4i16_t*)p)); }

struct UnitDesc {
    int mode;
    int qrow0;
    int qpos0;
    int h;
    int krowA, ntA;
    int krowB, ntB;
    int kindB;
    int nseq;
    int outrow0;
    float lgf, lgb;
    float lam, scale_out;
};

__device__ __forceinline__ void unit(const Frame& F, const UnitDesc& u) {
    LAS unsigned char* lds = F.lds;
    const int tid = F.tid, lane = F.lane, wid = F.wave, r32 = lane & 31, hi = lane >> 5;
    const bf16* PROJ = (const bf16*)(F.ws + WS_PROJ);
    const bool diff = u.mode == 0;
    const int comp = diff ? (wid >> 2) : 0;
    const int qoff = diff ? 32 * (wid & 3) : 32 * wid;
    const int kcol = diff ? C_DK + u.h * 128 : C_RK + u.h * 64, vcol = diff ? C_DV + u.h * 128 : C_RV + u.h * 128;
    const int qcol = diff ? C_DQ + u.h * 128 + comp * 64 : C_RQ + u.h * 64;
    const int NT = u.ntA + u.ntB;
    bf16x8 qf[4];
    { const bf16* qp = PROJ + (size_t)(u.qrow0 + qoff + r32) * NPROJ + qcol + 8 * hi;
#pragma unroll
      for (int s = 0; s < 4; ++s) qf[s] = *(const bf16x8*)(qp + 16 * s); }
    f32x16 o[4];
#pragma unroll
    for (int d = 0; d < 4; ++d) o[d] = (f32x16){};
    float lsum = 0.f;
    u32x4 kreg[2], vreg[2];
    auto tile_row = [&](int t) { return t < u.ntA ? u.krowA + 64 * t : u.krowB + 64 * (t - u.ntA); };
    auto load_tile = [&](int t) {
        const int row0 = tile_row(t);
#pragma unroll
        for (int i = 0; i < 2; ++i) { const int cid = tid + 512 * i, key = cid >> 4, c16 = cid & 15;
            vreg[i] = *(const u32x4*)(PROJ + (size_t)(row0 + key) * NPROJ + vcol + c16 * 8);
            if (diff) kreg[i] = *(const u32x4*)(PROJ + (size_t)(row0 + key) * NPROJ + kcol + c16 * 8); }
        if (!diff) { const int key = tid >> 3, c8 = tid & 7; kreg[0] = *(const u32x4*)(PROJ + (size_t)(row0 + key) * NPROJ + kcol + c8 * 8); }
    };
    auto store_tile = [&](int buf) {
        LAS unsigned char* b = lds + buf * BUF_BYTES;
#pragma unroll
        for (int i = 0; i < 2; ++i) { const int cid = tid + 512 * i, key = cid >> 4, c16 = cid & 15;
            *(LAS u32x4*)(b + 2 * KC_BYTES + key * VPITCH + c16 * 16) = vreg[i];
            if (diff) *(LAS u32x4*)(b + (c16 >> 3) * KC_BYTES + key * KPITCH + (c16 & 7) * 16) = kreg[i]; }
        if (!diff) { const int key = tid >> 3, c8 = tid & 7; *(LAS u32x4*)(b + key * KPITCH + c8 * 16) = kreg[0]; }
    };
    load_tile(0); store_tile(0);
    __syncthreads();
    const int qpos = u.qpos0 + qoff + r32;
    for (int t = 0; t < NT; ++t) {
        if (t + 1 < NT) load_tile(t + 1);
        const LAS unsigned char* b = lds + (t & 1) * BUF_BYTES;
        const LAS unsigned char* kb = b + comp * KC_BYTES + r32 * KPITCH + hi * 16;
        u32x4 pw[4];
        const bool segB = t >= u.ntA; const int j0 = 64 * (segB ? t - u.ntA : t);
#pragma unroll
        for (int kh = 0; kh < 2; ++kh) {
            f32x16 sc = (f32x16){};
#pragma unroll
            for (int s = 0; s < 4; ++s) { const bf16x8 kf = *(const LAS bf16x8*)(kb + kh * 32 * KPITCH + s * 32); sc = __builtin_amdgcn_mfma_f32_32x32x16_bf16(kf, qf[s], sc, 0, 0, 0); }
            if (diff) {
#pragma unroll
                for (int r = 0; r < 16; ++r) sc[r] = __builtin_amdgcn_exp2f(sc[r]);
                float a = 0.f;
#pragma unroll
                for (int r = 0; r < 16; ++r) a += sc[r];
                lsum += a;
            } else if (!segB || u.kindB == 0) {
#pragma unroll
                for (int r = 0; r < 16; ++r) { const int d = qpos - (j0 + 32 * kh + crow(r, hi)); sc[r] *= __builtin_amdgcn_exp2f((float)d * (d >= 0 ? u.lgf : -u.lgb)); }
            } else {
#pragma unroll
                for (int r = 0; r < 16; ++r) { const int na = j0 + 32 * kh + crow(r, hi);
                    sc[r] *= __builtin_amdgcn_exp2f((float)(qpos + CTX - na) * u.lgf) + __builtin_amdgcn_exp2f((float)(u.nseq - qpos + na) * u.lgb); }
            }
            pw[2 * kh] = (u32x4){pk2(sc[0], sc[1]), pk2(sc[2], sc[3]), pk2(sc[4], sc[5]), pk2(sc[6], sc[7])};
            pw[2 * kh + 1] = (u32x4){pk2(sc[8], sc[9]), pk2(sc[10], sc[11]), pk2(sc[12], sc[13]), pk2(sc[14], sc[15])};
            __builtin_amdgcn_sched_barrier(0);
        }
        const LAS unsigned char* vb = b + 2 * KC_BYTES + (4 * hi + ((lane & 15) >> 2)) * VPITCH + ((lane >> 4) & 1) * 32 + (lane & 3) * 8;
        __builtin_amdgcn_sched_barrier(0);
#pragma unroll
        for (int dvb = 0; dvb < 4; ++dvb) {
#pragma unroll
            for (int ks = 0; ks < 4; ++ks) {
                const s16x4 lo = vtr(vb + ks * 16 * VPITCH + dvb * 64), hi4 = vtr(vb + ks * 16 * VPITCH + 8 * VPITCH + dvb * 64);
                const bf16x8 vf = (bf16x8){lo[0], lo[1], lo[2], lo[3], hi4[0], hi4[1], hi4[2], hi4[3]};
                o[dvb] = __builtin_amdgcn_mfma_f32_32x32x16_bf16(__builtin_bit_cast(bf16x8, pw[ks]), vf, o[dvb], 0, 0, 0);
            }
            __builtin_amdgcn_sched_barrier(0);
        }
        if (t + 1 < NT) store_tile((t + 1) & 1);
        __syncthreads();
    }
    LAS float* wsf = (LAS float*)(lds + SCR_OFF) + wid * 64;
    int lz = lane; asm volatile("" : "+v"(lz));
    const int r32e = lz & 31, hie = lz >> 5;
    if (diff) {
        lsum += __shfl_xor(lsum, 32);
        if (hie == 0) wsf[r32e] = __builtin_amdgcn_rcpf(lsum);
        LDS_WAIT();
        float rl[16];
#pragma unroll
        for (int r = 0; r < 16; ++r) rl[r] = wsf[crow(r, hie)];
        LAS float* XC = (LAS float*)lds;
        if (comp == 1) {
#pragma unroll
            for (int r = 0; r < 16; ++r) { const int q = qoff + crow(r, hie);
#pragma unroll
                for (int d = 0; d < 4; ++d) XC[q * 128 + 32 * d + r32e] = o[d][r] * rl[r] * u.lam; }
        }
        __syncthreads();
        if (comp == 0) {
            float ss[16];
#pragma unroll
            for (int r = 0; r < 16; ++r) { const int q = qoff + crow(r, hie); float a = 0.f;
#pragma unroll
                for (int d = 0; d < 4; ++d) { const float v = o[d][r] * rl[r] - XC[q * 128 + 32 * d + r32e]; o[d][r] = v; a += v * v; }
                ss[r] = a; }
#pragma unroll
            for (int r = 0; r < 16; ++r) { float a = ss[r]; a += __shfl_xor(a, 1); a += __shfl_xor(a, 2); a += __shfl_xor(a, 4); a += __shfl_xor(a, 8); a += __shfl_xor(a, 16);
                ss[r] = u.scale_out * __builtin_amdgcn_rsqf(a * (1.0f / 128.0f) + EPS); }
            bf16* DO = (bf16*)(F.ws + WS_FO + 2 * MIX_ONE);
#pragma unroll
            for (int r = 0; r < 16; ++r) { bf16* op = DO + (size_t)(u.outrow0 + qoff + crow(r, hie)) * 512 + u.h * 128 + r32e;
#pragma unroll
                for (int d = 0; d < 4; ++d) op[32 * d] = (bf16)f2bf(o[d][r] * ss[r]); }
        }
    } else {
        bf16* RO = (bf16*)(F.ws + WS_FO + 1 * MIX_ONE);
#pragma unroll
        for (int r = 0; r < 16; ++r) {
            float a = (o[0][r] + o[1][r]) + (o[2][r] + o[3][r]);
            a += __shfl_xor(a, 1); a += __shfl_xor(a, 2); a += __shfl_xor(a, 4); a += __shfl_xor(a, 8); a += __shfl_xor(a, 16);
            const float mu = a * (1.0f / 128.0f); float q = 0.f;
#pragma unroll
            for (int d = 0; d < 4; ++d) { const float v = o[d][r] - mu; o[d][r] = v; q += v * v; }
            q += __shfl_xor(q, 1); q += __shfl_xor(q, 2); q += __shfl_xor(q, 4); q += __shfl_xor(q, 8); q += __shfl_xor(q, 16);
            const float rstd = __builtin_amdgcn_rsqf(q * (1.0f / 128.0f) + EPS);
            const size_t row = (size_t)(u.outrow0 + qoff + crow(r, hie));
            const bf16* gp = PROJ + row * NPROJ + C_RG + u.h * 128 + r32e; bf16* op = RO + row * 512 + u.h * 128 + r32e;
#pragma unroll
            for (int d = 0; d < 4; ++d) { const float g = bf2f(gp[32 * d]); op[32 * d] = (bf16)f2bf(o[d][r] * rstd * siluf_(g)); }
        }
    }
    __syncthreads();
}
}

constexpr int NDFT_CU = 128;

__device__ __forceinline__ void phase_mixers(Frame& F, int layer, int rep) {
    const bool last = layer == DEPTH - 1;
#if !defined(ONLY_SUB) || ONLY_SUB == 1
    if ((int)blockIdx.x < NDFT_CU && F.G > NDFT_CU) {
        {
            SchedGrid S{SEQ / 256, 4096 / 256, NDFT_CU, (int)blockIdx.x, (const char*)(F.ws + WS_DFTL), (const char*)(F.ws + WS_GT), (size_t)256 * 4096 * 2, (size_t)256 * 4096 * 2, 0, 0};
            EpiDFT E{(bf16*)(F.ws + WS_FO), SEQ, TC};
            pg8::gemm_phase(F.lds, F.tid, 4096, S, E);
        }
        if (!last) {
            SchedGrid S{1, 4096 / 256, NDFT_CU, (int)blockIdx.x, (const char*)(F.ws + WS_DFTC), (const char*)(F.ws + WS_GTC), (size_t)256 * 512 * 2, (size_t)256 * 512 * 2, 0, 0};
            EpiDFT E{(bf16*)(F.ws + WS_FO), CTX, 0};
            pg8::gemm_phase(F.lds, F.tid, 512, S, E);
        }
    }
#endif
#if defined(ONLY_SUB) && ONLY_SUB == 1
    return;
#endif
    const int nunits = last ? 768 : 864;
    const float lam = lam_of(F, layer), so = 1.0f - lam_init_of(layer);
    unsigned* qctr = F.ctl + CW_QUEUE + 64 * (layer + 2 * rep);
    volatile LAS unsigned* qw = (volatile LAS unsigned*)(F.lds + att::QW_OFF);
    const bool solo = F.G <= NDFT_CU;
    (void)solo;
    for (;;) {
        if (F.tid == 0) *qw = __hip_atomic_fetch_add(qctr, 1u, RLX_AGENT);
        __syncthreads();
        const int i = (int)*qw;
        __syncthreads();
        if (i >= nunits) break;
        att::UnitDesc u{};
        u.lam = lam; u.scale_out = so;
        if (i < 512) { const int b = i >> 6, h = (i >> 4) & 3, qb = i & 15; u.mode = 0; u.h = h; u.qrow0 = TC + b * SEQ + qb * 128; u.qpos0 = qb * 128; u.krowA = TC + b * SEQ; u.ntA = 32; u.krowB = b * CTX; u.ntB = 4; }
        else if (i < 768) { const int j = i - 512, b = j >> 5, h = (j >> 3) & 3, qb = j & 7; u.mode = 1; u.h = h; u.qrow0 = TC + b * SEQ + qb * 256; u.qpos0 = qb * 256; u.krowA = TC + b * SEQ; u.ntA = 32; u.krowB = b * CTX; u.ntB = 4; u.kindB = 1; u.nseq = SEQ; }
        else if (i < 832) { const int j = i - 768, b = j >> 3, h = (j >> 1) & 3, qb = j & 1; u.mode = 0; u.h = h; u.qrow0 = b * CTX + qb * 128; u.qpos0 = qb * 128; u.krowA = b * CTX; u.ntA = 4; u.krowB = 0; u.ntB = 0; }
        else { const int j = i - 832, b = j >> 2, h = j & 3; u.mode = 1; u.h = h; u.qrow0 = b * CTX; u.qpos0 = 0; u.krowA = b * CTX; u.ntA = 4; u.krowB = 0; u.ntB = 0; u.kindB = 0; u.nseq = CTX; }
        u.outrow0 = u.qrow0;
        if (u.mode == 1) { u.lgf = inp(F, IN_RDEC)[(layer * 2 + 0) * 4 + u.h] * LOG2E; u.lgb = inp(F, IN_RDEC)[(layer * 2 + 1) * 4 + u.h] * LOG2E; }
        att::unit(F, u);
    }
}

__device__ __forceinline__ void phase_merge(Frame& F, int layer) {
    const int row_off = layer == DEPTH - 1 ? TC : 0, M = TA - row_off;
    SchedMerge S{M / 256, D / 256, F.G, (int)blockIdx.x, (const char*)(F.ws + WS_FO) + (size_t)row_off * 512 * 2, (const char*)(F.ws + WS_WFO + (size_t)layer * 3 * WMG_ONE), MIX_ONE, WMG_ONE, (size_t)256 * 512 * 2, (size_t)256 * 512 * 2};
    EpiMerge E{(const bf16*)(F.ws + WS_PROJ), (bf16*)(F.ws + WS_MIXB), row_off};
    pg8::gemm_phase(F.lds, F.tid, 512, S, E);
}
__device__ __forceinline__ void phase_outproj(Frame& F, int layer) {
    const int row_off = layer == DEPTH - 1 ? TC : 0, M = TA - row_off;
    SchedGrid S{M / 256, D / 256, F.G, (int)blockIdx.x, (const char*)(F.ws + WS_MIXB) + (size_t)row_off * D * 2, (const char*)(F.ws + WS_WOUT + layer * WOUT_L), (size_t)256 * D * 2, (size_t)256 * D * 2, 0, 0};
    const float* XR = (const float*)(F.ws + WS_XR);
    EpiOut E{layer == 0 ? inp(F, IN_CTX) : XR, layer == 0 ? inp(F, IN_X) : XR + (size_t)TC * D, (float*)(F.ws + WS_XR), (const float*)(F.ws + WS_MOD) + (size_t)layer * 9 * 6144 + 2 * 1024, row_off};
    pg8::gemm_phase(F.lds, F.tid, D, S, E);
}

__device__ __forceinline__ void phase_norm2(Frame& F, int layer) {
    const int gw = F.vcu * 8 + F.wave, NGW = F.G * 8, lane = F.lane, tid = F.tid;
    LAS float* wr_t = (LAS float*)F.lds;
    const float* wrt = inp(F, IN_WROUTER) + (size_t)layer * D * NE;
    for (int i = tid; i < D * NE; i += 512) { const int k = i >> 4, e = i & 15; wr_t[e * 1024 + k] = wrt[i]; }
    __syncthreads();
    const int r_lo = layer == DEPTH - 1 ? TC : 0;
    const float* XR = (const float*)(F.ws + WS_XR); bf16* HB = (bf16*)(F.ws + WS_HB); float* AFF = (float*)(F.ws + WS_AFF);
    for (int r = r_lo + gw; r < TA; r += NGW) {
        const int v = vec_of_row(r);
        f32x4 x[4];
#pragma unroll
        for (int j = 0; j < 4; ++j) x[j] = *(const f32x4*)(XR + (size_t)r * D + 4 * lane + 256 * j);
        float ss = 0.f;
#pragma unroll
        for (int j = 0; j < 4; ++j) ss += (x[j].x * x[j].x + x[j].y * x[j].y) + (x[j].z * x[j].z + x[j].w * x[j].w);
        const float rinv = __builtin_amdgcn_rsqf(wave_sum(ss) * (1.0f / D) + EPS);
        const float* g = inp(F, IN_GFFN) + (size_t)layer * D; const float* sh = mod_ptr(F, layer, v, 3); const float* scl = mod_ptr(F, layer, v, 4);
#pragma unroll
        for (int j = 0; j < 4; ++j) { const int k = 4 * lane + 256 * j; const f32x4 gv = *(const f32x4*)(g + k), sv = *(const f32x4*)(sh + k), cv = *(const f32x4*)(scl + k);
            x[j] = (x[j] * rinv * gv) * (cv + 1.0f) + sv;
            u32x2 w; w.x = pk2(x[j].x, x[j].y); w.y = pk2(x[j].z, x[j].w); *(u32x2*)(HB + (size_t)r * D + k) = w; }
        float mine = 0.f;
#pragma unroll
        for (int eg = 0; eg < 4; ++eg) {
            float a[4];
#pragma unroll
            for (int q = 0; q < 4; ++q) { float t = 0.f;
#pragma unroll
                for (int j = 0; j < 4; ++j) { const f32x4 w = *(const LAS f32x4*)(wr_t + (4 * eg + q) * 1024 + 4 * lane + 256 * j); t += (x[j].x * w.x + x[j].y * w.y) + (x[j].z * w.z + x[j].w * w.w); }
                a[q] = t; }
#pragma unroll
            for (int o = 1; o < 64; o <<= 1) {
#pragma unroll
                for (int q = 0; q < 4; ++q) a[q] += __shfl_xor(a[q], o); }
#pragma unroll
            for (int q = 0; q < 4; ++q) mine = (lane == 4 * eg + q) ? a[q] : mine;
            asm volatile("" ::: "memory");
        }
        float mx = mine;
        mx = fmaxf(mx, __shfl_xor(mx, 1)); mx = fmaxf(mx, __shfl_xor(mx, 2)); mx = fmaxf(mx, __shfl_xor(mx, 4)); mx = fmaxf(mx, __shfl_xor(mx, 8));
        const float ex = __expf(mine - mx); float den = ex;
        den += __shfl_xor(den, 1); den += __shfl_xor(den, 2); den += __shfl_xor(den, 4); den += __shfl_xor(den, 8);
        if (lane < 16) AFF[(size_t)r * 16 + lane] = ex * __builtin_amdgcn_rcpf(den);
    }
    __syncthreads();
}

__device__ __forceinline__ void phase_topk(Frame& F, int layer) {
    const bool last = layer == DEPTH - 1; const int tid = F.tid, lane = F.lane;
    const int RPE = last ? 2048 : 2304, lat_off = last ? 0 : 256;
    LAS float* vals = (LAS float*)F.lds;
    LAS int* sel = (LAS int*)(F.lds + 8192);
    const float* AFF = (const float*)(F.ws + WS_AFF); int* INV = (int*)(F.ws + WS_INV); float* TOPW = (float*)(F.ws + WS_TOPW);
    const bf16* HB = (const bf16*)(F.ws + WS_HB); bf16* XS = (bf16*)(F.ws + WS_XS);
    const int nitems = last ? 256 : 384;
    for (int item = F.vcu; item < nitems; item += F.G) {
        int n, C, tokrow0, e, slot0, el0, nel;
        if (item < 256) { const int be = item >> 1, half = item & 1, b = be >> 4; e = be & 15; n = SEQ; C = 256; tokrow0 = TC + b * SEQ; slot0 = e * RPE + lat_off + b * 256; el0 = half * 1024; nel = 1024; }
        else { const int be = item - 256, b = be >> 4; e = be & 15; n = CTX; C = 32; tokrow0 = b * CTX; slot0 = e * RPE + b * 32; el0 = 0; nel = 256; }
        for (int k = tid; k < n; k += 512) vals[k] = AFF[(size_t)(tokrow0 + k) * 16 + e];
        __syncthreads();
        const int i0 = el0 + tid, i1 = i0 + 512; const bool act0 = tid < nel, act1 = (tid + 512) < nel;
        const float v0 = act0 ? vals[i0] : 0.f, v1 = act1 ? vals[i1] : 0.f;
        int c0 = 0, c1 = 0;
        for (int j4 = 0; j4 < n / 4; ++j4) { const f32x4 a = *(const LAS f32x4*)(vals + 4 * j4);
#pragma unroll
            for (int q = 0; q < 4; ++q) { const int j = 4 * j4 + q; const float aj = a[q];
                c0 += (aj > v0 || (aj == v0 && j < i0)) ? 1 : 0; c1 += (aj > v1 || (aj == v1 && j < i1)) ? 1 : 0; } }
        if (act0) { const int R = c0 < C ? slot0 + c0 : -1; sel[tid] = R; INV[(size_t)(tokrow0 + i0) * 16 + e] = R; if (R >= 0) TOPW[R] = v0; }
        if (act1) { const int R = c1 < C ? slot0 + c1 : -1; sel[tid + 512] = R; INV[(size_t)(tokrow0 + i1) * 16 + e] = R; if (R >= 0) TOPW[R] = v1; }
        __syncthreads();
        for (int li = F.wave; li < nel; li += 8) { const int R = sel[li];
            if (R >= 0) { const u32x4* src = (const u32x4*)(HB + (size_t)(tokrow0 + el0 + li) * D); u32x4* dst = (u32x4*)(XS + (size_t)R * D);
                const u32x4 a = src[lane], bq = src[lane + 64]; dst[lane] = a; dst[lane + 64] = bq; } }
        __syncthreads();
    }
}

__device__ __forceinline__ void phase_gateup(Frame& F, int layer) {
    const int RPE = layer == DEPTH - 1 ? 2048 : 2304;
    SchedGrid S{NE * RPE / 256, 4096 / 256, F.G, (int)blockIdx.x, (const char*)(F.ws + WS_XS), (const char*)(F.ws + WS_WGU), (size_t)256 * D * 2, (size_t)256 * D * 2, RPE / 256, WGU_E};
    EpiGU E{(bf16*)(F.ws + WS_HID)};
    pg8::gemm_phase(F.lds, F.tid, D, S, E);
}
__device__ __forceinline__ void phase_down(Frame& F, int layer) {
    const int RPE = layer == DEPTH - 1 ? 2048 : 2304;
    SchedGrid S{NE * RPE / 256, D / 256, F.G, (int)blockIdx.x, (const char*)(F.ws + WS_HID), (const char*)(F.ws + WS_WD), (size_t)256 * EH * 2, (size_t)256 * EH * 2, RPE / 256, WD_E};
    EpiDown E{(bf16*)(F.ws + WS_YE), (const float*)(F.ws + WS_TOPW)};
    pg8::gemm_phase(F.lds, F.tid, EH, S, E);
}

constexpr int NPHASE = 1 + 10 * DEPTH + 1;
__global__ void __launch_bounds__(512, 2) mk_fwd(Args args) {
    extern __shared__ __attribute__((aligned(16))) unsigned char lds_raw[];
    Frame F;
    F.lds = (LAS unsigned char*)lds_raw; F.MISC = (volatile LAS unsigned*)(F.lds + MISC_OFF);
    F.tid = threadIdx.x; F.lane = F.tid & 63; F.wave = __builtin_amdgcn_readfirstlane(F.tid >> 6);
    F.G = gridDim.x; { const int bx = blockIdx.x; F.vcu = (F.G % 8 == 0) ? (bx % 8) * (F.G / 8) + bx / 8 : bx; }
    F.ws = args.ws; F.ctl = (unsigned*)(args.ws + WS_CTL); F.out = args.out;
    for (int u = F.tid; u < (LDS_BYTES - LDSCTL_OFF) / 4; u += 512) ((LAS unsigned*)(F.lds + LDSCTL_OFF))[u] = 0u;
    __syncthreads();
    XcdBarrier bar; bar.bar = F.ctl + CW_BAR; bar.x = 0; bar.st = nullptr;
    const bool multi = (args.ph_hi - args.ph_lo) > 1;
    if (multi) bar = xcd_barrier_post(F.ctl + CW_BAR, F.MISC + 8);
    for (int ph = args.ph_lo; ph < args.ph_hi; ++ph) {
        const int layer = (ph - 1) / 10, k = (ph == 0) ? 10 : (ph == NPHASE - 1) ? 12 : (ph - 1) % 10;
        int reps = 1 + ((PROBE_MASK >> k) & 1);
        if (k == 0 && layer > 0 && (PROBE_MASK & 2048)) reps = 2;
        for (int rep = 0; rep < reps; ++rep) {
            { unsigned long long w = (unsigned long long)args.ws; asm volatile("" : "+s"(w)); F.ws = (unsigned char*)w; F.ctl = (unsigned*)(F.ws + WS_CTL); }
            { unsigned long long kp = (unsigned long long)__builtin_amdgcn_kernarg_segment_ptr(); asm volatile("" : "+s"(kp)); F.karg = (const void __attribute__((address_space(4)))*)kp; }
            { int l = (int)__builtin_amdgcn_mbcnt_hi(~0u, __builtin_amdgcn_mbcnt_lo(~0u, 0u)); asm volatile("" : "+v"(l)); F.lane = l; F.tid = F.wave * 64 + l; }
#ifdef ONLY_PHASE
            if (k != ONLY_PHASE) continue;
#endif
            switch (k) {
                case 10: phase_prologue(F); break;
                case 12: phase_norm(F, DEPTH); break;
                case 0: if (rep == 0) phase_norm(F, layer); if (layer > 0) convert_expert_weights(F, layer); break;
                case 1: phase_inproj(F, layer); break;
                case 2: if (rep == 0) phase_rope(F, layer); break;
                case 3: phase_mixers(F, layer, rep); break;
                case 4: phase_merge(F, layer); break;
                case 5: if (rep == 0) phase_outproj(F, layer); break;
                case 6: phase_norm2(F, layer); break;
                case 7: phase_topk(F, layer); break;
                case 8: phase_gateup(F, layer); break;
                default: phase_down(F, layer); break;
            }
            if (rep + 1 < reps || ph + 1 < args.ph_hi) xcd_barrier(bar);
        }
    }
}

extern "C" void kernel_launch(void* const* d_in, const int* in_sizes, int n_in, void* d_out, int out_size, void* d_ws, size_t ws_size, hipStream_t stream) {
    static int grid = 0;
    if (grid == 0) {
        if (n_in != 21 || out_size != TL * D || ws_size < WS_END) { fprintf(stderr, "kernel_launch: unexpected shapes (n_in %d, out %d, ws %zu need %zu)\n", n_in, out_size, ws_size, (size_t)WS_END); grid = -1; return; }
        int dev = 0, cus = 0, per_cu = 0;
        if (hipGetDevice(&dev) != hipSuccess || hipDeviceGetAttribute(&cus, hipDeviceAttributeMultiprocessorCount, dev) != hipSuccess) { grid = -1; return; }
        if (hipFuncSetAttribute((const void*)mk_fwd, hipFuncAttributeMaxDynamicSharedMemorySize, LDS_BYTES) != hipSuccess) { fprintf(stderr, "kernel_launch: hipFuncSetAttribute failed\n"); grid = -1; return; }
        if (hipOccupancyMaxActiveBlocksPerMultiprocessor(&per_cu, (const void*)mk_fwd, 512, LDS_BYTES) != hipSuccess || per_cu < 1) { fprintf(stderr, "kernel_launch: occupancy query says %d\n", per_cu); per_cu = 1; }
        (void)hipGetLastError();
        grid = cus * (per_cu >= 1 ? 1 : 1);
        if (grid % 8 != 0 || grid <= NDFT_CU) fprintf(stderr, "kernel_launch: unusual grid %d\n", grid);
    }
    if (grid < 0) return;
    (void)hipMemsetAsync((char*)d_ws + WS_CTL, 0, CTL_BYTES, stream);
    Args a{};
    for (int i = 0; i < 21; ++i) a.in[i] = (const float*)d_in[i];
    a.out = (float*)d_out; a.ws = (unsigned char*)d_ws;
#if MK_MULTI_LAUNCH
    for (int ph = 0; ph < NPHASE; ++ph) { a.ph_lo = ph; a.ph_hi = ph + 1; hipLaunchKernelGGL(mk_fwd, dim3(grid), dim3(512), LDS_BYTES, stream, a); }
#else
    a.ph_lo = 0; a.ph_hi = NPHASE;
    void* kargs[] = {&a};
    hipError_t e = hipLaunchCooperativeKernel((const void*)mk_fwd, dim3(grid), dim3(512), kargs, LDS_BYTES, stream);
    if (e != hipSuccess) fprintf(stderr, "kernel_launch: cooperative launch failed: %s (grid %d)\n", hipGetErrorString(e), grid);
#endif
}
```

```cpp
#include <hip/hip_runtime.h>
#include <cstdio>
#include <cstdint>

#ifndef PROBE_MASK
#define PROBE_MASK 0
#endif
#ifndef MK_MULTI_LAUNCH
#define MK_MULTI_LAUNCH 0
#endif

#define GAS __attribute__((address_space(1)))
#define LAS __attribute__((address_space(3)))
typedef unsigned short bf16;
typedef short bf16x8 __attribute__((ext_vector_type(8)));
typedef short s16x4 __attribute__((ext_vector_type(4)));
typedef float f32x4 __attribute__((ext_vector_type(4)));
typedef float f32x16 __attribute__((ext_vector_type(16)));
typedef unsigned u32x4 __attribute__((ext_vector_type(4)));
typedef unsigned u32x2 __attribute__((ext_vector_type(2)));
typedef float f32x2_t __attribute__((ext_vector_type(2)));
typedef __bf16 bf16x2_t __attribute__((ext_vector_type(2)));

constexpr int D = 1024, NB = 8, SEQ = 2048, CTX = 256, DEPTH = 2, GRIDW = 64;
constexpr int TC = NB * CTX, TL = NB * SEQ, TA = TC + TL;
constexpr int NPROJ = 6144;
constexpr int C_RQ = 0, C_RK = 256, C_RV = 512, C_RG = 1024, C_DQ = 1536, C_DK = 2048, C_DV = 2560, C_GATE = 3072;
constexpr int INW = 6656;
constexpr int NE = 16, EH = 2048;
constexpr float EPS = 1e-6f;
constexpr float LOG2E = 1.4426950408889634f;

constexpr size_t al(size_t x) { return (x + 0xFFFFFull) & ~0xFFFFFull; }
constexpr size_t WS_CTL = 0, CTL_BYTES = 1u << 20;
constexpr size_t WS_MOD = WS_CTL + CTL_BYTES;
constexpr size_t WS_ROPE = WS_MOD + al((size_t)DEPTH * 9 * 6 * D * 4);
constexpr size_t WS_AFF = WS_ROPE + al((size_t)2 * SEQ * 32 * 4);
constexpr size_t WS_INV = WS_AFF + al((size_t)TA * 16 * 4);
constexpr size_t WS_TOPW = WS_INV + al((size_t)TA * 16 * 4);
constexpr size_t WS_WIN = WS_TOPW + al((size_t)36864 * 4);
constexpr size_t WIN_L = (size_t)7168 * 1024 * 2;
constexpr size_t WS_WFO = WS_WIN + al(2 * WIN_L);
constexpr size_t WMG_ONE = (size_t)1024 * 512 * 2;
constexpr size_t WS_WOUT = WS_WFO + al(6 * WMG_ONE);
constexpr size_t WOUT_L = (size_t)1024 * 1024 * 2;
constexpr size_t WS_WGU = WS_WOUT + al(2 * WOUT_L);
constexpr size_t WGU_E = (size_t)4096 * 1024 * 2;
constexpr size_t WS_WD = WS_WGU + al(16 * WGU_E);
constexpr size_t WD_E = (size_t)1024 * 2048 * 2;
constexpr size_t WS_DFTL = WS_WD + al(16 * WD_E);
constexpr size_t WS_DFTC = WS_DFTL + al((size_t)2048 * 4096 * 2);
constexpr size_t WS_XR = WS_DFTC + al((size_t)256 * 512 * 2);
constexpr size_t WS_HB = WS_XR + al((size_t)TA * D * 4);
constexpr size_t WS_PROJ = WS_HB + al((size_t)TA * D * 2);
constexpr size_t WS_GT = WS_PROJ + al((size_t)TA * NPROJ * 2);
constexpr size_t WS_GTC = WS_GT + al((size_t)4096 * 4096 * 2);
constexpr size_t WS_FO = WS_GTC + al((size_t)4096 * 512 * 2);
constexpr size_t MIX_ONE = (size_t)TA * 512 * 2;
constexpr size_t WS_MIXB = WS_FO + al(3 * MIX_ONE);
constexpr size_t WS_XS = WS_MIXB + al((size_t)TA * D * 2);
constexpr size_t WS_END = WS_XS + al((size_t)36864 * D * 2);
constexpr size_t WS_HID = WS_PROJ;
constexpr size_t WS_YE = WS_XS;
static_assert((size_t)36864 * EH * 2 <= (size_t)TA * NPROJ * 2, "HID overlays PROJ");
static_assert(WS_END <= (size_t)1024 * 1024 * 1024, "workspace map must fit 1 GiB");

constexpr int CW_BAR = 4096;
constexpr int CW_QUEUE = 16384;

constexpr int RING_BYTES = 131072;
constexpr int LDSCTL_OFF = RING_BYTES, MISC_OFF = LDSCTL_OFF + 320;
constexpr int LDS_BYTES = 147456;

#define RLX_AGENT __ATOMIC_RELAXED, __HIP_MEMORY_SCOPE_AGENT
#define LDS_WAIT() asm volatile("s_waitcnt lgkmcnt(0)" ::: "memory")
#define VM_WAIT() asm volatile("s_waitcnt vmcnt(0)" ::: "memory")
__device__ __forceinline__ unsigned f2bf(float f) { unsigned u = __builtin_bit_cast(unsigned, f); return (u + 0x7fffu + ((u >> 16) & 1u)) >> 16; }
__device__ __forceinline__ unsigned pk2(float lo, float hi) { f32x2_t v = {lo, hi}; bf16x2_t b = __builtin_convertvector(v, bf16x2_t); return __builtin_bit_cast(unsigned, b); }
__device__ __forceinline__ float bflo(unsigned w) { return __builtin_bit_cast(float, w << 16); }
__device__ __forceinline__ float bfhi(unsigned w) { return __builtin_bit_cast(float, w & 0xffff0000u); }
__device__ __forceinline__ float bf2f(bf16 h) { return __builtin_bit_cast(float, (unsigned)h << 16); }
__device__ __forceinline__ float wave_sum(float v) {
#pragma unroll
    for (int o = 1; o < 64; o <<= 1) v += __shfl_xor(v, o);
    return v;
}
__device__ __forceinline__ float sigmoidf_(float x) { return __builtin_amdgcn_rcpf(1.0f + __builtin_amdgcn_exp2f(-x * LOG2E)); }
__device__ __forceinline__ float siluf_(float x) { return x * sigmoidf_(x); }

namespace pg8 {
constexpr int BM = 256, BK = 64, HALF = 128, HTB = HALF * BK * 2, STAGE_BYTES = 8 * HTB, NXCD = 8, WGM = 8;
__host__ __device__ __forceinline__ int lds_byte(int r, int c) { const int st = (r >> 4) * 2 + (c >> 5), rr = r & 15, cc = c & 31, ob = rr * 64 + cc * 2; return st * 1024 + (ob ^ (((ob >> 9) & 1) << 5)); }
__host__ __device__ __forceinline__ void stage_rc(int b, int& R, int& C) { const int st = b / 1024, sb = b % 1024, swz = sb ^ (((sb >> 9) & 1) << 5); R = (st >> 1) * 16 + swz / 64; C = (st & 1) * 32 + (swz % 64) / 2; }
__host__ __device__ __forceinline__ int perm32(int rho) { const int n = rho >> 4, i = rho & 15; return 8 * (i >> 2) + 4 * n + (i & 3); }

struct Unit { int pm, pn, tag; const char* A; const char* B; };

__device__ __forceinline__ bool grid_order(long L, int nM, int nN, int& pm, int& pn) {
    const int nwg = nM * nN; if (L >= nwg) return false;
    int wgid = (int)L; { const int q = nwg / NXCD, r = nwg % NXCD, xcd = wgid % NXCD, off = wgid / NXCD; wgid = (xcd < r ? xcd * (q + 1) : r * (q + 1) + (xcd - r) * q) + off; }
    const int nig = WGM * nN, gid = wgid / nig, fm = gid * WGM, gsz = (nM - fm) < WGM ? (nM - fm) : WGM;
    pm = fm + ((wgid % nig) % gsz); pn = (wgid % nig) / gsz; return true;
}

typedef f32x4 Acc[2][2][4][2];
__device__ __forceinline__ void zero_acc(Acc& acc) {
#pragma unroll
    for (int a = 0; a < 2; ++a)
#pragma unroll
        for (int b = 0; b < 2; ++b)
#pragma unroll
            for (int m = 0; m < 4; ++m)
#pragma unroll
                for (int n = 0; n < 2; ++n) acc[a][b][m][n] = (f32x4){0.f, 0.f, 0.f, 0.f};
}

template <class Epi, class Sched>
__device__ __forceinline__ void gemm_phase(LAS unsigned char* lds, const int tid, const int K, const Sched& S, const Epi& E) {
    const int wid = __builtin_amdgcn_readfirstlane(tid >> 6), lane = tid & 63, wr = wid >> 2, wc = wid & 3, fr = lane & 15, fq = lane >> 4;
    const int nt = K / BK;
    unsigned voffA[2], voffB[2];
#pragma unroll
    for (int i = 0; i < 2; ++i) { int R, C; stage_rc(tid * 16 + i * 8192, R, C); const int Rb = Epi::PERM ? ((R & ~31) + perm32(R & 31)) : R;
        voffA[i] = (unsigned)(R * K + C) * 2u; voffB[i] = (unsigned)(Rb * K + C) * 2u; }
    const size_t kstep = (size_t)(BK * 2);
    const size_t hstep = (size_t)HALF * K * 2;
    const unsigned ldsw = (unsigned)wid * 1024u;
    const int aoff = lds_byte(wr * 64 + fr, fq * 8), boff = lds_byte(wc * 32 + fr, fq * 8);
#define PG8_SA(b, h) (((b) * 2 + (h)) * HTB)
#define PG8_SB(b, h) ((4 + (b) * 2 + (h)) * HTB)
#define PG8_STAGE(bufoff, gbase, voff) do { _Pragma("unroll") for (int _i = 0; _i < 2; ++_i) \
        __builtin_amdgcn_global_load_lds((const unsigned*)((const char*)(gbase) + (voff)[_i]), (LAS unsigned*)(lds + (bufoff) + ldsw + _i * 8192), 16, 0, 0); } while (0)
#define PG8_LDA(dst, b, h) do { _Pragma("unroll") for (int m = 0; m < 4; ++m) _Pragma("unroll") for (int k = 0; k < 2; ++k) dst[m][k] = *(const LAS bf16x8*)(lds + PG8_SA(b, h) + aoff + m * 2048 + k * 1024); } while (0)
#define PG8_LDB(dst, b, h) do { _Pragma("unroll") for (int n = 0; n < 2; ++n) _Pragma("unroll") for (int k = 0; k < 2; ++k) dst[n][k] = *(const LAS bf16x8*)(lds + PG8_SB(b, h) + boff + n * 2048 + k * 1024); } while (0)
#define PG8_MMA(ai, bj, At, Bt) do { __builtin_amdgcn_s_setprio(1); _Pragma("unroll") for (int m = 0; m < 4; ++m) _Pragma("unroll") for (int n = 0; n < 2; ++n) _Pragma("unroll") for (int k = 0; k < 2; ++k) \
        acc[ai][bj][m][n] = __builtin_amdgcn_mfma_f32_16x16x32_bf16(Bt[n][k], At[m][k], acc[ai][bj][m][n], 0, 0, 0); __builtin_amdgcn_s_setprio(0); } while (0)
#define PG8_WAIT_V(n) asm volatile("s_waitcnt vmcnt(" #n ")" ::: "memory")
#define PG8_WAIT_L(n) asm volatile("s_waitcnt lgkmcnt(" #n ")" ::: "memory")
#define PG8_BAR __builtin_amdgcn_s_barrier()
#define PG8_SCHED __builtin_amdgcn_sched_barrier(0)
    Unit cur, nxt; int ui = 0;
    if (!S.next(0, cur)) return;
    Acc acc; zero_acc(acc);
    bf16x8 At[4][2], B0[2][2], B1[2][2];
    const char* cA = cur.A; const char* cB = cur.B;
    PG8_STAGE(PG8_SB(0, 0), cB, voffB); PG8_STAGE(PG8_SB(0, 1), cB + hstep, voffB); PG8_STAGE(PG8_SA(0, 0), cA, voffA); PG8_STAGE(PG8_SA(0, 1), cA + hstep, voffA);
    if (wr == 1) PG8_BAR;
    PG8_WAIT_V(2); PG8_BAR;
    PG8_STAGE(PG8_SB(1, 0), cB + kstep, voffB); PG8_STAGE(PG8_SA(1, 0), cA + kstep, voffA); PG8_STAGE(PG8_SB(1, 1), cB + hstep + kstep, voffB);
    PG8_WAIT_V(6); PG8_BAR;
    for (;;) {
        const bool has_next = S.next(ui + 1, nxt);
        const char* nA = has_next ? nxt.A : cA; const char* nB = has_next ? nxt.B : cB;
        for (int t = 0; t < nt; t += 2) {
            const bool last = (t == nt - 2);
            const char* a1 = cA + (size_t)(t + 1) * kstep;
            const char* a2 = last ? nA : cA + (size_t)(t + 2) * kstep; const char* b2 = last ? nB : cB + (size_t)(t + 2) * kstep;
            const char* a3 = a2 + kstep; const char* b3 = b2 + kstep;
            PG8_LDB(B0, 0, 0); PG8_LDB(B1, 0, 1); PG8_SCHED; PG8_LDA(At, 0, 0); PG8_STAGE(PG8_SA(1, 1), a1 + hstep, voffA);
            PG8_WAIT_V(8); PG8_WAIT_L(0); PG8_BAR; PG8_MMA(0, 0, At, B0); PG8_MMA(0, 1, At, B1); PG8_BAR; PG8_SCHED;
            PG8_LDA(At, 0, 1); PG8_STAGE(PG8_SB(0, 0), b2, voffB); PG8_STAGE(PG8_SB(0, 1), b2 + hstep, voffB); PG8_STAGE(PG8_SA(0, 0), a2, voffA);
            PG8_WAIT_V(8); PG8_WAIT_L(0); PG8_BAR; PG8_MMA(1, 0, At, B0); PG8_MMA(1, 1, At, B1); PG8_BAR; PG8_SCHED;
            PG8_LDB(B0, 1, 0); PG8_LDB(B1, 1, 1); PG8_SCHED; PG8_LDA(At, 1, 0); PG8_STAGE(PG8_SA(0, 1), a2 + hstep, voffA);
            PG8_WAIT_V(8); PG8_WAIT_L(0); PG8_BAR; PG8_MMA(0, 0, At, B0); PG8_MMA(0, 1, At, B1); PG8_BAR; PG8_SCHED;
            PG8_LDA(At, 1, 1); PG8_STAGE(PG8_SB(1, 0), b3, voffB); PG8_STAGE(PG8_SB(1, 1), b3 + hstep, voffB); PG8_STAGE(PG8_SA(1, 0), a3, voffA);
            PG8_WAIT_V(8); PG8_WAIT_L(0); PG8_BAR; PG8_MMA(1, 0, At, B0); PG8_MMA(1, 1, At, B1); PG8_BAR; PG8_SCHED;
        }
        if (wr == 0) PG8_BAR;
        E(acc, cur, wr, wc, fr, fq);
        if (!has_next) break;
        cur = nxt; cA = nA; cB = nB; ++ui;
        if (wr == 1) PG8_BAR;
    }
    PG8_WAIT_V(0);
    PG8_BAR;
#undef PG8_SA
#undef PG8_SB
#undef PG8_STAGE
#undef PG8_LDA
#undef PG8_LDB
#undef PG8_MMA
#undef PG8_WAIT_V
#undef PG8_WAIT_L
#undef PG8_BAR
#undef PG8_SCHED
}
}

#define XB_TMO      128
#define XB_XCNT(j)  (256  + 64 * (j))
#define XB_XSUB(j)  (1280 + 64 * (j))
#define XB_XGEN(j)  (2304 + 64 * (j))
#define XB_TOP      3328
#define XB_TOPGEN   3392
#define XCD_BAR_WORDS 3456
#define XB_SPIN_CAP (1u << 22)
__device__ __forceinline__ unsigned xb_ld(unsigned* p)              { return __hip_atomic_load(p, __ATOMIC_RELAXED, __HIP_MEMORY_SCOPE_AGENT); }
__device__ __forceinline__ unsigned xb_add(unsigned* p, unsigned v) { return __hip_atomic_fetch_add(p, v, __ATOMIC_RELAXED, __HIP_MEMORY_SCOPE_AGENT); }
__device__ __forceinline__ unsigned xb_xcc_id() { return (unsigned)__builtin_amdgcn_s_getreg((3 << 11) | 20) & 0xFu; }
#define XB_SPIN(cond, bar) do { unsigned _sp = 0; while (cond) { __builtin_amdgcn_s_sleep(1); \
    if ((++_sp & 255u) == 0u) { if (xb_ld(&(bar)[XB_TMO])) break; if (_sp > XB_SPIN_CAP) { atomicAdd(&(bar)[XB_TMO], 1u); break; } } } } while (0)
struct XcdBarrier { unsigned* bar; unsigned x; volatile LAS unsigned* st; };
__device__ __forceinline__ XcdBarrier xcd_barrier_post(unsigned* bar, volatile LAS unsigned* st) {
    XcdBarrier b; b.bar = bar; b.x = xb_xcc_id(); b.st = st;
    if (threadIdx.x == 0) (void)xb_add(&bar[XB_XCNT(b.x)], 1u);
    return b;
}
__device__ __forceinline__ void xcd_barrier_complete(unsigned* bar, unsigned x, unsigned& nloc, unsigned& nx) {
    const unsigned G = gridDim.x * gridDim.y * gridDim.z;
    unsigned sum, cnt, mine, sp = 0u;
    for (;;) {
        sum = 0u; cnt = 0u; mine = 0u;
#pragma unroll
        for (unsigned j = 0; j < 16; ++j) { const unsigned c = xb_ld(&bar[XB_XCNT(j)]); sum += c; cnt += (c > 0u) ? 1u : 0u; mine = (j == x) ? c : mine; }
        if (sum == G) break;
        __builtin_amdgcn_s_sleep(1);
        if ((++sp & 255u) == 0u) { if (xb_ld(&bar[XB_TMO])) break; if (sp > XB_SPIN_CAP) { atomicAdd(&bar[XB_TMO], 1u); break; } }
    }
    nloc = mine > 0u ? mine : 1u; nx = cnt > 0u ? cnt : 1u;
}
__device__ __forceinline__ void xcd_barrier(const XcdBarrier& b) {
    asm volatile("s_waitcnt vmcnt(0)" ::: "memory");
    __syncthreads();
    if (threadIdx.x == 0) {
        unsigned* bar = b.bar;
        __builtin_amdgcn_s_waitcnt(0);
        unsigned nloc = b.st[0], nx = b.st[1];
        if (nloc == 0u) { xcd_barrier_complete(bar, b.x, nloc, nx); b.st[0] = nloc; b.st[1] = nx; }
        const unsigned old = xb_add(&bar[XB_XSUB(b.x)], 1u);
        const unsigned gen = old / nloc;
        if (old + 1u == (gen + 1u) * nloc) {
            __builtin_amdgcn_fence(__ATOMIC_RELEASE, "agent");
            asm volatile("s_waitcnt vmcnt(0)" ::: "memory");
            const unsigned og = xb_add(&bar[XB_TOP], 1u);
            const unsigned tg = og / nx;
            if (og + 1u == (tg + 1u) * nx) xb_add(&bar[XB_TOPGEN], 1u);
            else XB_SPIN(xb_ld(&bar[XB_TOPGEN]) == tg, bar);
            __builtin_amdgcn_fence(__ATOMIC_ACQUIRE, "agent");
            xb_add(&bar[XB_XGEN(b.x)], 1u);
            asm volatile("s_waitcnt vmcnt(0)" ::: "memory");
        } else {
            XB_SPIN(xb_ld(&bar[XB_XGEN(b.x)]) == gen, bar);
            __builtin_amdgcn_fence(__ATOMIC_ACQUIRE, "agent");
            asm volatile("s_waitcnt vmcnt(0)" ::: "memory");
        }
    }
    __syncthreads();
}

struct Args { const float* in[21]; float* out; unsigned char* ws; int ph_lo, ph_hi; };
struct Frame {
    LAS unsigned char* lds; volatile LAS unsigned* MISC; unsigned* ctl;
    int tid, lane, wave, vcu, G;
    const void __attribute__((address_space(4)))* karg; float* out; unsigned char* ws;
};
__device__ __forceinline__ const float* inp(const Frame& F, int i) { return ((const float* const __attribute__((address_space(4)))*)F.karg)[i]; }
#define IN_X 0
#define IN_C 1
#define IN_CTX 2
#define IN_CCTX 3
#define IN_WMOD 4
#define IN_BMOD 5
#define IN_GATTN 6
#define IN_GFFN 7
#define IN_WIN 8
#define IN_RDEC 9
#define IN_QN 10
#define IN_KN 11
#define IN_LAMBDA 12
#define IN_WFO 13
#define IN_WRO 14
#define IN_WDO 15
#define IN_WOUT 16
#define IN_WROUTER 17
#define IN_WEG 18
#define IN_WEU 19
#define IN_WED 20

__device__ __forceinline__ int vec_of_row(int r) { return r < TC ? 8 : (r - TC) / SEQ; }
__device__ __forceinline__ const float* mod_ptr(const Frame& F, int layer, int v, int i) { return (const float*)(F.ws + WS_MOD) + ((size_t)(layer * 9 + v) * 6 + i) * D; }
__device__ __forceinline__ float lam_init_of(int layer) { return layer == 0 ? 0.2f : 0.8f - 0.6f * 0.74081822068171788f; }
__device__ __forceinline__ float lam_of(const Frame& F, int layer) {
    const float* L = inp(F, IN_LAMBDA) + (size_t)layer * 4 * 64; float s1 = 0.f, s2 = 0.f;
    for (int i = 0; i < 64; ++i) { s1 += L[i] * L[64 + i]; s2 += L[128 + i] * L[192 + i]; }
    return __expf(s1) - __expf(s2) + lam_init_of(layer);
}

__device__ __forceinline__ void transpose_item(const float* W, int ldw, int K, int k0, int n0src, bf16* WT, int dst_row0, LAS float* scr, int lane) {
#pragma unroll 8
    for (int i = 0; i < 32; ++i) { const int kk = 2 * i + (lane >> 5); scr[kk * 33 + (lane & 31)] = W[(size_t)(k0 + kk) * ldw + n0src + (lane & 31)]; }
    LDS_WAIT(); asm volatile("" ::: "memory");
    const int c = lane & 7;
#pragma unroll
    for (int j = 0; j < 4; ++j) { const int n = (lane >> 3) + 8 * j; const LAS float* s = scr + (8 * c) * 33 + n;
        u32x4 o; o.x = pk2(s[0 * 33], s[1 * 33]); o.y = pk2(s[2 * 33], s[3 * 33]); o.z = pk2(s[4 * 33], s[5 * 33]); o.w = pk2(s[6 * 33], s[7 * 33]);
        *(u32x4*)(WT + (size_t)(dst_row0 + n) * K + k0 + 8 * c) = o; }
    LDS_WAIT(); asm volatile("" ::: "memory");
}
template <class RowMap>
__device__ __forceinline__ void transpose_matrix(Frame& F, const float* W, int ldw, int csrc, int K, int N, bf16* WT, RowMap map, int& item_base) {
    LAS float* scr = (LAS float*)(F.lds + F.wave * 16384);
    const int gw = F.vcu * 8 + F.wave, NGW = F.G * 8;
    const int nblk = N / 32, nitems = (K / 64) * nblk;
    int start = (gw - item_base % NGW + NGW) % NGW;
    for (int it = start; it < nitems; it += NGW) { const int kb = it / nblk, nb = it % nblk; transpose_item(W, ldw, K, 64 * kb, csrc + 32 * nb, WT, map(32 * nb), scr, F.lane); }
    item_base += nitems;
}
struct MapId { int off; __device__ int operator()(int n) const { return off + n; } };
struct MapGU { int up; __device__ int operator()(int n) const { return (n >> 7) * 256 + up * 128 + (n & 127); } };

__device__ __forceinline__ void convert_expert_weights(Frame& F, int layer) {
    int base = 0;
    for (int e = 0; e < NE; ++e) {
        const float* wg = inp(F, IN_WEG) + ((size_t)layer * NE + e) * D * EH; const float* wu = inp(F, IN_WEU) + ((size_t)layer * NE + e) * D * EH; const float* wd = inp(F, IN_WED) + ((size_t)layer * NE + e) * EH * D;
        bf16* gu = (bf16*)(F.ws + WS_WGU + e * WGU_E); bf16* dn = (bf16*)(F.ws + WS_WD + e * WD_E);
        transpose_matrix(F, wg, EH, 0, D, EH, gu, MapGU{0}, base);
        transpose_matrix(F, wu, EH, 0, D, EH, gu, MapGU{1}, base);
        transpose_matrix(F, wd, D, 0, EH, D, dn, MapId{0}, base);
    }
}

__device__ __forceinline__ void phase_prologue(Frame& F) {
    const int tid = F.tid;
    {
        LAS float* sc = (LAS float*)F.lds;
        LAS float* red = sc + 9 * 1024;
        for (int i = tid; i < 9 * 1024; i += 512) { const int v = i >> 10, k = i & 1023; const float c = v < 8 ? inp(F, IN_C)[v * D + k] : inp(F, IN_CCTX)[k]; sc[i] = siluf_(c); }
        __syncthreads();
        for (int item = F.vcu; item < DEPTH * 96; item += F.G) {
            const int layer = item / 96, cb = item % 96, col = cb * 64 + (tid & 63), kg = tid >> 6;
            const float* w = inp(F, IN_WMOD) + (size_t)layer * D * 6144 + col;
            float a[9];
#pragma unroll
            for (int v = 0; v < 9; ++v) a[v] = 0.f;
#pragma unroll 4
            for (int kk = 0; kk < 128; ++kk) { const int k = kg * 128 + kk; const float wv = w[(size_t)k * 6144];
#pragma unroll
                for (int v = 0; v < 9; ++v) a[v] += sc[v * 1024 + k] * wv; }
#pragma unroll
            for (int v = 0; v < 9; ++v) red[(kg * 64 + (tid & 63)) * 9 + v] = a[v];
            __syncthreads();
            for (int o = tid; o < 64 * 9; o += 512) { const int cc = o / 9, v = o % 9; float s = 0.f;
                for (int g = 0; g < 8; ++g) s += red[(g * 64 + cc) * 9 + v];
                const int colo = cb * 64 + cc;
                ((float*)(F.ws + WS_MOD))[(size_t)(layer * 9 + v) * 6144 + colo] = s + inp(F, IN_BMOD)[layer * 6144 + colo]; }
            __syncthreads();
        }
    }
    {
        const int gt = F.vcu * 512 + tid, NT = F.G * 512;
        float* rc = (float*)(F.ws + WS_ROPE); float* rs = rc + SEQ * 32;
        for (int i = gt; i < SEQ * 32; i += NT) { const int pos = i >> 5, f = i & 31; const float inv = __builtin_amdgcn_exp2f(-(float)(f & 15) * (13.287712379549449f / 16.0f));
            const float p = (f < 16) ? (float)(pos / GRIDW) : (float)(pos % GRIDW); const float ang = p * inv; rc[i] = __builtin_amdgcn_cosf(ang * 0.15915494309189535f); rs[i] = __builtin_amdgcn_sinf(ang * 0.15915494309189535f); }
        LAS float* ct = (LAS float*)F.lds;
        __syncthreads();
        for (int m = tid; m < 2048; m += 512) ct[m] = __builtin_amdgcn_cosf((float)m * (1.0f / 2048.0f));
        __syncthreads();
        bf16* dl = (bf16*)(F.ws + WS_DFTL); const float sl = 0.022097086912079608f;
        for (int i = gt; i < 2048 * 2048; i += NT) {
            const int k = i >> 11, n = i & 2047, m = (k * n) & 2047; const float c = ct[m], s = ct[(m - 512) & 2047];
            dl[(size_t)k * 4096 + n] = (bf16)f2bf(c * sl); dl[(size_t)k * 4096 + 2048 + n] = (bf16)f2bf(-s * sl); }
        bf16* dc = (bf16*)(F.ws + WS_DFTC);
        for (int i = gt; i < 256 * 256; i += NT) { const int k = i >> 8, n = i & 255, m = ((k * n) & 255) * 8; const float c = ct[m], s = ct[(m - 512) & 2047];
            dc[(size_t)k * 512 + n] = (bf16)f2bf(c * 0.0625f); dc[(size_t)k * 512 + 256 + n] = (bf16)f2bf(-s * 0.0625f); }
        for (int layer = 0; layer < DEPTH; ++layer) {
            const float* win = inp(F, IN_WIN) + (size_t)layer * D * INW; bf16* wt = (bf16*)(F.ws + WS_WIN + layer * WIN_L) + (size_t)6144 * 1024;
            for (int i = gt; i < 1024 * 1024; i += NT) { const int k = i & 1023, no = i >> 10, part = no >> 9, g = (no >> 6) & 7, cp = no & 63;
                const float* src = win + (size_t)k * INW + g * 64; float s = 0.f;
                for (int c = 0; c < 64; ++c) { const int m = ((c * cp) & 63) * 32; const float t = part == 0 ? ct[m] : ct[(m - 512) & 2047]; s += src[c] * t; }
                wt[(size_t)no * 1024 + k] = (bf16)f2bf(s * 0.125f); }
        }
        __syncthreads();
    }
    {
        int base = 0;
        for (int layer = 0; layer < DEPTH; ++layer) {
            transpose_matrix(F, inp(F, IN_WIN) + (size_t)layer * D * INW, INW, 512, D, NPROJ, (bf16*)(F.ws + WS_WIN + layer * WIN_L), MapId{0}, base);
            transpose_matrix(F, inp(F, IN_WFO) + (size_t)layer * 512 * D, D, 0, 512, D, (bf16*)(F.ws + WS_WFO + (layer * 3 + 0) * WMG_ONE), MapId{0}, base);
            transpose_matrix(F, inp(F, IN_WRO) + (size_t)layer * 512 * D, D, 0, 512, D, (bf16*)(F.ws + WS_WFO + (layer * 3 + 1) * WMG_ONE), MapId{0}, base);
            transpose_matrix(F, inp(F, IN_WDO) + (size_t)layer * 512 * D, D, 0, 512, D, (bf16*)(F.ws + WS_WFO + (layer * 3 + 2) * WMG_ONE), MapId{0}, base);
            transpose_matrix(F, inp(F, IN_WOUT) + (size_t)layer * D * D, D, 0, D, D, (bf16*)(F.ws + WS_WOUT + layer * WOUT_L), MapId{0}, base);
        }
    }
    convert_expert_weights(F, 0);
}

__device__ __forceinline__ void phase_norm(Frame& F, int layer) {
    const int gw = F.vcu * 8 + F.wave, NGW = F.G * 8, lane = F.lane;
    const bool fin = layer == DEPTH; const int r_lo = (layer >= DEPTH - 1) ? (fin ? TC : 0) : 0;
    float* XR = (float*)(F.ws + WS_XR); const int* INV = (const int*)(F.ws + WS_INV); const bf16* YE = (const bf16*)(F.ws + WS_YE); bf16* HB = (bf16*)(F.ws + WS_HB);
    for (int r = r_lo + gw; r < TA; r += NGW) {
        const int v = vec_of_row(r);
        f32x4 x[4];
        if (layer == 0) { const float* src = r < TC ? inp(F, IN_CTX) + (size_t)r * D : inp(F, IN_X) + (size_t)(r - TC) * D;
#pragma unroll
            for (int j = 0; j < 4; ++j) x[j] = *(const f32x4*)(src + 4 * lane + 256 * j);
        } else {
            const float* src = XR + (size_t)r * D;
#pragma unroll
            for (int j = 0; j < 4; ++j) x[j] = *(const f32x4*)(src + 4 * lane + 256 * j);
            if (!(layer == DEPTH - 1 + 1 && false)) {
                const bool has_moe = !(layer == 1 && r < TC && false);
                if (has_moe) {
                    f32x4 s[4];
#pragma unroll
                    for (int j = 0; j < 4; ++j) s[j] = (f32x4){0.f, 0.f, 0.f, 0.f};
                    const int* inv = INV + (size_t)r * 16;
                    for (int e = 0; e < NE; ++e) { const int slot = __builtin_amdgcn_readfirstlane(inv[e]);
                        if (slot >= 0) { const bf16* y = YE + (size_t)slot * D;
#pragma unroll
                            for (int j = 0; j < 4; ++j) { const u32x2 w = *(const u32x2*)(y + 4 * lane + 256 * j); s[j] += (f32x4){bflo(w.x), bfhi(w.x), bflo(w.y), bfhi(w.y)}; } } }
                    const float* m5 = mod_ptr(F, layer - 1, v, 5);
#pragma unroll
                    for (int j = 0; j < 4; ++j) x[j] += *(const f32x4*)(m5 + 4 * lane + 256 * j) * s[j];
                }
            }
        }
        if (fin) {
#pragma unroll
            for (int j = 0; j < 4; ++j) *(f32x4*)(F.out + (size_t)(r - TC) * D + 4 * lane + 256 * j) = x[j];
            continue;
        }
        if (layer > 0) {
#pragma unroll
            for (int j = 0; j < 4; ++j) *(f32x4*)(XR + (size_t)r * D + 4 * lane + 256 * j) = x[j];
        }
        float ss = 0.f;
#pragma unroll
        for (int j = 0; j < 4; ++j) ss += (x[j].x * x[j].x + x[j].y * x[j].y) + (x[j].z * x[j].z + x[j].w * x[j].w);
        const float rinv = __builtin_amdgcn_rsqf(wave_sum(ss) * (1.0f / D) + EPS);
        const float* g = inp(F, IN_GATTN) + (size_t)layer * D; const float* sh = mod_ptr(F, layer, v, 0); const float* scl = mod_ptr(F, layer, v, 1);
#pragma unroll
        for (int j = 0; j < 4; ++j) { const int k = 4 * lane + 256 * j; const f32x4 gv = *(const f32x4*)(g + k), sv = *(const f32x4*)(sh + k), cv = *(const f32x4*)(scl + k);
            const f32x4 y = (x[j] * rinv * gv) * (cv + 1.0f) + sv;
            u32x2 w; w.x = pk2(y.x, y.y); w.y = pk2(y.z, y.w); *(u32x2*)(HB + (size_t)r * D + k) = w; }
    }
}

using pg8::Unit; using pg8::Acc;
struct SchedGrid {
    int nM, nN, G, c; const char* A; const char* B; size_t a_tile, b_tile; int pm_per_group; size_t b_group;
    __device__ __forceinline__ bool next(int i, Unit& u) const {
        int pm, pn; if (c < 0 || !pg8::grid_order((long)i * G + c, nM, nN, pm, pn)) return false;
        u.pm = pm; u.pn = pn; u.tag = 0; u.A = A + (size_t)pm * a_tile; u.B = B + (size_t)pn * b_tile + (pm_per_group ? (size_t)(pm / pm_per_group) * b_group : 0); return true; }
};
struct SchedMerge {
    int nM, nN, G, c; const char* A; const char* B; size_t a_seg, b_seg, a_tile, b_tile;
    __device__ __forceinline__ bool next(int i, Unit& u) const {
        const int t = i / 3, seg = i - 3 * t; int pm, pn; if (!pg8::grid_order((long)t * G + c, nM, nN, pm, pn)) return false;
        u.pm = pm; u.pn = pn; u.tag = seg; u.A = A + (size_t)seg * a_seg + (size_t)pm * a_tile; u.B = B + (size_t)seg * b_seg + (size_t)pn * b_tile; return true; }
};

struct EpiBf16 {
    static constexpr bool PERM = true;
    bf16* C; int ldc; int sig_pn0;
    __device__ __forceinline__ void operator()(Acc& acc, const Unit& u, int wr, int wc, int fr, int fq) const {
        const int row0 = u.pm * 256 + wr * 64 + fr, col0 = u.pn * 256 + wc * 32 + 8 * fq;
        const bool sig = u.pn >= sig_pn0;
#pragma unroll
        for (int ai = 0; ai < 2; ++ai)
#pragma unroll
            for (int m = 0; m < 4; ++m) { bf16* rowp = C + (size_t)(row0 + ai * 128 + m * 16) * ldc + col0;
#pragma unroll
                for (int bj = 0; bj < 2; ++bj) { f32x4 v0 = acc[ai][bj][m][0], v1 = acc[ai][bj][m][1];
                    if (sig) {
#pragma unroll
                        for (int j = 0; j < 4; ++j) { v0[j] = sigmoidf_(v0[j]); v1[j] = sigmoidf_(v1[j]); } }
                    u32x4 w; w.x = pk2(v0[0], v0[1]); w.y = pk2(v0[2], v0[3]); w.z = pk2(v1[0], v1[1]); w.w = pk2(v1[2], v1[3]);
                    *(u32x4*)(rowp + bj * 128) = w; } }
        pg8::zero_acc(acc);
    }
};
struct EpiGT {
    static constexpr bool PERM = true;
    bf16* GT; bf16* GTC;
    __device__ __forceinline__ void operator()(Acc& acc, const Unit& u, int wr, int wc, int fr, int fq) const {
        const int tok0 = u.pn * 256;
        bf16* base; int pitch, nseq, n0;
        if (tok0 < TC) { const int b = tok0 / CTX; base = GTC + (size_t)b * 512 * 512; pitch = 512; nseq = CTX; n0 = tok0 - b * CTX; }
        else { const int t = tok0 - TC, b = t / SEQ; base = GT + (size_t)b * 512 * 4096; pitch = 4096; nseq = SEQ; n0 = t - b * SEQ; }
        const int crow0 = u.pm * 256 + wr * 64 + fr, ccol0 = wc * 32 + 8 * fq;
#pragma unroll
        for (int ai = 0; ai < 2; ++ai)
#pragma unroll
            for (int m = 0; m < 4; ++m) { const int c = crow0 + ai * 128 + m * 16, part = c >> 9, ch = c & 511;
                bf16* rowp = base + (size_t)ch * pitch + part * nseq + n0 + ccol0;
#pragma unroll
                for (int bj = 0; bj < 2; ++bj) { const f32x4 v0 = acc[ai][bj][m][0], v1 = acc[ai][bj][m][1];
                    u32x4 w; w.x = pk2(v0[0], v0[1]); w.y = pk2(v0[2], v0[3]); w.z = pk2(v1[0], v1[1]); w.w = pk2(v1[2], v1[3]);
                    *(u32x4*)(rowp + bj * 128) = w; } }
        pg8::zero_acc(acc);
    }
};
struct EpiDFT {
    static constexpr bool PERM = true;
    bf16* FO; int nseq; int row_base0;
    __device__ __forceinline__ void operator()(Acc& acc, const Unit& u, int wr, int wc, int fr, int fq) const {
        const int k0 = u.pm * 256 + wr * 64 + fr, b = (u.pn * 256) >> 9, ch0 = ((u.pn * 256) & 511) + wc * 32 + 8 * fq;
        bf16* base = FO + (size_t)(row_base0 + b * nseq + k0) * 512 + ch0;
#pragma unroll
        for (int ai = 0; ai < 2; ++ai)
#pragma unroll
            for (int m = 0; m < 4; ++m) { bf16* rowp = base + (size_t)(ai * 128 + m * 16) * 512;
#pragma unroll
                for (int bj = 0; bj < 2; ++bj) { const f32x4 v0 = acc[ai][bj][m][0], v1 = acc[ai][bj][m][1];
                    u32x4 w; w.x = pk2(v0[0], v0[1]); w.y = pk2(v0[2], v0[3]); w.z = pk2(v1[0], v1[1]); w.w = pk2(v1[2], v1[3]);
                    *(u32x4*)(rowp + bj * 128) = w; } }
        pg8::zero_acc(acc);
    }
};
struct EpiMerge {
    static constexpr bool PERM = true;
    const bf16* PROJ; bf16* MIXB; int row_off;
    __device__ __forceinline__ void operator()(Acc& acc, const Unit& u, int wr, int wc, int fr, int fq) const {
        const int row0 = row_off + u.pm * 256 + wr * 64 + fr, col0 = u.pn * 256 + wc * 32 + 8 * fq, seg = u.tag;
#pragma unroll
        for (int ai = 0; ai < 2; ++ai)
#pragma unroll
            for (int m = 0; m < 4; ++m) { const size_t row = (size_t)(row0 + ai * 128 + m * 16);
#pragma unroll
                for (int bj = 0; bj < 2; ++bj) { const int col = col0 + bj * 128;
                    const u32x4 ga = *(const u32x4*)(PROJ + row * NPROJ + C_GATE + seg * 1024 + col);
                    float f[8];
                    if (seg < 2) { const u32x4 gb = *(const u32x4*)(PROJ + row * NPROJ + C_GATE + (seg + 1) * 1024 + col);
#pragma unroll
                        for (int q = 0; q < 4; ++q) { f[2 * q] = bflo(ga[q]) * __builtin_amdgcn_rcpf(bflo(gb[q])); f[2 * q + 1] = bfhi(ga[q]) * __builtin_amdgcn_rcpf(bfhi(gb[q])); }
                    } else {
#pragma unroll
                        for (int q = 0; q < 4; ++q) { f[2 * q] = bflo(ga[q]); f[2 * q + 1] = bfhi(ga[q]); }
                    }
                    f32x4 v0 = acc[ai][bj][m][0], v1 = acc[ai][bj][m][1];
                    v0 = v0 * (f32x4){f[0], f[1], f[2], f[3]}; v1 = v1 * (f32x4){f[4], f[5], f[6], f[7]};
                    if (seg < 2) { acc[ai][bj][m][0] = v0; acc[ai][bj][m][1] = v1; }
                    else { u32x4 w; w.x = pk2(v0[0], v0[1]); w.y = pk2(v0[2], v0[3]); w.z = pk2(v1[0], v1[1]); w.w = pk2(v1[2], v1[3]);
                        *(u32x4*)(MIXB + row * D + col) = w; acc[ai][bj][m][0] = (f32x4){0.f, 0.f, 0.f, 0.f}; acc[ai][bj][m][1] = (f32x4){0.f, 0.f, 0.f, 0.f}; } }
                asm volatile("" ::: "memory"); }
    }
};
struct EpiOut {
    static constexpr bool PERM = false;
    const float* base_ctx; const float* base_lat; float* XR; const float* mod2; int row_off;
    __device__ __forceinline__ void operator()(Acc& acc, const Unit& u, int wr, int wc, int fr, int fq) const {
        const int row0 = row_off + u.pm * 256 + wr * 64 + fr, col0 = u.pn * 256 + wc * 32 + 4 * fq;
        const int v = vec_of_row(row_off + u.pm * 256);
        f32x4 mv[2][2];
#pragma unroll
        for (int bj = 0; bj < 2; ++bj)
#pragma unroll
            for (int n = 0; n < 2; ++n) mv[bj][n] = *(const f32x4*)(mod2 + (size_t)v * 6144 + col0 + bj * 128 + n * 16);
#pragma unroll
        for (int ai = 0; ai < 2; ++ai)
#pragma unroll
            for (int m = 0; m < 4; ++m) { const int row = row0 + ai * 128 + m * 16;
                const float* bp = row < TC ? base_ctx + (size_t)row * D : base_lat + (size_t)(row - TC) * D; float* op = XR + (size_t)row * D;
#pragma unroll
                for (int bj = 0; bj < 2; ++bj)
#pragma unroll
                    for (int n = 0; n < 2; ++n) { const int c = col0 + bj * 128 + n * 16; *(f32x4*)(op + c) = *(const f32x4*)(bp + c) + mv[bj][n] * acc[ai][bj][m][n]; } }
        pg8::zero_acc(acc);
    }
};
struct EpiGU {
    static constexpr bool PERM = true;
    bf16* HID;
    __device__ __forceinline__ void operator()(Acc& acc, const Unit& u, int wr, int wc, int fr, int fq) const {
        const int row0 = u.pm * 256 + wr * 64 + fr, col0 = u.pn * 128 + wc * 32 + 8 * fq;
#pragma unroll
        for (int ai = 0; ai < 2; ++ai)
#pragma unroll
            for (int m = 0; m < 4; ++m) { float h[8];
#pragma unroll
                for (int n = 0; n < 2; ++n)
#pragma unroll
                    for (int j = 0; j < 4; ++j) { const float g = acc[ai][0][m][n][j], up = acc[ai][1][m][n][j]; h[4 * n + j] = siluf_(g) * up; }
                u32x4 w; w.x = pk2(h[0], h[1]); w.y = pk2(h[2], h[3]); w.z = pk2(h[4], h[5]); w.w = pk2(h[6], h[7]);
                *(u32x4*)(HID + (size_t)(row0 + ai * 128 + m * 16) * EH + col0) = w; }
        pg8::zero_acc(acc);
    }
};
struct EpiDown {
    static constexpr bool PERM = true;
    bf16* YE; const float* topw;
    __device__ __forceinline__ void operator()(Acc& acc, const Unit& u, int wr, int wc, int fr, int fq) const {
        const int row0 = u.pm * 256 + wr * 64 + fr, col0 = u.pn * 256 + wc * 32 + 8 * fq;
#pragma unroll
        for (int ai = 0; ai < 2; ++ai)
#pragma unroll
            for (int m = 0; m < 4; ++m) { const int row = row0 + ai * 128 + m * 16; const float tw = topw[row];
#pragma unroll
                for (int bj = 0; bj < 2; ++bj) { const f32x4 v0 = acc[ai][bj][m][0] * tw, v1 = acc[ai][bj][m][1] * tw;
                    u32x4 w; w.x = pk2(v0[0], v0[1]); w.y = pk2(v0[2], v0[3]); w.z = pk2(v1[0], v1[1]); w.w = pk2(v1[2], v1[3]);
                    *(u32x4*)(YE + (size_t)row * D + col0 + bj * 128) = w; } }
        pg8::zero_acc(acc);
    }
};

__device__ __forceinline__ void phase_inproj(Frame& F, int layer) {
    const char* HB = (const char*)(F.ws + WS_HB); const char* WT = (const char*)(F.ws + WS_WIN + layer * WIN_L);
    {
        SchedGrid S{TA / 256, NPROJ / 256, F.G, (int)blockIdx.x, HB, WT, (size_t)256 * D * 2, (size_t)256 * D * 2, 0, 0};
        EpiBf16 E{(bf16*)(F.ws + WS_PROJ), NPROJ, C_GATE / 256};
        pg8::gemm_phase(F.lds, F.tid, D, S, E);
    }
    {
        SchedGrid S{4, TA / 256, F.G, (int)blockIdx.x, WT + (size_t)6144 * D * 2, HB, (size_t)256 * D * 2, (size_t)256 * D * 2, 0, 0};
        EpiGT E{(bf16*)(F.ws + WS_GT), (bf16*)(F.ws + WS_GTC)};
        pg8::gemm_phase(F.lds, F.tid, D, S, E);
    }
}

__device__ __forceinline__ void phase_rope(Frame& F, int layer) {
    const int gw = F.vcu * 8 + F.wave, NGW = F.G * 8, lane = F.lane, s = lane & 15, vq = lane >> 4;
    bf16* PROJ = (bf16*)(F.ws + WS_PROJ); const float* rc = (const float*)(F.ws + WS_ROPE); const float* rs = rc + SEQ * 32;
    const float qg0 = inp(F, IN_QN)[layer * 64 + 2 * s], qg1 = inp(F, IN_QN)[layer * 64 + 2 * s + 1], qg2 = inp(F, IN_QN)[layer * 64 + 32 + 2 * s], qg3 = inp(F, IN_QN)[layer * 64 + 33 + 2 * s];
    const float kg0 = inp(F, IN_KN)[layer * 64 + 2 * s], kg1 = inp(F, IN_KN)[layer * 64 + 2 * s + 1], kg2 = inp(F, IN_KN)[layer * 64 + 32 + 2 * s], kg3 = inp(F, IN_KN)[layer * 64 + 33 + 2 * s];
    for (int r = gw; r < TA; r += NGW) {
        const bool lat = r >= TC; const int pos = lat ? (r - TC) % SEQ : 0;
        float c0 = 1.f, c1 = 1.f, s0 = 0.f, s1 = 0.f;
        if (lat) { c0 = rc[pos * 32 + 2 * s]; c1 = rc[pos * 32 + 2 * s + 1]; s0 = rs[pos * 32 + 2 * s]; s1 = rs[pos * 32 + 2 * s + 1]; }
#pragma unroll
        for (int pass = 0; pass < 6; ++pass) {
            const int vi = pass * 4 + vq;
            const int col = vi < 4 ? C_RQ + vi * 64 : vi < 8 ? C_RK + (vi - 4) * 64 : vi < 16 ? C_DQ + (vi - 8) * 64 : C_DK + (vi - 16) * 64;
            bf16* p = PROJ + (size_t)r * NPROJ + col;
            const unsigned wa = *(const unsigned*)(p + 2 * s), wb = *(const unsigned*)(p + 32 + 2 * s);
            float a0 = bflo(wa), a1 = bfhi(wa), b0 = bflo(wb), b1 = bfhi(wb);
            if (vi >= 8) {
                float ss = a0 * a0 + a1 * a1 + b0 * b0 + b1 * b1;
                ss += __shfl_xor(ss, 1); ss += __shfl_xor(ss, 2); ss += __shfl_xor(ss, 4); ss += __shfl_xor(ss, 8);
                const float rinv = __builtin_amdgcn_rsqf(ss * (1.0f / 64.0f) + EPS);
                if (vi < 16) { a0 *= rinv * qg0; a1 *= rinv * qg1; b0 *= rinv * qg2; b1 *= rinv * qg3; }
                else { a0 *= rinv * kg0; a1 *= rinv * kg1; b0 *= rinv * kg2; b1 *= rinv * kg3; }
            } else if (vi < 4) { a0 *= 0.125f; a1 *= 0.125f; b0 *= 0.125f; b1 *= 0.125f; }
            float o0 = a0 * c0 - b0 * s0, o1 = a1 * c1 - b1 * s1, o2 = b0 * c0 + a0 * s0, o3 = b1 * c1 + a1 * s1;
            if (vi >= 8 && vi < 16) { const float k = 0.125f * LOG2E; o0 *= k; o1 *= k; o2 *= k; o3 *= k; }
            *(unsigned*)(p + 2 * s) = pk2(o0, o1); *(unsigned*)(p + 32 + 2 * s) = pk2(o2, o3);
        }
    }
}

namespace att {
constexpr int KPITCH = 144, VPITCH = 320, KC_BYTES = 64 * KPITCH, V_BYTES = 64 * VPITCH, BUF_BYTES = 2 * KC_BYTES + V_BYTES;
constexpr int SCR_OFF = 2 * BUF_BYTES;
constexpr int QW_OFF = SCR_OFF + 8 * 256;
__device__ __forceinline__ int crow(int r, int hi) { return (r & 3) + 8 * (r >> 2) + 4 * hi; }
__device__ __forceinline__ s16x4 vtr(const LAS unsigned char* p) { typedef short v4i16_t __attribute__((ext_vector_type(4))); return __builtin_bit_cast(s16x4, __builtin_amdgcn_ds_read_tr16_b64_v4i16((LAS v4i16_t*)p)); }

struct UnitDesc {
    int mode;
    int qrow0;
    int qpos0;
    int h;
    int krowA, ntA;
    int krowB, ntB;
    int kindB;
    int nseq;
    int outrow0;
    float lgf, lgb;
    float lam, scale_out;
};

__device__ __forceinline__ void unit(const Frame& F, const UnitDesc& u) {
    LAS unsigned char* lds = F.lds;
    const int tid = F.tid, lane = F.lane, wid = F.wave, r32 = lane & 31, hi = lane >> 5;
    const bf16* PROJ = (const bf16*)(F.ws + WS_PROJ);
    const bool diff = u.mode == 0;
    const int comp = diff ? (wid >> 2) : 0;
    const int qoff = diff ? 32 * (wid & 3) : 32 * wid;
    const int kcol = diff ? C_DK + u.h * 128 : C_RK + u.h * 64, vcol = diff ? C_DV + u.h * 128 : C_RV + u.h * 128;
    const int qcol = diff ? C_DQ + u.h * 128 + comp * 64 : C_RQ + u.h * 64;
    const int NT = u.ntA + u.ntB;
    bf16x8 qf[4];
    { const bf16* qp = PROJ + (size_t)(u.qrow0 + qoff + r32) * NPROJ + qcol + 8 * hi;
#pragma unroll
      for (int s = 0; s < 4; ++s) qf[s] = *(const bf16x8*)(qp + 16 * s); }
    f32x16 o[4];
#pragma unroll
    for (int d = 0; d < 4; ++d) o[d] = (f32x16){};
    float lsum = 0.f;
    u32x4 kreg[2], vreg[2];
    auto tile_row = [&](int t) { return t < u.ntA ? u.krowA + 64 * t : u.krowB + 64 * (t - u.ntA); };
    auto load_tile = [&](int t) {
        const int row0 = tile_row(t);
#pragma unroll
        for (int i = 0; i < 2; ++i) { const int cid = tid + 512 * i, key = cid >> 4, c16 = cid & 15;
            vreg[i] = *(const u32x4*)(PROJ + (size_t)(row0 + key) * NPROJ + vcol + c16 * 8);
            if (diff) kreg[i] = *(const u32x4*)(PROJ + (size_t)(row0 + key) * NPROJ + kcol + c16 * 8); }
        if (!diff) { const int key = tid >> 3, c8 = tid & 7; kreg[0] = *(const u32x4*)(PROJ + (size_t)(row0 + key) * NPROJ + kcol + c8 * 8); }
    };
    auto store_tile = [&](int buf) {
        LAS unsigned char* b = lds + buf * BUF_BYTES;
#pragma unroll
        for (int i = 0; i < 2; ++i) { const int cid = tid + 512 * i, key = cid >> 4, c16 = cid & 15;
            *(LAS u32x4*)(b + 2 * KC_BYTES + key * VPITCH + c16 * 16) = vreg[i];
            if (diff) *(LAS u32x4*)(b + (c16 >> 3) * KC_BYTES + key * KPITCH + (c16 & 7) * 16) = kreg[i]; }
        if (!diff) { const int key = tid >> 3, c8 = tid & 7; *(LAS u32x4*)(b + key * KPITCH + c8 * 16) = kreg[0]; }
    };
    load_tile(0); store_tile(0);
    __syncthreads();
    const int qpos = u.qpos0 + qoff + r32;
    for (int t = 0; t < NT; ++t) {
        if (t + 1 < NT) load_tile(t + 1);
        const LAS unsigned char* b = lds + (t & 1) * BUF_BYTES;
        const LAS unsigned char* kb = b + comp * KC_BYTES + r32 * KPITCH + hi * 16;
        u32x4 pw[4];
        const bool segB = t >= u.ntA; const int j0 = 64 * (segB ? t - u.ntA : t);
#pragma unroll
        for (int kh = 0; kh < 2; ++kh) {
            f32x16 sc = (f32x16){};
#pragma unroll
            for (int s = 0; s < 4; ++s) { const bf16x8 kf = *(const LAS bf16x8*)(kb + kh * 32 * KPITCH + s * 32); sc = __builtin_amdgcn_mfma_f32_32x32x16_bf16(kf, qf[s], sc, 0, 0, 0); }
            if (diff) {
#pragma unroll
                for (int r = 0; r < 16; ++r) sc[r] = __builtin_amdgcn_exp2f(sc[r]);
                float a = 0.f;
#pragma unroll
                for (int r = 0; r < 16; ++r) a += sc[r];
                lsum += a;
            } else if (!segB || u.kindB == 0) {
#pragma unroll
                for (int r = 0; r < 16; ++r) { const int d = qpos - (j0 + 32 * kh + crow(r, hi)); sc[r] *= __builtin_amdgcn_exp2f((float)d * (d >= 0 ? u.lgf : -u.lgb)); }
            } else {
#pragma unroll
                for (int r = 0; r < 16; ++r) { const int na = j0 + 32 * kh + crow(r, hi);
                    sc[r] *= __builtin_amdgcn_exp2f((float)(qpos + CTX - na) * u.lgf) + __builtin_amdgcn_exp2f((float)(u.nseq - qpos + na) * u.lgb); }
            }
            pw[2 * kh] = (u32x4){pk2(sc[0], sc[1]), pk2(sc[2], sc[3]), pk2(sc[4], sc[5]), pk2(sc[6], sc[7])};
            pw[2 * kh + 1] = (u32x4){pk2(sc[8], sc[9]), pk2(sc[10], sc[11]), pk2(sc[12], sc[13]), pk2(sc[14], sc[15])};
            __builtin_amdgcn_sched_barrier(0);
        }
        const LAS unsigned char* vb = b + 2 * KC_BYTES + (4 * hi + ((lane & 15) >> 2)) * VPITCH + ((lane >> 4) & 1) * 32 + (lane & 3) * 8;
        __builtin_amdgcn_sched_barrier(0);
#pragma unroll
        for (int dvb = 0; dvb < 4; ++dvb) {
#pragma unroll
            for (int ks = 0; ks < 4; ++ks) {
                const s16x4 lo = vtr(vb + ks * 16 * VPITCH + dvb * 64), hi4 = vtr(vb + ks * 16 * VPITCH + 8 * VPITCH + dvb * 64);
                const bf16x8 vf = (bf16x8){lo[0], lo[1], lo[2], lo[3], hi4[0], hi4[1], hi4[2], hi4[3]};
                o[dvb] = __builtin_amdgcn_mfma_f32_32x32x16_bf16(__builtin_bit_cast(bf16x8, pw[ks]), vf, o[dvb], 0, 0, 0);
            }
            __builtin_amdgcn_sched_barrier(0);
        }
        if (t + 1 < NT) store_tile((t + 1) & 1);
        __syncthreads();
    }
    LAS float* wsf = (LAS float*)(lds + SCR_OFF) + wid * 64;
    int lz = lane; asm volatile("" : "+v"(lz));
    const int r32e = lz & 31, hie = lz >> 5;
    if (diff) {
        lsum += __shfl_xor(lsum, 32);
        if (hie == 0) wsf[r32e] = __builtin_amdgcn_rcpf(lsum);
        LDS_WAIT();
        float rl[16];
#pragma unroll
        for (int r = 0; r < 16; ++r) rl[r] = wsf[crow(r, hie)];
        LAS float* XC = (LAS float*)lds;
        if (comp == 1) {
#pragma unroll
            for (int r = 0; r < 16; ++r) { const int q = qoff + crow(r, hie);
#pragma unroll
                for (int d = 0; d < 4; ++d) XC[q * 128 + 32 * d + r32e] = o[d][r] * rl[r] * u.lam; }
        }
        __syncthreads();
        if (comp == 0) {
            float ss[16];
#pragma unroll
            for (int r = 0; r < 16; ++r) { const int q = qoff + crow(r, hie); float a = 0.f;
#pragma unroll
                for (int d = 0; d < 4; ++d) { const float v = o[d][r] * rl[r] - XC[q * 128 + 32 * d + r32e]; o[d][r] = v; a += v * v; }
                ss[r] = a; }
#pragma unroll
            for (int r = 0; r < 16; ++r) { float a = ss[r]; a += __shfl_xor(a, 1); a += __shfl_xor(a, 2); a += __shfl_xor(a, 4); a += __shfl_xor(a, 8); a += __shfl_xor(a, 16);
                ss[r] = u.scale_out * __builtin_amdgcn_rsqf(a * (1.0f / 128.0f) + EPS); }
            bf16* DO = (bf16*)(F.ws + WS_FO + 2 * MIX_ONE);
#pragma unroll
            for (int r = 0; r < 16; ++r) { bf16* op = DO + (size_t)(u.outrow0 + qoff + crow(r, hie)) * 512 + u.h * 128 + r32e;
#pragma unroll
                for (int d = 0; d < 4; ++d) op[32 * d] = (bf16)f2bf(o[d][r] * ss[r]); }
        }
    } else {
        bf16* RO = (bf16*)(F.ws + WS_FO + 1 * MIX_ONE);
#pragma unroll
        for (int r = 0; r < 16; ++r) {
            float a = (o[0][r] + o[1][r]) + (o[2][r] + o[3][r]);
            a += __shfl_xor(a, 1); a += __shfl_xor(a, 2); a += __shfl_xor(a, 4); a += __shfl_xor(a, 8); a += __shfl_xor(a, 16);
            const float mu = a * (1.0f / 128.0f); float q = 0.f;
#pragma unroll
            for (int d = 0; d < 4; ++d) { const float v = o[d][r] - mu; o[d][r] = v; q += v * v; }
            q += __shfl_xor(q, 1); q += __shfl_xor(q, 2); q += __shfl_xor(q, 4); q += __shfl_xor(q, 8); q += __shfl_xor(q, 16);
            const float rstd = __builtin_amdgcn_rsqf(q * (1.0f / 128.0f) + EPS);
            const size_t row = (size_t)(u.outrow0 + qoff + crow(r, hie));
            const bf16* gp = PROJ + row * NPROJ + C_RG + u.h * 128 + r32e; bf16* op = RO + row * 512 + u.h * 128 + r32e;
#pragma unroll
            for (int d = 0; d < 4; ++d) { const float g = bf2f(gp[32 * d]); op[32 * d] = (bf16)f2bf(o[d][r] * rstd * siluf_(g)); }
        }
    }
    __syncthreads();
}
}

constexpr int NDFT_CU = 128;

__device__ __forceinline__ void phase_mixers(Frame& F, int layer, int rep) {
    const bool last = layer == DEPTH - 1;
#if !defined(ONLY_SUB) || ONLY_SUB == 1
    if ((int)blockIdx.x < NDFT_CU && F.G > NDFT_CU) {
        {
            SchedGrid S{SEQ / 256, 4096 / 256, NDFT_CU, (int)blockIdx.x, (const char*)(F.ws + WS_DFTL), (const char*)(F.ws + WS_GT), (size_t)256 * 4096 * 2, (size_t)256 * 4096 * 2, 0, 0};
            EpiDFT E{(bf16*)(F.ws + WS_FO), SEQ, TC};
            pg8::gemm_phase(F.lds, F.tid, 4096, S, E);
        }
        if (!last) {
            SchedGrid S{1, 4096 / 256, NDFT_CU, (int)blockIdx.x, (const char*)(F.ws + WS_DFTC), (const char*)(F.ws + WS_GTC), (size_t)256 * 512 * 2, (size_t)256 * 512 * 2, 0, 0};
            EpiDFT E{(bf16*)(F.ws + WS_FO), CTX, 0};
            pg8::gemm_phase(F.lds, F.tid, 512, S, E);
        }
    }
#endif
#if defined(ONLY_SUB) && ONLY_SUB == 1
    return;
#endif
    const int nunits = last ? 768 : 864;
    const float lam = lam_of(F, layer), so = 1.0f - lam_init_of(layer);
    unsigned* qctr = F.ctl + CW_QUEUE + 64 * (layer + 2 * rep);
    volatile LAS unsigned* qw = (volatile LAS unsigned*)(F.lds + att::QW_OFF);
    const bool solo = F.G <= NDFT_CU;
    (void)solo;
    for (;;) {
        if (F.tid == 0) *qw = __hip_atomic_fetch_add(qctr, 1u, RLX_AGENT);
        __syncthreads();
        const int i = (int)*qw;
        __syncthreads();
        if (i >= nunits) break;
        att::UnitDesc u{};
        u.lam = lam; u.scale_out = so;
        if (i < 512) { const int b = i >> 6, h = (i >> 4) & 3, qb = i & 15; u.mode = 0; u.h = h; u.qrow0 = TC + b * SEQ + qb * 128; u.qpos0 = qb * 128; u.krowA = TC + b * SEQ; u.ntA = 32; u.krowB = b * CTX; u.ntB = 4; }
        else if (i < 768) { const int j = i - 512, b = j >> 5, h = (j >> 3) & 3, qb = j & 7; u.mode = 1; u.h = h; u.qrow0 = TC + b * SEQ + qb * 256; u.qpos0 = qb * 256; u.krowA = TC + b * SEQ; u.ntA = 32; u.krowB = b * CTX; u.ntB = 4; u.kindB = 1; u.nseq = SEQ; }
        else if (i < 832) { const int j = i - 768, b = j >> 3, h = (j >> 1) & 3, qb = j & 1; u.mode = 0; u.h = h; u.qrow0 = b * CTX + qb * 128; u.qpos0 = qb * 128; u.krowA = b * CTX; u.ntA = 4; u.krowB = 0; u.ntB = 0; }
        else { const int j = i - 832, b = j >> 2, h = j & 3; u.mode = 1; u.h = h; u.qrow0 = b * CTX; u.qpos0 = 0; u.krowA = b * CTX; u.ntA = 4; u.krowB = 0; u.ntB = 0; u.kindB = 0; u.nseq = CTX; }
        u.outrow0 = u.qrow0;
        if (u.mode == 1) { u.lgf = inp(F, IN_RDEC)[(layer * 2 + 0) * 4 + u.h] * LOG2E; u.lgb = inp(F, IN_RDEC)[(layer * 2 + 1) * 4 + u.h] * LOG2E; }
        att::unit(F, u);
    }
}

__device__ __forceinline__ void phase_merge(Frame& F, int layer) {
    const int row_off = layer == DEPTH - 1 ? TC : 0, M = TA - row_off;
    SchedMerge S{M / 256, D / 256, F.G, (int)blockIdx.x, (const char*)(F.ws + WS_FO) + (size_t)row_off * 512 * 2, (const char*)(F.ws + WS_WFO + (size_t)layer * 3 * WMG_ONE), MIX_ONE, WMG_ONE, (size_t)256 * 512 * 2, (size_t)256 * 512 * 2};
    EpiMerge E{(const bf16*)(F.ws + WS_PROJ), (bf16*)(F.ws + WS_MIXB), row_off};
    pg8::gemm_phase(F.lds, F.tid, 512, S, E);
}
__device__ __forceinline__ void phase_outproj(Frame& F, int layer) {
    const int row_off = layer == DEPTH - 1 ? TC : 0, M = TA - row_off;
    SchedGrid S{M / 256, D / 256, F.G, (int)blockIdx.x, (const char*)(F.ws + WS_MIXB) + (size_t)row_off * D * 2, (const char*)(F.ws + WS_WOUT + layer * WOUT_L), (size_t)256 * D * 2, (size_t)256 * D * 2, 0, 0};
    const float* XR = (const float*)(F.ws + WS_XR);
    EpiOut E{layer == 0 ? inp(F, IN_CTX) : XR, layer == 0 ? inp(F, IN_X) : XR + (size_t)TC * D, (float*)(F.ws + WS_XR), (const float*)(F.ws + WS_MOD) + (size_t)layer * 9 * 6144 + 2 * 1024, row_off};
    pg8::gemm_phase(F.lds, F.tid, D, S, E);
}

__device__ __forceinline__ void phase_norm2(Frame& F, int layer) {
    const int gw = F.vcu * 8 + F.wave, NGW = F.G * 8, lane = F.lane, tid = F.tid;
    LAS float* wr_t = (LAS float*)F.lds;
    const float* wrt = inp(F, IN_WROUTER) + (size_t)layer * D * NE;
    for (int i = tid; i < D * NE; i += 512) { const int k = i >> 4, e = i & 15; wr_t[e * 1024 + k] = wrt[i]; }
    __syncthreads();
    const int r_lo = layer == DEPTH - 1 ? TC : 0;
    const float* XR = (const float*)(F.ws + WS_XR); bf16* HB = (bf16*)(F.ws + WS_HB); float* AFF = (float*)(F.ws + WS_AFF);
    for (int r = r_lo + gw; r < TA; r += NGW) {
        const int v = vec_of_row(r);
        f32x4 x[4];
#pragma unroll
        for (int j = 0; j < 4; ++j) x[j] = *(const f32x4*)(XR + (size_t)r * D + 4 * lane + 256 * j);
        float ss = 0.f;
#pragma unroll
        for (int j = 0; j < 4; ++j) ss += (x[j].x * x[j].x + x[j].y * x[j].y) + (x[j].z * x[j].z + x[j].w * x[j].w);
        const float rinv = __builtin_amdgcn_rsqf(wave_sum(ss) * (1.0f / D) + EPS);
        const float* g = inp(F, IN_GFFN) + (size_t)layer * D; const float* sh = mod_ptr(F, layer, v, 3); const float* scl = mod_ptr(F, layer, v, 4);
#pragma unroll
        for (int j = 0; j < 4; ++j) { const int k = 4 * lane + 256 * j; const f32x4 gv = *(const f32x4*)(g + k), sv = *(const f32x4*)(sh + k), cv = *(const f32x4*)(scl + k);
            x[j] = (x[j] * rinv * gv) * (cv + 1.0f) + sv;
            u32x2 w; w.x = pk2(x[j].x, x[j].y); w.y = pk2(x[j].z, x[j].w); *(u32x2*)(HB + (size_t)r * D + k) = w; }
        float mine = 0.f;
#pragma unroll
        for (int eg = 0; eg < 4; ++eg) {
            float a[4];
#pragma unroll
            for (int q = 0; q < 4; ++q) { float t = 0.f;
#pragma unroll
                for (int j = 0; j < 4; ++j) { const f32x4 w = *(const LAS f32x4*)(wr_t + (4 * eg + q) * 1024 + 4 * lane + 256 * j); t += (x[j].x * w.x + x[j].y * w.y) + (x[j].z * w.z + x[j].w * w.w); }
                a[q] = t; }
#pragma unroll
            for (int o = 1; o < 64; o <<= 1) {
#pragma unroll
                for (int q = 0; q < 4; ++q) a[q] += __shfl_xor(a[q], o); }
#pragma unroll
            for (int q = 0; q < 4; ++q) mine = (lane == 4 * eg + q) ? a[q] : mine;
            asm volatile("" ::: "memory");
        }
        float mx = mine;
        mx = fmaxf(mx, __shfl_xor(mx, 1)); mx = fmaxf(mx, __shfl_xor(mx, 2)); mx = fmaxf(mx, __shfl_xor(mx, 4)); mx = fmaxf(mx, __shfl_xor(mx, 8));
        const float ex = __expf(mine - mx); float den = ex;
        den += __shfl_xor(den, 1); den += __shfl_xor(den, 2); den += __shfl_xor(den, 4); den += __shfl_xor(den, 8);
        if (lane < 16) AFF[(size_t)r * 16 + lane] = ex * __builtin_amdgcn_rcpf(den);
    }
    __syncthreads();
}

__device__ __forceinline__ void phase_topk(Frame& F, int layer) {
    const bool last = layer == DEPTH - 1; const int tid = F.tid, lane = F.lane, wave = F.wave;
    const int RPE = last ? 2048 : 2304, lat_off = last ? 0 : 256;
    LAS unsigned* part = (LAS unsigned*)F.lds;
    LAS unsigned* cntG = part + 16;
    LAS unsigned* cntE = cntG + 32;
    LAS int* lst = (LAS int*)(cntE + 32);
    const float* AFF = (const float*)(F.ws + WS_AFF); int* INV = (int*)(F.ws + WS_INV); float* TOPW = (float*)(F.ws + WS_TOPW);
    const bf16* HB = (const bf16*)(F.ws + WS_HB); bf16* XS = (bf16*)(F.ws + WS_XS);
    const int nitems = last ? 128 : 256;
    for (int item = F.vcu; item < nitems; item += F.G) {
        int n, C, tokrow0, e, slot0;
        if (item < 128) { const int b = item >> 4; e = item & 15; n = SEQ; C = 256; tokrow0 = TC + b * SEQ; slot0 = e * RPE + lat_off + b * 256; }
        else { const int be = item - 128, b = be >> 4; e = be & 15; n = CTX; C = 32; tokrow0 = b * CTX; slot0 = e * RPE + b * 32; }
        float v[4]; unsigned key[4];
#pragma unroll
        for (int q = 0; q < 4; ++q) { const int i = tid + 512 * q; v[q] = i < n ? AFF[(size_t)(tokrow0 + i) * 16 + e] : 0.f; key[q] = __builtin_bit_cast(unsigned, v[q]); }
        unsigned t = 0u;
        for (int bit = 30; bit >= 0; --bit) {
            const unsigned cand = t | (1u << bit); unsigned c = 0u;
#pragma unroll
            for (int q = 0; q < 4; ++q) c += (unsigned)__builtin_popcountll(__ballot(key[q] >= cand));
            if (lane == 0) part[(bit & 1) * 8 + wave] = c;
            __syncthreads();
            unsigned tot = 0u;
#pragma unroll
            for (int w = 0; w < 8; ++w) tot += part[(bit & 1) * 8 + w];
            if (tot >= (unsigned)C) t = cand;
        }
        unsigned long long bg[4], be_[4];
#pragma unroll
        for (int q = 0; q < 4; ++q) { bg[q] = __ballot(key[q] > t); be_[q] = __ballot(key[q] == t && key[q] != 0u);
            if (lane == 0) { cntG[q * 8 + wave] = (unsigned)__builtin_popcountll(bg[q]); cntE[q * 8 + wave] = (unsigned)__builtin_popcountll(be_[q]); } }
        __syncthreads();
        unsigned totG = 0u, baseG[4] = {0u, 0u, 0u, 0u}, baseE[4] = {0u, 0u, 0u, 0u}; unsigned runG = 0u, runE = 0u;
#pragma unroll
        for (int q = 0; q < 4; ++q)
#pragma unroll
            for (int w = 0; w < 8; ++w) { const unsigned g = cntG[q * 8 + w], ee = cntE[q * 8 + w]; if (w == wave) { baseG[q] = runG; baseE[q] = runE; } runG += g; runE += ee; }
        totG = runG;
        const unsigned need = (unsigned)C - totG;
        const unsigned long long lt = (1ull << lane) - 1ull;
#pragma unroll
        for (int q = 0; q < 4; ++q) { const int i = tid + 512 * q;
            if (i < n) {
                const bool g = (bg[q] >> lane) & 1ull, eq = (be_[q] >> lane) & 1ull;
                const unsigned myG = baseG[q] + (unsigned)__builtin_popcountll(bg[q] & lt), myE = baseE[q] + (unsigned)__builtin_popcountll(be_[q] & lt);
                int sl = -1;
                if (g) sl = (int)myG; else if (eq && myE < need) sl = (int)(totG + myE);
                const int R = sl >= 0 ? slot0 + sl : -1;
                INV[(size_t)(tokrow0 + i) * 16 + e] = R;
                if (sl >= 0) { TOPW[R] = v[q]; lst[sl] = i; }
            } }
        __syncthreads();
        for (int sidx = wave; sidx < C; sidx += 8) { const int i = lst[sidx];
            const u32x4* src = (const u32x4*)(HB + (size_t)(tokrow0 + i) * D); u32x4* dst = (u32x4*)(XS + (size_t)(slot0 + sidx) * D);
            const u32x4 a = src[lane], bq = src[lane + 64]; dst[lane] = a; dst[lane + 64] = bq; }
        __syncthreads();
    }
}

__device__ __forceinline__ void phase_gateup(Frame& F, int layer) {
    const int RPE = layer == DEPTH - 1 ? 2048 : 2304;
    SchedGrid S{NE * RPE / 256, 4096 / 256, F.G, (int)blockIdx.x, (const char*)(F.ws + WS_XS), (const char*)(F.ws + WS_WGU), (size_t)256 * D * 2, (size_t)256 * D * 2, RPE / 256, WGU_E};
    EpiGU E{(bf16*)(F.ws + WS_HID)};
    pg8::gemm_phase(F.lds, F.tid, D, S, E);
}
__device__ __forceinline__ void phase_down(Frame& F, int layer) {
    const int RPE = layer == DEPTH - 1 ? 2048 : 2304;
    SchedGrid S{NE * RPE / 256, D / 256, F.G, (int)blockIdx.x, (const char*)(F.ws + WS_HID), (const char*)(F.ws + WS_WD), (size_t)256 * EH * 2, (size_t)256 * EH * 2, RPE / 256, WD_E};
    EpiDown E{(bf16*)(F.ws + WS_YE), (const float*)(F.ws + WS_TOPW)};
    pg8::gemm_phase(F.lds, F.tid, EH, S, E);
}

constexpr int NPHASE = 1 + 10 * DEPTH + 1;
__global__ void __launch_bounds__(512, 2) mk_fwd(Args args) {
    extern __shared__ __attribute__((aligned(16))) unsigned char lds_raw[];
    Frame F;
    F.lds = (LAS unsigned char*)lds_raw; F.MISC = (volatile LAS unsigned*)(F.lds + MISC_OFF);
    F.tid = threadIdx.x; F.lane = F.tid & 63; F.wave = __builtin_amdgcn_readfirstlane(F.tid >> 6);
    F.G = gridDim.x; { const int bx = blockIdx.x; F.vcu = (F.G % 8 == 0) ? (bx % 8) * (F.G / 8) + bx / 8 : bx; }
    F.ws = args.ws; F.ctl = (unsigned*)(args.ws + WS_CTL); F.out = args.out;
    for (int u = F.tid; u < (LDS_BYTES - LDSCTL_OFF) / 4; u += 512) ((LAS unsigned*)(F.lds + LDSCTL_OFF))[u] = 0u;
    __syncthreads();
    XcdBarrier bar; bar.bar = F.ctl + CW_BAR; bar.x = 0; bar.st = nullptr;
    const bool multi = (args.ph_hi - args.ph_lo) > 1;
    if (multi) bar = xcd_barrier_post(F.ctl + CW_BAR, F.MISC + 8);
    for (int ph = args.ph_lo; ph < args.ph_hi; ++ph) {
        const int layer = (ph - 1) / 10, k = (ph == 0) ? 10 : (ph == NPHASE - 1) ? 12 : (ph - 1) % 10;
        int reps = 1 + ((PROBE_MASK >> k) & 1);
        if (k == 0 && layer > 0 && (PROBE_MASK & 2048)) reps = 2;
        for (int rep = 0; rep < reps; ++rep) {
            { unsigned long long w = (unsigned long long)args.ws; asm volatile("" : "+s"(w)); F.ws = (unsigned char*)w; F.ctl = (unsigned*)(F.ws + WS_CTL); }
            { unsigned long long kp = (unsigned long long)__builtin_amdgcn_kernarg_segment_ptr(); asm volatile("" : "+s"(kp)); F.karg = (const void __attribute__((address_space(4)))*)kp; }
            { int l = (int)__builtin_amdgcn_mbcnt_hi(~0u, __builtin_amdgcn_mbcnt_lo(~0u, 0u)); asm volatile("" : "+v"(l)); F.lane = l; F.tid = F.wave * 64 + l; }
#ifdef ONLY_PHASE
            if (k != ONLY_PHASE) continue;
#endif
            switch (k) {
                case 10: phase_prologue(F); break;
                case 12: phase_norm(F, DEPTH); break;
                case 0: if (rep == 0) phase_norm(F, layer); if (layer > 0) convert_expert_weights(F, layer); break;
                case 1: phase_inproj(F, layer); break;
                case 2: if (rep == 0) phase_rope(F, layer); break;
                case 3: phase_mixers(F, layer, rep); break;
                case 4: phase_merge(F, layer); break;
                case 5: if (rep == 0) phase_outproj(F, layer); break;
                case 6: phase_norm2(F, layer); break;
                case 7: phase_topk(F, layer); break;
                case 8: phase_gateup(F, layer); break;
                default: phase_down(F, layer); break;
            }
            if (rep + 1 < reps || ph + 1 < args.ph_hi) xcd_barrier(bar);
        }
    }
}

extern "C" void kernel_launch(void* const* d_in, const int* in_sizes, int n_in, void* d_out, int out_size, void* d_ws, size_t ws_size, hipStream_t stream) {
    static int grid = 0;
    if (grid == 0) {
        if (n_in != 21 || out_size != TL * D || ws_size < WS_END) { fprintf(stderr, "kernel_launch: unexpected shapes (n_in %d, out %d, ws %zu need %zu)\n", n_in, out_size, ws_size, (size_t)WS_END); grid = -1; return; }
        int dev = 0, cus = 0, per_cu = 0;
        if (hipGetDevice(&dev) != hipSuccess || hipDeviceGetAttribute(&cus, hipDeviceAttributeMultiprocessorCount, dev) != hipSuccess) { grid = -1; return; }
        if (hipFuncSetAttribute((const void*)mk_fwd, hipFuncAttributeMaxDynamicSharedMemorySize, LDS_BYTES) != hipSuccess) { fprintf(stderr, "kernel_launch: hipFuncSetAttribute failed\n"); grid = -1; return; }
        if (hipOccupancyMaxActiveBlocksPerMultiprocessor(&per_cu, (const void*)mk_fwd, 512, LDS_BYTES) != hipSuccess || per_cu < 1) { fprintf(stderr, "kernel_launch: occupancy query says %d\n", per_cu); per_cu = 1; }
        (void)hipGetLastError();
        grid = cus * (per_cu >= 1 ? 1 : 1);
        if (grid % 8 != 0 || grid <= NDFT_CU) fprintf(stderr, "kernel_launch: unusual grid %d\n", grid);
    }
    if (grid < 0) return;
    (void)hipMemsetAsync((char*)d_ws + WS_CTL, 0, CTL_BYTES, stream);
    Args a{};
    for (int i = 0; i < 21; ++i) a.in[i] = (const float*)d_in[i];
    a.out = (float*)d_out; a.ws = (unsigned char*)d_ws;
#if MK_MULTI_LAUNCH
    for (int ph = 0; ph < NPHASE; ++ph) { a.ph_lo = ph; a.ph_hi = ph + 1; hipLaunchKernelGGL(mk_fwd, dim3(grid), dim3(512), LDS_BYTES, stream, a); }
#else
    a.ph_lo = 0; a.ph_hi = NPHASE;
    void* kargs[] = {&a};
    hipError_t e = hipLaunchCooperativeKernel((const void*)mk_fwd, dim3(grid), dim3(512), kargs, LDS_BYTES, stream);
    if (e != hipSuccess) fprintf(stderr, "kernel_launch: cooperative launch failed: %s (grid %d)\n", hipGetErrorString(e), grid);
#endif
}
```

```cpp
#include <hip/hip_runtime.h>
#include <cstdio>
#include <cstdint>

#ifndef PROBE_MASK
#define PROBE_MASK 0
#endif
#ifndef MK_MULTI_LAUNCH
#define MK_MULTI_LAUNCH 0
#endif

#define GAS __attribute__((address_space(1)))
#define LAS __attribute__((address_space(3)))
typedef unsigned short bf16;
typedef short bf16x8 __attribute__((ext_vector_type(8)));
typedef short s16x4 __attribute__((ext_vector_type(4)));
typedef float f32x4 __attribute__((ext_vector_type(4)));
typedef float f32x16 __attribute__((ext_vector_type(16)));
typedef unsigned u32x4 __attribute__((ext_vector_type(4)));
typedef unsigned u32x2 __attribute__((ext_vector_type(2)));
typedef float f32x2_t __attribute__((ext_vector_type(2)));
typedef __bf16 bf16x2_t __attribute__((ext_vector_type(2)));

constexpr int D = 1024, NB = 8, SEQ = 2048, CTX = 256, DEPTH = 2, GRIDW = 64;
constexpr int TC = NB * CTX, TL = NB * SEQ, TA = TC + TL;
constexpr int NPROJ = 6144;
constexpr int C_RQ = 0, C_RK = 256, C_RV = 512, C_RG = 1024, C_DQ = 1536, C_DK = 2048, C_DV = 2560, C_GATE = 3072;
constexpr int INW = 6656;
constexpr int NE = 16, EH = 2048;
constexpr float EPS = 1e-6f;
constexpr float LOG2E = 1.4426950408889634f;

constexpr size_t al(size_t x) { return (x + 0xFFFFFull) & ~0xFFFFFull; }
constexpr size_t WS_CTL = 0, CTL_BYTES = 1u << 20;
constexpr size_t WS_MOD = WS_CTL + CTL_BYTES;
constexpr size_t WS_ROPE = WS_MOD + al((size_t)DEPTH * 9 * 6 * D * 4);
constexpr size_t WS_AFF = WS_ROPE + al((size_t)2 * SEQ * 32 * 4);
constexpr size_t WS_INV = WS_AFF + al((size_t)TA * 16 * 4);
constexpr size_t WS_TOPW = WS_INV + al((size_t)TA * 16 * 4);
constexpr size_t WS_WIN = WS_TOPW + al((size_t)36864 * 4);
constexpr size_t WIN_L = (size_t)7168 * 1024 * 2;
constexpr size_t WS_WFO = WS_WIN + al(2 * WIN_L);
constexpr size_t WMG_ONE = (size_t)1024 * 512 * 2;
constexpr size_t WS_WOUT = WS_WFO + al(6 * WMG_ONE);
constexpr size_t WOUT_L = (size_t)1024 * 1024 * 2;
constexpr size_t WS_WGU = WS_WOUT + al(2 * WOUT_L);
constexpr size_t WGU_E = (size_t)4096 * 1024 * 2;
constexpr size_t WS_WD = WS_WGU + al(16 * WGU_E);
constexpr size_t WD_E = (size_t)1024 * 2048 * 2;
constexpr size_t WS_DFTL = WS_WD + al(16 * WD_E);
constexpr size_t WS_DFTC = WS_DFTL + al((size_t)2048 * 4096 * 2);
constexpr size_t WS_XR = WS_DFTC + al((size_t)256 * 512 * 2);
constexpr size_t WS_HB = WS_XR + al((size_t)TA * D * 4);
constexpr size_t WS_PROJ = WS_HB + al((size_t)TA * D * 2);
constexpr size_t WS_GT = WS_PROJ + al((size_t)TA * NPROJ * 2);
constexpr size_t WS_GTC = WS_GT + al((size_t)4096 * 4096 * 2);
constexpr size_t WS_FO = WS_GTC + al((size_t)4096 * 512 * 2);
constexpr size_t MIX_ONE = (size_t)TA * 512 * 2;
constexpr size_t WS_MIXB = WS_FO + al(3 * MIX_ONE);
constexpr size_t WS_XS = WS_MIXB + al((size_t)TA * D * 2);
constexpr size_t WS_LBUF = WS_XS + al((size_t)36864 * D * 2);
constexpr size_t LBUF_ONE = (size_t)64 * 128 * 4;
constexpr size_t WS_END = WS_LBUF + al((size_t)32 * 9 * 2 * LBUF_ONE);
constexpr size_t WS_HID = WS_PROJ;
constexpr size_t WS_YE = WS_XS;
static_assert((size_t)36864 * EH * 2 <= (size_t)TA * NPROJ * 2, "HID overlays PROJ");
static_assert(WS_END <= (size_t)1024 * 1024 * 1024, "workspace map must fit 1 GiB");

constexpr int CW_BAR = 4096;
constexpr int CW_QUEUE = 16384;

constexpr int RING_BYTES = 131072;
constexpr int LDSCTL_OFF = RING_BYTES, MISC_OFF = LDSCTL_OFF + 320;
constexpr int LDS_BYTES = 147456;

#define RLX_AGENT __ATOMIC_RELAXED, __HIP_MEMORY_SCOPE_AGENT
#define LDS_WAIT() asm volatile("s_waitcnt lgkmcnt(0)" ::: "memory")
#define VM_WAIT() asm volatile("s_waitcnt vmcnt(0)" ::: "memory")
__device__ __forceinline__ unsigned f2bf(float f) { unsigned u = __builtin_bit_cast(unsigned, f); return (u + 0x7fffu + ((u >> 16) & 1u)) >> 16; }
__device__ __forceinline__ unsigned pk2(float lo, float hi) { f32x2_t v = {lo, hi}; bf16x2_t b = __builtin_convertvector(v, bf16x2_t); return __builtin_bit_cast(unsigned, b); }
__device__ __forceinline__ float bflo(unsigned w) { return __builtin_bit_cast(float, w << 16); }
__device__ __forceinline__ float bfhi(unsigned w) { return __builtin_bit_cast(float, w & 0xffff0000u); }
__device__ __forceinline__ float bf2f(bf16 h) { return __builtin_bit_cast(float, (unsigned)h << 16); }
__device__ __forceinline__ float wave_sum(float v) {
#pragma unroll
    for (int o = 1; o < 64; o <<= 1) v += __shfl_xor(v, o);
    return v;
}
__device__ __forceinline__ float sigmoidf_(float x) { return __builtin_amdgcn_rcpf(1.0f + __builtin_amdgcn_exp2f(-x * LOG2E)); }
__device__ __forceinline__ float siluf_(float x) { return x * sigmoidf_(x); }

namespace pg8 {
constexpr int BM = 256, BK = 64, HALF = 128, HTB = HALF * BK * 2, STAGE_BYTES = 8 * HTB, NXCD = 8, WGM = 8;
__host__ __device__ __forceinline__ int lds_byte(int r, int c) { const int st = (r >> 4) * 2 + (c >> 5), rr = r & 15, cc = c & 31, ob = rr * 64 + cc * 2; return st * 1024 + (ob ^ (((ob >> 9) & 1) << 5)); }
__host__ __device__ __forceinline__ void stage_rc(int b, int& R, int& C) { const int st = b / 1024, sb = b % 1024, swz = sb ^ (((sb >> 9) & 1) << 5); R = (st >> 1) * 16 + swz / 64; C = (st & 1) * 32 + (swz % 64) / 2; }
__host__ __device__ __forceinline__ int perm32(int rho) { const int n = rho >> 4, i = rho & 15; return 8 * (i >> 2) + 4 * n + (i & 3); }

struct Unit { int pm, pn, tag; const char* A; const char* B; };

__device__ __forceinline__ bool grid_order(long L, int nM, int nN, int& pm, int& pn) {
    const int nwg = nM * nN; if (L >= nwg) return false;
    int wgid = (int)L; { const int q = nwg / NXCD, r = nwg % NXCD, xcd = wgid % NXCD, off = wgid / NXCD; wgid = (xcd < r ? xcd * (q + 1) : r * (q + 1) + (xcd - r) * q) + off; }
    const int nig = WGM * nN, gid = wgid / nig, fm = gid * WGM, gsz = (nM - fm) < WGM ? (nM - fm) : WGM;
    pm = fm + ((wgid % nig) % gsz); pn = (wgid % nig) / gsz; return true;
}

typedef f32x4 Acc[2][2][4][2];
__device__ __forceinline__ void zero_acc(Acc& acc) {
#pragma unroll
    for (int a = 0; a < 2; ++a)
#pragma unroll
        for (int b = 0; b < 2; ++b)
#pragma unroll
            for (int m = 0; m < 4; ++m)
#pragma unroll
                for (int n = 0; n < 2; ++n) acc[a][b][m][n] = (f32x4){0.f, 0.f, 0.f, 0.f};
}

template <class Epi, class Sched>
__device__ __forceinline__ void gemm_phase(LAS unsigned char* lds, const int tid, const int K, const Sched& S, const Epi& E) {
    const int wid = __builtin_amdgcn_readfirstlane(tid >> 6), lane = tid & 63, wr = wid >> 2, wc = wid & 3, fr = lane & 15, fq = lane >> 4;
    const int nt = K / BK;
    unsigned voffA[2], voffB[2];
#pragma unroll
    for (int i = 0; i < 2; ++i) { int R, C; stage_rc(tid * 16 + i * 8192, R, C); const int Rb = Epi::PERM ? ((R & ~31) + perm32(R & 31)) : R;
        voffA[i] = (unsigned)(R * K + C) * 2u; voffB[i] = (unsigned)(Rb * K + C) * 2u; }
    const size_t kstep = (size_t)(BK * 2);
    const size_t hstep = (size_t)HALF * K * 2;
    const unsigned ldsw = (unsigned)wid * 1024u;
    const int aoff = lds_byte(wr * 64 + fr, fq * 8), boff = lds_byte(wc * 32 + fr, fq * 8);
#define PG8_SA(b, h) (((b) * 2 + (h)) * HTB)
#define PG8_SB(b, h) ((4 + (b) * 2 + (h)) * HTB)
#define PG8_STAGE(bufoff, gbase, voff) do { _Pragma("unroll") for (int _i = 0; _i < 2; ++_i) \
        __builtin_amdgcn_global_load_lds((const unsigned*)((const char*)(gbase) + (voff)[_i]), (LAS unsigned*)(lds + (bufoff) + ldsw + _i * 8192), 16, 0, 0); } while (0)
#define PG8_LDA(dst, b, h) do { _Pragma("unroll") for (int m = 0; m < 4; ++m) _Pragma("unroll") for (int k = 0; k < 2; ++k) dst[m][k] = *(const LAS bf16x8*)(lds + PG8_SA(b, h) + aoff + m * 2048 + k * 1024); } while (0)
#define PG8_LDB(dst, b, h) do { _Pragma("unroll") for (int n = 0; n < 2; ++n) _Pragma("unroll") for (int k = 0; k < 2; ++k) dst[n][k] = *(const LAS bf16x8*)(lds + PG8_SB(b, h) + boff + n * 2048 + k * 1024); } while (0)
#define PG8_MMA(ai, bj, At, Bt) do { __builtin_amdgcn_s_setprio(1); _Pragma("unroll") for (int m = 0; m < 4; ++m) _Pragma("unroll") for (int n = 0; n < 2; ++n) _Pragma("unroll") for (int k = 0; k < 2; ++k) \
        acc[ai][bj][m][n] = __builtin_amdgcn_mfma_f32_16x16x32_bf16(Bt[n][k], At[m][k], acc[ai][bj][m][n], 0, 0, 0); __builtin_amdgcn_s_setprio(0); } while (0)
#define PG8_WAIT_V(n) asm volatile("s_waitcnt vmcnt(" #n ")" ::: "memory")
#define PG8_WAIT_L(n) asm volatile("s_waitcnt lgkmcnt(" #n ")" ::: "memory")
#define PG8_BAR __builtin_amdgcn_s_barrier()
#define PG8_SCHED __builtin_amdgcn_sched_barrier(0)
    Unit cur, nxt; int ui = 0;
    if (!S.next(0, cur)) return;
    Acc acc; zero_acc(acc);
    bf16x8 At[4][2], B0[2][2], B1[2][2];
    const char* cA = cur.A; const char* cB = cur.B;
    PG8_STAGE(PG8_SB(0, 0), cB, voffB); PG8_STAGE(PG8_SB(0, 1), cB + hstep, voffB); PG8_STAGE(PG8_SA(0, 0), cA, voffA); PG8_STAGE(PG8_SA(0, 1), cA + hstep, voffA);
    if (wr == 1) PG8_BAR;
    PG8_WAIT_V(2); PG8_BAR;
    PG8_STAGE(PG8_SB(1, 0), cB + kstep, voffB); PG8_STAGE(PG8_SA(1, 0), cA + kstep, voffA); PG8_STAGE(PG8_SB(1, 1), cB + hstep + kstep, voffB);
    PG8_WAIT_V(6); PG8_BAR;
    for (;;) {
        const bool has_next = S.next(ui + 1, nxt);
        const char* nA = has_next ? nxt.A : cA; const char* nB = has_next ? nxt.B : cB;
        for (int t = 0; t < nt; t += 2) {
            const bool last = (t == nt - 2);
            const char* a1 = cA + (size_t)(t + 1) * kstep;
            const char* a2 = last ? nA : cA + (size_t)(t + 2) * kstep; const char* b2 = last ? nB : cB + (size_t)(t + 2) * kstep;
            const char* a3 = a2 + kstep; const char* b3 = b2 + kstep;
            PG8_LDB(B0, 0, 0); PG8_LDB(B1, 0, 1); PG8_SCHED; PG8_LDA(At, 0, 0); PG8_STAGE(PG8_SA(1, 1), a1 + hstep, voffA);
            PG8_WAIT_V(8); PG8_WAIT_L(0); PG8_BAR; PG8_MMA(0, 0, At, B0); PG8_MMA(0, 1, At, B1); PG8_BAR; PG8_SCHED;
            PG8_LDA(At, 0, 1); PG8_STAGE(PG8_SB(0, 0), b2, voffB); PG8_STAGE(PG8_SB(0, 1), b2 + hstep, voffB); PG8_STAGE(PG8_SA(0, 0), a2, voffA);
            PG8_WAIT_V(8); PG8_WAIT_L(0); PG8_BAR; PG8_MMA(1, 0, At, B0); PG8_MMA(1, 1, At, B1); PG8_BAR; PG8_SCHED;
            PG8_LDB(B0, 1, 0); PG8_LDB(B1, 1, 1); PG8_SCHED; PG8_LDA(At, 1, 0); PG8_STAGE(PG8_SA(0, 1), a2 + hstep, voffA);
            PG8_WAIT_V(8); PG8_WAIT_L(0); PG8_BAR; PG8_MMA(0, 0, At, B0); PG8_MMA(0, 1, At, B1); PG8_BAR; PG8_SCHED;
            PG8_LDA(At, 1, 1); PG8_STAGE(PG8_SB(1, 0), b3, voffB); PG8_STAGE(PG8_SB(1, 1), b3 + hstep, voffB); PG8_STAGE(PG8_SA(1, 0), a3, voffA);
            PG8_WAIT_V(8); PG8_WAIT_L(0); PG8_BAR; PG8_MMA(1, 0, At, B0); PG8_MMA(1, 1, At, B1); PG8_BAR; PG8_SCHED;
        }
        if (wr == 0) PG8_BAR;
        E(acc, cur, wr, wc, fr, fq);
        if (!has_next) break;
        cur = nxt; cA = nA; cB = nB; ++ui;
        if (wr == 1) PG8_BAR;
    }
    PG8_WAIT_V(0);
    PG8_BAR;
#undef PG8_SA
#undef PG8_SB
#undef PG8_STAGE
#undef PG8_LDA
#undef PG8_LDB
#undef PG8_MMA
#undef PG8_WAIT_V
#undef PG8_WAIT_L
#undef PG8_BAR
#undef PG8_SCHED
}
}

#define XB_TMO      128
#define XB_XCNT(j)  (256  + 64 * (j))
#define XB_XSUB(j)  (1280 + 64 * (j))
#define XB_XGEN(j)  (2304 + 64 * (j))
#define XB_TOP      3328
#define XB_TOPGEN   3392
#define XCD_BAR_WORDS 3456
#define XB_SPIN_CAP (1u << 22)
__device__ __forceinline__ unsigned xb_ld(unsigned* p)              { return __hip_atomic_load(p, __ATOMIC_RELAXED, __HIP_MEMORY_SCOPE_AGENT); }
__device__ __forceinline__ unsigned xb_add(unsigned* p, unsigned v) { return __hip_atomic_fetch_add(p, v, __ATOMIC_RELAXED, __HIP_MEMORY_SCOPE_AGENT); }
__device__ __forceinline__ unsigned xb_xcc_id() { return (unsigned)__builtin_amdgcn_s_getreg((3 << 11) | 20) & 0xFu; }
#define XB_SPIN(cond, bar) do { unsigned _sp = 0; while (cond) { __builtin_amdgcn_s_sleep(1); \
    if ((++_sp & 255u) == 0u) { if (xb_ld(&(bar)[XB_TMO])) break; if (_sp > XB_SPIN_CAP) { atomicAdd(&(bar)[XB_TMO], 1u); break; } } } } while (0)
struct XcdBarrier { unsigned* bar; unsigned x; volatile LAS unsigned* st; };
__device__ __forceinline__ XcdBarrier xcd_barrier_post(unsigned* bar, volatile LAS unsigned* st) {
    XcdBarrier b; b.bar = bar; b.x = xb_xcc_id(); b.st = st;
    if (threadIdx.x == 0) (void)xb_add(&bar[XB_XCNT(b.x)], 1u);
    return b;
}
__device__ __forceinline__ void xcd_barrier_complete(unsigned* bar, unsigned x, unsigned& nloc, unsigned& nx) {
    const unsigned G = gridDim.x * gridDim.y * gridDim.z;
    unsigned sum, cnt, mine, sp = 0u;
    for (;;) {
        sum = 0u; cnt = 0u; mine = 0u;
#pragma unroll
        for (unsigned j = 0; j < 16; ++j) { const unsigned c = xb_ld(&bar[XB_XCNT(j)]); sum += c; cnt += (c > 0u) ? 1u : 0u; mine = (j == x) ? c : mine; }
        if (sum == G) break;
        __builtin_amdgcn_s_sleep(1);
        if ((++sp & 255u) == 0u) { if (xb_ld(&bar[XB_TMO])) break; if (sp > XB_SPIN_CAP) { atomicAdd(&bar[XB_TMO], 1u); break; } }
    }
    nloc = mine > 0u ? mine : 1u; nx = cnt > 0u ? cnt : 1u;
}
__device__ __forceinline__ void xcd_barrier(const XcdBarrier& b) {
    asm volatile("s_waitcnt vmcnt(0)" ::: "memory");
    __syncthreads();
    if (threadIdx.x == 0) {
        unsigned* bar = b.bar;
        __builtin_amdgcn_s_waitcnt(0);
        unsigned nloc = b.st[0], nx = b.st[1];
        if (nloc == 0u) { xcd_barrier_complete(bar, b.x, nloc, nx); b.st[0] = nloc; b.st[1] = nx; }
        const unsigned old = xb_add(&bar[XB_XSUB(b.x)], 1u);
        const unsigned gen = old / nloc;
        if (old + 1u == (gen + 1u) * nloc) {
            __builtin_amdgcn_fence(__ATOMIC_RELEASE, "agent");
            asm volatile("s_waitcnt vmcnt(0)" ::: "memory");
            const unsigned og = xb_add(&bar[XB_TOP], 1u);
            const unsigned tg = og / nx;
            if (og + 1u == (tg + 1u) * nx) xb_add(&bar[XB_TOPGEN], 1u);
            else XB_SPIN(xb_ld(&bar[XB_TOPGEN]) == tg, bar);
            __builtin_amdgcn_fence(__ATOMIC_ACQUIRE, "agent");
            xb_add(&bar[XB_XGEN(b.x)], 1u);
            asm volatile("s_waitcnt vmcnt(0)" ::: "memory");
        } else {
            XB_SPIN(xb_ld(&bar[XB_XGEN(b.x)]) == gen, bar);
            __builtin_amdgcn_fence(__ATOMIC_ACQUIRE, "agent");
            asm volatile("s_waitcnt vmcnt(0)" ::: "memory");
        }
    }
    __syncthreads();
}

struct Args { const float* in[21]; float* out; unsigned char* ws; int ph_lo, ph_hi; };
struct Frame {
    LAS unsigned char* lds; volatile LAS unsigned* MISC; unsigned* ctl;
    int tid, lane, wave, vcu, G;
    const void __attribute__((address_space(4)))* karg; float* out; unsigned char* ws;
};
__device__ __forceinline__ const float* inp(const Frame& F, int i) { return ((const float* const __attribute__((address_space(4)))*)F.karg)[i]; }
#define IN_X 0
#define IN_C 1
#define IN_CTX 2
#define IN_CCTX 3
#define IN_WMOD 4
#define IN_BMOD 5
#define IN_GATTN 6
#define IN_GFFN 7
#define IN_WIN 8
#define IN_RDEC 9
#define IN_QN 10
#define IN_KN 11
#define IN_LAMBDA 12
#define IN_WFO 13
#define IN_WRO 14
#define IN_WDO 15
#define IN_WOUT 16
#define IN_WROUTER 17
#define IN_WEG 18
#define IN_WEU 19
#define IN_WED 20

__device__ __forceinline__ int vec_of_row(int r) { return r < TC ? 8 : (r - TC) / SEQ; }
__device__ __forceinline__ const float* mod_ptr(const Frame& F, int layer, int v, int i) { return (const float*)(F.ws + WS_MOD) + ((size_t)(layer * 9 + v) * 6 + i) * D; }
__device__ __forceinline__ float lam_init_of(int layer) { return layer == 0 ? 0.2f : 0.8f - 0.6f * 0.74081822068171788f; }
__device__ __forceinline__ float lam_of(const Frame& F, int layer) {
    const float* L = inp(F, IN_LAMBDA) + (size_t)layer * 4 * 64; float s1 = 0.f, s2 = 0.f;
    for (int i = 0; i < 64; ++i) { s1 += L[i] * L[64 + i]; s2 += L[128 + i] * L[192 + i]; }
    return __expf(s1) - __expf(s2) + lam_init_of(layer);
}

__device__ __forceinline__ void transpose_item(const float* W, int ldw, int K, int k0, int n0src, bf16* WT, int dst_row0, LAS float* scr, int lane) {
#pragma unroll 8
    for (int i = 0; i < 32; ++i) { const int kk = 2 * i + (lane >> 5); scr[kk * 33 + (lane & 31)] = W[(size_t)(k0 + kk) * ldw + n0src + (lane & 31)]; }
    LDS_WAIT(); asm volatile("" ::: "memory");
    const int c = lane & 7;
#pragma unroll
    for (int j = 0; j < 4; ++j) { const int n = (lane >> 3) + 8 * j; const LAS float* s = scr + (8 * c) * 33 + n;
        u32x4 o; o.x = pk2(s[0 * 33], s[1 * 33]); o.y = pk2(s[2 * 33], s[3 * 33]); o.z = pk2(s[4 * 33], s[5 * 33]); o.w = pk2(s[6 * 33], s[7 * 33]);
        *(u32x4*)(WT + (size_t)(dst_row0 + n) * K + k0 + 8 * c) = o; }
    LDS_WAIT(); asm volatile("" ::: "memory");
}
template <class RowMap>
__device__ __forceinline__ void transpose_matrix(Frame& F, const float* W, int ldw, int csrc, int K, int N, bf16* WT, RowMap map, int& item_base) {
    LAS float* scr = (LAS float*)(F.lds + F.wave * 16384);
    const int gw = F.vcu * 8 + F.wave, NGW = F.G * 8;
    const int nblk = N / 32, nitems = (K / 64) * nblk;
    int start = (gw - item_base % NGW + NGW) % NGW;
    for (int it = start; it < nitems; it += NGW) { const int kb = it / nblk, nb = it % nblk; transpose_item(W, ldw, K, 64 * kb, csrc + 32 * nb, WT, map(32 * nb), scr, F.lane); }
    item_base += nitems;
}
struct MapId { int off; __device__ int operator()(int n) const { return off + n; } };
struct MapProj { __device__ int operator()(int n) const { const int tile = n >> 8; const bool qk = tile < 2 || (tile >= 6 && tile < 10); return qk ? (tile << 8) + 128 * ((n >> 5) & 1) + 32 * ((n >> 6) & 3) + (n & 31) : n; } };
struct MapGU { int up; __device__ int operator()(int n) const { return (n >> 7) * 256 + up * 128 + (n & 127); } };

__device__ __forceinline__ void convert_expert_weights(Frame& F, int layer) {
    int base = 0;
    for (int e = 0; e < NE; ++e) {
        const float* wg = inp(F, IN_WEG) + ((size_t)layer * NE + e) * D * EH; const float* wu = inp(F, IN_WEU) + ((size_t)layer * NE + e) * D * EH; const float* wd = inp(F, IN_WED) + ((size_t)layer * NE + e) * EH * D;
        bf16* gu = (bf16*)(F.ws + WS_WGU + e * WGU_E); bf16* dn = (bf16*)(F.ws + WS_WD + e * WD_E);
        transpose_matrix(F, wg, EH, 0, D, EH, gu, MapGU{0}, base);
        transpose_matrix(F, wu, EH, 0, D, EH, gu, MapGU{1}, base);
        transpose_matrix(F, wd, D, 0, EH, D, dn, MapId{0}, base);
    }
}

__device__ __forceinline__ void phase_prologue(Frame& F) {
    const int tid = F.tid;
    {
        LAS float* sc = (LAS float*)F.lds;
        LAS float* red = sc + 9 * 1024;
        for (int i = tid; i < 9 * 1024; i += 512) { const int v = i >> 10, k = i & 1023; const float c = v < 8 ? inp(F, IN_C)[v * D + k] : inp(F, IN_CCTX)[k]; sc[i] = siluf_(c); }
        __syncthreads();
        for (int item = F.vcu; item < DEPTH * 96; item += F.G) {
            const int layer = item / 96, cb = item % 96, col = cb * 64 + (tid & 63), kg = tid >> 6;
            const float* w = inp(F, IN_WMOD) + (size_t)layer * D * 6144 + col;
            float a[9];
#pragma unroll
            for (int v = 0; v < 9; ++v) a[v] = 0.f;
#pragma unroll 4
            for (int kk = 0; kk < 128; ++kk) { const int k = kg * 128 + kk; const float wv = w[(size_t)k * 6144];
#pragma unroll
                for (int v = 0; v < 9; ++v) a[v] += sc[v * 1024 + k] * wv; }
#pragma unroll
            for (int v = 0; v < 9; ++v) red[(kg * 64 + (tid & 63)) * 9 + v] = a[v];
            __syncthreads();
            for (int o = tid; o < 64 * 9; o += 512) { const int cc = o / 9, v = o % 9; float s = 0.f;
                for (int g = 0; g < 8; ++g) s += red[(g * 64 + cc) * 9 + v];
                const int colo = cb * 64 + cc;
                ((float*)(F.ws + WS_MOD))[(size_t)(layer * 9 + v) * 6144 + colo] = s + inp(F, IN_BMOD)[layer * 6144 + colo]; }
            __syncthreads();
        }
    }
    {
        const int gt = F.vcu * 512 + tid, NT = F.G * 512;
        float* rc = (float*)(F.ws + WS_ROPE); float* rs = rc + SEQ * 32;
        for (int i = gt; i < SEQ * 32; i += NT) { const int pos = i >> 5, f = i & 31; const float inv = __builtin_amdgcn_exp2f(-(float)(f & 15) * (13.287712379549449f / 16.0f));
            const float p = (f < 16) ? (float)(pos / GRIDW) : (float)(pos % GRIDW); const float ang = p * inv; rc[i] = __builtin_amdgcn_cosf(ang * 0.15915494309189535f); rs[i] = __builtin_amdgcn_sinf(ang * 0.15915494309189535f); }
        LAS float* ct = (LAS float*)F.lds;
        __syncthreads();
        for (int m = tid; m < 2048; m += 512) ct[m] = __builtin_amdgcn_cosf((float)m * (1.0f / 2048.0f));
        __syncthreads();
        bf16* dl = (bf16*)(F.ws + WS_DFTL); const float sl = 0.022097086912079608f;
        for (int i = gt; i < 2048 * 2048; i += NT) {
            const int k = i >> 11, n = i & 2047, m = (k * n) & 2047; const float c = ct[m], s = ct[(m - 512) & 2047];
            dl[(size_t)k * 4096 + n] = (bf16)f2bf(c * sl); dl[(size_t)k * 4096 + 2048 + n] = (bf16)f2bf(-s * sl); }
        bf16* dc = (bf16*)(F.ws + WS_DFTC);
        for (int i = gt; i < 256 * 256; i += NT) { const int k = i >> 8, n = i & 255, m = ((k * n) & 255) * 8; const float c = ct[m], s = ct[(m - 512) & 2047];
            dc[(size_t)k * 512 + n] = (bf16)f2bf(c * 0.0625f); dc[(size_t)k * 512 + 256 + n] = (bf16)f2bf(-s * 0.0625f); }
        for (int layer = 0; layer < DEPTH; ++layer) {
            const float* win = inp(F, IN_WIN) + (size_t)layer * D * INW; bf16* wt = (bf16*)(F.ws + WS_WIN + layer * WIN_L) + (size_t)6144 * 1024;
            for (int i = gt; i < 1024 * 1024; i += NT) { const int k = i & 1023, no = i >> 10, part = no >> 9, g = (no >> 6) & 7, cp = no & 63;
                const float* src = win + (size_t)k * INW + g * 64; float s = 0.f;
                for (int c = 0; c < 64; ++c) { const int m = ((c * cp) & 63) * 32; const float t = part == 0 ? ct[m] : ct[(m - 512) & 2047]; s += src[c] * t; }
                wt[(size_t)no * 1024 + k] = (bf16)f2bf(s * 0.125f); }
        }
        __syncthreads();
    }
    {
        int base = 0;
        for (int layer = 0; layer < DEPTH; ++layer) {
            transpose_matrix(F, inp(F, IN_WIN) + (size_t)layer * D * INW, INW, 512, D, NPROJ, (bf16*)(F.ws + WS_WIN + layer * WIN_L), MapProj{}, base);
            transpose_matrix(F, inp(F, IN_WFO) + (size_t)layer * 512 * D, D, 0, 512, D, (bf16*)(F.ws + WS_WFO + (layer * 3 + 0) * WMG_ONE), MapId{0}, base);
            transpose_matrix(F, inp(F, IN_WRO) + (size_t)layer * 512 * D, D, 0, 512, D, (bf16*)(F.ws + WS_WFO + (layer * 3 + 1) * WMG_ONE), MapId{0}, base);
            transpose_matrix(F, inp(F, IN_WDO) + (size_t)layer * 512 * D, D, 0, 512, D, (bf16*)(F.ws + WS_WFO + (layer * 3 + 2) * WMG_ONE), MapId{0}, base);
            transpose_matrix(F, inp(F, IN_WOUT) + (size_t)layer * D * D, D, 0, D, D, (bf16*)(F.ws + WS_WOUT + layer * WOUT_L), MapId{0}, base);
        }
    }
    convert_expert_weights(F, 0);
}

__device__ __forceinline__ void phase_norm(Frame& F, int layer) {
    const int gw = F.vcu * 8 + F.wave, NGW = F.G * 8, lane = F.lane;
    const bool fin = layer == DEPTH; const int r_lo = (layer >= DEPTH - 1) ? (fin ? TC : 0) : 0;
    float* XR = (float*)(F.ws + WS_XR); const int* INV = (const int*)(F.ws + WS_INV); const bf16* YE = (const bf16*)(F.ws + WS_YE); bf16* HB = (bf16*)(F.ws + WS_HB);
    for (int r = r_lo + gw; r < TA; r += NGW) {
        const int v = vec_of_row(r);
        f32x4 x[4];
        if (layer == 0) { const float* src = r < TC ? inp(F, IN_CTX) + (size_t)r * D : inp(F, IN_X) + (size_t)(r - TC) * D;
#pragma unroll
            for (int j = 0; j < 4; ++j) x[j] = *(const f32x4*)(src + 4 * lane + 256 * j);
        } else {
            const float* src = XR + (size_t)r * D;
#pragma unroll
            for (int j = 0; j < 4; ++j) x[j] = *(const f32x4*)(src + 4 * lane + 256 * j);
            if (!(layer == DEPTH - 1 + 1 && false)) {
                const bool has_moe = !(layer == 1 && r < TC && false);
                if (has_moe) {
                    f32x4 s[4];
#pragma unroll
                    for (int j = 0; j < 4; ++j) s[j] = (f32x4){0.f, 0.f, 0.f, 0.f};
                    const int* inv = INV + (size_t)r * 16;
                    for (int e = 0; e < NE; ++e) { const int slot = __builtin_amdgcn_readfirstlane(inv[e]);
                        if (slot >= 0) { const bf16* y = YE + (size_t)slot * D;
#pragma unroll
                            for (int j = 0; j < 4; ++j) { const u32x2 w = *(const u32x2*)(y + 4 * lane + 256 * j); s[j] += (f32x4){bflo(w.x), bfhi(w.x), bflo(w.y), bfhi(w.y)}; } } }
                    const float* m5 = mod_ptr(F, layer - 1, v, 5);
#pragma unroll
                    for (int j = 0; j < 4; ++j) x[j] += *(const f32x4*)(m5 + 4 * lane + 256 * j) * s[j];
                }
            }
        }
        if (fin) {
#pragma unroll
            for (int j = 0; j < 4; ++j) *(f32x4*)(F.out + (size_t)(r - TC) * D + 4 * lane + 256 * j) = x[j];
            continue;
        }
        if (layer > 0) {
#pragma unroll
            for (int j = 0; j < 4; ++j) *(f32x4*)(XR + (size_t)r * D + 4 * lane + 256 * j) = x[j];
        }
        float ss = 0.f;
#pragma unroll
        for (int j = 0; j < 4; ++j) ss += (x[j].x * x[j].x + x[j].y * x[j].y) + (x[j].z * x[j].z + x[j].w * x[j].w);
        const float rinv = __builtin_amdgcn_rsqf(wave_sum(ss) * (1.0f / D) + EPS);
        const float* g = inp(F, IN_GATTN) + (size_t)layer * D; const float* sh = mod_ptr(F, layer, v, 0); const float* scl = mod_ptr(F, layer, v, 1);
#pragma unroll
        for (int j = 0; j < 4; ++j) { const int k = 4 * lane + 256 * j; const f32x4 gv = *(const f32x4*)(g + k), sv = *(const f32x4*)(sh + k), cv = *(const f32x4*)(scl + k);
            const f32x4 y = (x[j] * rinv * gv) * (cv + 1.0f) + sv;
            u32x2 w; w.x = pk2(y.x, y.y); w.y = pk2(y.z, y.w); *(u32x2*)(HB + (size_t)r * D + k) = w; }
    }
}

using pg8::Unit; using pg8::Acc;
struct SchedGrid {
    int nM, nN, G, c; const char* A; const char* B; size_t a_tile, b_tile; int pm_per_group; size_t b_group;
    __device__ __forceinline__ bool next(int i, Unit& u) const {
        int pm, pn; if (c < 0 || !pg8::grid_order((long)i * G + c, nM, nN, pm, pn)) return false;
        u.pm = pm; u.pn = pn; u.tag = 0; u.A = A + (size_t)pm * a_tile; u.B = B + (size_t)pn * b_tile + (pm_per_group ? (size_t)(pm / pm_per_group) * b_group : 0); return true; }
};
struct SchedMerge {
    int nM, nN, G, c; const char* A; const char* B; size_t a_seg, b_seg, a_tile, b_tile;
    __device__ __forceinline__ bool next(int i, Unit& u) const {
        const int t = i / 3, seg = i - 3 * t; int pm, pn; if (!pg8::grid_order((long)t * G + c, nM, nN, pm, pn)) return false;
        u.pm = pm; u.pn = pn; u.tag = seg; u.A = A + (size_t)seg * a_seg + (size_t)pm * a_tile; u.B = B + (size_t)seg * b_seg + (size_t)pn * b_tile; return true; }
};

struct EpiBf16 {
    static constexpr bool PERM = true;
    bf16* C; int ldc; int sig_pn0;
    __device__ __forceinline__ void operator()(Acc& acc, const Unit& u, int wr, int wc, int fr, int fq) const {
        const int row0 = u.pm * 256 + wr * 64 + fr, col0 = u.pn * 256 + wc * 32 + 8 * fq;
        const bool sig = u.pn >= sig_pn0;
#pragma unroll
        for (int ai = 0; ai < 2; ++ai)
#pragma unroll
            for (int m = 0; m < 4; ++m) { bf16* rowp = C + (size_t)(row0 + ai * 128 + m * 16) * ldc + col0;
#pragma unroll
                for (int bj = 0; bj < 2; ++bj) { f32x4 v0 = acc[ai][bj][m][0], v1 = acc[ai][bj][m][1];
                    if (sig) {
#pragma unroll
                        for (int j = 0; j < 4; ++j) { v0[j] = sigmoidf_(v0[j]); v1[j] = sigmoidf_(v1[j]); } }
                    u32x4 w; w.x = pk2(v0[0], v0[1]); w.y = pk2(v0[2], v0[3]); w.z = pk2(v1[0], v1[1]); w.w = pk2(v1[2], v1[3]);
                    *(u32x4*)(rowp + bj * 128) = w; } }
        pg8::zero_acc(acc);
    }
};
struct EpiGT {
    static constexpr bool PERM = true;
    bf16* GT; bf16* GTC;
    __device__ __forceinline__ void operator()(Acc& acc, const Unit& u, int wr, int wc, int fr, int fq) const {
        const int tok0 = u.pn * 256;
        bf16* base; int pitch, nseq, n0;
        if (tok0 < TC) { const int b = tok0 / CTX; base = GTC + (size_t)b * 512 * 512; pitch = 512; nseq = CTX; n0 = tok0 - b * CTX; }
        else { const int t = tok0 - TC, b = t / SEQ; base = GT + (size_t)b * 512 * 4096; pitch = 4096; nseq = SEQ; n0 = t - b * SEQ; }
        const int crow0 = u.pm * 256 + wr * 64 + fr, ccol0 = wc * 32 + 8 * fq;
#pragma unroll
        for (int ai = 0; ai < 2; ++ai)
#pragma unroll
            for (int m = 0; m < 4; ++m) { const int c = crow0 + ai * 128 + m * 16, part = c >> 9, ch = c & 511;
                bf16* rowp = base + (size_t)ch * pitch + part * nseq + n0 + ccol0;
#pragma unroll
                for (int bj = 0; bj < 2; ++bj) { const f32x4 v0 = acc[ai][bj][m][0], v1 = acc[ai][bj][m][1];
                    u32x4 w; w.x = pk2(v0[0], v0[1]); w.y = pk2(v0[2], v0[3]); w.z = pk2(v1[0], v1[1]); w.w = pk2(v1[2], v1[3]);
                    *(u32x4*)(rowp + bj * 128) = w; } }
        pg8::zero_acc(acc);
    }
};
struct EpiDFT {
    static constexpr bool PERM = true;
    bf16* FO; int nseq; int row_base0;
    __device__ __forceinline__ void operator()(Acc& acc, const Unit& u, int wr, int wc, int fr, int fq) const {
        const int k0 = u.pm * 256 + wr * 64 + fr, b = (u.pn * 256) >> 9, ch0 = ((u.pn * 256) & 511) + wc * 32 + 8 * fq;
        bf16* base = FO + (size_t)(row_base0 + b * nseq + k0) * 512 + ch0;
#pragma unroll
        for (int ai = 0; ai < 2; ++ai)
#pragma unroll
            for (int m = 0; m < 4; ++m) { bf16* rowp = base + (size_t)(ai * 128 + m * 16) * 512;
#pragma unroll
                for (int bj = 0; bj < 2; ++bj) { const f32x4 v0 = acc[ai][bj][m][0], v1 = acc[ai][bj][m][1];
                    u32x4 w; w.x = pk2(v0[0], v0[1]); w.y = pk2(v0[2], v0[3]); w.z = pk2(v1[0], v1[1]); w.w = pk2(v1[2], v1[3]);
                    *(u32x4*)(rowp + bj * 128) = w; } }
        pg8::zero_acc(acc);
    }
};
struct EpiMerge {
    static constexpr bool PERM = true;
    const bf16* PROJ; bf16* MIXB; int row_off;
    __device__ __forceinline__ void operator()(Acc& acc, const Unit& u, int wr, int wc, int fr, int fq) const {
        const int row0 = row_off + u.pm * 256 + wr * 64 + fr, col0 = u.pn * 256 + wc * 32 + 8 * fq, seg = u.tag;
#pragma unroll
        for (int ai = 0; ai < 2; ++ai)
#pragma unroll
            for (int m = 0; m < 4; ++m) { const size_t row = (size_t)(row0 + ai * 128 + m * 16);
#pragma unroll
                for (int bj = 0; bj < 2; ++bj) { const int col = col0 + bj * 128;
                    const u32x4 ga = *(const u32x4*)(PROJ + row * NPROJ + C_GATE + seg * 1024 + col);
                    float f[8];
                    if (seg < 2) { const u32x4 gb = *(const u32x4*)(PROJ + row * NPROJ + C_GATE + (seg + 1) * 1024 + col);
#pragma unroll
                        for (int q = 0; q < 4; ++q) { f[2 * q] = bflo(ga[q]) * __builtin_amdgcn_rcpf(bflo(gb[q])); f[2 * q + 1] = bfhi(ga[q]) * __builtin_amdgcn_rcpf(bfhi(gb[q])); }
                    } else {
#pragma unroll
                        for (int q = 0; q < 4; ++q) { f[2 * q] = bflo(ga[q]); f[2 * q + 1] = bfhi(ga[q]); }
                    }
                    f32x4 v0 = acc[ai][bj][m][0], v1 = acc[ai][bj][m][1];
                    v0 = v0 * (f32x4){f[0], f[1], f[2], f[3]}; v1 = v1 * (f32x4){f[4], f[5], f[6], f[7]};
                    if (seg < 2) { acc[ai][bj][m][0] = v0; acc[ai][bj][m][1] = v1; }
                    else { u32x4 w; w.x = pk2(v0[0], v0[1]); w.y = pk2(v0[2], v0[3]); w.z = pk2(v1[0], v1[1]); w.w = pk2(v1[2], v1[3]);
                        *(u32x4*)(MIXB + row * D + col) = w; acc[ai][bj][m][0] = (f32x4){0.f, 0.f, 0.f, 0.f}; acc[ai][bj][m][1] = (f32x4){0.f, 0.f, 0.f, 0.f}; } }
                asm volatile("" ::: "memory"); }
    }
};
struct EpiOut {
    static constexpr bool PERM = false;
    const float* base_ctx; const float* base_lat; float* XR; const float* mod2; int row_off;
    __device__ __forceinline__ void operator()(Acc& acc, const Unit& u, int wr, int wc, int fr, int fq) const {
        const int row0 = row_off + u.pm * 256 + wr * 64 + fr, col0 = u.pn * 256 + wc * 32 + 4 * fq;
        const int v = vec_of_row(row_off + u.pm * 256);
        f32x4 mv[2][2];
#pragma unroll
        for (int bj = 0; bj < 2; ++bj)
#pragma unroll
            for (int n = 0; n < 2; ++n) mv[bj][n] = *(const f32x4*)(mod2 + (size_t)v * 6144 + col0 + bj * 128 + n * 16);
#pragma unroll
        for (int ai = 0; ai < 2; ++ai)
#pragma unroll
            for (int m = 0; m < 4; ++m) { const int row = row0 + ai * 128 + m * 16;
                const float* bp = row < TC ? base_ctx + (size_t)row * D : base_lat + (size_t)(row - TC) * D; float* op = XR + (size_t)row * D;
#pragma unroll
                for (int bj = 0; bj < 2; ++bj)
#pragma unroll
                    for (int n = 0; n < 2; ++n) { const int c = col0 + bj * 128 + n * 16; *(f32x4*)(op + c) = *(const f32x4*)(bp + c) + mv[bj][n] * acc[ai][bj][m][n]; } }
        pg8::zero_acc(acc);
    }
};
struct EpiGU {
    static constexpr bool PERM = true;
    bf16* HID;
    __device__ __forceinline__ void operator()(Acc& acc, const Unit& u, int wr, int wc, int fr, int fq) const {
        const int row0 = u.pm * 256 + wr * 64 + fr, col0 = u.pn * 128 + wc * 32 + 8 * fq;
#pragma unroll
        for (int ai = 0; ai < 2; ++ai)
#pragma unroll
            for (int m = 0; m < 4; ++m) { float h[8];
#pragma unroll
                for (int n = 0; n < 2; ++n)
#pragma unroll
                    for (int j = 0; j < 4; ++j) { const float g = acc[ai][0][m][n][j], up = acc[ai][1][m][n][j]; h[4 * n + j] = siluf_(g) * up; }
                u32x4 w; w.x = pk2(h[0], h[1]); w.y = pk2(h[2], h[3]); w.z = pk2(h[4], h[5]); w.w = pk2(h[6], h[7]);
                *(u32x4*)(HID + (size_t)(row0 + ai * 128 + m * 16) * EH + col0) = w; }
        pg8::zero_acc(acc);
    }
};
struct EpiDown {
    static constexpr bool PERM = true;
    bf16* YE; const float* topw;
    __device__ __forceinline__ void operator()(Acc& acc, const Unit& u, int wr, int wc, int fr, int fq) const {
        const int row0 = u.pm * 256 + wr * 64 + fr, col0 = u.pn * 256 + wc * 32 + 8 * fq;
#pragma unroll
        for (int ai = 0; ai < 2; ++ai)
#pragma unroll
            for (int m = 0; m < 4; ++m) { const int row = row0 + ai * 128 + m * 16; const float tw = topw[row];
#pragma unroll
                for (int bj = 0; bj < 2; ++bj) { const f32x4 v0 = acc[ai][bj][m][0] * tw, v1 = acc[ai][bj][m][1] * tw;
                    u32x4 w; w.x = pk2(v0[0], v0[1]); w.y = pk2(v0[2], v0[3]); w.z = pk2(v1[0], v1[1]); w.w = pk2(v1[2], v1[3]);
                    *(u32x4*)(YE + (size_t)row * D + col0 + bj * 128) = w; } }
        pg8::zero_acc(acc);
    }
};

struct SchedInproj {
    int G, c, ncc; const char* HB; const char* WT;
    __device__ __forceinline__ bool next(int i, Unit& u) const {
        const long L = (long)i * G + c; int pm, pn;
        if (L < 64 * 28) { pg8::grid_order(L, 64, 28, pm, pn); pm += 8; }
        else { if (!pg8::grid_order(L - 64 * 28, 8, ncc, pm, pn)) return false; if (ncc == 7) pn = pn < 3 ? pn + 1 : pn + 5; }
        const size_t tile = (size_t)256 * D * 2;
        if (pn < 24) { u.pm = pm; u.pn = pn; u.A = HB + pm * tile; u.B = WT + pn * tile; u.tag = (pn < 2 || (pn >= 6 && pn < 10)) ? 2 : (pn >= 12 ? 1 : 0); }
        else { u.pm = pn - 24; u.pn = pm; u.A = WT + (size_t)(24 + pn - 24) * tile; u.B = HB + pm * tile; u.tag = 3; }
        return true; }
};
struct EpiInproj {
    static constexpr bool PERM = true;
    bf16* PROJ; bf16* GT; bf16* GTC; const float* rc; const float* rs; const float* qn; const float* kn;
    __device__ __forceinline__ void operator()(Acc& acc, const Unit& u, int wr, int wc, int fr, int fq) const {
        if (u.tag == 3) { EpiGT E{GT, GTC}; E(acc, u, wr, wc, fr, fq); return; }
        if (u.tag < 2) { EpiBf16 E{PROJ, NPROJ, u.tag == 1 ? 0 : 1000}; E(acc, u, wr, wc, fr, fq); return; }
        const int tile = u.pn; const bool is_d = tile >= 6, is_q = (tile == 0 || tile == 6 || tile == 7);
        f32x4 g1[2], g2[2];
        if (is_d) { const float* G = is_q ? qn : kn;
#pragma unroll
            for (int n = 0; n < 2; ++n) { g1[n] = *(const f32x4*)(G + 8 * fq + 4 * n); g2[n] = *(const f32x4*)(G + 32 + 8 * fq + 4 * n); } }
        const int row0 = u.pm * 256 + wr * 64 + fr; const bool lat = u.pm >= 8;
#pragma unroll
        for (int ai = 0; ai < 2; ++ai)
#pragma unroll
            for (int m = 0; m < 4; ++m) { const int row = row0 + ai * 128 + m * 16;
                f32x4 x1[2] = {acc[ai][0][m][0], acc[ai][0][m][1]}, x2[2] = {acc[ai][1][m][0], acc[ai][1][m][1]};
                if (is_d) {
                    float ss = 0.f;
#pragma unroll
                    for (int n = 0; n < 2; ++n) ss += (x1[n][0] * x1[n][0] + x1[n][1] * x1[n][1]) + (x1[n][2] * x1[n][2] + x1[n][3] * x1[n][3]) + (x2[n][0] * x2[n][0] + x2[n][1] * x2[n][1]) + (x2[n][2] * x2[n][2] + x2[n][3] * x2[n][3]);
                    ss += __shfl_xor(ss, 16); ss += __shfl_xor(ss, 32);
                    const float rinv = __builtin_amdgcn_rsqf(ss * (1.0f / 64.0f) + EPS);
#pragma unroll
                    for (int n = 0; n < 2; ++n) { x1[n] = x1[n] * rinv * g1[n]; x2[n] = x2[n] * rinv * g2[n]; }
                } else if (tile == 0) {
#pragma unroll
                    for (int n = 0; n < 2; ++n) { x1[n] = x1[n] * 0.125f; x2[n] = x2[n] * 0.125f; }
                }
                f32x4 o1[2], o2[2];
                if (lat) { const int pos = (row - TC) & (SEQ - 1);
#pragma unroll
                    for (int n = 0; n < 2; ++n) { const f32x4 c = *(const f32x4*)(rc + pos * 32 + 8 * fq + 4 * n), sn = *(const f32x4*)(rs + pos * 32 + 8 * fq + 4 * n);
                        o1[n] = x1[n] * c - x2[n] * sn; o2[n] = x2[n] * c + x1[n] * sn; }
                } else { o1[0] = x1[0]; o1[1] = x1[1]; o2[0] = x2[0]; o2[1] = x2[1]; }
                if (is_d && is_q) { const float k = 0.125f * LOG2E;
#pragma unroll
                    for (int n = 0; n < 2; ++n) { o1[n] = o1[n] * k; o2[n] = o2[n] * k; } }
                bf16* dst = PROJ + (size_t)row * NPROJ + tile * 256 + 64 * wc + 8 * fq;
                u32x4 w; w.x = pk2(o1[0][0], o1[0][1]); w.y = pk2(o1[0][2], o1[0][3]); w.z = pk2(o1[1][0], o1[1][1]); w.w = pk2(o1[1][2], o1[1][3]); *(u32x4*)dst = w;
                w.x = pk2(o2[0][0], o2[0][1]); w.y = pk2(o2[0][2], o2[0][3]); w.z = pk2(o2[1][0], o2[1][1]); w.w = pk2(o2[1][2], o2[1][3]); *(u32x4*)(dst + 32) = w;
                asm volatile("" ::: "memory"); }
        pg8::zero_acc(acc);
    }
};
__device__ __forceinline__ void phase_inproj(Frame& F, int layer) {
    const float* rc = (const float*)(F.ws + WS_ROPE);
    SchedInproj S{F.G, (int)blockIdx.x, layer == DEPTH - 1 ? 7 : 28, (const char*)(F.ws + WS_HB), (const char*)(F.ws + WS_WIN + layer * WIN_L)};
    EpiInproj E{(bf16*)(F.ws + WS_PROJ), (bf16*)(F.ws + WS_GT), (bf16*)(F.ws + WS_GTC), rc, rc + SEQ * 32, inp(F, IN_QN) + layer * 64, inp(F, IN_KN) + layer * 64};
    pg8::gemm_phase(F.lds, F.tid, D, S, E);
}

namespace att {
constexpr int KPITCH = 144, VPITCH = 320, KC_BYTES = 64 * KPITCH, V_BYTES = 64 * VPITCH, BUF_BYTES = 2 * KC_BYTES + V_BYTES;
constexpr int SCR_OFF = 2 * BUF_BYTES;
constexpr int QW_OFF = SCR_OFF + 8 * 256;
__device__ __forceinline__ int crow(int r, int hi) { return (r & 3) + 8 * (r >> 2) + 4 * hi; }
__device__ __forceinline__ s16x4 vtr(const LAS unsigned char* p) { typedef short v4i16_t __attribute__((ext_vector_type(4))); return __builtin_bit_cast(s16x4, __builtin_amdgcn_ds_read_tr16_b64_v4i16((LAS v4i16_t*)p)); }

struct UnitDesc {
    int mode;
    int qrow0;
    int qpos0;
    int h;
    int krowA, ntA;
    int krowB, ntB;
    int kindB;
    int nseq;
    int outrow0;
    float lgf, lgb;
    float lam, scale_out;
};

__device__ __forceinline__ void unit(const Frame& F, const UnitDesc& u) {
    LAS unsigned char* lds = F.lds;
    const int tid = F.tid, lane = F.lane, wid = F.wave, r32 = lane & 31, hi = lane >> 5;
    const bf16* PROJ = (const bf16*)(F.ws + WS_PROJ);
    const bool diff = u.mode == 0;
    const int comp = diff ? (wid >> 2) : 0;
    const int qoff = diff ? 32 * (wid & 3) : 32 * wid;
    const int kcol = diff ? C_DK + u.h * 128 : C_RK + u.h * 64, vcol = diff ? C_DV + u.h * 128 : C_RV + u.h * 128;
    const int qcol = diff ? C_DQ + u.h * 128 + comp * 64 : C_RQ + u.h * 64;
    const int NT = u.ntA + u.ntB;
    bf16x8 qf[4];
    { const bf16* qp = PROJ + (size_t)(u.qrow0 + qoff + r32) * NPROJ + qcol + 8 * hi;
#pragma unroll
      for (int s = 0; s < 4; ++s) qf[s] = *(const bf16x8*)(qp + 16 * s); }
    f32x16 o[4];
#pragma unroll
    for (int d = 0; d < 4; ++d) o[d] = (f32x16){};
    float lsum = 0.f;
    u32x4 kreg[2], vreg[2];
    auto tile_row = [&](int t) { return t < u.ntA ? u.krowA + 64 * t : u.krowB + 64 * (t - u.ntA); };
    auto load_tile = [&](int t) {
        const int row0 = tile_row(t);
#pragma unroll
        for (int i = 0; i < 2; ++i) { const int cid = tid + 512 * i, key = cid >> 4, c16 = cid & 15;
            vreg[i] = *(const u32x4*)(PROJ + (size_t)(row0 + key) * NPROJ + vcol + c16 * 8);
            if (diff) kreg[i] = *(const u32x4*)(PROJ + (size_t)(row0 + key) * NPROJ + kcol + c16 * 8); }
        if (!diff) { const int key = tid >> 3, c8 = tid & 7; kreg[0] = *(const u32x4*)(PROJ + (size_t)(row0 + key) * NPROJ + kcol + c8 * 8); }
    };
    auto store_tile = [&](int buf) {
        LAS unsigned char* b = lds + buf * BUF_BYTES;
#pragma unroll
        for (int i = 0; i < 2; ++i) { const int cid = tid + 512 * i, key = cid >> 4, c16 = cid & 15;
            *(LAS u32x4*)(b + 2 * KC_BYTES + key * VPITCH + c16 * 16) = vreg[i];
            if (diff) *(LAS u32x4*)(b + (c16 >> 3) * KC_BYTES + key * KPITCH + (c16 & 7) * 16) = kreg[i]; }
        if (!diff) { const int key = tid >> 3, c8 = tid & 7; *(LAS u32x4*)(b + key * KPITCH + c8 * 16) = kreg[0]; }
    };
    load_tile(0); store_tile(0);
    __syncthreads();
    const int qpos = u.qpos0 + qoff + r32;
    for (int t = 0; t < NT; ++t) {
        if (t + 1 < NT) load_tile(t + 1);
        const LAS unsigned char* b = lds + (t & 1) * BUF_BYTES;
        const LAS unsigned char* kb = b + comp * KC_BYTES + r32 * KPITCH + hi * 16;
        u32x4 pw[4];
        const bool segB = t >= u.ntA; const int j0 = 64 * (segB ? t - u.ntA : t);
#pragma unroll
        for (int kh = 0; kh < 2; ++kh) {
            f32x16 sc = (f32x16){};
#pragma unroll
            for (int s = 0; s < 4; ++s) { const bf16x8 kf = *(const LAS bf16x8*)(kb + kh * 32 * KPITCH + s * 32); sc = __builtin_amdgcn_mfma_f32_32x32x16_bf16(kf, qf[s], sc, 0, 0, 0); }
            if (diff) {
#pragma unroll
                for (int r = 0; r < 16; ++r) sc[r] = __builtin_amdgcn_exp2f(sc[r]);
                float a = 0.f;
#pragma unroll
                for (int r = 0; r < 16; ++r) a += sc[r];
                lsum += a;
            } else if (!segB || u.kindB == 0) {
#pragma unroll
                for (int r = 0; r < 16; ++r) { const int d = qpos - (j0 + 32 * kh + crow(r, hi)); sc[r] *= __builtin_amdgcn_exp2f((float)d * (d >= 0 ? u.lgf : -u.lgb)); }
            } else {
#pragma unroll
                for (int r = 0; r < 16; ++r) { const int na = j0 + 32 * kh + crow(r, hi);
                    sc[r] *= __builtin_amdgcn_exp2f((float)(qpos + CTX - na) * u.lgf) + __builtin_amdgcn_exp2f((float)(u.nseq - qpos + na) * u.lgb); }
            }
            pw[2 * kh] = (u32x4){pk2(sc[0], sc[1]), pk2(sc[2], sc[3]), pk2(sc[4], sc[5]), pk2(sc[6], sc[7])};
            pw[2 * kh + 1] = (u32x4){pk2(sc[8], sc[9]), pk2(sc[10], sc[11]), pk2(sc[12], sc[13]), pk2(sc[14], sc[15])};
            __builtin_amdgcn_sched_barrier(0);
        }
        const LAS unsigned char* vb = b + 2 * KC_BYTES + (4 * hi + ((lane & 15) >> 2)) * VPITCH + ((lane >> 4) & 1) * 32 + (lane & 3) * 8;
        __builtin_amdgcn_sched_barrier(0);
#pragma unroll
        for (int dvb = 0; dvb < 4; ++dvb) {
#pragma unroll
            for (int ks = 0; ks < 4; ++ks) {
                const s16x4 lo = vtr(vb + ks * 16 * VPITCH + dvb * 64), hi4 = vtr(vb + ks * 16 * VPITCH + 8 * VPITCH + dvb * 64);
                const bf16x8 vf = (bf16x8){lo[0], lo[1], lo[2], lo[3], hi4[0], hi4[1], hi4[2], hi4[3]};
                o[dvb] = __builtin_amdgcn_mfma_f32_32x32x16_bf16(__builtin_bit_cast(bf16x8, pw[ks]), vf, o[dvb], 0, 0, 0);
            }
            __builtin_amdgcn_sched_barrier(0);
        }
        if (t + 1 < NT) store_tile((t + 1) & 1);
        __syncthreads();
    }
    LAS float* wsf = (LAS float*)(lds + SCR_OFF) + wid * 64;
    int lz = lane; asm volatile("" : "+v"(lz));
    const int r32e = lz & 31, hie = lz >> 5;
    if (diff) {
        lsum += __shfl_xor(lsum, 32);
        if (hie == 0) wsf[r32e] = __builtin_amdgcn_rcpf(lsum);
        LDS_WAIT();
        float rl[16];
#pragma unroll
        for (int r = 0; r < 16; ++r) rl[r] = wsf[crow(r, hie)];
        LAS float* XC = (LAS float*)lds;
        if (comp == 1) {
#pragma unroll
            for (int r = 0; r < 16; ++r) { const int q = qoff + crow(r, hie);
#pragma unroll
                for (int d = 0; d < 4; ++d) XC[q * 128 + 32 * d + r32e] = o[d][r] * rl[r] * u.lam; }
        }
        __syncthreads();
        if (comp == 0) {
            float ss[16];
#pragma unroll
            for (int r = 0; r < 16; ++r) { const int q = qoff + crow(r, hie); float a = 0.f;
#pragma unroll
                for (int d = 0; d < 4; ++d) { const float v = o[d][r] * rl[r] - XC[q * 128 + 32 * d + r32e]; o[d][r] = v; a += v * v; }
                ss[r] = a; }
#pragma unroll
            for (int r = 0; r < 16; ++r) { float a = ss[r]; a += __shfl_xor(a, 1); a += __shfl_xor(a, 2); a += __shfl_xor(a, 4); a += __shfl_xor(a, 8); a += __shfl_xor(a, 16);
                ss[r] = u.scale_out * __builtin_amdgcn_rsqf(a * (1.0f / 128.0f) + EPS); }
            bf16* DO = (bf16*)(F.ws + WS_FO + 2 * MIX_ONE);
#pragma unroll
            for (int r = 0; r < 16; ++r) { bf16* op = DO + (size_t)(u.outrow0 + qoff + crow(r, hie)) * 512 + u.h * 128 + r32e;
#pragma unroll
                for (int d = 0; d < 4; ++d) op[32 * d] = (bf16)f2bf(o[d][r] * ss[r]); }
        }
    } else {
        bf16* RO = (bf16*)(F.ws + WS_FO + 1 * MIX_ONE);
#pragma unroll
        for (int r = 0; r < 16; ++r) {
            float a = (o[0][r] + o[1][r]) + (o[2][r] + o[3][r]);
            a += __shfl_xor(a, 1); a += __shfl_xor(a, 2); a += __shfl_xor(a, 4); a += __shfl_xor(a, 8); a += __shfl_xor(a, 16);
            const float mu = a * (1.0f / 128.0f); float q = 0.f;
#pragma unroll
            for (int d = 0; d < 4; ++d) { const float v = o[d][r] - mu; o[d][r] = v; q += v * v; }
            q += __shfl_xor(q, 1); q += __shfl_xor(q, 2); q += __shfl_xor(q, 4); q += __shfl_xor(q, 8); q += __shfl_xor(q, 16);
            const float rstd = __builtin_amdgcn_rsqf(q * (1.0f / 128.0f) + EPS);
            const size_t row = (size_t)(u.outrow0 + qoff + crow(r, hie));
            const bf16* gp = PROJ + row * NPROJ + C_RG + u.h * 128 + r32e; bf16* op = RO + row * 512 + u.h * 128 + r32e;
#pragma unroll
            for (int d = 0; d < 4; ++d) { const float g = bf2f(gp[32 * d]); op[32 * d] = (bf16)f2bf(o[d][r] * rstd * siluf_(g)); }
        }
    }
    __syncthreads();
}
}

constexpr int NDFT_CU = 128;

__device__ __forceinline__ void phase_mixers(Frame& F, int layer, int rep) {
    const bool last = layer == DEPTH - 1;
#if !defined(ONLY_SUB) || ONLY_SUB == 1
    if ((int)blockIdx.x < NDFT_CU && F.G > NDFT_CU) {
        {
            SchedGrid S{SEQ / 256, 4096 / 256, NDFT_CU, (int)blockIdx.x, (const char*)(F.ws + WS_DFTL), (const char*)(F.ws + WS_GT), (size_t)256 * 4096 * 2, (size_t)256 * 4096 * 2, 0, 0};
            EpiDFT E{(bf16*)(F.ws + WS_FO), SEQ, TC};
            pg8::gemm_phase(F.lds, F.tid, 4096, S, E);
        }
        if (!last) {
            SchedGrid S{1, 4096 / 256, NDFT_CU, (int)blockIdx.x, (const char*)(F.ws + WS_DFTC), (const char*)(F.ws + WS_GTC), (size_t)256 * 512 * 2, (size_t)256 * 512 * 2, 0, 0};
            EpiDFT E{(bf16*)(F.ws + WS_FO), CTX, 0};
            pg8::gemm_phase(F.lds, F.tid, 512, S, E);
        }
    }
#endif
#if defined(ONLY_SUB) && ONLY_SUB == 1
    return;
#endif
    const int nunits = last ? 768 : 864;
    const float lam = lam_of(F, layer), so = 1.0f - lam_init_of(layer);
    unsigned* qctr = F.ctl + CW_QUEUE + 64 * (layer + 2 * rep);
    volatile LAS unsigned* qw = (volatile LAS unsigned*)(F.lds + att::QW_OFF);
    const bool solo = F.G <= NDFT_CU;
    (void)solo;
    for (;;) {
        if (F.tid == 0) *qw = __hip_atomic_fetch_add(qctr, 1u, RLX_AGENT);
        __syncthreads();
        const int i = (int)*qw;
        __syncthreads();
        if (i >= nunits) break;
        att::UnitDesc u{};
        u.lam = lam; u.scale_out = so;
        if (i < 512) { const int b = i >> 6, h = (i >> 4) & 3, qb = i & 15; u.mode = 0; u.h = h; u.qrow0 = TC + b * SEQ + qb * 128; u.qpos0 = qb * 128; u.krowA = TC + b * SEQ; u.ntA = 32; u.krowB = b * CTX; u.ntB = 4; }
        else if (i < 768) { const int j = i - 512, b = j >> 5, h = (j >> 3) & 3, qb = j & 7; u.mode = 1; u.h = h; u.qrow0 = TC + b * SEQ + qb * 256; u.qpos0 = qb * 256; u.krowA = TC + b * SEQ; u.ntA = 32; u.krowB = b * CTX; u.ntB = 4; u.kindB = 1; u.nseq = SEQ; }
        else if (i < 832) { const int j = i - 768, b = j >> 3, h = (j >> 1) & 3, qb = j & 1; u.mode = 0; u.h = h; u.qrow0 = b * CTX + qb * 128; u.qpos0 = qb * 128; u.krowA = b * CTX; u.ntA = 4; u.krowB = 0; u.ntB = 0; }
        else { const int j = i - 832, b = j >> 2, h = j & 3; u.mode = 1; u.h = h; u.qrow0 = b * CTX; u.qpos0 = 0; u.krowA = b * CTX; u.ntA = 4; u.krowB = 0; u.ntB = 0; u.kindB = 0; u.nseq = CTX; }
        u.outrow0 = u.qrow0;
        if (u.mode == 1) { u.lgf = inp(F, IN_RDEC)[(layer * 2 + 0) * 4 + u.h] * LOG2E; u.lgb = inp(F, IN_RDEC)[(layer * 2 + 1) * 4 + u.h] * LOG2E; }
        att::unit(F, u);
    }
}

__device__ __forceinline__ void phase_merge(Frame& F, int layer) {
    const int row_off = layer == DEPTH - 1 ? TC : 0, M = TA - row_off;
    SchedMerge S{M / 256, D / 256, F.G, (int)blockIdx.x, (const char*)(F.ws + WS_FO) + (size_t)row_off * 512 * 2, (const char*)(F.ws + WS_WFO + (size_t)layer * 3 * WMG_ONE), MIX_ONE, WMG_ONE, (size_t)256 * 512 * 2, (size_t)256 * 512 * 2};
    EpiMerge E{(const bf16*)(F.ws + WS_PROJ), (bf16*)(F.ws + WS_MIXB), row_off};
    pg8::gemm_phase(F.lds, F.tid, 512, S, E);
}
__device__ __forceinline__ void phase_outproj(Frame& F, int layer) {
    const int row_off = layer == DEPTH - 1 ? TC : 0, M = TA - row_off;
    SchedGrid S{M / 256, D / 256, F.G, (int)blockIdx.x, (const char*)(F.ws + WS_MIXB) + (size_t)row_off * D * 2, (const char*)(F.ws + WS_WOUT + layer * WOUT_L), (size_t)256 * D * 2, (size_t)256 * D * 2, 0, 0};
    const float* XR = (const float*)(F.ws + WS_XR);
    EpiOut E{layer == 0 ? inp(F, IN_CTX) : XR, layer == 0 ? inp(F, IN_X) : XR + (size_t)TC * D, (float*)(F.ws + WS_XR), (const float*)(F.ws + WS_MOD) + (size_t)layer * 9 * 6144 + 2 * 1024, row_off};
    pg8::gemm_phase(F.lds, F.tid, D, S, E);
}

__device__ __forceinline__ void phase_norm2(Frame& F, int layer) {
    const int gw = F.vcu * 8 + F.wave, NGW = F.G * 8, lane = F.lane, tid = F.tid;
    LAS float* wr_t = (LAS float*)F.lds;
    const float* wrt = inp(F, IN_WROUTER) + (size_t)layer * D * NE;
    for (int i = tid; i < D * NE; i += 512) { const int k = i >> 4, e = i & 15; wr_t[e * 1024 + k] = wrt[i]; }
    __syncthreads();
    const int r_lo = layer == DEPTH - 1 ? TC : 0;
    const float* XR = (const float*)(F.ws + WS_XR); bf16* HB = (bf16*)(F.ws + WS_HB); float* AFF = (float*)(F.ws + WS_AFF);
    for (int r = r_lo + gw; r < TA; r += NGW) {
        const int v = vec_of_row(r);
        f32x4 x[4];
#pragma unroll
        for (int j = 0; j < 4; ++j) x[j] = *(const f32x4*)(XR + (size_t)r * D + 4 * lane + 256 * j);
        float ss = 0.f;
#pragma unroll
        for (int j = 0; j < 4; ++j) ss += (x[j].x * x[j].x + x[j].y * x[j].y) + (x[j].z * x[j].z + x[j].w * x[j].w);
        const float rinv = __builtin_amdgcn_rsqf(wave_sum(ss) * (1.0f / D) + EPS);
        const float* g = inp(F, IN_GFFN) + (size_t)layer * D; const float* sh = mod_ptr(F, layer, v, 3); const float* scl = mod_ptr(F, layer, v, 4);
#pragma unroll
        for (int j = 0; j < 4; ++j) { const int k = 4 * lane + 256 * j; const f32x4 gv = *(const f32x4*)(g + k), sv = *(const f32x4*)(sh + k), cv = *(const f32x4*)(scl + k);
            x[j] = (x[j] * rinv * gv) * (cv + 1.0f) + sv;
            u32x2 w; w.x = pk2(x[j].x, x[j].y); w.y = pk2(x[j].z, x[j].w); *(u32x2*)(HB + (size_t)r * D + k) = w; }
        float mine = 0.f;
#pragma unroll
        for (int eg = 0; eg < 4; ++eg) {
            float a[4];
#pragma unroll
            for (int q = 0; q < 4; ++q) { float t = 0.f;
#pragma unroll
                for (int j = 0; j < 4; ++j) { const f32x4 w = *(const LAS f32x4*)(wr_t + (4 * eg + q) * 1024 + 4 * lane + 256 * j); t += (x[j].x * w.x + x[j].y * w.y) + (x[j].z * w.z + x[j].w * w.w); }
                a[q] = t; }
#pragma unroll
            for (int o = 1; o < 64; o <<= 1) {
#pragma unroll
                for (int q = 0; q < 4; ++q) a[q] += __shfl_xor(a[q], o); }
#pragma unroll
            for (int q = 0; q < 4; ++q) mine = (lane == 4 * eg + q) ? a[q] : mine;
            asm volatile("" ::: "memory");
        }
        float mx = mine;
        mx = fmaxf(mx, __shfl_xor(mx, 1)); mx = fmaxf(mx, __shfl_xor(mx, 2)); mx = fmaxf(mx, __shfl_xor(mx, 4)); mx = fmaxf(mx, __shfl_xor(mx, 8));
        const float ex = __expf(mine - mx); float den = ex;
        den += __shfl_xor(den, 1); den += __shfl_xor(den, 2); den += __shfl_xor(den, 4); den += __shfl_xor(den, 8);
        if (lane < 16) AFF[(size_t)r * 16 + lane] = ex * __builtin_amdgcn_rcpf(den);
    }
    __syncthreads();
}

__device__ __forceinline__ void phase_topk(Frame& F, int layer) {
    const bool last = layer == DEPTH - 1; const int tid = F.tid, lane = F.lane, wave = F.wave;
    const int RPE = last ? 2048 : 2304, lat_off = last ? 0 : 256;
    LAS unsigned* part = (LAS unsigned*)F.lds;
    LAS unsigned* cntG = part + 16;
    LAS unsigned* cntE = cntG + 32;
    LAS int* lst = (LAS int*)(cntE + 32);
    const float* AFF = (const float*)(F.ws + WS_AFF); int* INV = (int*)(F.ws + WS_INV); float* TOPW = (float*)(F.ws + WS_TOPW);
    const bf16* HB = (const bf16*)(F.ws + WS_HB); bf16* XS = (bf16*)(F.ws + WS_XS);
    const int nitems = last ? 128 : 256;
    for (int item = F.vcu; item < nitems; item += F.G) {
        int n, C, tokrow0, e, slot0;
        if (item < 128) { const int b = item >> 4; e = item & 15; n = SEQ; C = 256; tokrow0 = TC + b * SEQ; slot0 = e * RPE + lat_off + b * 256; }
        else { const int be = item - 128, b = be >> 4; e = be & 15; n = CTX; C = 32; tokrow0 = b * CTX; slot0 = e * RPE + b * 32; }
        float v[4]; unsigned key[4];
#pragma unroll
        for (int q = 0; q < 4; ++q) { const int i = tid + 512 * q; v[q] = i < n ? AFF[(size_t)(tokrow0 + i) * 16 + e] : 0.f; key[q] = __builtin_bit_cast(unsigned, v[q]); }
        unsigned t = 0u;
        for (int bit = 30; bit >= 0; --bit) {
            const unsigned cand = t | (1u << bit); unsigned c = 0u;
#pragma unroll
            for (int q = 0; q < 4; ++q) c += (unsigned)__builtin_popcountll(__ballot(key[q] >= cand));
            if (lane == 0) part[(bit & 1) * 8 + wave] = c;
            __syncthreads();
            unsigned tot = 0u;
#pragma unroll
            for (int w = 0; w < 8; ++w) tot += part[(bit & 1) * 8 + w];
            if (tot >= (unsigned)C) t = cand;
        }
        unsigned long long bg[4], be_[4];
#pragma unroll
        for (int q = 0; q < 4; ++q) { bg[q] = __ballot(key[q] > t); be_[q] = __ballot(key[q] == t && key[q] != 0u);
            if (lane == 0) { cntG[q * 8 + wave] = (unsigned)__builtin_popcountll(bg[q]); cntE[q * 8 + wave] = (unsigned)__builtin_popcountll(be_[q]); } }
        __syncthreads();
        unsigned totG = 0u, baseG[4] = {0u, 0u, 0u, 0u}, baseE[4] = {0u, 0u, 0u, 0u}; unsigned runG = 0u, runE = 0u;
#pragma unroll
        for (int q = 0; q < 4; ++q)
#pragma unroll
            for (int w = 0; w < 8; ++w) { const unsigned g = cntG[q * 8 + w], ee = cntE[q * 8 + w]; if (w == wave) { baseG[q] = runG; baseE[q] = runE; } runG += g; runE += ee; }
        totG = runG;
        const unsigned need = (unsigned)C - totG;
        const unsigned long long lt = (1ull << lane) - 1ull;
#pragma unroll
        for (int q = 0; q < 4; ++q) { const int i = tid + 512 * q;
            if (i < n) {
                const bool g = (bg[q] >> lane) & 1ull, eq = (be_[q] >> lane) & 1ull;
                const unsigned myG = baseG[q] + (unsigned)__builtin_popcountll(bg[q] & lt), myE = baseE[q] + (unsigned)__builtin_popcountll(be_[q] & lt);
                int sl = -1;
                if (g) sl = (int)myG; else if (eq && myE < need) sl = (int)(totG + myE);
                const int R = sl >= 0 ? slot0 + sl : -1;
                INV[(size_t)(tokrow0 + i) * 16 + e] = R;
                if (sl >= 0) { TOPW[R] = v[q]; lst[sl] = i; }
            } }
        __syncthreads();
        for (int sidx = wave; sidx < C; sidx += 8) { const int i = lst[sidx];
            const u32x4* src = (const u32x4*)(HB + (size_t)(tokrow0 + i) * D); u32x4* dst = (u32x4*)(XS + (size_t)(slot0 + sidx) * D);
            const u32x4 a = src[lane], bq = src[lane + 64]; dst[lane] = a; dst[lane + 64] = bq; }
        __syncthreads();
    }
}

__device__ __forceinline__ void phase_gateup(Frame& F, int layer) {
    const int RPE = layer == DEPTH - 1 ? 2048 : 2304;
    SchedGrid S{NE * RPE / 256, 4096 / 256, F.G, (int)blockIdx.x, (const char*)(F.ws + WS_XS), (const char*)(F.ws + WS_WGU), (size_t)256 * D * 2, (size_t)256 * D * 2, RPE / 256, WGU_E};
    EpiGU E{(bf16*)(F.ws + WS_HID)};
    pg8::gemm_phase(F.lds, F.tid, D, S, E);
}
__device__ __forceinline__ void phase_down(Frame& F, int layer) {
    const int RPE = layer == DEPTH - 1 ? 2048 : 2304;
    SchedGrid S{NE * RPE / 256, D / 256, F.G, (int)blockIdx.x, (const char*)(F.ws + WS_HID), (const char*)(F.ws + WS_WD), (size_t)256 * EH * 2, (size_t)256 * EH * 2, RPE / 256, WD_E};
    EpiDown E{(bf16*)(F.ws + WS_YE), (const float*)(F.ws + WS_TOPW)};
    pg8::gemm_phase(F.lds, F.tid, EH, S, E);
}

constexpr int NPHASE = 1 + 10 * DEPTH + 1;
__global__ void __launch_bounds__(512, 2) mk_fwd(Args args) {
    extern __shared__ __attribute__((aligned(16))) unsigned char lds_raw[];
    Frame F;
    F.lds = (LAS unsigned char*)lds_raw; F.MISC = (volatile LAS unsigned*)(F.lds + MISC_OFF);
    F.tid = threadIdx.x; F.lane = F.tid & 63; F.wave = __builtin_amdgcn_readfirstlane(F.tid >> 6);
    F.G = gridDim.x; { const int bx = blockIdx.x; F.vcu = (F.G % 8 == 0) ? (bx % 8) * (F.G / 8) + bx / 8 : bx; }
    F.ws = args.ws; F.ctl = (unsigned*)(args.ws + WS_CTL); F.out = args.out;
    for (int u = F.tid; u < (LDS_BYTES - LDSCTL_OFF) / 4; u += 512) ((LAS unsigned*)(F.lds + LDSCTL_OFF))[u] = 0u;
    __syncthreads();
    XcdBarrier bar; bar.bar = F.ctl + CW_BAR; bar.x = 0; bar.st = nullptr;
    const bool multi = (args.ph_hi - args.ph_lo) > 1;
    if (multi) bar = xcd_barrier_post(F.ctl + CW_BAR, F.MISC + 8);
    for (int ph = args.ph_lo; ph < args.ph_hi; ++ph) {
        const int layer = (ph - 1) / 10, k = (ph == 0) ? 10 : (ph == NPHASE - 1) ? 12 : (ph - 1) % 10;
        int reps = 1 + ((PROBE_MASK >> k) & 1);
        if (k == 0 && layer > 0 && (PROBE_MASK & 2048)) reps = 2;
        for (int rep = 0; rep < reps; ++rep) {
            { unsigned long long w = (unsigned long long)args.ws; asm volatile("" : "+s"(w)); F.ws = (unsigned char*)w; F.ctl = (unsigned*)(F.ws + WS_CTL); }
            { unsigned long long kp = (unsigned long long)__builtin_amdgcn_kernarg_segment_ptr(); asm volatile("" : "+s"(kp)); F.karg = (const void __attribute__((address_space(4)))*)kp; }
            { int l = (int)__builtin_amdgcn_mbcnt_hi(~0u, __builtin_amdgcn_mbcnt_lo(~0u, 0u)); asm volatile("" : "+v"(l)); F.lane = l; F.tid = F.wave * 64 + l; }
#ifdef ONLY_PHASE
            if (k != ONLY_PHASE) continue;
#endif
            switch (k) {
                case 10: phase_prologue(F); break;
                case 12: phase_norm(F, DEPTH); break;
                case 0: if (rep == 0) phase_norm(F, layer); if (layer > 0) convert_expert_weights(F, layer); break;
                case 1: phase_inproj(F, layer); break;
                case 2: break;
                case 3: phase_mixers(F, layer, rep); break;
                case 4: phase_merge(F, layer); break;
                case 5: if (rep == 0) phase_outproj(F, layer); break;
                case 6: phase_norm2(F, layer); break;
                case 7: phase_topk(F, layer); break;
                case 8: phase_gateup(F, layer); break;
                default: phase_down(F, layer); break;
            }
            if (rep + 1 < reps || ph + 1 < args.ph_hi) xcd_barrier(bar);
        }
    }
}

extern "C" void kernel_launch(void* const* d_in, const int* in_sizes, int n_in, void* d_out, int out_size, void* d_ws, size_t ws_size, hipStream_t stream) {
    static int grid = 0;
    if (grid == 0) {
        if (n_in != 21 || out_size != TL * D || ws_size < WS_END) { fprintf(stderr, "kernel_launch: unexpected shapes (n_in %d, out %d, ws %zu need %zu)\n", n_in, out_size, ws_size, (size_t)WS_END); grid = -1; return; }
        int dev = 0, cus = 0, per_cu = 0;
        if (hipGetDevice(&dev) != hipSuccess || hipDeviceGetAttribute(&cus, hipDeviceAttributeMultiprocessorCount, dev) != hipSuccess) { grid = -1; return; }
        if (hipFuncSetAttribute((const void*)mk_fwd, hipFuncAttributeMaxDynamicSharedMemorySize, LDS_BYTES) != hipSuccess) { fprintf(stderr, "kernel_launch: hipFuncSetAttribute failed\n"); grid = -1; return; }
        if (hipOccupancyMaxActiveBlocksPerMultiprocessor(&per_cu, (const void*)mk_fwd, 512, LDS_BYTES) != hipSuccess || per_cu < 1) { fprintf(stderr, "kernel_launch: occupancy query says %d\n", per_cu); per_cu = 1; }
        (void)hipGetLastError();
        grid = cus * (per_cu >= 1 ? 1 : 1);
        if (grid % 8 != 0 || grid <= NDFT_CU) fprintf(stderr, "kernel_launch: unusual grid %d\n", grid);
    }
    if (grid < 0) return;
    (void)hipMemsetAsync((char*)d_ws + WS_CTL, 0, CTL_BYTES, stream);
    Args a{};
    for (int i = 0; i < 21; ++i) a.in[i] = (const float*)d_in[i];
    a.out = (float*)d_out; a.ws = (unsigned char*)d_ws;
#if MK_MULTI_LAUNCH
    for (int ph = 0; ph < NPHASE; ++ph) { a.ph_lo = ph; a.ph_hi = ph + 1; hipLaunchKernelGGL(mk_fwd, dim3(grid), dim3(512), LDS_BYTES, stream, a); }
#else
    a.ph_lo = 0; a.ph_hi = NPHASE;
    void* kargs[] = {&a};
    hipError_t e = hipLaunchCooperativeKernel((const void*)mk_fwd, dim3(grid), dim3(512), kargs, LDS_BYTES, stream);
    if (e != hipSuccess) fprintf(stderr, "kernel_launch: cooperative launch failed: %s (grid %d)\n", hipGetErrorString(e), grid);
#endif
}
```

```cpp
#include <hip/hip_runtime.h>
#include <cstdio>
#include <cstdint>

#ifndef PROBE_MASK
#define PROBE_MASK 0
#endif
#ifndef MK_MULTI_LAUNCH
#define MK_MULTI_LAUNCH 0
#endif

#define GAS __attribute__((address_space(1)))
#define LAS __attribute__((address_space(3)))
typedef unsigned short bf16;
typedef short bf16x8 __attribute__((ext_vector_type(8)));
typedef short s16x4 __attribute__((ext_vector_type(4)));
typedef float f32x4 __attribute__((ext_vector_type(4)));
typedef float f32x16 __attribute__((ext_vector_type(16)));
typedef unsigned u32x4 __attribute__((ext_vector_type(4)));
typedef unsigned u32x2 __attribute__((ext_vector_type(2)));
typedef float f32x2_t __attribute__((ext_vector_type(2)));
typedef __bf16 bf16x2_t __attribute__((ext_vector_type(2)));

constexpr int D = 1024, NB = 8, SEQ = 2048, CTX = 256, DEPTH = 2, GRIDW = 64;
constexpr int TC = NB * CTX, TL = NB * SEQ, TA = TC + TL;
constexpr int NPROJ = 6144;
constexpr int C_RQ = 0, C_RK = 256, C_RV = 512, C_RG = 1024, C_DQ = 1536, C_DK = 2048, C_DV = 2560, C_GATE = 3072;
constexpr int INW = 6656;
constexpr int NE = 16, EH = 2048;
constexpr float EPS = 1e-6f;
constexpr float LOG2E = 1.4426950408889634f;

constexpr size_t al(size_t x) { return (x + 0xFFFFFull) & ~0xFFFFFull; }
constexpr size_t WS_CTL = 0, CTL_BYTES = 1u << 20;
constexpr size_t WS_MOD = WS_CTL + CTL_BYTES;
constexpr size_t WS_ROPE = WS_MOD + al((size_t)DEPTH * 9 * 6 * D * 4);
constexpr size_t WS_AFF = WS_ROPE + al((size_t)2 * SEQ * 32 * 4);
constexpr size_t WS_INV = WS_AFF + al((size_t)TA * 16 * 4);
constexpr size_t WS_TOPW = WS_INV + al((size_t)TA * 16 * 4);
constexpr size_t WS_WIN = WS_TOPW + al((size_t)36864 * 4);
constexpr size_t WIN_L = (size_t)7168 * 1024 * 2;
constexpr size_t WS_WFO = WS_WIN + al(2 * WIN_L);
constexpr size_t WMG_ONE = (size_t)1024 * 512 * 2;
constexpr size_t WS_WOUT = WS_WFO + al(6 * WMG_ONE);
constexpr size_t WOUT_L = (size_t)1024 * 1024 * 2;
constexpr size_t WS_WGU = WS_WOUT + al(2 * WOUT_L);
constexpr size_t WGU_E = (size_t)4096 * 1024 * 2;
constexpr size_t WS_WD = WS_WGU + al(16 * WGU_E);
constexpr size_t WD_E = (size_t)1024 * 2048 * 2;
constexpr size_t WS_DFTL = WS_WD + al(16 * WD_E);
constexpr size_t WS_DFTC = WS_DFTL + al((size_t)2048 * 4096 * 2);
constexpr size_t WS_XR = WS_DFTC + al((size_t)256 * 512 * 2);
constexpr size_t WS_HB = WS_XR + al((size_t)TA * D * 4);
constexpr size_t WS_PROJ = WS_HB + al((size_t)TA * D * 2);
constexpr size_t WS_GT = WS_PROJ + al((size_t)TA * NPROJ * 2);
constexpr size_t WS_GTC = WS_GT + al((size_t)4096 * 4096 * 2);
constexpr size_t WS_FO = WS_GTC + al((size_t)4096 * 512 * 2);
constexpr size_t MIX_ONE = (size_t)TA * 512 * 2;
constexpr size_t WS_MIXB = WS_FO + al(3 * MIX_ONE);
constexpr size_t WS_XS = WS_MIXB + al((size_t)TA * D * 2);
constexpr size_t WS_LBUF = WS_XS + al((size_t)36864 * D * 2);
constexpr size_t LBUF_ONE = (size_t)64 * 128 * 4;
constexpr size_t WS_END = WS_LBUF + al((size_t)32 * 9 * 2 * LBUF_ONE);
constexpr size_t WS_HID = WS_PROJ;
constexpr size_t WS_YE = WS_XS;
static_assert((size_t)36864 * EH * 2 <= (size_t)TA * NPROJ * 2, "HID overlays PROJ");
static_assert(WS_END <= (size_t)1024 * 1024 * 1024, "workspace map must fit 1 GiB");

constexpr int CW_BAR = 4096;
constexpr int CW_QUEUE = 16384;

constexpr int RING_BYTES = 131072;
constexpr int LDSCTL_OFF = RING_BYTES, MISC_OFF = LDSCTL_OFF + 320;
constexpr int LDS_BYTES = 147456;

#define RLX_AGENT __ATOMIC_RELAXED, __HIP_MEMORY_SCOPE_AGENT
#define LDS_WAIT() asm volatile("s_waitcnt lgkmcnt(0)" ::: "memory")
#define VM_WAIT() asm volatile("s_waitcnt vmcnt(0)" ::: "memory")
__device__ __forceinline__ unsigned f2bf(float f) { unsigned u = __builtin_bit_cast(unsigned, f); return (u + 0x7fffu + ((u >> 16) & 1u)) >> 16; }
__device__ __forceinline__ unsigned pk2(float lo, float hi) { f32x2_t v = {lo, hi}; bf16x2_t b = __builtin_convertvector(v, bf16x2_t); return __builtin_bit_cast(unsigned, b); }
__device__ __forceinline__ float bflo(unsigned w) { return __builtin_bit_cast(float, w << 16); }
__device__ __forceinline__ float bfhi(unsigned w) { return __builtin_bit_cast(float, w & 0xffff0000u); }
__device__ __forceinline__ float bf2f(bf16 h) { return __builtin_bit_cast(float, (unsigned)h << 16); }
__device__ __forceinline__ float wave_sum(float v) {
#pragma unroll
    for (int o = 1; o < 64; o <<= 1) v += __shfl_xor(v, o);
    return v;
}
__device__ __forceinline__ float sigmoidf_(float x) { return __builtin_amdgcn_rcpf(1.0f + __builtin_amdgcn_exp2f(-x * LOG2E)); }
__device__ __forceinline__ float siluf_(float x) { return x * sigmoidf_(x); }

namespace pg8 {
constexpr int BM = 256, BK = 64, HALF = 128, HTB = HALF * BK * 2, STAGE_BYTES = 8 * HTB, NXCD = 8, WGM = 8;
__host__ __device__ __forceinline__ int lds_byte(int r, int c) { const int st = (r >> 4) * 2 + (c >> 5), rr = r & 15, cc = c & 31, ob = rr * 64 + cc * 2; return st * 1024 + (ob ^ (((ob >> 9) & 1) << 5)); }
__host__ __device__ __forceinline__ void stage_rc(int b, int& R, int& C) { const int st = b / 1024, sb = b % 1024, swz = sb ^ (((sb >> 9) & 1) << 5); R = (st >> 1) * 16 + swz / 64; C = (st & 1) * 32 + (swz % 64) / 2; }
__host__ __device__ __forceinline__ int perm32(int rho) { const int n = rho >> 4, i = rho & 15; return 8 * (i >> 2) + 4 * n + (i & 3); }

struct Unit { int pm, pn, tag; const char* A; const char* B; };

__device__ __forceinline__ bool grid_order(long L, int nM, int nN, int& pm, int& pn) {
    const int nwg = nM * nN; if (L >= nwg) return false;
    int wgid = (int)L; { const int q = nwg / NXCD, r = nwg % NXCD, xcd = wgid % NXCD, off = wgid / NXCD; wgid = (xcd < r ? xcd * (q + 1) : r * (q + 1) + (xcd - r) * q) + off; }
    const int nig = WGM * nN, gid = wgid / nig, fm = gid * WGM, gsz = (nM - fm) < WGM ? (nM - fm) : WGM;
    pm = fm + ((wgid % nig) % gsz); pn = (wgid % nig) / gsz; return true;
}

typedef f32x4 Acc[2][2][4][2];
__device__ __forceinline__ void zero_acc(Acc& acc) {
#pragma unroll
    for (int a = 0; a < 2; ++a)
#pragma unroll
        for (int b = 0; b < 2; ++b)
#pragma unroll
            for (int m = 0; m < 4; ++m)
#pragma unroll
                for (int n = 0; n < 2; ++n) acc[a][b][m][n] = (f32x4){0.f, 0.f, 0.f, 0.f};
}

template <class Epi, class Sched>
__device__ __forceinline__ void gemm_phase(LAS unsigned char* lds, const int tid, const int K, const Sched& S, const Epi& E) {
    const int wid = __builtin_amdgcn_readfirstlane(tid >> 6), lane = tid & 63, wr = wid >> 2, wc = wid & 3, fr = lane & 15, fq = lane >> 4;
    const int nt = K / BK;
    unsigned voffA[2], voffB[2];
#pragma unroll
    for (int i = 0; i < 2; ++i) { int R, C; stage_rc(tid * 16 + i * 8192, R, C); const int Rb = Epi::PERM ? ((R & ~31) + perm32(R & 31)) : R;
        voffA[i] = (unsigned)(R * K + C) * 2u; voffB[i] = (unsigned)(Rb * K + C) * 2u; }
    const size_t kstep = (size_t)(BK * 2);
    const size_t hstep = (size_t)HALF * K * 2;
    const unsigned ldsw = (unsigned)wid * 1024u;
    const int aoff = lds_byte(wr * 64 + fr, fq * 8), boff = lds_byte(wc * 32 + fr, fq * 8);
#define PG8_SA(b, h) (((b) * 2 + (h)) * HTB)
#define PG8_SB(b, h) ((4 + (b) * 2 + (h)) * HTB)
#define PG8_STAGE(bufoff, gbase, voff) do { _Pragma("unroll") for (int _i = 0; _i < 2; ++_i) \
        __builtin_amdgcn_global_load_lds((const unsigned*)((const char*)(gbase) + (voff)[_i]), (LAS unsigned*)(lds + (bufoff) + ldsw + _i * 8192), 16, 0, 0); } while (0)
#define PG8_LDA(dst, b, h) do { _Pragma("unroll") for (int m = 0; m < 4; ++m) _Pragma("unroll") for (int k = 0; k < 2; ++k) dst[m][k] = *(const LAS bf16x8*)(lds + PG8_SA(b, h) + aoff + m * 2048 + k * 1024); } while (0)
#define PG8_LDB(dst, b, h) do { _Pragma("unroll") for (int n = 0; n < 2; ++n) _Pragma("unroll") for (int k = 0; k < 2; ++k) dst[n][k] = *(const LAS bf16x8*)(lds + PG8_SB(b, h) + boff + n * 2048 + k * 1024); } while (0)
#define PG8_MMA(ai, bj, At, Bt) do { __builtin_amdgcn_s_setprio(1); _Pragma("unroll") for (int m = 0; m < 4; ++m) _Pragma("unroll") for (int n = 0; n < 2; ++n) _Pragma("unroll") for (int k = 0; k < 2; ++k) \
        acc[ai][bj][m][n] = __builtin_amdgcn_mfma_f32_16x16x32_bf16(Bt[n][k], At[m][k], acc[ai][bj][m][n], 0, 0, 0); __builtin_amdgcn_s_setprio(0); } while (0)
#define PG8_WAIT_V(n) asm volatile("s_waitcnt vmcnt(" #n ")" ::: "memory")
#define PG8_WAIT_L(n) asm volatile("s_waitcnt lgkmcnt(" #n ")" ::: "memory")
#define PG8_BAR __builtin_amdgcn_s_barrier()
#define PG8_SCHED __builtin_amdgcn_sched_barrier(0)
    Unit cur, nxt; int ui = 0;
    if (!S.next(0, cur)) return;
    Acc acc; zero_acc(acc);
    bf16x8 At[4][2], B0[2][2], B1[2][2];
    const char* cA = cur.A; const char* cB = cur.B;
    PG8_STAGE(PG8_SB(0, 0), cB, voffB); PG8_STAGE(PG8_SB(0, 1), cB + hstep, voffB); PG8_STAGE(PG8_SA(0, 0), cA, voffA); PG8_STAGE(PG8_SA(0, 1), cA + hstep, voffA);
    if (wr == 1) PG8_BAR;
    PG8_WAIT_V(2); PG8_BAR;
    PG8_STAGE(PG8_SB(1, 0), cB + kstep, voffB); PG8_STAGE(PG8_SA(1, 0), cA + kstep, voffA); PG8_STAGE(PG8_SB(1, 1), cB + hstep + kstep, voffB);
    PG8_WAIT_V(6); PG8_BAR;
    for (;;) {
        const bool has_next = S.next(ui + 1, nxt);
        const char* nA = has_next ? nxt.A : cA; const char* nB = has_next ? nxt.B : cB;
        for (int t = 0; t < nt; t += 2) {
            const bool last = (t == nt - 2);
            const char* a1 = cA + (size_t)(t + 1) * kstep;
            const char* a2 = last ? nA : cA + (size_t)(t + 2) * kstep; const char* b2 = last ? nB : cB + (size_t)(t + 2) * kstep;
            const char* a3 = a2 + kstep; const char* b3 = b2 + kstep;
            PG8_LDB(B0, 0, 0); PG8_LDB(B1, 0, 1); PG8_SCHED; PG8_LDA(At, 0, 0); PG8_STAGE(PG8_SA(1, 1), a1 + hstep, voffA);
            PG8_WAIT_V(8); PG8_WAIT_L(0); PG8_BAR; PG8_MMA(0, 0, At, B0); PG8_MMA(0, 1, At, B1); PG8_BAR; PG8_SCHED;
            PG8_LDA(At, 0, 1); PG8_STAGE(PG8_SB(0, 0), b2, voffB); PG8_STAGE(PG8_SB(0, 1), b2 + hstep, voffB); PG8_STAGE(PG8_SA(0, 0), a2, voffA);
            PG8_WAIT_V(8); PG8_WAIT_L(0); PG8_BAR; PG8_MMA(1, 0, At, B0); PG8_MMA(1, 1, At, B1); PG8_BAR; PG8_SCHED;
            PG8_LDB(B0, 1, 0); PG8_LDB(B1, 1, 1); PG8_SCHED; PG8_LDA(At, 1, 0); PG8_STAGE(PG8_SA(0, 1), a2 + hstep, voffA);
            PG8_WAIT_V(8); PG8_WAIT_L(0); PG8_BAR; PG8_MMA(0, 0, At, B0); PG8_MMA(0, 1, At, B1); PG8_BAR; PG8_SCHED;
            PG8_LDA(At, 1, 1); PG8_STAGE(PG8_SB(1, 0), b3, voffB); PG8_STAGE(PG8_SB(1, 1), b3 + hstep, voffB); PG8_STAGE(PG8_SA(1, 0), a3, voffA);
            PG8_WAIT_V(8); PG8_WAIT_L(0); PG8_BAR; PG8_MMA(1, 0, At, B0); PG8_MMA(1, 1, At, B1); PG8_BAR; PG8_SCHED;
        }
        if (wr == 0) PG8_BAR;
        E(acc, cur, wr, wc, fr, fq);
        if (!has_next) break;
        cur = nxt; cA = nA; cB = nB; ++ui;
        if (wr == 1) PG8_BAR;
    }
    PG8_WAIT_V(0);
    PG8_BAR;
#undef PG8_SA
#undef PG8_SB
#undef PG8_STAGE
#undef PG8_LDA
#undef PG8_LDB
#undef PG8_MMA
#undef PG8_WAIT_V
#undef PG8_WAIT_L
#undef PG8_BAR
#undef PG8_SCHED
}
}

#define XB_TMO      128
#define XB_XCNT(j)  (256  + 64 * (j))
#define XB_XSUB(j)  (1280 + 64 * (j))
#define XB_XGEN(j)  (2304 + 64 * (j))
#define XB_TOP      3328
#define XB_TOPGEN   3392
#define XCD_BAR_WORDS 3456
#define XB_SPIN_CAP (1u << 22)
__device__ __forceinline__ unsigned xb_ld(unsigned* p)              { return __hip_atomic_load(p, __ATOMIC_RELAXED, __HIP_MEMORY_SCOPE_AGENT); }
__device__ __forceinline__ unsigned xb_add(unsigned* p, unsigned v) { return __hip_atomic_fetch_add(p, v, __ATOMIC_RELAXED, __HIP_MEMORY_SCOPE_AGENT); }
__device__ __forceinline__ unsigned xb_xcc_id() { return (unsigned)__builtin_amdgcn_s_getreg((3 << 11) | 20) & 0xFu; }
#define XB_SPIN(cond, bar) do { unsigned _sp = 0; while (cond) { __builtin_amdgcn_s_sleep(1); \
    if ((++_sp & 255u) == 0u) { if (xb_ld(&(bar)[XB_TMO])) break; if (_sp > XB_SPIN_CAP) { atomicAdd(&(bar)[XB_TMO], 1u); break; } } } } while (0)
struct XcdBarrier { unsigned* bar; unsigned x; volatile LAS unsigned* st; };
__device__ __forceinline__ XcdBarrier xcd_barrier_post(unsigned* bar, volatile LAS unsigned* st) {
    XcdBarrier b; b.bar = bar; b.x = xb_xcc_id(); b.st = st;
    if (threadIdx.x == 0) (void)xb_add(&bar[XB_XCNT(b.x)], 1u);
    return b;
}
__device__ __forceinline__ void xcd_barrier_complete(unsigned* bar, unsigned x, unsigned& nloc, unsigned& nx) {
    const unsigned G = gridDim.x * gridDim.y * gridDim.z;
    unsigned sum, cnt, mine, sp = 0u;
    for (;;) {
        sum = 0u; cnt = 0u; mine = 0u;
#pragma unroll
        for (unsigned j = 0; j < 16; ++j) { const unsigned c = xb_ld(&bar[XB_XCNT(j)]); sum += c; cnt += (c > 0u) ? 1u : 0u; mine = (j == x) ? c : mine; }
        if (sum == G) break;
        __builtin_amdgcn_s_sleep(1);
        if ((++sp & 255u) == 0u) { if (xb_ld(&bar[XB_TMO])) break; if (sp > XB_SPIN_CAP) { atomicAdd(&bar[XB_TMO], 1u); break; } }
    }
    nloc = mine > 0u ? mine : 1u; nx = cnt > 0u ? cnt : 1u;
}
__device__ __forceinline__ void xcd_barrier(const XcdBarrier& b) {
    asm volatile("s_waitcnt vmcnt(0)" ::: "memory");
    __syncthreads();
    if (threadIdx.x == 0) {
        unsigned* bar = b.bar;
        __builtin_amdgcn_s_waitcnt(0);
        unsigned nloc = b.st[0], nx = b.st[1];
        if (nloc == 0u) { xcd_barrier_complete(bar, b.x, nloc, nx); b.st[0] = nloc; b.st[1] = nx; }
        const unsigned old = xb_add(&bar[XB_XSUB(b.x)], 1u);
        const unsigned gen = old / nloc;
        if (old + 1u == (gen + 1u) * nloc) {
            __builtin_amdgcn_fence(__ATOMIC_RELEASE, "agent");
            asm volatile("s_waitcnt vmcnt(0)" ::: "memory");
            const unsigned og = xb_add(&bar[XB_TOP], 1u);
            const unsigned tg = og / nx;
            if (og + 1u == (tg + 1u) * nx) xb_add(&bar[XB_TOPGEN], 1u);
            else XB_SPIN(xb_ld(&bar[XB_TOPGEN]) == tg, bar);
            __builtin_amdgcn_fence(__ATOMIC_ACQUIRE, "agent");
            xb_add(&bar[XB_XGEN(b.x)], 1u);
            asm volatile("s_waitcnt vmcnt(0)" ::: "memory");
        } else {
            XB_SPIN(xb_ld(&bar[XB_XGEN(b.x)]) == gen, bar);
            __builtin_amdgcn_fence(__ATOMIC_ACQUIRE, "agent");
            asm volatile("s_waitcnt vmcnt(0)" ::: "memory");
        }
    }
    __syncthreads();
}

struct Args { const float* in[21]; float* out; unsigned char* ws; int ph_lo, ph_hi; };
struct Frame {
    LAS unsigned char* lds; volatile LAS unsigned* MISC; unsigned* ctl;
    int tid, lane, wave, vcu, G;
    const void __attribute__((address_space(4)))* karg; float* out; unsigned char* ws;
};
__device__ __forceinline__ const float* inp(const Frame& F, int i) { return ((const float* const __attribute__((address_space(4)))*)F.karg)[i]; }
#define IN_X 0
#define IN_C 1
#define IN_CTX 2
#define IN_CCTX 3
#define IN_WMOD 4
#define IN_BMOD 5
#define IN_GATTN 6
#define IN_GFFN 7
#define IN_WIN 8
#define IN_RDEC 9
#define IN_QN 10
#define IN_KN 11
#define IN_LAMBDA 12
#define IN_WFO 13
#define IN_WRO 14
#define IN_WDO 15
#define IN_WOUT 16
#define IN_WROUTER 17
#define IN_WEG 18
#define IN_WEU 19
#define IN_WED 20

__device__ __forceinline__ int vec_of_row(int r) { return r < TC ? 8 : (r - TC) / SEQ; }
__device__ __forceinline__ const float* mod_ptr(const Frame& F, int layer, int v, int i) { return (const float*)(F.ws + WS_MOD) + ((size_t)(layer * 9 + v) * 6 + i) * D; }
__device__ __forceinline__ float lam_init_of(int layer) { return layer == 0 ? 0.2f : 0.8f - 0.6f * 0.74081822068171788f; }
__device__ __forceinline__ float lam_of(const Frame& F, int layer) {
    const float* L = inp(F, IN_LAMBDA) + (size_t)layer * 4 * 64; float s1 = 0.f, s2 = 0.f;
    for (int i = 0; i < 64; ++i) { s1 += L[i] * L[64 + i]; s2 += L[128 + i] * L[192 + i]; }
    return __expf(s1) - __expf(s2) + lam_init_of(layer);
}

__device__ __forceinline__ void transpose_item(const float* W, int ldw, int K, int k0, int n0src, bf16* WT, int dst_row0, LAS float* scr, int lane) {
#pragma unroll 8
    for (int i = 0; i < 32; ++i) { const int kk = 2 * i + (lane >> 5); scr[kk * 33 + (lane & 31)] = W[(size_t)(k0 + kk) * ldw + n0src + (lane & 31)]; }
    LDS_WAIT(); asm volatile("" ::: "memory");
    const int c = lane & 7;
#pragma unroll
    for (int j = 0; j < 4; ++j) { const int n = (lane >> 3) + 8 * j; const LAS float* s = scr + (8 * c) * 33 + n;
        u32x4 o; o.x = pk2(s[0 * 33], s[1 * 33]); o.y = pk2(s[2 * 33], s[3 * 33]); o.z = pk2(s[4 * 33], s[5 * 33]); o.w = pk2(s[6 * 33], s[7 * 33]);
        *(u32x4*)(WT + (size_t)(dst_row0 + n) * K + k0 + 8 * c) = o; }
    LDS_WAIT(); asm volatile("" ::: "memory");
}
template <class RowMap>
__device__ __forceinline__ void transpose_matrix(Frame& F, const float* W, int ldw, int csrc, int K, int N, bf16* WT, RowMap map, int& item_base) {
    LAS float* scr = (LAS float*)(F.lds + F.wave * 16384);
    const int gw = F.vcu * 8 + F.wave, NGW = F.G * 8;
    const int nblk = N / 32, nitems = (K / 64) * nblk;
    int start = (gw - item_base % NGW + NGW) % NGW;
    for (int it = start; it < nitems; it += NGW) { const int kb = it / nblk, nb = it % nblk; transpose_item(W, ldw, K, 64 * kb, csrc + 32 * nb, WT, map(32 * nb), scr, F.lane); }
    item_base += nitems;
}
struct MapId { int off; __device__ int operator()(int n) const { return off + n; } };
struct MapProj { __device__ int operator()(int n) const { const int tile = n >> 8; const bool qk = tile < 2 || (tile >= 6 && tile < 10); return qk ? (tile << 8) + 128 * ((n >> 5) & 1) + 32 * ((n >> 6) & 3) + (n & 31) : n; } };
struct MapGU { int up; __device__ int operator()(int n) const { return (n >> 7) * 256 + up * 128 + (n & 127); } };

__device__ __forceinline__ void convert_expert_weights(Frame& F, int layer) {
    int base = 0;
    for (int e = 0; e < NE; ++e) {
        const float* wg = inp(F, IN_WEG) + ((size_t)layer * NE + e) * D * EH; const float* wu = inp(F, IN_WEU) + ((size_t)layer * NE + e) * D * EH; const float* wd = inp(F, IN_WED) + ((size_t)layer * NE + e) * EH * D;
        bf16* gu = (bf16*)(F.ws + WS_WGU + e * WGU_E); bf16* dn = (bf16*)(F.ws + WS_WD + e * WD_E);
        transpose_matrix(F, wg, EH, 0, D, EH, gu, MapGU{0}, base);
        transpose_matrix(F, wu, EH, 0, D, EH, gu, MapGU{1}, base);
        transpose_matrix(F, wd, D, 0, EH, D, dn, MapId{0}, base);
    }
}

__device__ __forceinline__ void phase_prologue(Frame& F) {
    const int tid = F.tid;
    {
        LAS float* sc = (LAS float*)F.lds;
        LAS float* red = sc + 9 * 1024;
        for (int i = tid; i < 9 * 1024; i += 512) { const int v = i >> 10, k = i & 1023; const float c = v < 8 ? inp(F, IN_C)[v * D + k] : inp(F, IN_CCTX)[k]; sc[i] = siluf_(c); }
        __syncthreads();
        for (int item = F.vcu; item < DEPTH * 96; item += F.G) {
            const int layer = item / 96, cb = item % 96, col = cb * 64 + (tid & 63), kg = tid >> 6;
            const float* w = inp(F, IN_WMOD) + (size_t)layer * D * 6144 + col;
            float a[9];
#pragma unroll
            for (int v = 0; v < 9; ++v) a[v] = 0.f;
#pragma unroll 4
            for (int kk = 0; kk < 128; ++kk) { const int k = kg * 128 + kk; const float wv = w[(size_t)k * 6144];
#pragma unroll
                for (int v = 0; v < 9; ++v) a[v] += sc[v * 1024 + k] * wv; }
#pragma unroll
            for (int v = 0; v < 9; ++v) red[(kg * 64 + (tid & 63)) * 9 + v] = a[v];
            __syncthreads();
            for (int o = tid; o < 64 * 9; o += 512) { const int cc = o / 9, v = o % 9; float s = 0.f;
                for (int g = 0; g < 8; ++g) s += red[(g * 64 + cc) * 9 + v];
                const int colo = cb * 64 + cc;
                ((float*)(F.ws + WS_MOD))[(size_t)(layer * 9 + v) * 6144 + colo] = s + inp(F, IN_BMOD)[layer * 6144 + colo]; }
            __syncthreads();
        }
    }
    {
        const int gt = F.vcu * 512 + tid, NT = F.G * 512;
        float* rc = (float*)(F.ws + WS_ROPE); float* rs = rc + SEQ * 32;
        for (int i = gt; i < SEQ * 32; i += NT) { const int pos = i >> 5, f = i & 31; const float inv = __builtin_amdgcn_exp2f(-(float)(f & 15) * (13.287712379549449f / 16.0f));
            const float p = (f < 16) ? (float)(pos / GRIDW) : (float)(pos % GRIDW); const float ang = p * inv; rc[i] = __builtin_amdgcn_cosf(ang * 0.15915494309189535f); rs[i] = __builtin_amdgcn_sinf(ang * 0.15915494309189535f); }
        LAS float* ct = (LAS float*)F.lds;
        __syncthreads();
        for (int m = tid; m < 2048; m += 512) ct[m] = __builtin_amdgcn_cosf((float)m * (1.0f / 2048.0f));
        __syncthreads();
        bf16* dl = (bf16*)(F.ws + WS_DFTL); const float sl = 0.022097086912079608f;
        for (int i = gt; i < 2048 * 2048; i += NT) {
            const int k = i >> 11, n = i & 2047, m = (k * n) & 2047; const float c = ct[m], s = ct[(m - 512) & 2047];
            dl[(size_t)k * 4096 + n] = (bf16)f2bf(c * sl); dl[(size_t)k * 4096 + 2048 + n] = (bf16)f2bf(-s * sl); }
        bf16* dc = (bf16*)(F.ws + WS_DFTC);
        for (int i = gt; i < 256 * 256; i += NT) { const int k = i >> 8, n = i & 255, m = ((k * n) & 255) * 8; const float c = ct[m], s = ct[(m - 512) & 2047];
            dc[(size_t)k * 512 + n] = (bf16)f2bf(c * 0.0625f); dc[(size_t)k * 512 + 256 + n] = (bf16)f2bf(-s * 0.0625f); }
        for (int layer = 0; layer < DEPTH; ++layer) {
            const float* win = inp(F, IN_WIN) + (size_t)layer * D * INW; bf16* wt = (bf16*)(F.ws + WS_WIN + layer * WIN_L) + (size_t)6144 * 1024;
            for (int i = gt; i < 1024 * 1024; i += NT) { const int k = i & 1023, no = i >> 10, part = no >> 9, g = (no >> 6) & 7, cp = no & 63;
                const float* src = win + (size_t)k * INW + g * 64; float s = 0.f;
                for (int c = 0; c < 64; ++c) { const int m = ((c * cp) & 63) * 32; const float t = part == 0 ? ct[m] : ct[(m - 512) & 2047]; s += src[c] * t; }
                wt[(size_t)no * 1024 + k] = (bf16)f2bf(s * 0.125f); }
        }
        __syncthreads();
    }
    {
        int base = 0;
        for (int layer = 0; layer < DEPTH; ++layer) {
            transpose_matrix(F, inp(F, IN_WIN) + (size_t)layer * D * INW, INW, 512, D, NPROJ, (bf16*)(F.ws + WS_WIN + layer * WIN_L), MapProj{}, base);
            transpose_matrix(F, inp(F, IN_WFO) + (size_t)layer * 512 * D, D, 0, 512, D, (bf16*)(F.ws + WS_WFO + (layer * 3 + 0) * WMG_ONE), MapId{0}, base);
            transpose_matrix(F, inp(F, IN_WRO) + (size_t)layer * 512 * D, D, 0, 512, D, (bf16*)(F.ws + WS_WFO + (layer * 3 + 1) * WMG_ONE), MapId{0}, base);
            transpose_matrix(F, inp(F, IN_WDO) + (size_t)layer * 512 * D, D, 0, 512, D, (bf16*)(F.ws + WS_WFO + (layer * 3 + 2) * WMG_ONE), MapId{0}, base);
            transpose_matrix(F, inp(F, IN_WOUT) + (size_t)layer * D * D, D, 0, D, D, (bf16*)(F.ws + WS_WOUT + layer * WOUT_L), MapId{0}, base);
        }
    }
    convert_expert_weights(F, 0);
}

__device__ __forceinline__ void phase_norm(Frame& F, int layer) {
    const int gw = F.vcu * 8 + F.wave, NGW = F.G * 8, lane = F.lane;
    const bool fin = layer == DEPTH; const int r_lo = (layer >= DEPTH - 1) ? (fin ? TC : 0) : 0;
    float* XR = (float*)(F.ws + WS_XR); const int* INV = (const int*)(F.ws + WS_INV); const bf16* YE = (const bf16*)(F.ws + WS_YE); bf16* HB = (bf16*)(F.ws + WS_HB);
    for (int r = r_lo + gw; r < TA; r += NGW) {
        const int v = vec_of_row(r);
        f32x4 x[4];
        if (layer == 0) { const float* src = r < TC ? inp(F, IN_CTX) + (size_t)r * D : inp(F, IN_X) + (size_t)(r - TC) * D;
#pragma unroll
            for (int j = 0; j < 4; ++j) x[j] = *(const f32x4*)(src + 4 * lane + 256 * j);
        } else {
            const float* src = XR + (size_t)r * D;
#pragma unroll
            for (int j = 0; j < 4; ++j) x[j] = *(const f32x4*)(src + 4 * lane + 256 * j);
            if (!(layer == DEPTH - 1 + 1 && false)) {
                const bool has_moe = !(layer == 1 && r < TC && false);
                if (has_moe) {
                    f32x4 s[4];
#pragma unroll
                    for (int j = 0; j < 4; ++j) s[j] = (f32x4){0.f, 0.f, 0.f, 0.f};
                    const int* inv = INV + (size_t)r * 16;
                    for (int e = 0; e < NE; ++e) { const int slot = __builtin_amdgcn_readfirstlane(inv[e]);
                        if (slot >= 0) { const bf16* y = YE + (size_t)slot * D;
#pragma unroll
                            for (int j = 0; j < 4; ++j) { const u32x2 w = *(const u32x2*)(y + 4 * lane + 256 * j); s[j] += (f32x4){bflo(w.x), bfhi(w.x), bflo(w.y), bfhi(w.y)}; } } }
                    const float* m5 = mod_ptr(F, layer - 1, v, 5);
#pragma unroll
                    for (int j = 0; j < 4; ++j) x[j] += *(const f32x4*)(m5 + 4 * lane + 256 * j) * s[j];
                }
            }
        }
        if (fin) {
#pragma unroll
            for (int j = 0; j < 4; ++j) *(f32x4*)(F.out + (size_t)(r - TC) * D + 4 * lane + 256 * j) = x[j];
            continue;
        }
        if (layer > 0) {
#pragma unroll
            for (int j = 0; j < 4; ++j) *(f32x4*)(XR + (size_t)r * D + 4 * lane + 256 * j) = x[j];
        }
        float ss = 0.f;
#pragma unroll
        for (int j = 0; j < 4; ++j) ss += (x[j].x * x[j].x + x[j].y * x[j].y) + (x[j].z * x[j].z + x[j].w * x[j].w);
        const float rinv = __builtin_amdgcn_rsqf(wave_sum(ss) * (1.0f / D) + EPS);
        const float* g = inp(F, IN_GATTN) + (size_t)layer * D; const float* sh = mod_ptr(F, layer, v, 0); const float* scl = mod_ptr(F, layer, v, 1);
#pragma unroll
        for (int j = 0; j < 4; ++j) { const int k = 4 * lane + 256 * j; const f32x4 gv = *(const f32x4*)(g + k), sv = *(const f32x4*)(sh + k), cv = *(const f32x4*)(scl + k);
            const f32x4 y = (x[j] * rinv * gv) * (cv + 1.0f) + sv;
            u32x2 w; w.x = pk2(y.x, y.y); w.y = pk2(y.z, y.w); *(u32x2*)(HB + (size_t)r * D + k) = w; }
    }
}

using pg8::Unit; using pg8::Acc;
struct SchedGrid {
    int nM, nN, G, c; const char* A; const char* B; size_t a_tile, b_tile; int pm_per_group; size_t b_group;
    __device__ __forceinline__ bool next(int i, Unit& u) const {
        int pm, pn; if (c < 0 || !pg8::grid_order((long)i * G + c, nM, nN, pm, pn)) return false;
        u.pm = pm; u.pn = pn; u.tag = 0; u.A = A + (size_t)pm * a_tile; u.B = B + (size_t)pn * b_tile + (pm_per_group ? (size_t)(pm / pm_per_group) * b_group : 0); return true; }
};
struct SchedMerge {
    int nM, nN, G, c; const char* A; const char* B; size_t a_seg, b_seg, a_tile, b_tile;
    __device__ __forceinline__ bool next(int i, Unit& u) const {
        const int t = i / 3, seg = i - 3 * t; int pm, pn; if (!pg8::grid_order((long)t * G + c, nM, nN, pm, pn)) return false;
        u.pm = pm; u.pn = pn; u.tag = seg; u.A = A + (size_t)seg * a_seg + (size_t)pm * a_tile; u.B = B + (size_t)seg * b_seg + (size_t)pn * b_tile; return true; }
};

struct EpiBf16 {
    static constexpr bool PERM = true;
    bf16* C; int ldc; int sig_pn0;
    __device__ __forceinline__ void operator()(Acc& acc, const Unit& u, int wr, int wc, int fr, int fq) const {
        const int row0 = u.pm * 256 + wr * 64 + fr, col0 = u.pn * 256 + wc * 32 + 8 * fq;
        const bool sig = u.pn >= sig_pn0;
#pragma unroll
        for (int ai = 0; ai < 2; ++ai)
#pragma unroll
            for (int m = 0; m < 4; ++m) { bf16* rowp = C + (size_t)(row0 + ai * 128 + m * 16) * ldc + col0;
#pragma unroll
                for (int bj = 0; bj < 2; ++bj) { f32x4 v0 = acc[ai][bj][m][0], v1 = acc[ai][bj][m][1];
                    if (sig) {
#pragma unroll
                        for (int j = 0; j < 4; ++j) { v0[j] = sigmoidf_(v0[j]); v1[j] = sigmoidf_(v1[j]); } }
                    u32x4 w; w.x = pk2(v0[0], v0[1]); w.y = pk2(v0[2], v0[3]); w.z = pk2(v1[0], v1[1]); w.w = pk2(v1[2], v1[3]);
                    *(u32x4*)(rowp + bj * 128) = w; } }
        pg8::zero_acc(acc);
    }
};
struct EpiGT {
    static constexpr bool PERM = true;
    bf16* GT; bf16* GTC;
    __device__ __forceinline__ void operator()(Acc& acc, const Unit& u, int wr, int wc, int fr, int fq) const {
        const int tok0 = u.pn * 256;
        bf16* base; int pitch, nseq, n0;
        if (tok0 < TC) { const int b = tok0 / CTX; base = GTC + (size_t)b * 512 * 512; pitch = 512; nseq = CTX; n0 = tok0 - b * CTX; }
        else { const int t = tok0 - TC, b = t / SEQ; base = GT + (size_t)b * 512 * 4096; pitch = 4096; nseq = SEQ; n0 = t - b * SEQ; }
        const int crow0 = u.pm * 256 + wr * 64 + fr, ccol0 = wc * 32 + 8 * fq;
#pragma unroll
        for (int ai = 0; ai < 2; ++ai)
#pragma unroll
            for (int m = 0; m < 4; ++m) { const int c = crow0 + ai * 128 + m * 16, part = c >> 9, ch = c & 511;
                bf16* rowp = base + (size_t)ch * pitch + part * nseq + n0 + ccol0;
#pragma unroll
                for (int bj = 0; bj < 2; ++bj) { const f32x4 v0 = acc[ai][bj][m][0], v1 = acc[ai][bj][m][1];
                    u32x4 w; w.x = pk2(v0[0], v0[1]); w.y = pk2(v0[2], v0[3]); w.z = pk2(v1[0], v1[1]); w.w = pk2(v1[2], v1[3]);
                    *(u32x4*)(rowp + bj * 128) = w; } }
        pg8::zero_acc(acc);
    }
};
struct EpiDFT {
    static constexpr bool PERM = true;
    bf16* FO; int nseq; int row_base0;
    __device__ __forceinline__ void operator()(Acc& acc, const Unit& u, int wr, int wc, int fr, int fq) const {
        const int k0 = u.pm * 256 + wr * 64 + fr, b = (u.pn * 256) >> 9, ch0 = ((u.pn * 256) & 511) + wc * 32 + 8 * fq;
        bf16* base = FO + (size_t)(row_base0 + b * nseq + k0) * 512 + ch0;
#pragma unroll
        for (int ai = 0; ai < 2; ++ai)
#pragma unroll
            for (int m = 0; m < 4; ++m) { bf16* rowp = base + (size_t)(ai * 128 + m * 16) * 512;
#pragma unroll
                for (int bj = 0; bj < 2; ++bj) { const f32x4 v0 = acc[ai][bj][m][0], v1 = acc[ai][bj][m][1];
                    u32x4 w; w.x = pk2(v0[0], v0[1]); w.y = pk2(v0[2], v0[3]); w.z = pk2(v1[0], v1[1]); w.w = pk2(v1[2], v1[3]);
                    *(u32x4*)(rowp + bj * 128) = w; } }
        pg8::zero_acc(acc);
    }
};
struct EpiMerge {
    static constexpr bool PERM = true;
    const bf16* PROJ; bf16* MIXB; int row_off;
    __device__ __forceinline__ void operator()(Acc& acc, const Unit& u, int wr, int wc, int fr, int fq) const {
        const int row0 = row_off + u.pm * 256 + wr * 64 + fr, col0 = u.pn * 256 + wc * 32 + 8 * fq, seg = u.tag;
#pragma unroll
        for (int ai = 0; ai < 2; ++ai)
#pragma unroll
            for (int m = 0; m < 4; ++m) { const size_t row = (size_t)(row0 + ai * 128 + m * 16);
#pragma unroll
                for (int bj = 0; bj < 2; ++bj) { const int col = col0 + bj * 128;
                    const u32x4 ga = *(const u32x4*)(PROJ + row * NPROJ + C_GATE + seg * 1024 + col);
                    float f[8];
                    if (seg < 2) { const u32x4 gb = *(const u32x4*)(PROJ + row * NPROJ + C_GATE + (seg + 1) * 1024 + col);
#pragma unroll
                        for (int q = 0; q < 4; ++q) { f[2 * q] = bflo(ga[q]) * __builtin_amdgcn_rcpf(bflo(gb[q])); f[2 * q + 1] = bfhi(ga[q]) * __builtin_amdgcn_rcpf(bfhi(gb[q])); }
                    } else {
#pragma unroll
                        for (int q = 0; q < 4; ++q) { f[2 * q] = bflo(ga[q]); f[2 * q + 1] = bfhi(ga[q]); }
                    }
                    f32x4 v0 = acc[ai][bj][m][0], v1 = acc[ai][bj][m][1];
                    v0 = v0 * (f32x4){f[0], f[1], f[2], f[3]}; v1 = v1 * (f32x4){f[4], f[5], f[6], f[7]};
                    if (seg < 2) { acc[ai][bj][m][0] = v0; acc[ai][bj][m][1] = v1; }
                    else { u32x4 w; w.x = pk2(v0[0], v0[1]); w.y = pk2(v0[2], v0[3]); w.z = pk2(v1[0], v1[1]); w.w = pk2(v1[2], v1[3]);
                        *(u32x4*)(MIXB + row * D + col) = w; acc[ai][bj][m][0] = (f32x4){0.f, 0.f, 0.f, 0.f}; acc[ai][bj][m][1] = (f32x4){0.f, 0.f, 0.f, 0.f}; } }
                asm volatile("" ::: "memory"); }
    }
};
struct EpiOut {
    static constexpr bool PERM = false;
    const float* base_ctx; const float* base_lat; float* XR; const float* mod2; int row_off;
    __device__ __forceinline__ void operator()(Acc& acc, const Unit& u, int wr, int wc, int fr, int fq) const {
        const int row0 = row_off + u.pm * 256 + wr * 64 + fr, col0 = u.pn * 256 + wc * 32 + 4 * fq;
        const int v = vec_of_row(row_off + u.pm * 256);
        f32x4 mv[2][2];
#pragma unroll
        for (int bj = 0; bj < 2; ++bj)
#pragma unroll
            for (int n = 0; n < 2; ++n) mv[bj][n] = *(const f32x4*)(mod2 + (size_t)v * 6144 + col0 + bj * 128 + n * 16);
#pragma unroll
        for (int ai = 0; ai < 2; ++ai)
#pragma unroll
            for (int m = 0; m < 4; ++m) { const int row = row0 + ai * 128 + m * 16;
                const float* bp = row < TC ? base_ctx + (size_t)row * D : base_lat + (size_t)(row - TC) * D; float* op = XR + (size_t)row * D;
#pragma unroll
                for (int bj = 0; bj < 2; ++bj)
#pragma unroll
                    for (int n = 0; n < 2; ++n) { const int c = col0 + bj * 128 + n * 16; *(f32x4*)(op + c) = *(const f32x4*)(bp + c) + mv[bj][n] * acc[ai][bj][m][n]; } }
        pg8::zero_acc(acc);
    }
};
struct EpiGU {
    static constexpr bool PERM = true;
    bf16* HID;
    __device__ __forceinline__ void operator()(Acc& acc, const Unit& u, int wr, int wc, int fr, int fq) const {
        const int row0 = u.pm * 256 + wr * 64 + fr, col0 = u.pn * 128 + wc * 32 + 8 * fq;
#pragma unroll
        for (int ai = 0; ai < 2; ++ai)
#pragma unroll
            for (int m = 0; m < 4; ++m) { float h[8];
#pragma unroll
                for (int n = 0; n < 2; ++n)
#pragma unroll
                    for (int j = 0; j < 4; ++j) { const float g = acc[ai][0][m][n][j], up = acc[ai][1][m][n][j]; h[4 * n + j] = siluf_(g) * up; }
                u32x4 w; w.x = pk2(h[0], h[1]); w.y = pk2(h[2], h[3]); w.z = pk2(h[4], h[5]); w.w = pk2(h[6], h[7]);
                *(u32x4*)(HID + (size_t)(row0 + ai * 128 + m * 16) * EH + col0) = w; }
        pg8::zero_acc(acc);
    }
};
struct EpiDown {
    static constexpr bool PERM = true;
    bf16* YE; const float* topw;
    __device__ __forceinline__ void operator()(Acc& acc, const Unit& u, int wr, int wc, int fr, int fq) const {
        const int row0 = u.pm * 256 + wr * 64 + fr, col0 = u.pn * 256 + wc * 32 + 8 * fq;
#pragma unroll
        for (int ai = 0; ai < 2; ++ai)
#pragma unroll
            for (int m = 0; m < 4; ++m) { const int row = row0 + ai * 128 + m * 16; const float tw = topw[row];
#pragma unroll
                for (int bj = 0; bj < 2; ++bj) { const f32x4 v0 = acc[ai][bj][m][0] * tw, v1 = acc[ai][bj][m][1] * tw;
                    u32x4 w; w.x = pk2(v0[0], v0[1]); w.y = pk2(v0[2], v0[3]); w.z = pk2(v1[0], v1[1]); w.w = pk2(v1[2], v1[3]);
                    *(u32x4*)(YE + (size_t)row * D + col0 + bj * 128) = w; } }
        pg8::zero_acc(acc);
    }
};

struct SchedInproj {
    int G, c, ncc; const char* HB; const char* WT;
    __device__ __forceinline__ bool next(int i, Unit& u) const {
        const long L = (long)i * G + c; int pm, pn;
        if (L < 64 * 28) { pg8::grid_order(L, 64, 28, pm, pn); pm += 8; }
        else { if (!pg8::grid_order(L - 64 * 28, 8, ncc, pm, pn)) return false; if (ncc == 7) pn = pn < 3 ? pn + 1 : pn + 5; }
        const size_t tile = (size_t)256 * D * 2;
        if (pn < 24) { u.pm = pm; u.pn = pn; u.A = HB + pm * tile; u.B = WT + pn * tile; u.tag = (pn < 2 || (pn >= 6 && pn < 10)) ? 2 : (pn >= 12 ? 1 : 0); }
        else { u.pm = pn - 24; u.pn = pm; u.A = WT + (size_t)(24 + pn - 24) * tile; u.B = HB + pm * tile; u.tag = 3; }
        return true; }
};
struct EpiInproj {
    static constexpr bool PERM = true;
    bf16* PROJ; bf16* GT; bf16* GTC; const float* rc; const float* rs; const float* qn; const float* kn;
    __device__ __forceinline__ void operator()(Acc& acc, const Unit& u, int wr, int wc, int fr, int fq) const {
        if (u.tag == 3) { EpiGT E{GT, GTC}; E(acc, u, wr, wc, fr, fq); return; }
        if (u.tag < 2) { EpiBf16 E{PROJ, NPROJ, u.tag == 1 ? 0 : 1000}; E(acc, u, wr, wc, fr, fq); return; }
        const int tile = u.pn; const bool is_d = tile >= 6, is_q = (tile == 0 || tile == 6 || tile == 7);
        f32x4 g1[2], g2[2];
        if (is_d) { const float* G = is_q ? qn : kn;
#pragma unroll
            for (int n = 0; n < 2; ++n) { g1[n] = *(const f32x4*)(G + 8 * fq + 4 * n); g2[n] = *(const f32x4*)(G + 32 + 8 * fq + 4 * n); } }
        const int row0 = u.pm * 256 + wr * 64 + fr; const bool lat = u.pm >= 8;
#pragma unroll
        for (int ai = 0; ai < 2; ++ai)
#pragma unroll
            for (int m = 0; m < 4; ++m) { const int row = row0 + ai * 128 + m * 16;
                f32x4 x1[2] = {acc[ai][0][m][0], acc[ai][0][m][1]}, x2[2] = {acc[ai][1][m][0], acc[ai][1][m][1]};
                if (is_d) {
                    float ss = 0.f;
#pragma unroll
                    for (int n = 0; n < 2; ++n) ss += (x1[n][0] * x1[n][0] + x1[n][1] * x1[n][1]) + (x1[n][2] * x1[n][2] + x1[n][3] * x1[n][3]) + (x2[n][0] * x2[n][0] + x2[n][1] * x2[n][1]) + (x2[n][2] * x2[n][2] + x2[n][3] * x2[n][3]);
                    ss += __shfl_xor(ss, 16); ss += __shfl_xor(ss, 32);
                    const float rinv = __builtin_amdgcn_rsqf(ss * (1.0f / 64.0f) + EPS);
#pragma unroll
                    for (int n = 0; n < 2; ++n) { x1[n] = x1[n] * rinv * g1[n]; x2[n] = x2[n] * rinv * g2[n]; }
                } else if (tile == 0) {
#pragma unroll
                    for (int n = 0; n < 2; ++n) { x1[n] = x1[n] * 0.125f; x2[n] = x2[n] * 0.125f; }
                }
                f32x4 o1[2], o2[2];
                if (lat) { const int pos = (row - TC) & (SEQ - 1);
#pragma unroll
                    for (int n = 0; n < 2; ++n) { const f32x4 c = *(const f32x4*)(rc + pos * 32 + 8 * fq + 4 * n), sn = *(const f32x4*)(rs + pos * 32 + 8 * fq + 4 * n);
                        o1[n] = x1[n] * c - x2[n] * sn; o2[n] = x2[n] * c + x1[n] * sn; }
                } else { o1[0] = x1[0]; o1[1] = x1[1]; o2[0] = x2[0]; o2[1] = x2[1]; }
                if (is_d && is_q) { const float k = 0.125f * LOG2E;
#pragma unroll
                    for (int n = 0; n < 2; ++n) { o1[n] = o1[n] * k; o2[n] = o2[n] * k; } }
                bf16* dst = PROJ + (size_t)row * NPROJ + tile * 256 + 64 * wc + 8 * fq;
                u32x4 w; w.x = pk2(o1[0][0], o1[0][1]); w.y = pk2(o1[0][2], o1[0][3]); w.z = pk2(o1[1][0], o1[1][1]); w.w = pk2(o1[1][2], o1[1][3]); *(u32x4*)dst = w;
                w.x = pk2(o2[0][0], o2[0][1]); w.y = pk2(o2[0][2], o2[0][3]); w.z = pk2(o2[1][0], o2[1][1]); w.w = pk2(o2[1][2], o2[1][3]); *(u32x4*)(dst + 32) = w;
                asm volatile("" ::: "memory"); }
        pg8::zero_acc(acc);
    }
};
__device__ __forceinline__ void phase_inproj(Frame& F, int layer) {
    const float* rc = (const float*)(F.ws + WS_ROPE);
    SchedInproj S{F.G, (int)blockIdx.x, layer == DEPTH - 1 ? 7 : 28, (const char*)(F.ws + WS_HB), (const char*)(F.ws + WS_WIN + layer * WIN_L)};
    EpiInproj E{(bf16*)(F.ws + WS_PROJ), (bf16*)(F.ws + WS_GT), (bf16*)(F.ws + WS_GTC), rc, rc + SEQ * 32, inp(F, IN_QN) + layer * 64, inp(F, IN_KN) + layer * 64};
    pg8::gemm_phase(F.lds, F.tid, D, S, E);
}

namespace att {
constexpr int KPITCH = 144, VPITCH = 320, KC_BYTES = 64 * KPITCH, V_BYTES = 64 * VPITCH, BUF_BYTES = 2 * KC_BYTES + V_BYTES;
constexpr int SCR_OFF = 2 * BUF_BYTES;
constexpr int QW_OFF = SCR_OFF + 8 * 256;
constexpr int S_OFF = 81920, S_BYTES = 128 * KPITCH;
__device__ __forceinline__ int crow(int r, int hi) { return (r & 3) + 8 * (r >> 2) + 4 * hi; }
__device__ __forceinline__ s16x4 vtr(const LAS unsigned char* p) { typedef short v4i16_t __attribute__((ext_vector_type(4))); return __builtin_bit_cast(s16x4, __builtin_amdgcn_ds_read_tr16_b64_v4i16((LAS v4i16_t*)p)); }

struct UnitDesc {
    int mode;
    int qrow0;
    int qpos0;
    int h;
    int krowA, ntA;
    int krowB, ntB;
    int kindB;
    int nseq;
    int outrow0;
    float lgf, lgb;
    float lam, scale_out;
    int cross, bh, blk;
};

__device__ __forceinline__ void unit(const Frame& F, const UnitDesc& u) {
    LAS unsigned char* lds = F.lds;
    const int tid = F.tid, lane = F.lane, wid = F.wave, r32 = lane & 31, hi = lane >> 5;
    const bf16* PROJ = (const bf16*)(F.ws + WS_PROJ);
    const bool diff = u.mode == 0;
    const int comp = diff ? (wid >> 2) : 0;
    const int qoff = diff ? 32 * (wid & 3) : 32 * wid;
    const int kcol = diff ? C_DK + u.h * 128 : C_RK + u.h * 64, vcol = diff ? C_DV + u.h * 128 : C_RV + u.h * 128;
    const int qcol = diff ? C_DQ + u.h * 128 + comp * 64 : C_RQ + u.h * 64;
    const int NT = u.ntA + u.ntB;
    bf16x8 qf[4];
    { const bf16* qp = PROJ + (size_t)(u.qrow0 + qoff + r32) * NPROJ + qcol + 8 * hi;
#pragma unroll
      for (int s = 0; s < 4; ++s) qf[s] = *(const bf16x8*)(qp + 16 * s); }
    f32x16 o[4];
#pragma unroll
    for (int d = 0; d < 4; ++d) o[d] = (f32x16){};
    float lsum = 0.f;
    if (!diff && u.cross) {
        const float* LB = (const float*)(F.ws + WS_LBUF) + (size_t)u.bh * 9 * 2 * 64 * 128;
        const int dv = tid & 127, dg = tid >> 7, c = u.blk;
        float sf[16], sb[16];
#pragma unroll
        for (int k = 0; k < 16; ++k) { sf[k] = 0.f; sb[k] = 0.f; }
        for (int bp = 0; bp < 9; ++bp) {
            const float wf = bp == 8 ? __builtin_amdgcn_exp2f(u.lgf * 256.f * (float)c) : (bp < c ? __builtin_amdgcn_exp2f(u.lgf * 256.f * (float)(c - 1 - bp)) : 0.f);
            const float wb = bp == 8 ? __builtin_amdgcn_exp2f(u.lgb * 256.f * (float)(7 - c)) : (bp > c ? __builtin_amdgcn_exp2f(u.lgb * 256.f * (float)(bp - c - 1)) : 0.f);
            const float* Lf = LB + (size_t)(bp * 2 + 0) * 64 * 128 + (16 * dg) * 128 + dv; const float* Lb = Lf + 64 * 128;
            if (wf != 0.f) {
#pragma unroll
                for (int k = 0; k < 16; ++k) sf[k] += wf * Lf[k * 128]; }
            if (wb != 0.f) {
#pragma unroll
                for (int k = 0; k < 16; ++k) sb[k] += wb * Lb[k * 128]; }
        }
        LAS unsigned char* sp = lds + S_OFF + dv * KPITCH + dg * 32;
        *(LAS u32x4*)(sp) = (u32x4){pk2(sf[0], sf[1]), pk2(sf[2], sf[3]), pk2(sf[4], sf[5]), pk2(sf[6], sf[7])};
        *(LAS u32x4*)(sp + 16) = (u32x4){pk2(sf[8], sf[9]), pk2(sf[10], sf[11]), pk2(sf[12], sf[13]), pk2(sf[14], sf[15])};
        *(LAS u32x4*)(sp + S_BYTES) = (u32x4){pk2(sb[0], sb[1]), pk2(sb[2], sb[3]), pk2(sb[4], sb[5]), pk2(sb[6], sb[7])};
        *(LAS u32x4*)(sp + S_BYTES + 16) = (u32x4){pk2(sb[8], sb[9]), pk2(sb[10], sb[11]), pk2(sb[12], sb[13]), pk2(sb[14], sb[15])};
        __syncthreads();
        const int p = qoff + r32; const float ai = __builtin_amdgcn_exp2f(u.lgf * (float)(p + 1)), bi = __builtin_amdgcn_exp2f(u.lgb * (float)(256 - p));
#pragma unroll
        for (int s4 = 0; s4 < 4; ++s4) {
            const u32x4 qw = __builtin_bit_cast(u32x4, qf[s4]); u32x4 qa, qb;
#pragma unroll
            for (int q = 0; q < 4; ++q) { const float lo = bflo(qw[q]), hh = bfhi(qw[q]); qa[q] = pk2(lo * ai, hh * ai); qb[q] = pk2(lo * bi, hh * bi); }
#pragma unroll
            for (int d = 0; d < 4; ++d) {
                const LAS unsigned char* bp = lds + S_OFF + (32 * d + r32) * KPITCH + (16 * s4 + 8 * hi) * 2;
                o[d] = __builtin_amdgcn_mfma_f32_32x32x16_bf16(__builtin_bit_cast(bf16x8, qa), *(const LAS bf16x8*)bp, o[d], 0, 0, 0);
                o[d] = __builtin_amdgcn_mfma_f32_32x32x16_bf16(__builtin_bit_cast(bf16x8, qb), *(const LAS bf16x8*)(bp + S_BYTES), o[d], 0, 0, 0);
            }
        }
    }
    u32x4 kreg[2], vreg[2];
    auto tile_row = [&](int t) { return t < u.ntA ? u.krowA + 64 * t : u.krowB + 64 * (t - u.ntA); };
    auto load_tile = [&](int t) {
        const int row0 = tile_row(t);
#pragma unroll
        for (int i = 0; i < 2; ++i) { const int cid = tid + 512 * i, key = cid >> 4, c16 = cid & 15;
            vreg[i] = *(const u32x4*)(PROJ + (size_t)(row0 + key) * NPROJ + vcol + c16 * 8);
            if (diff) kreg[i] = *(const u32x4*)(PROJ + (size_t)(row0 + key) * NPROJ + kcol + c16 * 8); }
        if (!diff) { const int key = tid >> 3, c8 = tid & 7; kreg[0] = *(const u32x4*)(PROJ + (size_t)(row0 + key) * NPROJ + kcol + c8 * 8); }
    };
    auto store_tile = [&](int buf) {
        LAS unsigned char* b = lds + buf * BUF_BYTES;
#pragma unroll
        for (int i = 0; i < 2; ++i) { const int cid = tid + 512 * i, key = cid >> 4, c16 = cid & 15;
            *(LAS u32x4*)(b + 2 * KC_BYTES + key * VPITCH + c16 * 16) = vreg[i];
            if (diff) *(LAS u32x4*)(b + (c16 >> 3) * KC_BYTES + key * KPITCH + (c16 & 7) * 16) = kreg[i]; }
        if (!diff) { const int key = tid >> 3, c8 = tid & 7; *(LAS u32x4*)(b + key * KPITCH + c8 * 16) = kreg[0]; }
    };
    load_tile(0); store_tile(0);
    __syncthreads();
    const int qpos = u.qpos0 + qoff + r32;
    for (int t = 0; t < NT; ++t) {
        if (t + 1 < NT) load_tile(t + 1);
        const LAS unsigned char* b = lds + (t & 1) * BUF_BYTES;
        const LAS unsigned char* kb = b + comp * KC_BYTES + r32 * KPITCH + hi * 16;
        u32x4 pw[4];
        const bool segB = t >= u.ntA; const int j0 = 64 * (segB ? t - u.ntA : t);
#pragma unroll
        for (int kh = 0; kh < 2; ++kh) {
            f32x16 sc = (f32x16){};
#pragma unroll
            for (int s = 0; s < 4; ++s) { const bf16x8 kf = *(const LAS bf16x8*)(kb + kh * 32 * KPITCH + s * 32); sc = __builtin_amdgcn_mfma_f32_32x32x16_bf16(kf, qf[s], sc, 0, 0, 0); }
            if (diff) {
#pragma unroll
                for (int r = 0; r < 16; ++r) sc[r] = __builtin_amdgcn_exp2f(sc[r]);
                float a = 0.f;
#pragma unroll
                for (int r = 0; r < 16; ++r) a += sc[r];
                lsum += a;
            } else if (!segB || u.kindB == 0) {
#pragma unroll
                for (int r = 0; r < 16; ++r) { const int d = qpos - (j0 + 32 * kh + crow(r, hi)); sc[r] *= __builtin_amdgcn_exp2f((float)d * (d >= 0 ? u.lgf : -u.lgb)); }
            } else {
#pragma unroll
                for (int r = 0; r < 16; ++r) { const int na = j0 + 32 * kh + crow(r, hi);
                    sc[r] *= __builtin_amdgcn_exp2f((float)(qpos + CTX - na) * u.lgf) + __builtin_amdgcn_exp2f((float)(u.nseq - qpos + na) * u.lgb); }
            }
            pw[2 * kh] = (u32x4){pk2(sc[0], sc[1]), pk2(sc[2], sc[3]), pk2(sc[4], sc[5]), pk2(sc[6], sc[7])};
            pw[2 * kh + 1] = (u32x4){pk2(sc[8], sc[9]), pk2(sc[10], sc[11]), pk2(sc[12], sc[13]), pk2(sc[14], sc[15])};
            __builtin_amdgcn_sched_barrier(0);
        }
        const LAS unsigned char* vb = b + 2 * KC_BYTES + (4 * hi + ((lane & 15) >> 2)) * VPITCH + ((lane >> 4) & 1) * 32 + (lane & 3) * 8;
        __builtin_amdgcn_sched_barrier(0);
#pragma unroll
        for (int dvb = 0; dvb < 4; ++dvb) {
#pragma unroll
            for (int ks = 0; ks < 4; ++ks) {
                const s16x4 lo = vtr(vb + ks * 16 * VPITCH + dvb * 64), hi4 = vtr(vb + ks * 16 * VPITCH + 8 * VPITCH + dvb * 64);
                const bf16x8 vf = (bf16x8){lo[0], lo[1], lo[2], lo[3], hi4[0], hi4[1], hi4[2], hi4[3]};
                o[dvb] = __builtin_amdgcn_mfma_f32_32x32x16_bf16(__builtin_bit_cast(bf16x8, pw[ks]), vf, o[dvb], 0, 0, 0);
            }
            __builtin_amdgcn_sched_barrier(0);
        }
        if (t + 1 < NT) store_tile((t + 1) & 1);
        __syncthreads();
    }
    LAS float* wsf = (LAS float*)(lds + SCR_OFF) + wid * 64;
    int lz = lane; asm volatile("" : "+v"(lz));
    const int r32e = lz & 31, hie = lz >> 5;
    if (diff) {
        lsum += __shfl_xor(lsum, 32);
        if (hie == 0) wsf[r32e] = __builtin_amdgcn_rcpf(lsum);
        LDS_WAIT();
        float rl[16];
#pragma unroll
        for (int r = 0; r < 16; ++r) rl[r] = wsf[crow(r, hie)];
        LAS float* XC = (LAS float*)lds;
        if (comp == 1) {
#pragma unroll
            for (int r = 0; r < 16; ++r) { const int q = qoff + crow(r, hie);
#pragma unroll
                for (int d = 0; d < 4; ++d) XC[q * 128 + 32 * d + r32e] = o[d][r] * rl[r] * u.lam; }
        }
        __syncthreads();
        if (comp == 0) {
            float ss[16];
#pragma unroll
            for (int r = 0; r < 16; ++r) { const int q = qoff + crow(r, hie); float a = 0.f;
#pragma unroll
                for (int d = 0; d < 4; ++d) { const float v = o[d][r] * rl[r] - XC[q * 128 + 32 * d + r32e]; o[d][r] = v; a += v * v; }
                ss[r] = a; }
#pragma unroll
            for (int r = 0; r < 16; ++r) { float a = ss[r]; a += __shfl_xor(a, 1); a += __shfl_xor(a, 2); a += __shfl_xor(a, 4); a += __shfl_xor(a, 8); a += __shfl_xor(a, 16);
                ss[r] = u.scale_out * __builtin_amdgcn_rsqf(a * (1.0f / 128.0f) + EPS); }
            bf16* DO = (bf16*)(F.ws + WS_FO + 2 * MIX_ONE);
#pragma unroll
            for (int r = 0; r < 16; ++r) { bf16* op = DO + (size_t)(u.outrow0 + qoff + crow(r, hie)) * 512 + u.h * 128 + r32e;
#pragma unroll
                for (int d = 0; d < 4; ++d) op[32 * d] = (bf16)f2bf(o[d][r] * ss[r]); }
        }
    } else {
        bf16* RO = (bf16*)(F.ws + WS_FO + 1 * MIX_ONE);
#pragma unroll
        for (int r = 0; r < 16; ++r) {
            float a = (o[0][r] + o[1][r]) + (o[2][r] + o[3][r]);
            a += __shfl_xor(a, 1); a += __shfl_xor(a, 2); a += __shfl_xor(a, 4); a += __shfl_xor(a, 8); a += __shfl_xor(a, 16);
            const float mu = a * (1.0f / 128.0f); float q = 0.f;
#pragma unroll
            for (int d = 0; d < 4; ++d) { const float v = o[d][r] - mu; o[d][r] = v; q += v * v; }
            q += __shfl_xor(q, 1); q += __shfl_xor(q, 2); q += __shfl_xor(q, 4); q += __shfl_xor(q, 8); q += __shfl_xor(q, 16);
            const float rstd = __builtin_amdgcn_rsqf(q * (1.0f / 128.0f) + EPS);
            const size_t row = (size_t)(u.outrow0 + qoff + crow(r, hie));
            const bf16* gp = PROJ + row * NPROJ + C_RG + u.h * 128 + r32e; bf16* op = RO + row * 512 + u.h * 128 + r32e;
#pragma unroll
            for (int d = 0; d < 4; ++d) { const float g = bf2f(gp[32 * d]); op[32 * d] = (bf16)f2bf(o[d][r] * rstd * siluf_(g)); }
        }
    }
    __syncthreads();
}
}

namespace rst {
constexpr int KP = 192, VP = 320, KB_BYTES = 128 * KP, VB_BYTES = 128 * VP;
__device__ __forceinline__ void unit(const Frame& F, int layer, int b, int h, int blk) {
    LAS unsigned char* lds = F.lds; const int tid = F.tid, lane = F.lane, wid = F.wave, hi = lane >> 5;
    const bf16* PROJ = (const bf16*)(F.ws + WS_PROJ);
    const int row0 = blk < 8 ? TC + b * SEQ + blk * 256 : b * CTX;
    const float lgf = inp(F, IN_RDEC)[(layer * 2 + 0) * 4 + h] * LOG2E, lgb = inp(F, IN_RDEC)[(layer * 2 + 1) * 4 + h] * LOG2E;
    const int dir = wid >> 2, dvb = wid & 3;
    f32x16 acc0 = (f32x16){}, acc1 = (f32x16){};
    for (int half = 0; half < 2; ++half) {
#pragma unroll
        for (int i = 0; i < 2; ++i) { const int cid = tid + 512 * i, tok = cid >> 3, c8 = cid & 7, p = half * 128 + tok;
            const u32x4 kv = *(const u32x4*)(PROJ + (size_t)(row0 + p) * NPROJ + C_RK + h * 64 + c8 * 8);
            const float wf = __builtin_amdgcn_exp2f((float)(255 - p) * lgf), wb = __builtin_amdgcn_exp2f((float)p * lgb);
            u32x4 kf, kb;
#pragma unroll
            for (int q = 0; q < 4; ++q) { const float lo = bflo(kv[q]), hh = bfhi(kv[q]); kf[q] = pk2(lo * wf, hh * wf); kb[q] = pk2(lo * wb, hh * wb); }
            *(LAS u32x4*)(lds + tok * KP + c8 * 16) = kf; *(LAS u32x4*)(lds + KB_BYTES + tok * KP + c8 * 16) = kb; }
#pragma unroll
        for (int i = 0; i < 4; ++i) { const int cid = tid + 512 * i, tok = cid >> 4, c16 = cid & 15, p = half * 128 + tok;
            *(LAS u32x4*)(lds + 2 * KB_BYTES + tok * VP + c16 * 16) = *(const u32x4*)(PROJ + (size_t)(row0 + p) * NPROJ + C_RV + h * 128 + c16 * 8); }
        __syncthreads();
        const LAS unsigned char* ka = lds + dir * KB_BYTES + (8 * hi + ((lane & 15) >> 2)) * KP + ((lane >> 4) & 1) * 32 + (lane & 3) * 8;
        const LAS unsigned char* va = lds + 2 * KB_BYTES + (8 * hi + ((lane & 15) >> 2)) * VP + dvb * 64 + ((lane >> 4) & 1) * 32 + (lane & 3) * 8;
#pragma unroll
        for (int ks = 0; ks < 8; ++ks) {
            const s16x4 v0 = att::vtr(va + ks * 16 * VP), v1 = att::vtr(va + ks * 16 * VP + 4 * VP);
            const bf16x8 vf = (bf16x8){v0[0], v0[1], v0[2], v0[3], v1[0], v1[1], v1[2], v1[3]};
            const s16x4 a0 = att::vtr(ka + ks * 16 * KP), a1 = att::vtr(ka + ks * 16 * KP + 4 * KP);
            const s16x4 b0 = att::vtr(ka + ks * 16 * KP + 64), b1 = att::vtr(ka + ks * 16 * KP + 4 * KP + 64);
            acc0 = __builtin_amdgcn_mfma_f32_32x32x16_bf16((bf16x8){a0[0], a0[1], a0[2], a0[3], a1[0], a1[1], a1[2], a1[3]}, vf, acc0, 0, 0, 0);
            acc1 = __builtin_amdgcn_mfma_f32_32x32x16_bf16((bf16x8){b0[0], b0[1], b0[2], b0[3], b1[0], b1[1], b1[2], b1[3]}, vf, acc1, 0, 0, 0);
        }
        __syncthreads();
    }
    float* L = (float*)(F.ws + WS_LBUF) + ((size_t)((b * 4 + h) * 9 + blk) * 2 + dir) * 64 * 128;
    const int r32 = lane & 31;
#pragma unroll
    for (int r = 0; r < 16; ++r) { const int d = att::crow(r, hi); L[(size_t)d * 128 + 32 * dvb + r32] = acc0[r]; L[(size_t)(32 + d) * 128 + 32 * dvb + r32] = acc1[r]; }
}
}
__device__ __forceinline__ void phase_retstate(Frame& F, int layer) {
    for (int i = F.vcu; i < 288; i += F.G) { const int blk = i % 9, bh = i / 9; rst::unit(F, layer, bh >> 2, bh & 3, blk); }
}


constexpr int NDFT_CU = 128;

__device__ __forceinline__ void phase_mixers(Frame& F, int layer, int rep) {
    const bool last = layer == DEPTH - 1;
#if !defined(ONLY_SUB) || ONLY_SUB == 1
    if ((int)blockIdx.x < NDFT_CU && F.G > NDFT_CU) {
        {
            SchedGrid S{SEQ / 256, 4096 / 256, NDFT_CU, (int)blockIdx.x, (const char*)(F.ws + WS_DFTL), (const char*)(F.ws + WS_GT), (size_t)256 * 4096 * 2, (size_t)256 * 4096 * 2, 0, 0};
            EpiDFT E{(bf16*)(F.ws + WS_FO), SEQ, TC};
            pg8::gemm_phase(F.lds, F.tid, 4096, S, E);
        }
        if (!last) {
            SchedGrid S{1, 4096 / 256, NDFT_CU, (int)blockIdx.x, (const char*)(F.ws + WS_DFTC), (const char*)(F.ws + WS_GTC), (size_t)256 * 512 * 2, (size_t)256 * 512 * 2, 0, 0};
            EpiDFT E{(bf16*)(F.ws + WS_FO), CTX, 0};
            pg8::gemm_phase(F.lds, F.tid, 512, S, E);
        }
    }
#endif
#if defined(ONLY_SUB) && ONLY_SUB == 1
    return;
#endif
    const int nunits = last ? 768 : 864;
    const float lam = lam_of(F, layer), so = 1.0f - lam_init_of(layer);
    unsigned* qctr = F.ctl + CW_QUEUE + 64 * (layer + 2 * rep);
    volatile LAS unsigned* qw = (volatile LAS unsigned*)(F.lds + att::QW_OFF);
    const bool solo = F.G <= NDFT_CU;
    (void)solo;
    for (;;) {
        if (F.tid == 0) *qw = __hip_atomic_fetch_add(qctr, 1u, RLX_AGENT);
        __syncthreads();
        const int i = (int)*qw;
        __syncthreads();
        if (i >= nunits) break;
        att::UnitDesc u{};
        u.lam = lam; u.scale_out = so;
        if (i < 512) { const int b = i >> 6, h = (i >> 4) & 3, qb = i & 15; u.mode = 0; u.h = h; u.qrow0 = TC + b * SEQ + qb * 128; u.qpos0 = qb * 128; u.krowA = TC + b * SEQ; u.ntA = 32; u.krowB = b * CTX; u.ntB = 4; }
        else if (i < 768) { const int j = i - 512, b = j >> 5, h = (j >> 3) & 3, qb = j & 7; u.mode = 1; u.h = h; u.qrow0 = TC + b * SEQ + qb * 256; u.qpos0 = 0; u.krowA = u.qrow0; u.ntA = 4; u.krowB = 0; u.ntB = 0; u.kindB = 0; u.nseq = SEQ; u.cross = 1; u.bh = b * 4 + h; u.blk = qb; }
        else if (i < 832) { const int j = i - 768, b = j >> 3, h = (j >> 1) & 3, qb = j & 1; u.mode = 0; u.h = h; u.qrow0 = b * CTX + qb * 128; u.qpos0 = qb * 128; u.krowA = b * CTX; u.ntA = 4; u.krowB = 0; u.ntB = 0; }
        else { const int j = i - 832, b = j >> 2, h = j & 3; u.mode = 1; u.h = h; u.qrow0 = b * CTX; u.qpos0 = 0; u.krowA = b * CTX; u.ntA = 4; u.krowB = 0; u.ntB = 0; u.kindB = 0; u.nseq = CTX; }
        u.outrow0 = u.qrow0;
        if (u.mode == 1) { u.lgf = inp(F, IN_RDEC)[(layer * 2 + 0) * 4 + u.h] * LOG2E; u.lgb = inp(F, IN_RDEC)[(layer * 2 + 1) * 4 + u.h] * LOG2E; }
        att::unit(F, u);
    }
}

__device__ __forceinline__ void phase_merge(Frame& F, int layer) {
    const int row_off = layer == DEPTH - 1 ? TC : 0, M = TA - row_off;
    SchedMerge S{M / 256, D / 256, F.G, (int)blockIdx.x, (const char*)(F.ws + WS_FO) + (size_t)row_off * 512 * 2, (const char*)(F.ws + WS_WFO + (size_t)layer * 3 * WMG_ONE), MIX_ONE, WMG_ONE, (size_t)256 * 512 * 2, (size_t)256 * 512 * 2};
    EpiMerge E{(const bf16*)(F.ws + WS_PROJ), (bf16*)(F.ws + WS_MIXB), row_off};
    pg8::gemm_phase(F.lds, F.tid, 512, S, E);
}
__device__ __forceinline__ void phase_outproj(Frame& F, int layer) {
    const int row_off = layer == DEPTH - 1 ? TC : 0, M = TA - row_off;
    SchedGrid S{M / 256, D / 256, F.G, (int)blockIdx.x, (const char*)(F.ws + WS_MIXB) + (size_t)row_off * D * 2, (const char*)(F.ws + WS_WOUT + layer * WOUT_L), (size_t)256 * D * 2, (size_t)256 * D * 2, 0, 0};
    const float* XR = (const float*)(F.ws + WS_XR);
    EpiOut E{layer == 0 ? inp(F, IN_CTX) : XR, layer == 0 ? inp(F, IN_X) : XR + (size_t)TC * D, (float*)(F.ws + WS_XR), (const float*)(F.ws + WS_MOD) + (size_t)layer * 9 * 6144 + 2 * 1024, row_off};
    pg8::gemm_phase(F.lds, F.tid, D, S, E);
}

__device__ __forceinline__ void phase_norm2(Frame& F, int layer) {
    const int gw = F.vcu * 8 + F.wave, NGW = F.G * 8, lane = F.lane, tid = F.tid;
    LAS float* wr_t = (LAS float*)F.lds;
    const float* wrt = inp(F, IN_WROUTER) + (size_t)layer * D * NE;
    for (int i = tid; i < D * NE; i += 512) { const int k = i >> 4, e = i & 15; wr_t[e * 1024 + k] = wrt[i]; }
    __syncthreads();
    const int r_lo = layer == DEPTH - 1 ? TC : 0;
    const float* XR = (const float*)(F.ws + WS_XR); bf16* HB = (bf16*)(F.ws + WS_HB); float* AFF = (float*)(F.ws + WS_AFF);
    for (int r = r_lo + gw; r < TA; r += NGW) {
        const int v = vec_of_row(r);
        f32x4 x[4];
#pragma unroll
        for (int j = 0; j < 4; ++j) x[j] = *(const f32x4*)(XR + (size_t)r * D + 4 * lane + 256 * j);
        float ss = 0.f;
#pragma unroll
        for (int j = 0; j < 4; ++j) ss += (x[j].x * x[j].x + x[j].y * x[j].y) + (x[j].z * x[j].z + x[j].w * x[j].w);
        const float rinv = __builtin_amdgcn_rsqf(wave_sum(ss) * (1.0f / D) + EPS);
        const float* g = inp(F, IN_GFFN) + (size_t)layer * D; const float* sh = mod_ptr(F, layer, v, 3); const float* scl = mod_ptr(F, layer, v, 4);
#pragma unroll
        for (int j = 0; j < 4; ++j) { const int k = 4 * lane + 256 * j; const f32x4 gv = *(const f32x4*)(g + k), sv = *(const f32x4*)(sh + k), cv = *(const f32x4*)(scl + k);
            x[j] = (x[j] * rinv * gv) * (cv + 1.0f) + sv;
            u32x2 w; w.x = pk2(x[j].x, x[j].y); w.y = pk2(x[j].z, x[j].w); *(u32x2*)(HB + (size_t)r * D + k) = w; }
        float mine = 0.f;
#pragma unroll
        for (int eg = 0; eg < 4; ++eg) {
            float a[4];
#pragma unroll
            for (int q = 0; q < 4; ++q) { float t = 0.f;
#pragma unroll
                for (int j = 0; j < 4; ++j) { const f32x4 w = *(const LAS f32x4*)(wr_t + (4 * eg + q) * 1024 + 4 * lane + 256 * j); t += (x[j].x * w.x + x[j].y * w.y) + (x[j].z * w.z + x[j].w * w.w); }
                a[q] = t; }
#pragma unroll
            for (int o = 1; o < 64; o <<= 1) {
#pragma unroll
                for (int q = 0; q < 4; ++q) a[q] += __shfl_xor(a[q], o); }
#pragma unroll
            for (int q = 0; q < 4; ++q) mine = (lane == 4 * eg + q) ? a[q] : mine;
            asm volatile("" ::: "memory");
        }
        float mx = mine;
        mx = fmaxf(mx, __shfl_xor(mx, 1)); mx = fmaxf(mx, __shfl_xor(mx, 2)); mx = fmaxf(mx, __shfl_xor(mx, 4)); mx = fmaxf(mx, __shfl_xor(mx, 8));
        const float ex = __expf(mine - mx); float den = ex;
        den += __shfl_xor(den, 1); den += __shfl_xor(den, 2); den += __shfl_xor(den, 4); den += __shfl_xor(den, 8);
        if (lane < 16) AFF[(size_t)r * 16 + lane] = ex * __builtin_amdgcn_rcpf(den);
    }
    __syncthreads();
}

__device__ __forceinline__ void phase_topk(Frame& F, int layer) {
    const bool last = layer == DEPTH - 1; const int tid = F.tid, lane = F.lane, wave = F.wave;
    const int RPE = last ? 2048 : 2304, lat_off = last ? 0 : 256;
    LAS unsigned* part = (LAS unsigned*)F.lds;
    LAS unsigned* cntG = part + 16;
    LAS unsigned* cntE = cntG + 32;
    LAS int* lst = (LAS int*)(cntE + 32);
    const float* AFF = (const float*)(F.ws + WS_AFF); int* INV = (int*)(F.ws + WS_INV); float* TOPW = (float*)(F.ws + WS_TOPW);
    const bf16* HB = (const bf16*)(F.ws + WS_HB); bf16* XS = (bf16*)(F.ws + WS_XS);
    const int nitems = last ? 128 : 256;
    for (int item = F.vcu; item < nitems; item += F.G) {
        int n, C, tokrow0, e, slot0;
        if (item < 128) { const int b = item >> 4; e = item & 15; n = SEQ; C = 256; tokrow0 = TC + b * SEQ; slot0 = e * RPE + lat_off + b * 256; }
        else { const int be = item - 128, b = be >> 4; e = be & 15; n = CTX; C = 32; tokrow0 = b * CTX; slot0 = e * RPE + b * 32; }
        float v[4]; unsigned key[4];
#pragma unroll
        for (int q = 0; q < 4; ++q) { const int i = tid + 512 * q; v[q] = i < n ? AFF[(size_t)(tokrow0 + i) * 16 + e] : 0.f; key[q] = __builtin_bit_cast(unsigned, v[q]); }
        unsigned t = 0u;
        for (int bit = 30; bit >= 0; --bit) {
            const unsigned cand = t | (1u << bit); unsigned c = 0u;
#pragma unroll
            for (int q = 0; q < 4; ++q) c += (unsigned)__builtin_popcountll(__ballot(key[q] >= cand));
            if (lane == 0) part[(bit & 1) * 8 + wave] = c;
            __syncthreads();
            unsigned tot = 0u;
#pragma unroll
            for (int w = 0; w < 8; ++w) tot += part[(bit & 1) * 8 + w];
            if (tot >= (unsigned)C) t = cand;
        }
        unsigned long long bg[4], be_[4];
#pragma unroll
        for (int q = 0; q < 4; ++q) { bg[q] = __ballot(key[q] > t); be_[q] = __ballot(key[q] == t && key[q] != 0u);
            if (lane == 0) { cntG[q * 8 + wave] = (unsigned)__builtin_popcountll(bg[q]); cntE[q * 8 + wave] = (unsigned)__builtin_popcountll(be_[q]); } }
        __syncthreads();
        unsigned totG = 0u, baseG[4] = {0u, 0u, 0u, 0u}, baseE[4] = {0u, 0u, 0u, 0u}; unsigned runG = 0u, runE = 0u;
#pragma unroll
        for (int q = 0; q < 4; ++q)
#pragma unroll
            for (int w = 0; w < 8; ++w) { const unsigned g = cntG[q * 8 + w], ee = cntE[q * 8 + w]; if (w == wave) { baseG[q] = runG; baseE[q] = runE; } runG += g; runE += ee; }
        totG = runG;
        const unsigned need = (unsigned)C - totG;
        const unsigned long long lt = (1ull << lane) - 1ull;
#pragma unroll
        for (int q = 0; q < 4; ++q) { const int i = tid + 512 * q;
            if (i < n) {
                const bool g = (bg[q] >> lane) & 1ull, eq = (be_[q] >> lane) & 1ull;
                const unsigned myG = baseG[q] + (unsigned)__builtin_popcountll(bg[q] & lt), myE = baseE[q] + (unsigned)__builtin_popcountll(be_[q] & lt);
                int sl = -1;
                if (g) sl = (int)myG; else if (eq && myE < need) sl = (int)(totG + myE);
                const int R = sl >= 0 ? slot0 + sl : -1;
                INV[(size_t)(tokrow0 + i) * 16 + e] = R;
                if (sl >= 0) { TOPW[R] = v[q]; lst[sl] = i; }
            } }
        __syncthreads();
        for (int sidx = wave; sidx < C; sidx += 8) { const int i = lst[sidx];
            const u32x4* src = (const u32x4*)(HB + (size_t)(tokrow0 + i) * D); u32x4* dst = (u32x4*)(XS + (size_t)(slot0 + sidx) * D);
            const u32x4 a = src[lane], bq = src[lane + 64]; dst[lane] = a; dst[lane + 64] = bq; }
        __syncthreads();
    }
}

__device__ __forceinline__ void phase_gateup(Frame& F, int layer) {
    const int RPE = layer == DEPTH - 1 ? 2048 : 2304;
    SchedGrid S{NE * RPE / 256, 4096 / 256, F.G, (int)blockIdx.x, (const char*)(F.ws + WS_XS), (const char*)(F.ws + WS_WGU), (size_t)256 * D * 2, (size_t)256 * D * 2, RPE / 256, WGU_E};
    EpiGU E{(bf16*)(F.ws + WS_HID)};
    pg8::gemm_phase(F.lds, F.tid, D, S, E);
}
__device__ __forceinline__ void phase_down(Frame& F, int layer) {
    const int RPE = layer == DEPTH - 1 ? 2048 : 2304;
    SchedGrid S{NE * RPE / 256, D / 256, F.G, (int)blockIdx.x, (const char*)(F.ws + WS_HID), (const char*)(F.ws + WS_WD), (size_t)256 * EH * 2, (size_t)256 * EH * 2, RPE / 256, WD_E};
    EpiDown E{(bf16*)(F.ws + WS_YE), (const float*)(F.ws + WS_TOPW)};
    pg8::gemm_phase(F.lds, F.tid, EH, S, E);
}

constexpr int NPHASE = 1 + 10 * DEPTH + 1;
__global__ void __launch_bounds__(512, 2) mk_fwd(Args args) {
    extern __shared__ __attribute__((aligned(16))) unsigned char lds_raw[];
    Frame F;
    F.lds = (LAS unsigned char*)lds_raw; F.MISC = (volatile LAS unsigned*)(F.lds + MISC_OFF);
    F.tid = threadIdx.x; F.lane = F.tid & 63; F.wave = __builtin_amdgcn_readfirstlane(F.tid >> 6);
    F.G = gridDim.x; { const int bx = blockIdx.x; F.vcu = (F.G % 8 == 0) ? (bx % 8) * (F.G / 8) + bx / 8 : bx; }
    F.ws = args.ws; F.ctl = (unsigned*)(args.ws + WS_CTL); F.out = args.out;
    for (int u = F.tid; u < (LDS_BYTES - LDSCTL_OFF) / 4; u += 512) ((LAS unsigned*)(F.lds + LDSCTL_OFF))[u] = 0u;
    __syncthreads();
    XcdBarrier bar; bar.bar = F.ctl + CW_BAR; bar.x = 0; bar.st = nullptr;
    const bool multi = (args.ph_hi - args.ph_lo) > 1;
    if (multi) bar = xcd_barrier_post(F.ctl + CW_BAR, F.MISC + 8);
    for (int ph = args.ph_lo; ph < args.ph_hi; ++ph) {
        const int layer = (ph - 1) / 10, k = (ph == 0) ? 10 : (ph == NPHASE - 1) ? 12 : (ph - 1) % 10;
        int reps = 1 + ((PROBE_MASK >> k) & 1);
        if (k == 0 && layer > 0 && (PROBE_MASK & 2048)) reps = 2;
        for (int rep = 0; rep < reps; ++rep) {
            { unsigned long long w = (unsigned long long)args.ws; asm volatile("" : "+s"(w)); F.ws = (unsigned char*)w; F.ctl = (unsigned*)(F.ws + WS_CTL); }
            { unsigned long long kp = (unsigned long long)__builtin_amdgcn_kernarg_segment_ptr(); asm volatile("" : "+s"(kp)); F.karg = (const void __attribute__((address_space(4)))*)kp; }
            { int l = (int)__builtin_amdgcn_mbcnt_hi(~0u, __builtin_amdgcn_mbcnt_lo(~0u, 0u)); asm volatile("" : "+v"(l)); F.lane = l; F.tid = F.wave * 64 + l; }
#ifdef ONLY_PHASE
            if (k != ONLY_PHASE) continue;
#endif
            switch (k) {
                case 10: phase_prologue(F); break;
                case 12: phase_norm(F, DEPTH); break;
                case 0: if (rep == 0) phase_norm(F, layer); if (layer > 0) convert_expert_weights(F, layer); break;
                case 1: phase_inproj(F, layer); break;
                case 2: phase_retstate(F, layer); break;
                case 3: phase_mixers(F, layer, rep); break;
                case 4: phase_merge(F, layer); break;
                case 5: if (rep == 0) phase_outproj(F, layer); break;
                case 6: phase_norm2(F, layer); break;
                case 7: phase_topk(F, layer); break;
                case 8: phase_gateup(F, layer); break;
                default: phase_down(F, layer); break;
            }
            if (rep + 1 < reps || ph + 1 < args.ph_hi) xcd_barrier(bar);
        }
    }
}

extern "C" void kernel_launch(void* const* d_in, const int* in_sizes, int n_in, void* d_out, int out_size, void* d_ws, size_t ws_size, hipStream_t stream) {
    static int grid = 0;
    if (grid == 0) {
        if (n_in != 21 || out_size != TL * D || ws_size < WS_END) { fprintf(stderr, "kernel_launch: unexpected shapes (n_in %d, out %d, ws %zu need %zu)\n", n_in, out_size, ws_size, (size_t)WS_END); grid = -1; return; }
        int dev = 0, cus = 0, per_cu = 0;
        if (hipGetDevice(&dev) != hipSuccess || hipDeviceGetAttribute(&cus, hipDeviceAttributeMultiprocessorCount, dev) != hipSuccess) { grid = -1; return; }
        if (hipFuncSetAttribute((const void*)mk_fwd, hipFuncAttributeMaxDynamicSharedMemorySize, LDS_BYTES) != hipSuccess) { fprintf(stderr, "kernel_launch: hipFuncSetAttribute failed\n"); grid = -1; return; }
        if (hipOccupancyMaxActiveBlocksPerMultiprocessor(&per_cu, (const void*)mk_fwd, 512, LDS_BYTES) != hipSuccess || per_cu < 1) { fprintf(stderr, "kernel_launch: occupancy query says %d\n", per_cu); per_cu = 1; }
        (void)hipGetLastError();
        grid = cus * (per_cu >= 1 ? 1 : 1);
        if (grid % 8 != 0 || grid <= NDFT_CU) fprintf(stderr, "kernel_launch: unusual grid %d\n", grid);
    }
    if (grid < 0) return;
    (void)hipMemsetAsync((char*)d_ws + WS_CTL, 0, CTL_BYTES, stream);
    Args a{};
    for (int i = 0; i < 21; ++i) a.in[i] = (const float*)d_in[i];
    a.out = (float*)d_out; a.ws = (unsigned char*)d_ws;
#if MK_MULTI_LAUNCH
    for (int ph = 0; ph < NPHASE; ++ph) { a.ph_lo = ph; a.ph_hi = ph + 1; hipLaunchKernelGGL(mk_fwd, dim3(grid), dim3(512), LDS_BYTES, stream, a); }
#else
    a.ph_lo = 0; a.ph_hi = NPHASE;
    void* kargs[] = {&a};
    hipError_t e = hipLaunchCooperativeKernel((const void*)mk_fwd, dim3(grid), dim3(512), kargs, LDS_BYTES, stream);
    if (e != hipSuccess) fprintf(stderr, "kernel_launch: cooperative launch failed: %s (grid %d)\n", hipGetErrorString(e), grid);
#endif
}
```

```cpp
#include <hip/hip_runtime.h>
#include <cstdio>
#include <cstdint>

#ifndef PROBE_MASK
#define PROBE_MASK 0
#endif
#ifndef MK_MULTI_LAUNCH
#define MK_MULTI_LAUNCH 0
#endif

#define GAS __attribute__((address_space(1)))
#define LAS __attribute__((address_space(3)))
typedef unsigned short bf16;
typedef short bf16x8 __attribute__((ext_vector_type(8)));
typedef short s16x4 __attribute__((ext_vector_type(4)));
typedef float f32x4 __attribute__((ext_vector_type(4)));
typedef float f32x16 __attribute__((ext_vector_type(16)));
typedef unsigned u32x4 __attribute__((ext_vector_type(4)));
typedef unsigned u32x2 __attribute__((ext_vector_type(2)));
typedef float f32x2_t __attribute__((ext_vector_type(2)));
typedef __bf16 bf16x2_t __attribute__((ext_vector_type(2)));

constexpr int D = 1024, NB = 8, SEQ = 2048, CTX = 256, DEPTH = 2, GRIDW = 64;
constexpr int TC = NB * CTX, TL = NB * SEQ, TA = TC + TL;
constexpr int NPROJ = 6144;
constexpr int C_RQ = 0, C_RK = 256, C_RV = 512, C_RG = 1024, C_DQ = 1536, C_DK = 2048, C_DV = 2560, C_GATE = 3072;
constexpr int INW = 6656;
constexpr int NE = 16, EH = 2048;
constexpr float EPS = 1e-6f;
constexpr float LOG2E = 1.4426950408889634f;

constexpr size_t al(size_t x) { return (x + 0xFFFFFull) & ~0xFFFFFull; }
constexpr size_t WS_CTL = 0, CTL_BYTES = 1u << 20;
constexpr size_t WS_MOD = WS_CTL + CTL_BYTES;
constexpr size_t WS_ROPE = WS_MOD + al((size_t)DEPTH * 9 * 6 * D * 4);
constexpr size_t WS_AFF = WS_ROPE + al((size_t)2 * SEQ * 32 * 4);
constexpr size_t WS_INV = WS_AFF + al((size_t)TA * 16 * 4);
constexpr size_t WS_TOPW = WS_INV + al((size_t)TA * 16 * 4);
constexpr size_t WS_WIN = WS_TOPW + al((size_t)36864 * 4);
constexpr size_t WIN_L = (size_t)7168 * 1024 * 2;
constexpr size_t WS_WFO = WS_WIN + al(2 * WIN_L);
constexpr size_t WMG_ONE = (size_t)1024 * 512 * 2;
constexpr size_t WS_WOUT = WS_WFO + al(6 * WMG_ONE);
constexpr size_t WOUT_L = (size_t)1024 * 1024 * 2;
constexpr size_t WS_WGU = WS_WOUT + al(2 * WOUT_L);
constexpr size_t WGU_E = (size_t)4096 * 1024 * 2;
constexpr size_t WS_WD = WS_WGU + al(16 * WGU_E);
constexpr size_t WD_E = (size_t)1024 * 2048 * 2;
constexpr size_t WS_DFTL = WS_WD + al(16 * WD_E);
constexpr size_t WS_DFTC = WS_DFTL + al((size_t)2048 * 4096 * 2);
constexpr size_t WS_XR = WS_DFTC + al((size_t)256 * 512 * 2);
constexpr size_t WS_HB = WS_XR + al((size_t)TA * D * 4);
constexpr size_t WS_PROJ = WS_HB + al((size_t)TA * D * 2);
constexpr size_t WS_GT = WS_PROJ + al((size_t)TA * NPROJ * 2);
constexpr size_t WS_GTC = WS_GT + al((size_t)4096 * 4096 * 2);
constexpr size_t WS_FO = WS_GTC + al((size_t)4096 * 512 * 2);
constexpr size_t MIX_ONE = (size_t)TA * 512 * 2;
constexpr size_t WS_MIXB = WS_FO + al(3 * MIX_ONE);
constexpr size_t WS_XS = WS_MIXB + al((size_t)TA * D * 2);
constexpr size_t WS_LBUF = WS_XS + al((size_t)36864 * D * 2);
constexpr size_t LBUF_ONE = (size_t)64 * 128 * 4;
constexpr size_t WS_END = WS_LBUF + al((size_t)32 * 9 * 2 * LBUF_ONE);
constexpr size_t WS_HID = WS_PROJ;
constexpr size_t WS_YE = WS_XS;
static_assert((size_t)36864 * EH * 2 <= (size_t)TA * NPROJ * 2, "HID overlays PROJ");
static_assert(WS_END <= (size_t)1024 * 1024 * 1024, "workspace map must fit 1 GiB");

constexpr int CW_BAR = 4096;
constexpr int CW_QUEUE = 16384;

constexpr int RING_BYTES = 131072;
constexpr int LDSCTL_OFF = RING_BYTES, MISC_OFF = LDSCTL_OFF + 320;
constexpr int LDS_BYTES = 147456;

#define RLX_AGENT __ATOMIC_RELAXED, __HIP_MEMORY_SCOPE_AGENT
#define LDS_WAIT() asm volatile("s_waitcnt lgkmcnt(0)" ::: "memory")
#define VM_WAIT() asm volatile("s_waitcnt vmcnt(0)" ::: "memory")
__device__ __forceinline__ unsigned f2bf(float f) { unsigned u = __builtin_bit_cast(unsigned, f); return (u + 0x7fffu + ((u >> 16) & 1u)) >> 16; }
__device__ __forceinline__ unsigned pk2(float lo, float hi) { f32x2_t v = {lo, hi}; bf16x2_t b = __builtin_convertvector(v, bf16x2_t); return __builtin_bit_cast(unsigned, b); }
__device__ __forceinline__ float bflo(unsigned w) { return __builtin_bit_cast(float, w << 16); }
__device__ __forceinline__ float bfhi(unsigned w) { return __builtin_bit_cast(float, w & 0xffff0000u); }
__device__ __forceinline__ float bf2f(bf16 h) { return __builtin_bit_cast(float, (unsigned)h << 16); }
__device__ __forceinline__ float wave_sum(float v) {
#pragma unroll
    for (int o = 1; o < 64; o <<= 1) v += __shfl_xor(v, o);
    return v;
}
__device__ __forceinline__ float sigmoidf_(float x) { return __builtin_amdgcn_rcpf(1.0f + __builtin_amdgcn_exp2f(-x * LOG2E)); }
__device__ __forceinline__ float siluf_(float x) { return x * sigmoidf_(x); }

namespace pg8 {
constexpr int BM = 256, BK = 64, HALF = 128, HTB = HALF * BK * 2, STAGE_BYTES = 8 * HTB, NXCD = 8, WGM = 8;
__host__ __device__ __forceinline__ int lds_byte(int r, int c) { const int st = (r >> 4) * 2 + (c >> 5), rr = r & 15, cc = c & 31, ob = rr * 64 + cc * 2; return st * 1024 + (ob ^ (((ob >> 9) & 1) << 5)); }
__host__ __device__ __forceinline__ void stage_rc(int b, int& R, int& C) { const int st = b / 1024, sb = b % 1024, swz = sb ^ (((sb >> 9) & 1) << 5); R = (st >> 1) * 16 + swz / 64; C = (st & 1) * 32 + (swz % 64) / 2; }
__host__ __device__ __forceinline__ int perm32(int rho) { const int n = rho >> 4, i = rho & 15; return 8 * (i >> 2) + 4 * n + (i & 3); }

struct Unit { int pm, pn, tag; const char* A; const char* B; };

__device__ __forceinline__ bool grid_order(long L, int nM, int nN, int& pm, int& pn) {
    const int nwg = nM * nN; if (L >= nwg) return false;
    int wgid = (int)L; { const int q = nwg / NXCD, r = nwg % NXCD, xcd = wgid % NXCD, off = wgid / NXCD; wgid = (xcd < r ? xcd * (q + 1) : r * (q + 1) + (xcd - r) * q) + off; }
    const int nig = WGM * nN, gid = wgid / nig, fm = gid * WGM, gsz = (nM - fm) < WGM ? (nM - fm) : WGM;
    pm = fm + ((wgid % nig) % gsz); pn = (wgid % nig) / gsz; return true;
}

typedef f32x4 Acc[2][2][4][2];
__device__ __forceinline__ void zero_acc(Acc& acc) {
#pragma unroll
    for (int a = 0; a < 2; ++a)
#pragma unroll
        for (int b = 0; b < 2; ++b)
#pragma unroll
            for (int m = 0; m < 4; ++m)
#pragma unroll
                for (int n = 0; n < 2; ++n) acc[a][b][m][n] = (f32x4){0.f, 0.f, 0.f, 0.f};
}

template <class Epi, class Sched>
__device__ __forceinline__ void gemm_phase(LAS unsigned char* lds, const int tid, const int K, const Sched& S, const Epi& E) {
    const int wid = __builtin_amdgcn_readfirstlane(tid >> 6), lane = tid & 63, wr = wid >> 2, wc = wid & 3, fr = lane & 15, fq = lane >> 4;
    const int nt = K / BK;
    unsigned voffA[2], voffB[2];
#pragma unroll
    for (int i = 0; i < 2; ++i) { int R, C; stage_rc(tid * 16 + i * 8192, R, C); const int Rb = Epi::PERM ? ((R & ~31) + perm32(R & 31)) : R;
        voffA[i] = (unsigned)(R * K + C) * 2u; voffB[i] = (unsigned)(Rb * K + C) * 2u; }
    const size_t kstep = (size_t)(BK * 2);
    const size_t hstep = (size_t)HALF * K * 2;
    const unsigned ldsw = (unsigned)wid * 1024u;
    const int aoff = lds_byte(wr * 64 + fr, fq * 8), boff = lds_byte(wc * 32 + fr, fq * 8);
#define PG8_SA(b, h) (((b) * 2 + (h)) * HTB)
#define PG8_SB(b, h) ((4 + (b) * 2 + (h)) * HTB)
#define PG8_STAGE(bufoff, gbase, voff) do { _Pragma("unroll") for (int _i = 0; _i < 2; ++_i) \
        __builtin_amdgcn_global_load_lds((const unsigned*)((const char*)(gbase) + (voff)[_i]), (LAS unsigned*)(lds + (bufoff) + ldsw + _i * 8192), 16, 0, 0); } while (0)
#define PG8_LDA(dst, b, h) do { _Pragma("unroll") for (int m = 0; m < 4; ++m) _Pragma("unroll") for (int k = 0; k < 2; ++k) dst[m][k] = *(const LAS bf16x8*)(lds + PG8_SA(b, h) + aoff + m * 2048 + k * 1024); } while (0)
#define PG8_LDB(dst, b, h) do { _Pragma("unroll") for (int n = 0; n < 2; ++n) _Pragma("unroll") for (int k = 0; k < 2; ++k) dst[n][k] = *(const LAS bf16x8*)(lds + PG8_SB(b, h) + boff + n * 2048 + k * 1024); } while (0)
#define PG8_MMA(ai, bj, At, Bt) do { __builtin_amdgcn_s_setprio(1); _Pragma("unroll") for (int m = 0; m < 4; ++m) _Pragma("unroll") for (int n = 0; n < 2; ++n) _Pragma("unroll") for (int k = 0; k < 2; ++k) \
        acc[ai][bj][m][n] = __builtin_amdgcn_mfma_f32_16x16x32_bf16(Bt[n][k], At[m][k], acc[ai][bj][m][n], 0, 0, 0); __builtin_amdgcn_s_setprio(0); } while (0)
#define PG8_WAIT_V(n) asm volatile("s_waitcnt vmcnt(" #n ")" ::: "memory")
#define PG8_WAIT_L(n) asm volatile("s_waitcnt lgkmcnt(" #n ")" ::: "memory")
#define PG8_BAR __builtin_amdgcn_s_barrier()
#define PG8_SCHED __builtin_amdgcn_sched_barrier(0)
    Unit cur, nxt; int ui = 0;
    if (!S.next(0, cur)) return;
    Acc acc; zero_acc(acc);
    bf16x8 At[4][2], B0[2][2], B1[2][2];
    const char* cA = cur.A; const char* cB = cur.B;
    PG8_STAGE(PG8_SB(0, 0), cB, voffB); PG8_STAGE(PG8_SB(0, 1), cB + hstep, voffB); PG8_STAGE(PG8_SA(0, 0), cA, voffA); PG8_STAGE(PG8_SA(0, 1), cA + hstep, voffA);
    if (wr == 1) PG8_BAR;
    PG8_WAIT_V(2); PG8_BAR;
    PG8_STAGE(PG8_SB(1, 0), cB + kstep, voffB); PG8_STAGE(PG8_SA(1, 0), cA + kstep, voffA); PG8_STAGE(PG8_SB(1, 1), cB + hstep + kstep, voffB);
    PG8_WAIT_V(6); PG8_BAR;
    for (;;) {
        const bool has_next = S.next(ui + 1, nxt);
        const char* nA = has_next ? nxt.A : cA; const char* nB = has_next ? nxt.B : cB;
        for (int t = 0; t < nt; t += 2) {
            const bool last = (t == nt - 2);
            const char* a1 = cA + (size_t)(t + 1) * kstep;
            const char* a2 = last ? nA : cA + (size_t)(t + 2) * kstep; const char* b2 = last ? nB : cB + (size_t)(t + 2) * kstep;
            const char* a3 = a2 + kstep; const char* b3 = b2 + kstep;
            PG8_LDB(B0, 0, 0); PG8_LDB(B1, 0, 1); PG8_SCHED; PG8_LDA(At, 0, 0); PG8_STAGE(PG8_SA(1, 1), a1 + hstep, voffA);
            PG8_WAIT_V(8); PG8_WAIT_L(0); PG8_BAR; PG8_MMA(0, 0, At, B0); PG8_MMA(0, 1, At, B1); PG8_BAR; PG8_SCHED;
            PG8_LDA(At, 0, 1); PG8_STAGE(PG8_SB(0, 0), b2, voffB); PG8_STAGE(PG8_SB(0, 1), b2 + hstep, voffB); PG8_STAGE(PG8_SA(0, 0), a2, voffA);
            PG8_WAIT_V(8); PG8_WAIT_L(0); PG8_BAR; PG8_MMA(1, 0, At, B0); PG8_MMA(1, 1, At, B1); PG8_BAR; PG8_SCHED;
            PG8_LDB(B0, 1, 0); PG8_LDB(B1, 1, 1); PG8_SCHED; PG8_LDA(At, 1, 0); PG8_STAGE(PG8_SA(0, 1), a2 + hstep, voffA);
            PG8_WAIT_V(8); PG8_WAIT_L(0); PG8_BAR; PG8_MMA(0, 0, At, B0); PG8_MMA(0, 1, At, B1); PG8_BAR; PG8_SCHED;
            PG8_LDA(At, 1, 1); PG8_STAGE(PG8_SB(1, 0), b3, voffB); PG8_STAGE(PG8_SB(1, 1), b3 + hstep, voffB); PG8_STAGE(PG8_SA(1, 0), a3, voffA);
            PG8_WAIT_V(8); PG8_WAIT_L(0); PG8_BAR; PG8_MMA(1, 0, At, B0); PG8_MMA(1, 1, At, B1); PG8_BAR; PG8_SCHED;
        }
        if (wr == 0) PG8_BAR;
        E(acc, cur, wr, wc, fr, fq);
        if (!has_next) break;
        cur = nxt; cA = nA; cB = nB; ++ui;
        if (wr == 1) PG8_BAR;
    }
    PG8_WAIT_V(0);
    PG8_BAR;
#undef PG8_SA
#undef PG8_SB
#undef PG8_STAGE
#undef PG8_LDA
#undef PG8_LDB
#undef PG8_MMA
#undef PG8_WAIT_V
#undef PG8_WAIT_L
#undef PG8_BAR
#undef PG8_SCHED
}
}

#define XB_TMO      128
#define XB_XCNT(j)  (256  + 64 * (j))
#define XB_XSUB(j)  (1280 + 64 * (j))
#define XB_XGEN(j)  (2304 + 64 * (j))
#define XB_TOP      3328
#define XB_TOPGEN   3392
#define XCD_BAR_WORDS 3456
#define XB_SPIN_CAP (1u << 22)
__device__ __forceinline__ unsigned xb_ld(unsigned* p)              { return __hip_atomic_load(p, __ATOMIC_RELAXED, __HIP_MEMORY_SCOPE_AGENT); }
__device__ __forceinline__ unsigned xb_add(unsigned* p, unsigned v) { return __hip_atomic_fetch_add(p, v, __ATOMIC_RELAXED, __HIP_MEMORY_SCOPE_AGENT); }
__device__ __forceinline__ unsigned xb_xcc_id() { return (unsigned)__builtin_amdgcn_s_getreg((3 << 11) | 20) & 0xFu; }
#define XB_SPIN(cond, bar) do { unsigned _sp = 0; while (cond) { __builtin_amdgcn_s_sleep(1); \
    if ((++_sp & 255u) == 0u) { if (xb_ld(&(bar)[XB_TMO])) break; if (_sp > XB_SPIN_CAP) { atomicAdd(&(bar)[XB_TMO], 1u); break; } } } } while (0)
struct XcdBarrier { unsigned* bar; unsigned x; volatile LAS unsigned* st; };
__device__ __forceinline__ XcdBarrier xcd_barrier_post(unsigned* bar, volatile LAS unsigned* st) {
    XcdBarrier b; b.bar = bar; b.x = xb_xcc_id(); b.st = st;
    if (threadIdx.x == 0) (void)xb_add(&bar[XB_XCNT(b.x)], 1u);
    return b;
}
__device__ __forceinline__ void xcd_barrier_complete(unsigned* bar, unsigned x, unsigned& nloc, unsigned& nx) {
    const unsigned G = gridDim.x * gridDim.y * gridDim.z;
    unsigned sum, cnt, mine, sp = 0u;
    for (;;) {
        sum = 0u; cnt = 0u; mine = 0u;
#pragma unroll
        for (unsigned j = 0; j < 16; ++j) { const unsigned c = xb_ld(&bar[XB_XCNT(j)]); sum += c; cnt += (c > 0u) ? 1u : 0u; mine = (j == x) ? c : mine; }
        if (sum == G) break;
        __builtin_amdgcn_s_sleep(1);
        if ((++sp & 255u) == 0u) { if (xb_ld(&bar[XB_TMO])) break; if (sp > XB_SPIN_CAP) { atomicAdd(&bar[XB_TMO], 1u); break; } }
    }
    nloc = mine > 0u ? mine : 1u; nx = cnt > 0u ? cnt : 1u;
}
__device__ __forceinline__ void xcd_barrier(const XcdBarrier& b) {
    asm volatile("s_waitcnt vmcnt(0)" ::: "memory");
    __syncthreads();
    if (threadIdx.x == 0) {
        unsigned* bar = b.bar;
        __builtin_amdgcn_s_waitcnt(0);
        unsigned nloc = b.st[0], nx = b.st[1];
        if (nloc == 0u) { xcd_barrier_complete(bar, b.x, nloc, nx); b.st[0] = nloc; b.st[1] = nx; }
        const unsigned old = xb_add(&bar[XB_XSUB(b.x)], 1u);
        const unsigned gen = old / nloc;
        if (old + 1u == (gen + 1u) * nloc) {
            __builtin_amdgcn_fence(__ATOMIC_RELEASE, "agent");
            asm volatile("s_waitcnt vmcnt(0)" ::: "memory");
            const unsigned og = xb_add(&bar[XB_TOP], 1u);
            const unsigned tg = og / nx;
            if (og + 1u == (tg + 1u) * nx) xb_add(&bar[XB_TOPGEN], 1u);
            else XB_SPIN(xb_ld(&bar[XB_TOPGEN]) == tg, bar);
            __builtin_amdgcn_fence(__ATOMIC_ACQUIRE, "agent");
            xb_add(&bar[XB_XGEN(b.x)], 1u);
            asm volatile("s_waitcnt vmcnt(0)" ::: "memory");
        } else {
            XB_SPIN(xb_ld(&bar[XB_XGEN(b.x)]) == gen, bar);
            __builtin_amdgcn_fence(__ATOMIC_ACQUIRE, "agent");
            asm volatile("s_waitcnt vmcnt(0)" ::: "memory");
        }
    }
    __syncthreads();
}

struct Args { const float* in[21]; float* out; unsigned char* ws; int ph_lo, ph_hi; };
struct Frame {
    LAS unsigned char* lds; volatile LAS unsigned* MISC; unsigned* ctl;
    int tid, lane, wave, vcu, G;
    const void __attribute__((address_space(4)))* karg; float* out; unsigned char* ws;
};
__device__ __forceinline__ const float* inp(const Frame& F, int i) { const unsigned long long p = ((const unsigned long long __attribute__((address_space(4)))*)F.karg)[i]; return (const float*)(const GAS float*)p; }
#define IN_X 0
#define IN_C 1
#define IN_CTX 2
#define IN_CCTX 3
#define IN_WMOD 4
#define IN_BMOD 5
#define IN_GATTN 6
#define IN_GFFN 7
#define IN_WIN 8
#define IN_RDEC 9
#define IN_QN 10
#define IN_KN 11
#define IN_LAMBDA 12
#define IN_WFO 13
#define IN_WRO 14
#define IN_WDO 15
#define IN_WOUT 16
#define IN_WROUTER 17
#define IN_WEG 18
#define IN_WEU 19
#define IN_WED 20

__device__ __forceinline__ int vec_of_row(int r) { return r < TC ? 8 : (r - TC) / SEQ; }
__device__ __forceinline__ const float* mod_ptr(const Frame& F, int layer, int v, int i) { return (const float*)(F.ws + WS_MOD) + ((size_t)(layer * 9 + v) * 6 + i) * D; }
__device__ __forceinline__ float lam_init_of(int layer) { return layer == 0 ? 0.2f : 0.8f - 0.6f * 0.74081822068171788f; }
__device__ __forceinline__ float lam_of(const Frame& F, int layer) {
    const float* L = inp(F, IN_LAMBDA) + (size_t)layer * 4 * 64; float s1 = 0.f, s2 = 0.f;
    for (int i = 0; i < 64; ++i) { s1 += L[i] * L[64 + i]; s2 += L[128 + i] * L[192 + i]; }
    return __expf(s1) - __expf(s2) + lam_init_of(layer);
}

__device__ __forceinline__ void transpose_item(const float* W, int ldw, int K, int k0, int n0src, bf16* WT, int dst_row0, LAS float* scr, int lane) {
#pragma unroll 8
    for (int i = 0; i < 32; ++i) { const int kk = 2 * i + (lane >> 5); scr[kk * 33 + (lane & 31)] = W[(size_t)(k0 + kk) * ldw + n0src + (lane & 31)]; }
    LDS_WAIT(); asm volatile("" ::: "memory");
    const int c = lane & 7;
#pragma unroll
    for (int j = 0; j < 4; ++j) { const int n = (lane >> 3) + 8 * j; const LAS float* s = scr + (8 * c) * 33 + n;
        u32x4 o; o.x = pk2(s[0 * 33], s[1 * 33]); o.y = pk2(s[2 * 33], s[3 * 33]); o.z = pk2(s[4 * 33], s[5 * 33]); o.w = pk2(s[6 * 33], s[7 * 33]);
        *(u32x4*)(WT + (size_t)(dst_row0 + n) * K + k0 + 8 * c) = o; }
    LDS_WAIT(); asm volatile("" ::: "memory");
}
template <class RowMap>
__device__ __forceinline__ void transpose_matrix(Frame& F, const float* W, int ldw, int csrc, int K, int N, bf16* WT, RowMap map, int& item_base) {
    LAS float* scr = (LAS float*)(F.lds + F.wave * 16384);
    const int gw = F.vcu * 8 + F.wave, NGW = F.G * 8;
    const int nblk = N / 32, nitems = (K / 64) * nblk;
    int start = (gw - item_base % NGW + NGW) % NGW;
    for (int it = start; it < nitems; it += NGW) { const int kb = it / nblk, nb = it % nblk; transpose_item(W, ldw, K, 64 * kb, csrc + 32 * nb, WT, map(32 * nb), scr, F.lane); }
    item_base += nitems;
}
struct MapId { int off; __device__ int operator()(int n) const { return off + n; } };
struct MapProj { __device__ int operator()(int n) const { const int tile = n >> 8; const bool qk = tile < 2 || (tile >= 6 && tile < 10); return qk ? (tile << 8) + 128 * ((n >> 5) & 1) + 32 * ((n >> 6) & 3) + (n & 31) : n; } };
struct MapGU { int up; __device__ int operator()(int n) const { return (n >> 7) * 256 + up * 128 + (n & 127); } };

__device__ __forceinline__ void convert_expert_weights(Frame& F, int layer) {
    int base = 0;
    for (int e = 0; e < NE; ++e) {
        const float* wg = inp(F, IN_WEG) + ((size_t)layer * NE + e) * D * EH; const float* wu = inp(F, IN_WEU) + ((size_t)layer * NE + e) * D * EH; const float* wd = inp(F, IN_WED) + ((size_t)layer * NE + e) * EH * D;
        bf16* gu = (bf16*)(F.ws + WS_WGU + e * WGU_E); bf16* dn = (bf16*)(F.ws + WS_WD + e * WD_E);
        transpose_matrix(F, wg, EH, 0, D, EH, gu, MapGU{0}, base);
        transpose_matrix(F, wu, EH, 0, D, EH, gu, MapGU{1}, base);
        transpose_matrix(F, wd, D, 0, EH, D, dn, MapId{0}, base);
    }
}

__device__ __forceinline__ void phase_prologue(Frame& F) {
    const int tid = F.tid;
    {
        LAS float* sc = (LAS float*)F.lds;
        LAS float* red = sc + 9 * 1024;
        for (int i = tid; i < 9 * 1024; i += 512) { const int v = i >> 10, k = i & 1023; const float c = v < 8 ? inp(F, IN_C)[v * D + k] : inp(F, IN_CCTX)[k]; sc[i] = siluf_(c); }
        __syncthreads();
        for (int item = F.vcu; item < DEPTH * 96; item += F.G) {
            const int layer = item / 96, cb = item % 96, col = cb * 64 + (tid & 63), kg = tid >> 6;
            const float* w = inp(F, IN_WMOD) + (size_t)layer * D * 6144 + col;
            float a[9];
#pragma unroll
            for (int v = 0; v < 9; ++v) a[v] = 0.f;
#pragma unroll 4
            for (int kk = 0; kk < 128; ++kk) { const int k = kg * 128 + kk; const float wv = w[(size_t)k * 6144];
#pragma unroll
                for (int v = 0; v < 9; ++v) a[v] += sc[v * 1024 + k] * wv; }
#pragma unroll
            for (int v = 0; v < 9; ++v) red[(kg * 64 + (tid & 63)) * 9 + v] = a[v];
            __syncthreads();
            for (int o = tid; o < 64 * 9; o += 512) { const int cc = o / 9, v = o % 9; float s = 0.f;
                for (int g = 0; g < 8; ++g) s += red[(g * 64 + cc) * 9 + v];
                const int colo = cb * 64 + cc;
                ((float*)(F.ws + WS_MOD))[(size_t)(layer * 9 + v) * 6144 + colo] = s + inp(F, IN_BMOD)[layer * 6144 + colo]; }
            __syncthreads();
        }
    }
    {
        const int gt = F.vcu * 512 + tid, NT = F.G * 512;
        float* rc = (float*)(F.ws + WS_ROPE); float* rs = rc + SEQ * 32;
        for (int i = gt; i < SEQ * 32; i += NT) { const int pos = i >> 5, f = i & 31; const float inv = __builtin_amdgcn_exp2f(-(float)(f & 15) * (13.287712379549449f / 16.0f));
            const float p = (f < 16) ? (float)(pos / GRIDW) : (float)(pos % GRIDW); const float ang = p * inv; rc[i] = __builtin_amdgcn_cosf(ang * 0.15915494309189535f); rs[i] = __builtin_amdgcn_sinf(ang * 0.15915494309189535f); }
        LAS float* ct = (LAS float*)F.lds;
        __syncthreads();
        for (int m = tid; m < 2048; m += 512) ct[m] = __builtin_amdgcn_cosf((float)m * (1.0f / 2048.0f));
        __syncthreads();
        bf16* dl = (bf16*)(F.ws + WS_DFTL); const float sl = 0.022097086912079608f;
        for (int i = gt; i < 2048 * 2048; i += NT) {
            const int k = i >> 11, n = i & 2047, m = (k * n) & 2047; const float c = ct[m], s = ct[(m - 512) & 2047];
            dl[(size_t)k * 4096 + n] = (bf16)f2bf(c * sl); dl[(size_t)k * 4096 + 2048 + n] = (bf16)f2bf(-s * sl); }
        bf16* dc = (bf16*)(F.ws + WS_DFTC);
        for (int i = gt; i < 256 * 256; i += NT) { const int k = i >> 8, n = i & 255, m = ((k * n) & 255) * 8; const float c = ct[m], s = ct[(m - 512) & 2047];
            dc[(size_t)k * 512 + n] = (bf16)f2bf(c * 0.0625f); dc[(size_t)k * 512 + 256 + n] = (bf16)f2bf(-s * 0.0625f); }
        for (int layer = 0; layer < DEPTH; ++layer) {
            const float* win = inp(F, IN_WIN) + (size_t)layer * D * INW; bf16* wt = (bf16*)(F.ws + WS_WIN + layer * WIN_L) + (size_t)6144 * 1024;
            for (int i = gt; i < 1024 * 1024; i += NT) { const int k = i & 1023, no = i >> 10, part = no >> 9, g = (no >> 6) & 7, cp = no & 63;
                const float* src = win + (size_t)k * INW + g * 64; float s = 0.f;
                for (int c = 0; c < 64; ++c) { const int m = ((c * cp) & 63) * 32; const float t = part == 0 ? ct[m] : ct[(m - 512) & 2047]; s += src[c] * t; }
                wt[(size_t)no * 1024 + k] = (bf16)f2bf(s * 0.125f); }
        }
        __syncthreads();
    }
    {
        int base = 0;
        for (int layer = 0; layer < DEPTH; ++layer) {
            transpose_matrix(F, inp(F, IN_WIN) + (size_t)layer * D * INW, INW, 512, D, NPROJ, (bf16*)(F.ws + WS_WIN + layer * WIN_L), MapProj{}, base);
            transpose_matrix(F, inp(F, IN_WFO) + (size_t)layer * 512 * D, D, 0, 512, D, (bf16*)(F.ws + WS_WFO + (layer * 3 + 0) * WMG_ONE), MapId{0}, base);
            transpose_matrix(F, inp(F, IN_WRO) + (size_t)layer * 512 * D, D, 0, 512, D, (bf16*)(F.ws + WS_WFO + (layer * 3 + 1) * WMG_ONE), MapId{0}, base);
            transpose_matrix(F, inp(F, IN_WDO) + (size_t)layer * 512 * D, D, 0, 512, D, (bf16*)(F.ws + WS_WFO + (layer * 3 + 2) * WMG_ONE), MapId{0}, base);
            transpose_matrix(F, inp(F, IN_WOUT) + (size_t)layer * D * D, D, 0, D, D, (bf16*)(F.ws + WS_WOUT + layer * WOUT_L), MapId{0}, base);
        }
    }
    convert_expert_weights(F, 0);
}

__device__ __forceinline__ void phase_norm(Frame& F, int layer) {
    const int gw = F.vcu * 8 + F.wave, NGW = F.G * 8, lane = F.lane;
    const bool fin = layer == DEPTH; const int r_lo = (layer >= DEPTH - 1) ? (fin ? TC : 0) : 0;
    float* XR = (float*)(F.ws + WS_XR); const int* INV = (const int*)(F.ws + WS_INV); const bf16* YE = (const bf16*)(F.ws + WS_YE); bf16* HB = (bf16*)(F.ws + WS_HB);
    for (int r = r_lo + gw; r < TA; r += NGW) {
        const int v = vec_of_row(r);
        f32x4 x[4];
        if (layer == 0) { const float* src = r < TC ? inp(F, IN_CTX) + (size_t)r * D : inp(F, IN_X) + (size_t)(r - TC) * D;
#pragma unroll
            for (int j = 0; j < 4; ++j) x[j] = *(const f32x4*)(src + 4 * lane + 256 * j);
        } else {
            const float* src = XR + (size_t)r * D;
#pragma unroll
            for (int j = 0; j < 4; ++j) x[j] = *(const f32x4*)(src + 4 * lane + 256 * j);
            if (!(layer == DEPTH - 1 + 1 && false)) {
                const bool has_moe = !(layer == 1 && r < TC && false);
                if (has_moe) {
                    f32x4 s[4];
#pragma unroll
                    for (int j = 0; j < 4; ++j) s[j] = (f32x4){0.f, 0.f, 0.f, 0.f};
                    const int* inv = INV + (size_t)r * 16;
                    for (int e = 0; e < NE; ++e) { const int slot = __builtin_amdgcn_readfirstlane(inv[e]);
                        if (slot >= 0) { const bf16* y = YE + (size_t)slot * D;
#pragma unroll
                            for (int j = 0; j < 4; ++j) { const u32x2 w = *(const u32x2*)(y + 4 * lane + 256 * j); s[j] += (f32x4){bflo(w.x), bfhi(w.x), bflo(w.y), bfhi(w.y)}; } } }
                    const float* m5 = mod_ptr(F, layer - 1, v, 5);
#pragma unroll
                    for (int j = 0; j < 4; ++j) x[j] += *(const f32x4*)(m5 + 4 * lane + 256 * j) * s[j];
                }
            }
        }
        if (fin) {
#pragma unroll
            for (int j = 0; j < 4; ++j) *(f32x4*)(F.out + (size_t)(r - TC) * D + 4 * lane + 256 * j) = x[j];
            continue;
        }
        if (layer > 0) {
#pragma unroll
            for (int j = 0; j < 4; ++j) *(f32x4*)(XR + (size_t)r * D + 4 * lane + 256 * j) = x[j];
        }
        float ss = 0.f;
#pragma unroll
        for (int j = 0; j < 4; ++j) ss += (x[j].x * x[j].x + x[j].y * x[j].y) + (x[j].z * x[j].z + x[j].w * x[j].w);
        const float rinv = __builtin_amdgcn_rsqf(wave_sum(ss) * (1.0f / D) + EPS);
        const float* g = inp(F, IN_GATTN) + (size_t)layer * D; const float* sh = mod_ptr(F, layer, v, 0); const float* scl = mod_ptr(F, layer, v, 1);
#pragma unroll
        for (int j = 0; j < 4; ++j) { const int k = 4 * lane + 256 * j; const f32x4 gv = *(const f32x4*)(g + k), sv = *(const f32x4*)(sh + k), cv = *(const f32x4*)(scl + k);
            const f32x4 y = (x[j] * rinv * gv) * (cv + 1.0f) + sv;
            u32x2 w; w.x = pk2(y.x, y.y); w.y = pk2(y.z, y.w); *(u32x2*)(HB + (size_t)r * D + k) = w; }
    }
}

using pg8::Unit; using pg8::Acc;
struct SchedGrid {
    int nM, nN, G, c; const char* A; const char* B; size_t a_tile, b_tile; int pm_per_group; size_t b_group;
    __device__ __forceinline__ bool next(int i, Unit& u) const {
        int pm, pn; if (c < 0 || !pg8::grid_order((long)i * G + c, nM, nN, pm, pn)) return false;
        u.pm = pm; u.pn = pn; u.tag = 0; u.A = A + (size_t)pm * a_tile; u.B = B + (size_t)pn * b_tile + (pm_per_group ? (size_t)(pm / pm_per_group) * b_group : 0); return true; }
};
struct SchedMerge {
    int nM, nN, G, c; const char* A; const char* B; size_t a_seg, b_seg, a_tile, b_tile;
    __device__ __forceinline__ bool next(int i, Unit& u) const {
        const int t = i / 3, seg = i - 3 * t; int pm, pn; if (!pg8::grid_order((long)t * G + c, nM, nN, pm, pn)) return false;
        u.pm = pm; u.pn = pn; u.tag = seg; u.A = A + (size_t)seg * a_seg + (size_t)pm * a_tile; u.B = B + (size_t)seg * b_seg + (size_t)pn * b_tile; return true; }
};

struct EpiBf16 {
    static constexpr bool PERM = true;
    bf16* C; int ldc; int sig_pn0;
    __device__ __forceinline__ void operator()(Acc& acc, const Unit& u, int wr, int wc, int fr, int fq) const {
        const int row0 = u.pm * 256 + wr * 64 + fr, col0 = u.pn * 256 + wc * 32 + 8 * fq;
        const bool sig = u.pn >= sig_pn0;
#pragma unroll
        for (int ai = 0; ai < 2; ++ai)
#pragma unroll
            for (int m = 0; m < 4; ++m) { bf16* rowp = C + (size_t)(row0 + ai * 128 + m * 16) * ldc + col0;
#pragma unroll
                for (int bj = 0; bj < 2; ++bj) { f32x4 v0 = acc[ai][bj][m][0], v1 = acc[ai][bj][m][1];
                    if (sig) {
#pragma unroll
                        for (int j = 0; j < 4; ++j) { v0[j] = sigmoidf_(v0[j]); v1[j] = sigmoidf_(v1[j]); } }
                    u32x4 w; w.x = pk2(v0[0], v0[1]); w.y = pk2(v0[2], v0[3]); w.z = pk2(v1[0], v1[1]); w.w = pk2(v1[2], v1[3]);
                    *(u32x4*)(rowp + bj * 128) = w; } }
        pg8::zero_acc(acc);
    }
};
struct EpiGT {
    static constexpr bool PERM = true;
    bf16* GT; bf16* GTC;
    __device__ __forceinline__ void operator()(Acc& acc, const Unit& u, int wr, int wc, int fr, int fq) const {
        const int tok0 = u.pn * 256;
        bf16* base; int pitch, nseq, n0;
        if (tok0 < TC) { const int b = tok0 / CTX; base = GTC + (size_t)b * 512 * 512; pitch = 512; nseq = CTX; n0 = tok0 - b * CTX; }
        else { const int t = tok0 - TC, b = t / SEQ; base = GT + (size_t)b * 512 * 4096; pitch = 4096; nseq = SEQ; n0 = t - b * SEQ; }
        const int crow0 = u.pm * 256 + wr * 64 + fr, ccol0 = wc * 32 + 8 * fq;
#pragma unroll
        for (int ai = 0; ai < 2; ++ai)
#pragma unroll
            for (int m = 0; m < 4; ++m) { const int c = crow0 + ai * 128 + m * 16, part = c >> 9, ch = c & 511;
                bf16* rowp = base + (size_t)ch * pitch + part * nseq + n0 + ccol0;
#pragma unroll
                for (int bj = 0; bj < 2; ++bj) { const f32x4 v0 = acc[ai][bj][m][0], v1 = acc[ai][bj][m][1];
                    u32x4 w; w.x = pk2(v0[0], v0[1]); w.y = pk2(v0[2], v0[3]); w.z = pk2(v1[0], v1[1]); w.w = pk2(v1[2], v1[3]);
                    *(u32x4*)(rowp + bj * 128) = w; } }
        pg8::zero_acc(acc);
    }
};
struct EpiDFT {
    static constexpr bool PERM = true;
    bf16* FO; int nseq; int row_base0;
    __device__ __forceinline__ void operator()(Acc& acc, const Unit& u, int wr, int wc, int fr, int fq) const {
        const int k0 = u.pm * 256 + wr * 64 + fr, b = (u.pn * 256) >> 9, ch0 = ((u.pn * 256) & 511) + wc * 32 + 8 * fq;
        bf16* base = FO + (size_t)(row_base0 + b * nseq + k0) * 512 + ch0;
#pragma unroll
        for (int ai = 0; ai < 2; ++ai)
#pragma unroll
            for (int m = 0; m < 4; ++m) { bf16* rowp = base + (size_t)(ai * 128 + m * 16) * 512;
#pragma unroll
                for (int bj = 0; bj < 2; ++bj) { const f32x4 v0 = acc[ai][bj][m][0], v1 = acc[ai][bj][m][1];
                    u32x4 w; w.x = pk2(v0[0], v0[1]); w.y = pk2(v0[2], v0[3]); w.z = pk2(v1[0], v1[1]); w.w = pk2(v1[2], v1[3]);
                    *(u32x4*)(rowp + bj * 128) = w; } }
        pg8::zero_acc(acc);
    }
};
struct EpiMerge {
    static constexpr bool PERM = true;
    const bf16* PROJ; bf16* MIXB; int row_off;
    __device__ __forceinline__ void operator()(Acc& acc, const Unit& u, int wr, int wc, int fr, int fq) const {
        const int row0 = row_off + u.pm * 256 + wr * 64 + fr, col0 = u.pn * 256 + wc * 32 + 8 * fq, seg = u.tag;
#pragma unroll
        for (int ai = 0; ai < 2; ++ai)
#pragma unroll
            for (int m = 0; m < 4; ++m) { const size_t row = (size_t)(row0 + ai * 128 + m * 16);
#pragma unroll
                for (int bj = 0; bj < 2; ++bj) { const int col = col0 + bj * 128;
                    const u32x4 ga = *(const u32x4*)(PROJ + row * NPROJ + C_GATE + seg * 1024 + col);
                    float f[8];
                    if (seg < 2) { const u32x4 gb = *(const u32x4*)(PROJ + row * NPROJ + C_GATE + (seg + 1) * 1024 + col);
#pragma unroll
                        for (int q = 0; q < 4; ++q) { f[2 * q] = bflo(ga[q]) * __builtin_amdgcn_rcpf(bflo(gb[q])); f[2 * q + 1] = bfhi(ga[q]) * __builtin_amdgcn_rcpf(bfhi(gb[q])); }
                    } else {
#pragma unroll
                        for (int q = 0; q < 4; ++q) { f[2 * q] = bflo(ga[q]); f[2 * q + 1] = bfhi(ga[q]); }
                    }
                    f32x4 v0 = acc[ai][bj][m][0], v1 = acc[ai][bj][m][1];
                    v0 = v0 * (f32x4){f[0], f[1], f[2], f[3]}; v1 = v1 * (f32x4){f[4], f[5], f[6], f[7]};
                    if (seg < 2) { acc[ai][bj][m][0] = v0; acc[ai][bj][m][1] = v1; }
                    else { u32x4 w; w.x = pk2(v0[0], v0[1]); w.y = pk2(v0[2], v0[3]); w.z = pk2(v1[0], v1[1]); w.w = pk2(v1[2], v1[3]);
                        *(u32x4*)(MIXB + row * D + col) = w; acc[ai][bj][m][0] = (f32x4){0.f, 0.f, 0.f, 0.f}; acc[ai][bj][m][1] = (f32x4){0.f, 0.f, 0.f, 0.f}; } }
                asm volatile("" ::: "memory"); }
    }
};
struct EpiOut {
    static constexpr bool PERM = false;
    const float* base_ctx; const float* base_lat; float* XR; const float* mod2; int row_off;
    __device__ __forceinline__ void operator()(Acc& acc, const Unit& u, int wr, int wc, int fr, int fq) const {
        const int row0 = row_off + u.pm * 256 + wr * 64 + fr, col0 = u.pn * 256 + wc * 32 + 4 * fq;
        const int v = vec_of_row(row_off + u.pm * 256);
        f32x4 mv[2][2];
#pragma unroll
        for (int bj = 0; bj < 2; ++bj)
#pragma unroll
            for (int n = 0; n < 2; ++n) mv[bj][n] = *(const f32x4*)(mod2 + (size_t)v * 6144 + col0 + bj * 128 + n * 16);
#pragma unroll
        for (int ai = 0; ai < 2; ++ai)
#pragma unroll
            for (int m = 0; m < 4; ++m) { const int row = row0 + ai * 128 + m * 16;
                const float* bp = row < TC ? base_ctx + (size_t)row * D : base_lat + (size_t)(row - TC) * D; float* op = XR + (size_t)row * D;
#pragma unroll
                for (int bj = 0; bj < 2; ++bj)
#pragma unroll
                    for (int n = 0; n < 2; ++n) { const int c = col0 + bj * 128 + n * 16; *(f32x4*)(op + c) = *(const f32x4*)(bp + c) + mv[bj][n] * acc[ai][bj][m][n]; } }
        pg8::zero_acc(acc);
    }
};
struct EpiGU {
    static constexpr bool PERM = true;
    bf16* HID;
    __device__ __forceinline__ void operator()(Acc& acc, const Unit& u, int wr, int wc, int fr, int fq) const {
        const int row0 = u.pm * 256 + wr * 64 + fr, col0 = u.pn * 128 + wc * 32 + 8 * fq;
#pragma unroll
        for (int ai = 0; ai < 2; ++ai)
#pragma unroll
            for (int m = 0; m < 4; ++m) { float h[8];
#pragma unroll
                for (int n = 0; n < 2; ++n)
#pragma unroll
                    for (int j = 0; j < 4; ++j) { const float g = acc[ai][0][m][n][j], up = acc[ai][1][m][n][j]; h[4 * n + j] = siluf_(g) * up; }
                u32x4 w; w.x = pk2(h[0], h[1]); w.y = pk2(h[2], h[3]); w.z = pk2(h[4], h[5]); w.w = pk2(h[6], h[7]);
                *(u32x4*)(HID + (size_t)(row0 + ai * 128 + m * 16) * EH + col0) = w; }
        pg8::zero_acc(acc);
    }
};
struct EpiDown {
    static constexpr bool PERM = true;
    bf16* YE; const float* topw;
    __device__ __forceinline__ void operator()(Acc& acc, const Unit& u, int wr, int wc, int fr, int fq) const {
        const int row0 = u.pm * 256 + wr * 64 + fr, col0 = u.pn * 256 + wc * 32 + 8 * fq;
#pragma unroll
        for (int ai = 0; ai < 2; ++ai)
#pragma unroll
            for (int m = 0; m < 4; ++m) { const int row = row0 + ai * 128 + m * 16; const float tw = topw[row];
#pragma unroll
                for (int bj = 0; bj < 2; ++bj) { const f32x4 v0 = acc[ai][bj][m][0] * tw, v1 = acc[ai][bj][m][1] * tw;
                    u32x4 w; w.x = pk2(v0[0], v0[1]); w.y = pk2(v0[2], v0[3]); w.z = pk2(v1[0], v1[1]); w.w = pk2(v1[2], v1[3]);
                    *(u32x4*)(YE + (size_t)row * D + col0 + bj * 128) = w; } }
        pg8::zero_acc(acc);
    }
};

struct SchedInproj {
    int G, c, ncc; const char* HB; const char* WT;
    __device__ __forceinline__ bool next(int i, Unit& u) const {
        const long L = (long)i * G + c; int pm, pn;
        if (L < 64 * 28) { pg8::grid_order(L, 64, 28, pm, pn); pm += 8; }
        else { if (!pg8::grid_order(L - 64 * 28, 8, ncc, pm, pn)) return false; if (ncc == 7) pn = pn < 3 ? pn + 1 : pn + 5; }
        const size_t tile = (size_t)256 * D * 2;
        if (pn < 24) { u.pm = pm; u.pn = pn; u.A = HB + pm * tile; u.B = WT + pn * tile; u.tag = (pn < 2 || (pn >= 6 && pn < 10)) ? 2 : (pn >= 12 ? 1 : 0); }
        else { u.pm = pn - 24; u.pn = pm; u.A = WT + (size_t)(24 + pn - 24) * tile; u.B = HB + pm * tile; u.tag = 3; }
        return true; }
};
struct EpiInproj {
    static constexpr bool PERM = true;
    bf16* PROJ; bf16* GT; bf16* GTC; const float* rc; const float* rs; const float* qn; const float* kn;
    __device__ __forceinline__ void operator()(Acc& acc, const Unit& u, int wr, int wc, int fr, int fq) const {
        if (u.tag == 3) { EpiGT E{GT, GTC}; E(acc, u, wr, wc, fr, fq); return; }
        if (u.tag < 2) { EpiBf16 E{PROJ, NPROJ, u.tag == 1 ? 0 : 1000}; E(acc, u, wr, wc, fr, fq); return; }
        const int tile = u.pn; const bool is_d = tile >= 6, is_q = (tile == 0 || tile == 6 || tile == 7);
        f32x4 g1[2], g2[2];
        if (is_d) { const float* G = is_q ? qn : kn;
#pragma unroll
            for (int n = 0; n < 2; ++n) { g1[n] = *(const f32x4*)(G + 8 * fq + 4 * n); g2[n] = *(const f32x4*)(G + 32 + 8 * fq + 4 * n); } }
        const int row0 = u.pm * 256 + wr * 64 + fr; const bool lat = u.pm >= 8;
#pragma unroll
        for (int ai = 0; ai < 2; ++ai)
#pragma unroll
            for (int m = 0; m < 4; ++m) { const int row = row0 + ai * 128 + m * 16;
                f32x4 x1[2] = {acc[ai][0][m][0], acc[ai][0][m][1]}, x2[2] = {acc[ai][1][m][0], acc[ai][1][m][1]};
                if (is_d) {
                    float ss = 0.f;
#pragma unroll
                    for (int n = 0; n < 2; ++n) ss += (x1[n][0] * x1[n][0] + x1[n][1] * x1[n][1]) + (x1[n][2] * x1[n][2] + x1[n][3] * x1[n][3]) + (x2[n][0] * x2[n][0] + x2[n][1] * x2[n][1]) + (x2[n][2] * x2[n][2] + x2[n][3] * x2[n][3]);
                    ss += __shfl_xor(ss, 16); ss += __shfl_xor(ss, 32);
                    const float rinv = __builtin_amdgcn_rsqf(ss * (1.0f / 64.0f) + EPS);
#pragma unroll
                    for (int n = 0; n < 2; ++n) { x1[n] = x1[n] * rinv * g1[n]; x2[n] = x2[n] * rinv * g2[n]; }
                } else if (tile == 0) {
#pragma unroll
                    for (int n = 0; n < 2; ++n) { x1[n] = x1[n] * 0.125f; x2[n] = x2[n] * 0.125f; }
                }
                f32x4 o1[2], o2[2];
                if (lat) { const int pos = (row - TC) & (SEQ - 1);
#pragma unroll
                    for (int n = 0; n < 2; ++n) { const f32x4 c = *(const f32x4*)(rc + pos * 32 + 8 * fq + 4 * n), sn = *(const f32x4*)(rs + pos * 32 + 8 * fq + 4 * n);
                        o1[n] = x1[n] * c - x2[n] * sn; o2[n] = x2[n] * c + x1[n] * sn; }
                } else { o1[0] = x1[0]; o1[1] = x1[1]; o2[0] = x2[0]; o2[1] = x2[1]; }
                if (is_d && is_q) { const float k = 0.125f * LOG2E;
#pragma unroll
                    for (int n = 0; n < 2; ++n) { o1[n] = o1[n] * k; o2[n] = o2[n] * k; } }
                bf16* dst = PROJ + (size_t)row * NPROJ + tile * 256 + 64 * wc + 8 * fq;
                u32x4 w; w.x = pk2(o1[0][0], o1[0][1]); w.y = pk2(o1[0][2], o1[0][3]); w.z = pk2(o1[1][0], o1[1][1]); w.w = pk2(o1[1][2], o1[1][3]); *(u32x4*)dst = w;
                w.x = pk2(o2[0][0], o2[0][1]); w.y = pk2(o2[0][2], o2[0][3]); w.z = pk2(o2[1][0], o2[1][1]); w.w = pk2(o2[1][2], o2[1][3]); *(u32x4*)(dst + 32) = w;
                asm volatile("" ::: "memory"); }
        pg8::zero_acc(acc);
    }
};
__device__ __forceinline__ void phase_inproj(Frame& F, int layer) {
    const float* rc = (const float*)(F.ws + WS_ROPE);
    SchedInproj S{F.G, (int)blockIdx.x, layer == DEPTH - 1 ? 7 : 28, (const char*)(F.ws + WS_HB), (const char*)(F.ws + WS_WIN + layer * WIN_L)};
    EpiInproj E{(bf16*)(F.ws + WS_PROJ), (bf16*)(F.ws + WS_GT), (bf16*)(F.ws + WS_GTC), rc, rc + SEQ * 32, inp(F, IN_QN) + layer * 64, inp(F, IN_KN) + layer * 64};
    pg8::gemm_phase(F.lds, F.tid, D, S, E);
}

namespace att {
constexpr int KPITCH = 144, VPITCH = 320, KC_BYTES = 64 * KPITCH, V_BYTES = 64 * VPITCH, BUF_BYTES = 2 * KC_BYTES + V_BYTES;
constexpr int SCR_OFF = 2 * BUF_BYTES;
constexpr int QW_OFF = SCR_OFF + 8 * 256;
constexpr int S_OFF = 81920, S_BYTES = 128 * KPITCH;
__device__ __forceinline__ int crow(int r, int hi) { return (r & 3) + 8 * (r >> 2) + 4 * hi; }
__device__ __forceinline__ s16x4 vtr(const LAS unsigned char* p) { typedef short v4i16_t __attribute__((ext_vector_type(4))); return __builtin_bit_cast(s16x4, __builtin_amdgcn_ds_read_tr16_b64_v4i16((LAS v4i16_t*)p)); }

struct UnitDesc {
    int mode;
    int qrow0;
    int qpos0;
    int h;
    int krowA, ntA;
    int krowB, ntB;
    int kindB;
    int nseq;
    int outrow0;
    float lgf, lgb;
    float lam, scale_out;
    int cross, bh, blk;
};

__device__ __forceinline__ void unit(const Frame& F, const UnitDesc& u) {
    LAS unsigned char* lds = F.lds;
    const int tid = F.tid, lane = F.lane, wid = F.wave, r32 = lane & 31, hi = lane >> 5;
    const bf16* PROJ = (const bf16*)(F.ws + WS_PROJ);
    const bool diff = u.mode == 0;
    const int comp = diff ? (wid >> 2) : 0;
    const int qoff = diff ? 32 * (wid & 3) : 32 * wid;
    const int kcol = diff ? C_DK + u.h * 128 : C_RK + u.h * 64, vcol = diff ? C_DV + u.h * 128 : C_RV + u.h * 128;
    const int qcol = diff ? C_DQ + u.h * 128 + comp * 64 : C_RQ + u.h * 64;
    const int NT = u.ntA + u.ntB;
    bf16x8 qf[4];
    { const bf16* qp = PROJ + (size_t)(u.qrow0 + qoff + r32) * NPROJ + qcol + 8 * hi;
#pragma unroll
      for (int s = 0; s < 4; ++s) qf[s] = *(const bf16x8*)(qp + 16 * s); }
    f32x16 o[4];
#pragma unroll
    for (int d = 0; d < 4; ++d) o[d] = (f32x16){};
    float lsum = 0.f;
    if (!diff && u.cross) {
        const float* LB = (const float*)(F.ws + WS_LBUF) + (size_t)u.bh * 9 * 2 * 64 * 128;
        const int dv = tid & 127, dg = tid >> 7, c = u.blk;
        float sf[16], sb[16];
#pragma unroll
        for (int k = 0; k < 16; ++k) { sf[k] = 0.f; sb[k] = 0.f; }
        for (int bp = 0; bp < 9; ++bp) {
            const float wf = bp == 8 ? __builtin_amdgcn_exp2f(u.lgf * 256.f * (float)c) : (bp < c ? __builtin_amdgcn_exp2f(u.lgf * 256.f * (float)(c - 1 - bp)) : 0.f);
            const float wb = bp == 8 ? __builtin_amdgcn_exp2f(u.lgb * 256.f * (float)(7 - c)) : (bp > c ? __builtin_amdgcn_exp2f(u.lgb * 256.f * (float)(bp - c - 1)) : 0.f);
            const float* Lf = LB + (size_t)(bp * 2 + 0) * 64 * 128 + (16 * dg) * 128 + dv; const float* Lb = Lf + 64 * 128;
            if (wf != 0.f) {
#pragma unroll
                for (int k = 0; k < 16; ++k) sf[k] += wf * Lf[k * 128]; }
            if (wb != 0.f) {
#pragma unroll
                for (int k = 0; k < 16; ++k) sb[k] += wb * Lb[k * 128]; }
        }
        LAS unsigned char* sp = lds + S_OFF + dv * KPITCH + dg * 32;
        *(LAS u32x4*)(sp) = (u32x4){pk2(sf[0], sf[1]), pk2(sf[2], sf[3]), pk2(sf[4], sf[5]), pk2(sf[6], sf[7])};
        *(LAS u32x4*)(sp + 16) = (u32x4){pk2(sf[8], sf[9]), pk2(sf[10], sf[11]), pk2(sf[12], sf[13]), pk2(sf[14], sf[15])};
        *(LAS u32x4*)(sp + S_BYTES) = (u32x4){pk2(sb[0], sb[1]), pk2(sb[2], sb[3]), pk2(sb[4], sb[5]), pk2(sb[6], sb[7])};
        *(LAS u32x4*)(sp + S_BYTES + 16) = (u32x4){pk2(sb[8], sb[9]), pk2(sb[10], sb[11]), pk2(sb[12], sb[13]), pk2(sb[14], sb[15])};
        __syncthreads();
        const int p = qoff + r32; const float ai = __builtin_amdgcn_exp2f(u.lgf * (float)(p + 1)), bi = __builtin_amdgcn_exp2f(u.lgb * (float)(256 - p));
#pragma unroll
        for (int s4 = 0; s4 < 4; ++s4) {
            const u32x4 qw = __builtin_bit_cast(u32x4, qf[s4]); u32x4 qa, qb;
#pragma unroll
            for (int q = 0; q < 4; ++q) { const float lo = bflo(qw[q]), hh = bfhi(qw[q]); qa[q] = pk2(lo * ai, hh * ai); qb[q] = pk2(lo * bi, hh * bi); }
#pragma unroll
            for (int d = 0; d < 4; ++d) {
                const LAS unsigned char* bp = lds + S_OFF + (32 * d + r32) * KPITCH + (16 * s4 + 8 * hi) * 2;
                o[d] = __builtin_amdgcn_mfma_f32_32x32x16_bf16(__builtin_bit_cast(bf16x8, qa), *(const LAS bf16x8*)bp, o[d], 0, 0, 0);
                o[d] = __builtin_amdgcn_mfma_f32_32x32x16_bf16(__builtin_bit_cast(bf16x8, qb), *(const LAS bf16x8*)(bp + S_BYTES), o[d], 0, 0, 0);
            }
        }
    }
    u32x4 kreg[2], vreg[2];
    auto tile_row = [&](int t) { return t < u.ntA ? u.krowA + 64 * t : u.krowB + 64 * (t - u.ntA); };
    auto load_tile = [&](int t) {
        const int row0 = tile_row(t);
#pragma unroll
        for (int i = 0; i < 2; ++i) { const int cid = tid + 512 * i, key = cid >> 4, c16 = cid & 15;
            vreg[i] = *(const u32x4*)(PROJ + (size_t)(row0 + key) * NPROJ + vcol + c16 * 8);
            if (diff) kreg[i] = *(const u32x4*)(PROJ + (size_t)(row0 + key) * NPROJ + kcol + c16 * 8); }
        if (!diff) { const int key = tid >> 3, c8 = tid & 7; kreg[0] = *(const u32x4*)(PROJ + (size_t)(row0 + key) * NPROJ + kcol + c8 * 8); }
    };
    auto store_tile = [&](int buf) {
        LAS unsigned char* b = lds + buf * BUF_BYTES;
#pragma unroll
        for (int i = 0; i < 2; ++i) { const int cid = tid + 512 * i, key = cid >> 4, c16 = cid & 15;
            *(LAS u32x4*)(b + 2 * KC_BYTES + key * VPITCH + c16 * 16) = vreg[i];
            if (diff) *(LAS u32x4*)(b + (c16 >> 3) * KC_BYTES + key * KPITCH + (c16 & 7) * 16) = kreg[i]; }
        if (!diff) { const int key = tid >> 3, c8 = tid & 7; *(LAS u32x4*)(b + key * KPITCH + c8 * 16) = kreg[0]; }
    };
    load_tile(0); store_tile(0);
    __syncthreads();
    const int qpos = u.qpos0 + qoff + r32;
    for (int t = 0; t < NT; ++t) {
        if (t + 1 < NT) load_tile(t + 1);
        const LAS unsigned char* b = lds + (t & 1) * BUF_BYTES;
        const LAS unsigned char* kb = b + comp * KC_BYTES + r32 * KPITCH + hi * 16;
        u32x4 pw[4];
        const bool segB = t >= u.ntA; const int j0 = 64 * (segB ? t - u.ntA : t);
#pragma unroll
        for (int kh = 0; kh < 2; ++kh) {
            f32x16 sc = (f32x16){};
#pragma unroll
            for (int s = 0; s < 4; ++s) { const bf16x8 kf = *(const LAS bf16x8*)(kb + kh * 32 * KPITCH + s * 32); sc = __builtin_amdgcn_mfma_f32_32x32x16_bf16(kf, qf[s], sc, 0, 0, 0); }
            if (diff) {
#pragma unroll
                for (int r = 0; r < 16; ++r) sc[r] = __builtin_amdgcn_exp2f(sc[r]);
                float a = 0.f;
#pragma unroll
                for (int r = 0; r < 16; ++r) a += sc[r];
                lsum += a;
            } else if (!segB || u.kindB == 0) {
#pragma unroll
                for (int r = 0; r < 16; ++r) { const int d = qpos - (j0 + 32 * kh + crow(r, hi)); sc[r] *= __builtin_amdgcn_exp2f((float)d * (d >= 0 ? u.lgf : -u.lgb)); }
            } else {
#pragma unroll
                for (int r = 0; r < 16; ++r) { const int na = j0 + 32 * kh + crow(r, hi);
                    sc[r] *= __builtin_amdgcn_exp2f((float)(qpos + CTX - na) * u.lgf) + __builtin_amdgcn_exp2f((float)(u.nseq - qpos + na) * u.lgb); }
            }
            pw[2 * kh] = (u32x4){pk2(sc[0], sc[1]), pk2(sc[2], sc[3]), pk2(sc[4], sc[5]), pk2(sc[6], sc[7])};
            pw[2 * kh + 1] = (u32x4){pk2(sc[8], sc[9]), pk2(sc[10], sc[11]), pk2(sc[12], sc[13]), pk2(sc[14], sc[15])};
            __builtin_amdgcn_sched_barrier(0);
        }
        const LAS unsigned char* vb = b + 2 * KC_BYTES + (4 * hi + ((lane & 15) >> 2)) * VPITCH + ((lane >> 4) & 1) * 32 + (lane & 3) * 8;
        __builtin_amdgcn_sched_barrier(0);
#pragma unroll
        for (int dvb = 0; dvb < 4; ++dvb) {
#pragma unroll
            for (int ks = 0; ks < 4; ++ks) {
                const s16x4 lo = vtr(vb + ks * 16 * VPITCH + dvb * 64), hi4 = vtr(vb + ks * 16 * VPITCH + 8 * VPITCH + dvb * 64);
                const bf16x8 vf = (bf16x8){lo[0], lo[1], lo[2], lo[3], hi4[0], hi4[1], hi4[2], hi4[3]};
                o[dvb] = __builtin_amdgcn_mfma_f32_32x32x16_bf16(__builtin_bit_cast(bf16x8, pw[ks]), vf, o[dvb], 0, 0, 0);
            }
            __builtin_amdgcn_sched_barrier(0);
        }
        if (t + 1 < NT) store_tile((t + 1) & 1);
        __syncthreads();
    }
    LAS float* wsf = (LAS float*)(lds + SCR_OFF) + wid * 64;
    int lz = lane; asm volatile("" : "+v"(lz));
    const int r32e = lz & 31, hie = lz >> 5;
    if (diff) {
        lsum += __shfl_xor(lsum, 32);
        if (hie == 0) wsf[r32e] = __builtin_amdgcn_rcpf(lsum);
        LDS_WAIT();
        float rl[16];
#pragma unroll
        for (int r = 0; r < 16; ++r) rl[r] = wsf[crow(r, hie)];
        LAS float* XC = (LAS float*)lds;
        if (comp == 1) {
#pragma unroll
            for (int r = 0; r < 16; ++r) { const int q = qoff + crow(r, hie);
#pragma unroll
                for (int d = 0; d < 4; ++d) XC[q * 128 + 32 * d + r32e] = o[d][r] * rl[r] * u.lam; }
        }
        __syncthreads();
        if (comp == 0) {
            float ss[16];
#pragma unroll
            for (int r = 0; r < 16; ++r) { const int q = qoff + crow(r, hie); float a = 0.f;
#pragma unroll
                for (int d = 0; d < 4; ++d) { const float v = o[d][r] * rl[r] - XC[q * 128 + 32 * d + r32e]; o[d][r] = v; a += v * v; }
                ss[r] = a; }
#pragma unroll
            for (int r = 0; r < 16; ++r) { float a = ss[r]; a += __shfl_xor(a, 1); a += __shfl_xor(a, 2); a += __shfl_xor(a, 4); a += __shfl_xor(a, 8); a += __shfl_xor(a, 16);
                ss[r] = u.scale_out * __builtin_amdgcn_rsqf(a * (1.0f / 128.0f) + EPS); }
            bf16* DO = (bf16*)(F.ws + WS_FO + 2 * MIX_ONE);
#pragma unroll
            for (int r = 0; r < 16; ++r) { bf16* op = DO + (size_t)(u.outrow0 + qoff + crow(r, hie)) * 512 + u.h * 128 + r32e;
#pragma unroll
                for (int d = 0; d < 4; ++d) op[32 * d] = (bf16)f2bf(o[d][r] * ss[r]); }
        }
    } else {
        bf16* RO = (bf16*)(F.ws + WS_FO + 1 * MIX_ONE);
#pragma unroll
        for (int r = 0; r < 16; ++r) {
            float a = (o[0][r] + o[1][r]) + (o[2][r] + o[3][r]);
            a += __shfl_xor(a, 1); a += __shfl_xor(a, 2); a += __shfl_xor(a, 4); a += __shfl_xor(a, 8); a += __shfl_xor(a, 16);
            const float mu = a * (1.0f / 128.0f); float q = 0.f;
#pragma unroll
            for (int d = 0; d < 4; ++d) { const float v = o[d][r] - mu; o[d][r] = v; q += v * v; }
            q += __shfl_xor(q, 1); q += __shfl_xor(q, 2); q += __shfl_xor(q, 4); q += __shfl_xor(q, 8); q += __shfl_xor(q, 16);
            const float rstd = __builtin_amdgcn_rsqf(q * (1.0f / 128.0f) + EPS);
            const size_t row = (size_t)(u.outrow0 + qoff + crow(r, hie));
            const bf16* gp = PROJ + row * NPROJ + C_RG + u.h * 128 + r32e; bf16* op = RO + row * 512 + u.h * 128 + r32e;
#pragma unroll
            for (int d = 0; d < 4; ++d) { const float g = bf2f(gp[32 * d]); op[32 * d] = (bf16)f2bf(o[d][r] * rstd * siluf_(g)); }
        }
    }
    __syncthreads();
}
}

namespace rst {
constexpr int KP = 192, VP = 320, KB_BYTES = 128 * KP, VB_BYTES = 128 * VP;
__device__ __forceinline__ void unit(const Frame& F, int layer, int b, int h, int blk) {
    LAS unsigned char* lds = F.lds; const int tid = F.tid, lane = F.lane, wid = F.wave, hi = lane >> 5;
    const bf16* PROJ = (const bf16*)(F.ws + WS_PROJ);
    const int row0 = blk < 8 ? TC + b * SEQ + blk * 256 : b * CTX;
    const float lgf = inp(F, IN_RDEC)[(layer * 2 + 0) * 4 + h] * LOG2E, lgb = inp(F, IN_RDEC)[(layer * 2 + 1) * 4 + h] * LOG2E;
    const int dir = wid >> 2, dvb = wid & 3;
    f32x16 acc0 = (f32x16){}, acc1 = (f32x16){};
    for (int half = 0; half < 2; ++half) {
#pragma unroll
        for (int i = 0; i < 2; ++i) { const int cid = tid + 512 * i, tok = cid >> 3, c8 = cid & 7, p = half * 128 + tok;
            const u32x4 kv = *(const u32x4*)(PROJ + (size_t)(row0 + p) * NPROJ + C_RK + h * 64 + c8 * 8);
            const float wf = __builtin_amdgcn_exp2f((float)(255 - p) * lgf), wb = __builtin_amdgcn_exp2f((float)p * lgb);
            u32x4 kf, kb;
#pragma unroll
            for (int q = 0; q < 4; ++q) { const float lo = bflo(kv[q]), hh = bfhi(kv[q]); kf[q] = pk2(lo * wf, hh * wf); kb[q] = pk2(lo * wb, hh * wb); }
            *(LAS u32x4*)(lds + tok * KP + c8 * 16) = kf; *(LAS u32x4*)(lds + KB_BYTES + tok * KP + c8 * 16) = kb; }
#pragma unroll
        for (int i = 0; i < 4; ++i) { const int cid = tid + 512 * i, tok = cid >> 4, c16 = cid & 15, p = half * 128 + tok;
            *(LAS u32x4*)(lds + 2 * KB_BYTES + tok * VP + c16 * 16) = *(const u32x4*)(PROJ + (size_t)(row0 + p) * NPROJ + C_RV + h * 128 + c16 * 8); }
        __syncthreads();
        const LAS unsigned char* ka = lds + dir * KB_BYTES + (8 * hi + ((lane & 15) >> 2)) * KP + ((lane >> 4) & 1) * 32 + (lane & 3) * 8;
        const LAS unsigned char* va = lds + 2 * KB_BYTES + (8 * hi + ((lane & 15) >> 2)) * VP + dvb * 64 + ((lane >> 4) & 1) * 32 + (lane & 3) * 8;
#pragma unroll
        for (int ks = 0; ks < 8; ++ks) {
            const s16x4 v0 = att::vtr(va + ks * 16 * VP), v1 = att::vtr(va + ks * 16 * VP + 4 * VP);
            const bf16x8 vf = (bf16x8){v0[0], v0[1], v0[2], v0[3], v1[0], v1[1], v1[2], v1[3]};
            const s16x4 a0 = att::vtr(ka + ks * 16 * KP), a1 = att::vtr(ka + ks * 16 * KP + 4 * KP);
            const s16x4 b0 = att::vtr(ka + ks * 16 * KP + 64), b1 = att::vtr(ka + ks * 16 * KP + 4 * KP + 64);
            acc0 = __builtin_amdgcn_mfma_f32_32x32x16_bf16((bf16x8){a0[0], a0[1], a0[2], a0[3], a1[0], a1[1], a1[2], a1[3]}, vf, acc0, 0, 0, 0);
            acc1 = __builtin_amdgcn_mfma_f32_32x32x16_bf16((bf16x8){b0[0], b0[1], b0[2], b0[3], b1[0], b1[1], b1[2], b1[3]}, vf, acc1, 0, 0, 0);
        }
        __syncthreads();
    }
    float* L = (float*)(F.ws + WS_LBUF) + ((size_t)((b * 4 + h) * 9 + blk) * 2 + dir) * 64 * 128;
    const int r32 = lane & 31;
#pragma unroll
    for (int r = 0; r < 16; ++r) { const int d = att::crow(r, hi); L[(size_t)d * 128 + 32 * dvb + r32] = acc0[r]; L[(size_t)(32 + d) * 128 + 32 * dvb + r32] = acc1[r]; }
}
}
__device__ __forceinline__ void phase_retstate(Frame& F, int layer) {
    for (int i = F.vcu; i < 288; i += F.G) { const int blk = i % 9, bh = i / 9; rst::unit(F, layer, bh >> 2, bh & 3, blk); }
}


constexpr int NDFT_CU = 128;

__device__ __forceinline__ void phase_mixers(Frame& F, int layer, int rep) {
    const bool last = layer == DEPTH - 1;
#if !defined(ONLY_SUB) || ONLY_SUB == 1
    if ((int)blockIdx.x < NDFT_CU && F.G > NDFT_CU) {
        {
            SchedGrid S{SEQ / 256, 4096 / 256, NDFT_CU, (int)blockIdx.x, (const char*)(F.ws + WS_DFTL), (const char*)(F.ws + WS_GT), (size_t)256 * 4096 * 2, (size_t)256 * 4096 * 2, 0, 0};
            EpiDFT E{(bf16*)(F.ws + WS_FO), SEQ, TC};
            pg8::gemm_phase(F.lds, F.tid, 4096, S, E);
        }
        if (!last) {
            SchedGrid S{1, 4096 / 256, NDFT_CU, (int)blockIdx.x, (const char*)(F.ws + WS_DFTC), (const char*)(F.ws + WS_GTC), (size_t)256 * 512 * 2, (size_t)256 * 512 * 2, 0, 0};
            EpiDFT E{(bf16*)(F.ws + WS_FO), CTX, 0};
            pg8::gemm_phase(F.lds, F.tid, 512, S, E);
        }
    }
#endif
#if defined(ONLY_SUB) && ONLY_SUB == 1
    return;
#endif
    const int nunits = last ? 768 : 864;
    const float lam = lam_of(F, layer), so = 1.0f - lam_init_of(layer);
    unsigned* qctr = F.ctl + CW_QUEUE + 64 * (layer + 2 * rep);
    volatile LAS unsigned* qw = (volatile LAS unsigned*)(F.lds + att::QW_OFF);
    const bool solo = F.G <= NDFT_CU;
    (void)solo;
    for (;;) {
        if (F.tid == 0) *qw = __hip_atomic_fetch_add(qctr, 1u, RLX_AGENT);
        __syncthreads();
        const int i = (int)*qw;
        __syncthreads();
        if (i >= nunits) break;
        att::UnitDesc u{};
        u.lam = lam; u.scale_out = so;
        if (i < 512) { const int b = i >> 6, h = (i >> 4) & 3, qb = i & 15; u.mode = 0; u.h = h; u.qrow0 = TC + b * SEQ + qb * 128; u.qpos0 = qb * 128; u.krowA = TC + b * SEQ; u.ntA = 32; u.krowB = b * CTX; u.ntB = 4; }
        else if (i < 768) { const int j = i - 512, b = j >> 5, h = (j >> 3) & 3, qb = j & 7; u.mode = 1; u.h = h; u.qrow0 = TC + b * SEQ + qb * 256; u.qpos0 = 0; u.krowA = u.qrow0; u.ntA = 4; u.krowB = 0; u.ntB = 0; u.kindB = 0; u.nseq = SEQ; u.cross = 1; u.bh = b * 4 + h; u.blk = qb; }
        else if (i < 832) { const int j = i - 768, b = j >> 3, h = (j >> 1) & 3, qb = j & 1; u.mode = 0; u.h = h; u.qrow0 = b * CTX + qb * 128; u.qpos0 = qb * 128; u.krowA = b * CTX; u.ntA = 4; u.krowB = 0; u.ntB = 0; }
        else { const int j = i - 832, b = j >> 2, h = j & 3; u.mode = 1; u.h = h; u.qrow0 = b * CTX; u.qpos0 = 0; u.krowA = b * CTX; u.ntA = 4; u.krowB = 0; u.ntB = 0; u.kindB = 0; u.nseq = CTX; }
        u.outrow0 = u.qrow0;
        if (u.mode == 1) { u.lgf = inp(F, IN_RDEC)[(layer * 2 + 0) * 4 + u.h] * LOG2E; u.lgb = inp(F, IN_RDEC)[(layer * 2 + 1) * 4 + u.h] * LOG2E; }
        att::unit(F, u);
    }
}

__device__ __forceinline__ void phase_merge(Frame& F, int layer) {
    const int row_off = layer == DEPTH - 1 ? TC : 0, M = TA - row_off;
    SchedMerge S{M / 256, D / 256, F.G, (int)blockIdx.x, (const char*)(F.ws + WS_FO) + (size_t)row_off * 512 * 2, (const char*)(F.ws + WS_WFO + (size_t)layer * 3 * WMG_ONE), MIX_ONE, WMG_ONE, (size_t)256 * 512 * 2, (size_t)256 * 512 * 2};
    EpiMerge E{(const bf16*)(F.ws + WS_PROJ), (bf16*)(F.ws + WS_MIXB), row_off};
    pg8::gemm_phase(F.lds, F.tid, 512, S, E);
}
__device__ __forceinline__ void phase_outproj(Frame& F, int layer) {
    const int row_off = layer == DEPTH - 1 ? TC : 0, M = TA - row_off;
    SchedGrid S{M / 256, D / 256, F.G, (int)blockIdx.x, (const char*)(F.ws + WS_MIXB) + (size_t)row_off * D * 2, (const char*)(F.ws + WS_WOUT + layer * WOUT_L), (size_t)256 * D * 2, (size_t)256 * D * 2, 0, 0};
    const float* XR = (const float*)(F.ws + WS_XR);
    EpiOut E{layer == 0 ? inp(F, IN_CTX) : XR, layer == 0 ? inp(F, IN_X) : XR + (size_t)TC * D, (float*)(F.ws + WS_XR), (const float*)(F.ws + WS_MOD) + (size_t)layer * 9 * 6144 + 2 * 1024, row_off};
    pg8::gemm_phase(F.lds, F.tid, D, S, E);
}

__device__ __forceinline__ void phase_norm2(Frame& F, int layer) {
    const int gw = F.vcu * 8 + F.wave, NGW = F.G * 8, lane = F.lane, tid = F.tid;
    LAS float* wr_t = (LAS float*)F.lds;
    const float* wrt = inp(F, IN_WROUTER) + (size_t)layer * D * NE;
    for (int i = tid; i < D * NE; i += 512) { const int k = i >> 4, e = i & 15; wr_t[e * 1024 + k] = wrt[i]; }
    __syncthreads();
    const int r_lo = layer == DEPTH - 1 ? TC : 0;
    const float* XR = (const float*)(F.ws + WS_XR); bf16* HB = (bf16*)(F.ws + WS_HB); float* AFF = (float*)(F.ws + WS_AFF);
    for (int r = r_lo + gw; r < TA; r += NGW) {
        const int v = vec_of_row(r);
        f32x4 x[4];
#pragma unroll
        for (int j = 0; j < 4; ++j) x[j] = *(const f32x4*)(XR + (size_t)r * D + 4 * lane + 256 * j);
        float ss = 0.f;
#pragma unroll
        for (int j = 0; j < 4; ++j) ss += (x[j].x * x[j].x + x[j].y * x[j].y) + (x[j].z * x[j].z + x[j].w * x[j].w);
        const float rinv = __builtin_amdgcn_rsqf(wave_sum(ss) * (1.0f / D) + EPS);
        const float* g = inp(F, IN_GFFN) + (size_t)layer * D; const float* sh = mod_ptr(F, layer, v, 3); const float* scl = mod_ptr(F, layer, v, 4);
#pragma unroll
        for (int j = 0; j < 4; ++j) { const int k = 4 * lane + 256 * j; const f32x4 gv = *(const f32x4*)(g + k), sv = *(const f32x4*)(sh + k), cv = *(const f32x4*)(scl + k);
            x[j] = (x[j] * rinv * gv) * (cv + 1.0f) + sv;
            u32x2 w; w.x = pk2(x[j].x, x[j].y); w.y = pk2(x[j].z, x[j].w); *(u32x2*)(HB + (size_t)r * D + k) = w; }
        float mine = 0.f;
#pragma unroll
        for (int eg = 0; eg < 4; ++eg) {
            float a[4];
#pragma unroll
            for (int q = 0; q < 4; ++q) { float t = 0.f;
#pragma unroll
                for (int j = 0; j < 4; ++j) { const f32x4 w = *(const LAS f32x4*)(wr_t + (4 * eg + q) * 1024 + 4 * lane + 256 * j); t += (x[j].x * w.x + x[j].y * w.y) + (x[j].z * w.z + x[j].w * w.w); }
                a[q] = t; }
#pragma unroll
            for (int o = 1; o < 64; o <<= 1) {
#pragma unroll
                for (int q = 0; q < 4; ++q) a[q] += __shfl_xor(a[q], o); }
#pragma unroll
            for (int q = 0; q < 4; ++q) mine = (lane == 4 * eg + q) ? a[q] : mine;
            asm volatile("" ::: "memory");
        }
        float mx = mine;
        mx = fmaxf(mx, __shfl_xor(mx, 1)); mx = fmaxf(mx, __shfl_xor(mx, 2)); mx = fmaxf(mx, __shfl_xor(mx, 4)); mx = fmaxf(mx, __shfl_xor(mx, 8));
        const float ex = __expf(mine - mx); float den = ex;
        den += __shfl_xor(den, 1); den += __shfl_xor(den, 2); den += __shfl_xor(den, 4); den += __shfl_xor(den, 8);
        if (lane < 16) AFF[(size_t)r * 16 + lane] = ex * __builtin_amdgcn_rcpf(den);
    }
    __syncthreads();
}

__device__ __forceinline__ void phase_topk(Frame& F, int layer) {
    const bool last = layer == DEPTH - 1; const int tid = F.tid, lane = F.lane, wave = F.wave;
    const int RPE = last ? 2048 : 2304, lat_off = last ? 0 : 256;
    LAS unsigned* part = (LAS unsigned*)F.lds;
    LAS unsigned* cntG = part + 16;
    LAS unsigned* cntE = cntG + 32;
    LAS int* lst = (LAS int*)(cntE + 32);
    const float* AFF = (const float*)(F.ws + WS_AFF); int* INV = (int*)(F.ws + WS_INV); float* TOPW = (float*)(F.ws + WS_TOPW);
    const bf16* HB = (const bf16*)(F.ws + WS_HB); bf16* XS = (bf16*)(F.ws + WS_XS);
    const int nitems = last ? 128 : 256;
    for (int item = F.vcu; item < nitems; item += F.G) {
        int n, C, tokrow0, e, slot0;
        if (item < 128) { const int b = item >> 4; e = item & 15; n = SEQ; C = 256; tokrow0 = TC + b * SEQ; slot0 = e * RPE + lat_off + b * 256; }
        else { const int be = item - 128, b = be >> 4; e = be & 15; n = CTX; C = 32; tokrow0 = b * CTX; slot0 = e * RPE + b * 32; }
        float v[4]; unsigned key[4];
#pragma unroll
        for (int q = 0; q < 4; ++q) { const int i = tid + 512 * q; v[q] = i < n ? AFF[(size_t)(tokrow0 + i) * 16 + e] : 0.f; key[q] = __builtin_bit_cast(unsigned, v[q]); }
        unsigned t = 0u;
        for (int bit = 30; bit >= 0; --bit) {
            const unsigned cand = t | (1u << bit); unsigned c = 0u;
#pragma unroll
            for (int q = 0; q < 4; ++q) c += (unsigned)__builtin_popcountll(__ballot(key[q] >= cand));
            if (lane == 0) part[(bit & 1) * 8 + wave] = c;
            __syncthreads();
            unsigned tot = 0u;
#pragma unroll
            for (int w = 0; w < 8; ++w) tot += part[(bit & 1) * 8 + w];
            if (tot >= (unsigned)C) t = cand;
        }
        unsigned long long bg[4], be_[4];
#pragma unroll
        for (int q = 0; q < 4; ++q) { bg[q] = __ballot(key[q] > t); be_[q] = __ballot(key[q] == t && key[q] != 0u);
            if (lane == 0) { cntG[q * 8 + wave] = (unsigned)__builtin_popcountll(bg[q]); cntE[q * 8 + wave] = (unsigned)__builtin_popcountll(be_[q]); } }
        __syncthreads();
        unsigned totG = 0u, baseG[4] = {0u, 0u, 0u, 0u}, baseE[4] = {0u, 0u, 0u, 0u}; unsigned runG = 0u, runE = 0u;
#pragma unroll
        for (int q = 0; q < 4; ++q)
#pragma unroll
            for (int w = 0; w < 8; ++w) { const unsigned g = cntG[q * 8 + w], ee = cntE[q * 8 + w]; if (w == wave) { baseG[q] = runG; baseE[q] = runE; } runG += g; runE += ee; }
        totG = runG;
        const unsigned need = (unsigned)C - totG;
        const unsigned long long lt = (1ull << lane) - 1ull;
#pragma unroll
        for (int q = 0; q < 4; ++q) { const int i = tid + 512 * q;
            if (i < n) {
                const bool g = (bg[q] >> lane) & 1ull, eq = (be_[q] >> lane) & 1ull;
                const unsigned myG = baseG[q] + (unsigned)__builtin_popcountll(bg[q] & lt), myE = baseE[q] + (unsigned)__builtin_popcountll(be_[q] & lt);
                int sl = -1;
                if (g) sl = (int)myG; else if (eq && myE < need) sl = (int)(totG + myE);
                const int R = sl >= 0 ? slot0 + sl : -1;
                INV[(size_t)(tokrow0 + i) * 16 + e] = R;
                if (sl >= 0) { TOPW[R] = v[q]; lst[sl] = i; }
            } }
        __syncthreads();
        for (int sidx = wave; sidx < C; sidx += 8) { const int i = lst[sidx];
            const u32x4* src = (const u32x4*)(HB + (size_t)(tokrow0 + i) * D); u32x4* dst = (u32x4*)(XS + (size_t)(slot0 + sidx) * D);
            const u32x4 a = src[lane], bq = src[lane + 64]; dst[lane] = a; dst[lane + 64] = bq; }
        __syncthreads();
    }
}

__device__ __forceinline__ void phase_gateup(Frame& F, int layer) {
    const int RPE = layer == DEPTH - 1 ? 2048 : 2304;
    SchedGrid S{NE * RPE / 256, 4096 / 256, F.G, (int)blockIdx.x, (const char*)(F.ws + WS_XS), (const char*)(F.ws + WS_WGU), (size_t)256 * D * 2, (size_t)256 * D * 2, RPE / 256, WGU_E};
    EpiGU E{(bf16*)(F.ws + WS_HID)};
    pg8::gemm_phase(F.lds, F.tid, D, S, E);
}
__device__ __forceinline__ void phase_down(Frame& F, int layer) {
    const int RPE = layer == DEPTH - 1 ? 2048 : 2304;
    SchedGrid S{NE * RPE / 256, D / 256, F.G, (int)blockIdx.x, (const char*)(F.ws + WS_HID), (const char*)(F.ws + WS_WD), (size_t)256 * EH * 2, (size_t)256 * EH * 2, RPE / 256, WD_E};
    EpiDown E{(bf16*)(F.ws + WS_YE), (const float*)(F.ws + WS_TOPW)};
    pg8::gemm_phase(F.lds, F.tid, EH, S, E);
}

constexpr int NPHASE = 1 + 10 * DEPTH + 1;
__global__ void __launch_bounds__(512, 2) mk_fwd(Args args) {
    extern __shared__ __attribute__((aligned(16))) unsigned char lds_raw[];
    Frame F;
    F.lds = (LAS unsigned char*)lds_raw; F.MISC = (volatile LAS unsigned*)(F.lds + MISC_OFF);
    F.tid = threadIdx.x; F.lane = F.tid & 63; F.wave = __builtin_amdgcn_readfirstlane(F.tid >> 6);
    F.G = gridDim.x; { const int bx = blockIdx.x; F.vcu = (F.G % 8 == 0) ? (bx % 8) * (F.G / 8) + bx / 8 : bx; }
    F.ws = (unsigned char*)(GAS unsigned char*)(unsigned long long)args.ws; F.ctl = (unsigned*)(F.ws + WS_CTL); F.out = (float*)(GAS float*)(unsigned long long)args.out;
    for (int u = F.tid; u < (LDS_BYTES - LDSCTL_OFF) / 4; u += 512) ((LAS unsigned*)(F.lds + LDSCTL_OFF))[u] = 0u;
    __syncthreads();
    XcdBarrier bar; bar.bar = F.ctl + CW_BAR; bar.x = 0; bar.st = nullptr;
    const bool multi = (args.ph_hi - args.ph_lo) > 1;
    if (multi) bar = xcd_barrier_post(F.ctl + CW_BAR, F.MISC + 8);
    for (int ph = args.ph_lo; ph < args.ph_hi; ++ph) {
        const int layer = (ph - 1) / 10, k = (ph == 0) ? 10 : (ph == NPHASE - 1) ? 12 : (ph - 1) % 10;
        int reps = 1 + ((PROBE_MASK >> k) & 1);
        if (k == 0 && layer > 0 && (PROBE_MASK & 2048)) reps = 2;
        for (int rep = 0; rep < reps; ++rep) {
            { unsigned long long w = (unsigned long long)args.ws; asm volatile("" : "+s"(w)); F.ws = (unsigned char*)(GAS unsigned char*)w; F.ctl = (unsigned*)(F.ws + WS_CTL); }
            { unsigned long long kp = (unsigned long long)__builtin_amdgcn_kernarg_segment_ptr(); asm volatile("" : "+s"(kp)); F.karg = (const void __attribute__((address_space(4)))*)kp; }
            { int l = (int)__builtin_amdgcn_mbcnt_hi(~0u, __builtin_amdgcn_mbcnt_lo(~0u, 0u)); asm volatile("" : "+v"(l)); F.lane = l; F.tid = F.wave * 64 + l; }
#ifdef ONLY_PHASE
            if (k != ONLY_PHASE) continue;
#endif
            switch (k) {
                case 10: phase_prologue(F); break;
                case 12: phase_norm(F, DEPTH); break;
                case 0: if (rep == 0) phase_norm(F, layer); if (layer > 0) convert_expert_weights(F, layer); break;
                case 1: phase_inproj(F, layer); break;
                case 2: phase_retstate(F, layer); break;
                case 3: phase_mixers(F, layer, rep); break;
                case 4: phase_merge(F, layer); break;
                case 5: if (rep == 0) phase_outproj(F, layer); break;
                case 6: phase_norm2(F, layer); break;
                case 7: phase_topk(F, layer); break;
                case 8: phase_gateup(F, layer); break;
                default: phase_down(F, layer); break;
            }
            if (rep + 1 < reps || ph + 1 < args.ph_hi) xcd_barrier(bar);
        }
    }
}

extern "C" void kernel_launch(void* const* d_in, const int* in_sizes, int n_in, void* d_out, int out_size, void* d_ws, size_t ws_size, hipStream_t stream) {
    static int grid = 0;
    if (grid == 0) {
        if (n_in != 21 || out_size != TL * D || ws_size < WS_END) { fprintf(stderr, "kernel_launch: unexpected shapes (n_in %d, out %d, ws %zu need %zu)\n", n_in, out_size, ws_size, (size_t)WS_END); grid = -1; return; }
        int dev = 0, cus = 0, per_cu = 0;
        if (hipGetDevice(&dev) != hipSuccess || hipDeviceGetAttribute(&cus, hipDeviceAttributeMultiprocessorCount, dev) != hipSuccess) { grid = -1; return; }
        if (hipFuncSetAttribute((const void*)mk_fwd, hipFuncAttributeMaxDynamicSharedMemorySize, LDS_BYTES) != hipSuccess) { fprintf(stderr, "kernel_launch: hipFuncSetAttribute failed\n"); grid = -1; return; }
        if (hipOccupancyMaxActiveBlocksPerMultiprocessor(&per_cu, (const void*)mk_fwd, 512, LDS_BYTES) != hipSuccess || per_cu < 1) { fprintf(stderr, "kernel_launch: occupancy query says %d\n", per_cu); per_cu = 1; }
        (void)hipGetLastError();
        grid = cus * (per_cu >= 1 ? 1 : 1);
        if (grid % 8 != 0 || grid <= NDFT_CU) fprintf(stderr, "kernel_launch: unusual grid %d\n", grid);
    }
    if (grid < 0) return;
    (void)hipMemsetAsync((char*)d_ws + WS_CTL, 0, CTL_BYTES, stream);
    Args a{};
    for (int i = 0; i < 21; ++i) a.in[i] = (const float*)d_in[i];
    a.out = (float*)d_out; a.ws = (unsigned char*)d_ws;
#if MK_MULTI_LAUNCH
    for (int ph = 0; ph < NPHASE; ++ph) { a.ph_lo = ph; a.ph_hi = ph + 1; hipLaunchKernelGGL(mk_fwd, dim3(grid), dim3(512), LDS_BYTES, stream, a); }
#else
    a.ph_lo = 0; a.ph_hi = NPHASE;
    void* kargs[] = {&a};
    hipError_t e = hipLaunchCooperativeKernel((const void*)mk_fwd, dim3(grid), dim3(512), kargs, LDS_BYTES, stream);
    if (e != hipSuccess) fprintf(stderr, "kernel_launch: cooperative launch failed: %s (grid %d)\n", hipGetErrorString(e), grid);
#endif
}
```

```cpp
#include <hip/hip_runtime.h>
#include <cstdio>
#include <cstdint>

#ifndef PROBE_MASK
#define PROBE_MASK 0
#endif
#ifndef MK_MULTI_LAUNCH
#define MK_MULTI_LAUNCH 0
#endif

#define GAS __attribute__((address_space(1)))
#define LAS __attribute__((address_space(3)))
typedef unsigned short bf16;
typedef short bf16x8 __attribute__((ext_vector_type(8)));
typedef short s16x4 __attribute__((ext_vector_type(4)));
typedef float f32x4 __attribute__((ext_vector_type(4)));
typedef float f32x16 __attribute__((ext_vector_type(16)));
typedef unsigned u32x4 __attribute__((ext_vector_type(4)));
typedef unsigned u32x2 __attribute__((ext_vector_type(2)));
typedef float f32x2_t __attribute__((ext_vector_type(2)));
typedef __bf16 bf16x2_t __attribute__((ext_vector_type(2)));

constexpr int D = 1024, NB = 8, SEQ = 2048, CTX = 256, DEPTH = 2, GRIDW = 64;
constexpr int TC = NB * CTX, TL = NB * SEQ, TA = TC + TL;
constexpr int NPROJ = 6144;
constexpr int C_RQ = 0, C_RK = 256, C_RV = 512, C_RG = 1024, C_DQ = 1536, C_DK = 2048, C_DV = 2560, C_GATE = 3072;
constexpr int INW = 6656;
constexpr int NE = 16, EH = 2048;
constexpr float EPS = 1e-6f;
constexpr float LOG2E = 1.4426950408889634f;

constexpr size_t al(size_t x) { return (x + 0xFFFFFull) & ~0xFFFFFull; }
constexpr size_t WS_CTL = 0, CTL_BYTES = 1u << 20;
constexpr size_t WS_MOD = WS_CTL + CTL_BYTES;
constexpr size_t WS_ROPE = WS_MOD + al((size_t)DEPTH * 9 * 6 * D * 4);
constexpr size_t WS_AFF = WS_ROPE + al((size_t)2 * SEQ * 32 * 4);
constexpr size_t WS_INV = WS_AFF + al((size_t)TA * 16 * 4);
constexpr size_t WS_TOPW = WS_INV + al((size_t)TA * 16 * 4);
constexpr size_t WS_WIN = WS_TOPW + al((size_t)36864 * 4);
constexpr size_t WIN_L = (size_t)7168 * 1024 * 2;
constexpr size_t WS_WFO = WS_WIN + al(2 * WIN_L);
constexpr size_t WMG_ONE = (size_t)1024 * 512 * 2;
constexpr size_t WS_WOUT = WS_WFO + al(6 * WMG_ONE);
constexpr size_t WOUT_L = (size_t)1024 * 1024 * 2;
constexpr size_t WS_WGU = WS_WOUT + al(2 * WOUT_L);
constexpr size_t WGU_E = (size_t)4096 * 1024 * 2;
constexpr size_t WS_WD = WS_WGU + al(16 * WGU_E);
constexpr size_t WD_E = (size_t)1024 * 2048 * 2;
constexpr size_t WS_DFTL = WS_WD + al(16 * WD_E);
constexpr size_t WS_DFTC = WS_DFTL + al((size_t)2048 * 4096 * 2);
constexpr size_t WS_XR = WS_DFTC + al((size_t)256 * 512 * 2);
constexpr size_t WS_HB = WS_XR + al((size_t)TA * D * 4);
constexpr size_t WS_PROJ = WS_HB + al((size_t)TA * D * 2);
constexpr size_t WS_GT = WS_PROJ + al((size_t)TA * NPROJ * 2);
constexpr size_t WS_GTC = WS_GT + al((size_t)4096 * 4096 * 2);
constexpr size_t WS_FO = WS_GTC + al((size_t)4096 * 512 * 2);
constexpr size_t MIX_ONE = (size_t)TA * 512 * 2;
constexpr size_t WS_MIXB = WS_FO + al(3 * MIX_ONE);
constexpr size_t WS_XS = WS_MIXB + al((size_t)TA * D * 2);
constexpr size_t WS_LBUF = WS_XS + al((size_t)36864 * D * 2);
constexpr size_t LBUF_ONE = (size_t)64 * 128 * 4;
constexpr size_t WS_END = WS_LBUF + al((size_t)32 * 9 * 2 * LBUF_ONE);
constexpr size_t WS_HID = WS_PROJ;
constexpr size_t WS_YE = WS_XS;
static_assert((size_t)36864 * EH * 2 <= (size_t)TA * NPROJ * 2, "HID overlays PROJ");
static_assert(WS_END <= (size_t)1024 * 1024 * 1024, "workspace map must fit 1 GiB");

constexpr int CW_BAR = 4096;
constexpr int CW_QUEUE = 16384;

constexpr int RING_BYTES = 131072;
constexpr int LDSCTL_OFF = RING_BYTES, MISC_OFF = LDSCTL_OFF + 320;
constexpr int LDS_BYTES = 147456;

#define RLX_AGENT __ATOMIC_RELAXED, __HIP_MEMORY_SCOPE_AGENT
#define LDS_WAIT() asm volatile("s_waitcnt lgkmcnt(0)" ::: "memory")
#define VM_WAIT() asm volatile("s_waitcnt vmcnt(0)" ::: "memory")
__device__ __forceinline__ unsigned f2bf(float f) { unsigned u = __builtin_bit_cast(unsigned, f); return (u + 0x7fffu + ((u >> 16) & 1u)) >> 16; }
__device__ __forceinline__ unsigned pk2(float lo, float hi) { f32x2_t v = {lo, hi}; bf16x2_t b = __builtin_convertvector(v, bf16x2_t); return __builtin_bit_cast(unsigned, b); }
__device__ __forceinline__ float bflo(unsigned w) { return __builtin_bit_cast(float, w << 16); }
__device__ __forceinline__ float bfhi(unsigned w) { return __builtin_bit_cast(float, w & 0xffff0000u); }
__device__ __forceinline__ float bf2f(bf16 h) { return __builtin_bit_cast(float, (unsigned)h << 16); }
__device__ __forceinline__ float wave_sum(float v) {
#pragma unroll
    for (int o = 1; o < 64; o <<= 1) v += __shfl_xor(v, o);
    return v;
}
__device__ __forceinline__ float sigmoidf_(float x) { return __builtin_amdgcn_rcpf(1.0f + __builtin_amdgcn_exp2f(-x * LOG2E)); }
__device__ __forceinline__ float siluf_(float x) { return x * sigmoidf_(x); }

namespace pg8 {
constexpr int BM = 256, BK = 64, HALF = 128, HTB = HALF * BK * 2, STAGE_BYTES = 8 * HTB, NXCD = 8, WGM = 8;
__host__ __device__ __forceinline__ int lds_byte(int r, int c) { const int st = (r >> 4) * 2 + (c >> 5), rr = r & 15, cc = c & 31, ob = rr * 64 + cc * 2; return st * 1024 + (ob ^ (((ob >> 9) & 1) << 5)); }
__host__ __device__ __forceinline__ void stage_rc(int b, int& R, int& C) { const int st = b / 1024, sb = b % 1024, swz = sb ^ (((sb >> 9) & 1) << 5); R = (st >> 1) * 16 + swz / 64; C = (st & 1) * 32 + (swz % 64) / 2; }
__host__ __device__ __forceinline__ int perm32(int rho) { const int n = rho >> 4, i = rho & 15; return 8 * (i >> 2) + 4 * n + (i & 3); }

struct Unit { int pm, pn, tag; const char* A; const char* B; };

__device__ __forceinline__ bool grid_order(long L, int nM, int nN, int& pm, int& pn) {
    const int nwg = nM * nN; if (L >= nwg) return false;
    int wgid = (int)L; { const int q = nwg / NXCD, r = nwg % NXCD, xcd = wgid % NXCD, off = wgid / NXCD; wgid = (xcd < r ? xcd * (q + 1) : r * (q + 1) + (xcd - r) * q) + off; }
    const int nig = WGM * nN, gid = wgid / nig, fm = gid * WGM, gsz = (nM - fm) < WGM ? (nM - fm) : WGM;
    pm = fm + ((wgid % nig) % gsz); pn = (wgid % nig) / gsz; return true;
}

typedef f32x4 Acc[2][2][4][2];
__device__ __forceinline__ void zero_acc(Acc& acc) {
#pragma unroll
    for (int a = 0; a < 2; ++a)
#pragma unroll
        for (int b = 0; b < 2; ++b)
#pragma unroll
            for (int m = 0; m < 4; ++m)
#pragma unroll
                for (int n = 0; n < 2; ++n) acc[a][b][m][n] = (f32x4){0.f, 0.f, 0.f, 0.f};
}

template <class Epi, class Sched>
__device__ __forceinline__ void gemm_phase(LAS unsigned char* lds, const int tid, const int K, const Sched& S, const Epi& E) {
    const int wid = __builtin_amdgcn_readfirstlane(tid >> 6), lane = tid & 63, wr = wid >> 2, wc = wid & 3, fr = lane & 15, fq = lane >> 4;
    const int nt = K / BK;
    unsigned voffA[2], voffB[2];
#pragma unroll
    for (int i = 0; i < 2; ++i) { int R, C; stage_rc(tid * 16 + i * 8192, R, C); const int Rb = Epi::PERM ? ((R & ~31) + perm32(R & 31)) : R;
        voffA[i] = (unsigned)(R * K + C) * 2u; voffB[i] = (unsigned)(Rb * K + C) * 2u; }
    const size_t kstep = (size_t)(BK * 2);
    const size_t hstep = (size_t)HALF * K * 2;
    const unsigned ldsw = (unsigned)wid * 1024u;
    const int aoff = lds_byte(wr * 64 + fr, fq * 8), boff = lds_byte(wc * 32 + fr, fq * 8);
#define PG8_SA(b, h) (((b) * 2 + (h)) * HTB)
#define PG8_SB(b, h) ((4 + (b) * 2 + (h)) * HTB)
#define PG8_STAGE(bufoff, gbase, voff) do { _Pragma("unroll") for (int _i = 0; _i < 2; ++_i) \
        __builtin_amdgcn_global_load_lds((const unsigned*)((const char*)(gbase) + (voff)[_i]), (LAS unsigned*)(lds + (bufoff) + ldsw + _i * 8192), 16, 0, 0); } while (0)
#define PG8_LDA(dst, b, h) do { _Pragma("unroll") for (int m = 0; m < 4; ++m) _Pragma("unroll") for (int k = 0; k < 2; ++k) dst[m][k] = *(const LAS bf16x8*)(lds + PG8_SA(b, h) + aoff + m * 2048 + k * 1024); } while (0)
#define PG8_LDB(dst, b, h) do { _Pragma("unroll") for (int n = 0; n < 2; ++n) _Pragma("unroll") for (int k = 0; k < 2; ++k) dst[n][k] = *(const LAS bf16x8*)(lds + PG8_SB(b, h) + boff + n * 2048 + k * 1024); } while (0)
#define PG8_MMA(ai, bj, At, Bt) do { __builtin_amdgcn_s_setprio(1); _Pragma("unroll") for (int m = 0; m < 4; ++m) _Pragma("unroll") for (int n = 0; n < 2; ++n) _Pragma("unroll") for (int k = 0; k < 2; ++k) \
        acc[ai][bj][m][n] = __builtin_amdgcn_mfma_f32_16x16x32_bf16(Bt[n][k], At[m][k], acc[ai][bj][m][n], 0, 0, 0); __builtin_amdgcn_s_setprio(0); } while (0)
#define PG8_WAIT_V(n) asm volatile("s_waitcnt vmcnt(" #n ")" ::: "memory")
#define PG8_WAIT_L(n) asm volatile("s_waitcnt lgkmcnt(" #n ")" ::: "memory")
#define PG8_BAR __builtin_amdgcn_s_barrier()
#define PG8_SCHED __builtin_amdgcn_sched_barrier(0)
    Unit cur, nxt; int ui = 0;
    if (!S.next(0, cur)) return;
    Acc acc; zero_acc(acc);
    bf16x8 At[4][2], B0[2][2], B1[2][2];
    const char* cA = cur.A; const char* cB = cur.B;
    PG8_STAGE(PG8_SB(0, 0), cB, voffB); PG8_STAGE(PG8_SB(0, 1), cB + hstep, voffB); PG8_STAGE(PG8_SA(0, 0), cA, voffA); PG8_STAGE(PG8_SA(0, 1), cA + hstep, voffA);
    if (wr == 1) PG8_BAR;
    PG8_WAIT_V(2); PG8_BAR;
    PG8_STAGE(PG8_SB(1, 0), cB + kstep, voffB); PG8_STAGE(PG8_SA(1, 0), cA + kstep, voffA); PG8_STAGE(PG8_SB(1, 1), cB + hstep + kstep, voffB);
    PG8_WAIT_V(6); PG8_BAR;
    for (;;) {
        const bool has_next = S.next(ui + 1, nxt);
        const char* nA = has_next ? nxt.A : cA; const char* nB = has_next ? nxt.B : cB;
        for (int t = 0; t < nt; t += 2) {
            const bool last = (t == nt - 2);
            const char* a1 = cA + (size_t)(t + 1) * kstep;
            const char* a2 = last ? nA : cA + (size_t)(t + 2) * kstep; const char* b2 = last ? nB : cB + (size_t)(t + 2) * kstep;
            const char* a3 = a2 + kstep; const char* b3 = b2 + kstep;
            PG8_LDB(B0, 0, 0); PG8_LDB(B1, 0, 1); PG8_SCHED; PG8_LDA(At, 0, 0); PG8_STAGE(PG8_SA(1, 1), a1 + hstep, voffA);
            PG8_WAIT_V(8); PG8_WAIT_L(0); PG8_BAR; PG8_MMA(0, 0, At, B0); PG8_MMA(0, 1, At, B1); PG8_BAR; PG8_SCHED;
            PG8_LDA(At, 0, 1); PG8_STAGE(PG8_SB(0, 0), b2, voffB); PG8_STAGE(PG8_SB(0, 1), b2 + hstep, voffB); PG8_STAGE(PG8_SA(0, 0), a2, voffA);
            PG8_WAIT_V(8); PG8_WAIT_L(0); PG8_BAR; PG8_MMA(1, 0, At, B0); PG8_MMA(1, 1, At, B1); PG8_BAR; PG8_SCHED;
            PG8_LDB(B0, 1, 0); PG8_LDB(B1, 1, 1); PG8_SCHED; PG8_LDA(At, 1, 0); PG8_STAGE(PG8_SA(0, 1), a2 + hstep, voffA);
            PG8_WAIT_V(8); PG8_WAIT_L(0); PG8_BAR; PG8_MMA(0, 0, At, B0); PG8_MMA(0, 1, At, B1); PG8_BAR; PG8_SCHED;
            PG8_LDA(At, 1, 1); PG8_STAGE(PG8_SB(1, 0), b3, voffB); PG8_STAGE(PG8_SB(1, 1), b3 + hstep, voffB); PG8_STAGE(PG8_SA(1, 0), a3, voffA);
            PG8_WAIT_V(8); PG8_WAIT_L(0); PG8_BAR; PG8_MMA(1, 0, At, B0); PG8_MMA(1, 1, At, B1); PG8_BAR; PG8_SCHED;
        }
        if (wr == 0) PG8_BAR;
        E(acc, cur, wr, wc, fr, fq);
        if (!has_next) break;
        cur = nxt; cA = nA; cB = nB; ++ui;
        if (wr == 1) PG8_BAR;
    }
    PG8_WAIT_V(0);
    PG8_BAR;
#undef PG8_SA
#undef PG8_SB
#undef PG8_STAGE
#undef PG8_LDA
#undef PG8_LDB
#undef PG8_MMA
#undef PG8_WAIT_V
#undef PG8_WAIT_L
#undef PG8_BAR
#undef PG8_SCHED
}
}

#define XB_TMO      128
#define XB_XCNT(j)  (256  + 64 * (j))
#define XB_XSUB(j)  (1280 + 64 * (j))
#define XB_XGEN(j)  (2304 + 64 * (j))
#define XB_TOP      3328
#define XB_TOPGEN   3392
#define XCD_BAR_WORDS 3456
#define XB_SPIN_CAP (1u << 22)
__device__ __forceinline__ unsigned xb_ld(unsigned* p)              { return __hip_atomic_load(p, __ATOMIC_RELAXED, __HIP_MEMORY_SCOPE_AGENT); }
__device__ __forceinline__ unsigned xb_add(unsigned* p, unsigned v) { return __hip_atomic_fetch_add(p, v, __ATOMIC_RELAXED, __HIP_MEMORY_SCOPE_AGENT); }
__device__ __forceinline__ unsigned xb_xcc_id() { return (unsigned)__builtin_amdgcn_s_getreg((3 << 11) | 20) & 0xFu; }
#define XB_SPIN(cond, bar) do { unsigned _sp = 0; while (cond) { __builtin_amdgcn_s_sleep(1); \
    if ((++_sp & 255u) == 0u) { if (xb_ld(&(bar)[XB_TMO])) break; if (_sp > XB_SPIN_CAP) { atomicAdd(&(bar)[XB_TMO], 1u); break; } } } } while (0)
struct XcdBarrier { unsigned* bar; unsigned x; volatile LAS unsigned* st; };
__device__ __forceinline__ XcdBarrier xcd_barrier_post(unsigned* bar, volatile LAS unsigned* st) {
    XcdBarrier b; b.bar = bar; b.x = xb_xcc_id(); b.st = st;
    if (threadIdx.x == 0) (void)xb_add(&bar[XB_XCNT(b.x)], 1u);
    return b;
}
__device__ __forceinline__ void xcd_barrier_complete(unsigned* bar, unsigned x, unsigned& nloc, unsigned& nx) {
    const unsigned G = gridDim.x * gridDim.y * gridDim.z;
    unsigned sum, cnt, mine, sp = 0u;
    for (;;) {
        sum = 0u; cnt = 0u; mine = 0u;
#pragma unroll
        for (unsigned j = 0; j < 16; ++j) { const unsigned c = xb_ld(&bar[XB_XCNT(j)]); sum += c; cnt += (c > 0u) ? 1u : 0u; mine = (j == x) ? c : mine; }
        if (sum == G) break;
        __builtin_amdgcn_s_sleep(1);
        if ((++sp & 255u) == 0u) { if (xb_ld(&bar[XB_TMO])) break; if (sp > XB_SPIN_CAP) { atomicAdd(&bar[XB_TMO], 1u); break; } }
    }
    nloc = mine > 0u ? mine : 1u; nx = cnt > 0u ? cnt : 1u;
}
__device__ __forceinline__ void xcd_barrier(const XcdBarrier& b) {
    asm volatile("s_waitcnt vmcnt(0)" ::: "memory");
    __syncthreads();
    if (threadIdx.x == 0) {
        unsigned* bar = b.bar;
        __builtin_amdgcn_s_waitcnt(0);
        unsigned nloc = b.st[0], nx = b.st[1];
        if (nloc == 0u) { xcd_barrier_complete(bar, b.x, nloc, nx); b.st[0] = nloc; b.st[1] = nx; }
        const unsigned old = xb_add(&bar[XB_XSUB(b.x)], 1u);
        const unsigned gen = old / nloc;
        if (old + 1u == (gen + 1u) * nloc) {
            __builtin_amdgcn_fence(__ATOMIC_RELEASE, "agent");
            asm volatile("s_waitcnt vmcnt(0)" ::: "memory");
            const unsigned og = xb_add(&bar[XB_TOP], 1u);
            const unsigned tg = og / nx;
            if (og + 1u == (tg + 1u) * nx) xb_add(&bar[XB_TOPGEN], 1u);
            else XB_SPIN(xb_ld(&bar[XB_TOPGEN]) == tg, bar);
            __builtin_amdgcn_fence(__ATOMIC_ACQUIRE, "agent");
            xb_add(&bar[XB_XGEN(b.x)], 1u);
            asm volatile("s_waitcnt vmcnt(0)" ::: "memory");
        } else {
            XB_SPIN(xb_ld(&bar[XB_XGEN(b.x)]) == gen, bar);
            __builtin_amdgcn_fence(__ATOMIC_ACQUIRE, "agent");
            asm volatile("s_waitcnt vmcnt(0)" ::: "memory");
        }
    }
    __syncthreads();
}

struct Args { const float* in[21]; float* out; unsigned char* ws; int ph_lo, ph_hi; };
struct Frame {
    LAS unsigned char* lds; volatile LAS unsigned* MISC; unsigned* ctl;
    int tid, lane, wave, vcu, G;
    const void __attribute__((address_space(4)))* karg; float* out; unsigned char* ws;
};
__device__ __forceinline__ const float* inp(const Frame& F, int i) { const unsigned long long p = ((const unsigned long long __attribute__((address_space(4)))*)F.karg)[i]; return (const float*)(const GAS float*)p; }
#define IN_X 0
#define IN_C 1
#define IN_CTX 2
#define IN_CCTX 3
#define IN_WMOD 4
#define IN_BMOD 5
#define IN_GATTN 6
#define IN_GFFN 7
#define IN_WIN 8
#define IN_RDEC 9
#define IN_QN 10
#define IN_KN 11
#define IN_LAMBDA 12
#define IN_WFO 13
#define IN_WRO 14
#define IN_WDO 15
#define IN_WOUT 16
#define IN_WROUTER 17
#define IN_WEG 18
#define IN_WEU 19
#define IN_WED 20

__device__ __forceinline__ int vec_of_row(int r) { return r < TC ? 8 : (r - TC) / SEQ; }
__device__ __forceinline__ const float* mod_ptr(const Frame& F, int layer, int v, int i) { return (const float*)(F.ws + WS_MOD) + ((size_t)(layer * 9 + v) * 6 + i) * D; }
__device__ __forceinline__ float lam_init_of(int layer) { return layer == 0 ? 0.2f : 0.8f - 0.6f * 0.74081822068171788f; }
__device__ __forceinline__ float lam_of(const Frame& F, int layer) {
    const float* L = inp(F, IN_LAMBDA) + (size_t)layer * 4 * 64; float s1 = 0.f, s2 = 0.f;
    for (int i = 0; i < 64; ++i) { s1 += L[i] * L[64 + i]; s2 += L[128 + i] * L[192 + i]; }
    return __expf(s1) - __expf(s2) + lam_init_of(layer);
}

__device__ __forceinline__ void transpose_item(const float* W, int ldw, int K, int k0, int n0src, bf16* WT, int dst_row0, LAS float* scr, int lane) {
#pragma unroll 8
    for (int i = 0; i < 32; ++i) { const int kk = 2 * i + (lane >> 5); scr[kk * 33 + (lane & 31)] = W[(size_t)(k0 + kk) * ldw + n0src + (lane & 31)]; }
    LDS_WAIT(); asm volatile("" ::: "memory");
    const int c = lane & 7;
#pragma unroll
    for (int j = 0; j < 4; ++j) { const int n = (lane >> 3) + 8 * j; const LAS float* s = scr + (8 * c) * 33 + n;
        u32x4 o; o.x = pk2(s[0 * 33], s[1 * 33]); o.y = pk2(s[2 * 33], s[3 * 33]); o.z = pk2(s[4 * 33], s[5 * 33]); o.w = pk2(s[6 * 33], s[7 * 33]);
        *(u32x4*)(WT + (size_t)(dst_row0 + n) * K + k0 + 8 * c) = o; }
    LDS_WAIT(); asm volatile("" ::: "memory");
}
template <class RowMap>
__device__ __forceinline__ void transpose_matrix(Frame& F, const float* W, int ldw, int csrc, int K, int N, bf16* WT, RowMap map, int& item_base) {
    LAS float* scr = (LAS float*)(F.lds + F.wave * 16384);
    const int gw = F.vcu * 8 + F.wave, NGW = F.G * 8;
    const int nblk = N / 32, nitems = (K / 64) * nblk;
    int start = (gw - item_base % NGW + NGW) % NGW;
    for (int it = start; it < nitems; it += NGW) { const int kb = it / nblk, nb = it % nblk; transpose_item(W, ldw, K, 64 * kb, csrc + 32 * nb, WT, map(32 * nb), scr, F.lane); }
    item_base += nitems;
}
struct MapId { int off; __device__ int operator()(int n) const { return off + n; } };
struct MapProj { __device__ int operator()(int n) const { const int tile = n >> 8; const bool qk = tile < 2 || (tile >= 6 && tile < 10); return qk ? (tile << 8) + 128 * ((n >> 5) & 1) + 32 * ((n >> 6) & 3) + (n & 31) : n; } };
struct MapGU { int up; __device__ int operator()(int n) const { return (n >> 7) * 256 + up * 128 + (n & 127); } };

__device__ __forceinline__ void convert_expert_weights(Frame& F, int layer) {
    int base = 0;
    for (int e = 0; e < NE; ++e) {
        const float* wg = inp(F, IN_WEG) + ((size_t)layer * NE + e) * D * EH; const float* wu = inp(F, IN_WEU) + ((size_t)layer * NE + e) * D * EH; const float* wd = inp(F, IN_WED) + ((size_t)layer * NE + e) * EH * D;
        bf16* gu = (bf16*)(F.ws + WS_WGU + e * WGU_E); bf16* dn = (bf16*)(F.ws + WS_WD + e * WD_E);
        transpose_matrix(F, wg, EH, 0, D, EH, gu, MapGU{0}, base);
        transpose_matrix(F, wu, EH, 0, D, EH, gu, MapGU{1}, base);
        transpose_matrix(F, wd, D, 0, EH, D, dn, MapId{0}, base);
    }
}

__device__ __forceinline__ void phase_prologue(Frame& F) {
    const int tid = F.tid;
    {
        LAS float* sc = (LAS float*)F.lds;
        LAS float* red = sc + 9 * 1024;
        for (int i = tid; i < 9 * 1024; i += 512) { const int v = i >> 10, k = i & 1023; const float c = v < 8 ? inp(F, IN_C)[v * D + k] : inp(F, IN_CCTX)[k]; sc[i] = siluf_(c); }
        __syncthreads();
        for (int item = F.vcu; item < DEPTH * 96; item += F.G) {
            const int layer = item / 96, cb = item % 96, col = cb * 64 + (tid & 63), kg = tid >> 6;
            const float* w = inp(F, IN_WMOD) + (size_t)layer * D * 6144 + col;
            float a[9];
#pragma unroll
            for (int v = 0; v < 9; ++v) a[v] = 0.f;
#pragma unroll 4
            for (int kk = 0; kk < 128; ++kk) { const int k = kg * 128 + kk; const float wv = w[(size_t)k * 6144];
#pragma unroll
                for (int v = 0; v < 9; ++v) a[v] += sc[v * 1024 + k] * wv; }
#pragma unroll
            for (int v = 0; v < 9; ++v) red[(kg * 64 + (tid & 63)) * 9 + v] = a[v];
            __syncthreads();
            for (int o = tid; o < 64 * 9; o += 512) { const int cc = o / 9, v = o % 9; float s = 0.f;
                for (int g = 0; g < 8; ++g) s += red[(g * 64 + cc) * 9 + v];
                const int colo = cb * 64 + cc;
                ((float*)(F.ws + WS_MOD))[(size_t)(layer * 9 + v) * 6144 + colo] = s + inp(F, IN_BMOD)[layer * 6144 + colo]; }
            __syncthreads();
        }
    }
    {
        const int gt = F.vcu * 512 + tid, NT = F.G * 512;
        float* rc = (float*)(F.ws + WS_ROPE); float* rs = rc + SEQ * 32;
        for (int i = gt; i < SEQ * 32; i += NT) { const int pos = i >> 5, f = i & 31; const float inv = __builtin_amdgcn_exp2f(-(float)(f & 15) * (13.287712379549449f / 16.0f));
            const float p = (f < 16) ? (float)(pos / GRIDW) : (float)(pos % GRIDW); const float ang = p * inv; rc[i] = __builtin_amdgcn_cosf(ang * 0.15915494309189535f); rs[i] = __builtin_amdgcn_sinf(ang * 0.15915494309189535f); }
        LAS float* ct = (LAS float*)F.lds;
        __syncthreads();
        for (int m = tid; m < 2048; m += 512) ct[m] = __builtin_amdgcn_cosf((float)m * (1.0f / 2048.0f));
        __syncthreads();
        bf16* dl = (bf16*)(F.ws + WS_DFTL); const float sl = 0.022097086912079608f;
        for (int i = gt; i < 2048 * 2048; i += NT) {
            const int k = i >> 11, n = i & 2047, m = (k * n) & 2047; const float c = ct[m], s = ct[(m - 512) & 2047];
            dl[(size_t)k * 4096 + n] = (bf16)f2bf(c * sl); dl[(size_t)k * 4096 + 2048 + n] = (bf16)f2bf(-s * sl); }
        bf16* dc = (bf16*)(F.ws + WS_DFTC);
        for (int i = gt; i < 256 * 256; i += NT) { const int k = i >> 8, n = i & 255, m = ((k * n) & 255) * 8; const float c = ct[m], s = ct[(m - 512) & 2047];
            dc[(size_t)k * 512 + n] = (bf16)f2bf(c * 0.0625f); dc[(size_t)k * 512 + 256 + n] = (bf16)f2bf(-s * 0.0625f); }
        for (int layer = 0; layer < DEPTH; ++layer) {
            const float* win = inp(F, IN_WIN) + (size_t)layer * D * INW; bf16* wt = (bf16*)(F.ws + WS_WIN + layer * WIN_L) + (size_t)6144 * 1024;
            for (int i = gt; i < 1024 * 1024; i += NT) { const int k = i & 1023, no = i >> 10, part = no >> 9, g = (no >> 6) & 7, cp = no & 63;
                const float* src = win + (size_t)k * INW + g * 64; float s = 0.f;
                for (int c = 0; c < 64; ++c) { const int m = ((c * cp) & 63) * 32; const float t = part == 0 ? ct[m] : ct[(m - 512) & 2047]; s += src[c] * t; }
                wt[(size_t)no * 1024 + k] = (bf16)f2bf(s * 0.125f); }
        }
        __syncthreads();
    }
    {
        int base = 0;
        for (int layer = 0; layer < DEPTH; ++layer) {
            transpose_matrix(F, inp(F, IN_WIN) + (size_t)layer * D * INW, INW, 512, D, NPROJ, (bf16*)(F.ws + WS_WIN + layer * WIN_L), MapProj{}, base);
            transpose_matrix(F, inp(F, IN_WFO) + (size_t)layer * 512 * D, D, 0, 512, D, (bf16*)(F.ws + WS_WFO + (layer * 3 + 0) * WMG_ONE), MapId{0}, base);
            transpose_matrix(F, inp(F, IN_WRO) + (size_t)layer * 512 * D, D, 0, 512, D, (bf16*)(F.ws + WS_WFO + (layer * 3 + 1) * WMG_ONE), MapId{0}, base);
            transpose_matrix(F, inp(F, IN_WDO) + (size_t)layer * 512 * D, D, 0, 512, D, (bf16*)(F.ws + WS_WFO + (layer * 3 + 2) * WMG_ONE), MapId{0}, base);
            transpose_matrix(F, inp(F, IN_WOUT) + (size_t)layer * D * D, D, 0, D, D, (bf16*)(F.ws + WS_WOUT + layer * WOUT_L), MapId{0}, base);
        }
    }
    convert_expert_weights(F, 0);
}

__device__ __forceinline__ void phase_norm(Frame& F, int layer) {
    const int gw = F.vcu * 8 + F.wave, NGW = F.G * 8, lane = F.lane;
    const bool fin = layer == DEPTH; const int r_lo = (layer >= DEPTH - 1) ? (fin ? TC : 0) : 0;
    float* XR = (float*)(F.ws + WS_XR); const int* INV = (const int*)(F.ws + WS_INV); const bf16* YE = (const bf16*)(F.ws + WS_YE); bf16* HB = (bf16*)(F.ws + WS_HB);
    for (int r = r_lo + gw; r < TA; r += NGW) {
        const int v = vec_of_row(r);
        f32x4 x[4];
        if (layer == 0) { const float* src = r < TC ? inp(F, IN_CTX) + (size_t)r * D : inp(F, IN_X) + (size_t)(r - TC) * D;
#pragma unroll
            for (int j = 0; j < 4; ++j) x[j] = *(const f32x4*)(src + 4 * lane + 256 * j);
        } else {
            const float* src = XR + (size_t)r * D;
#pragma unroll
            for (int j = 0; j < 4; ++j) x[j] = *(const f32x4*)(src + 4 * lane + 256 * j);
            if (!(layer == DEPTH - 1 + 1 && false)) {
                const bool has_moe = !(layer == 1 && r < TC && false);
                if (has_moe) {
                    f32x4 s[4];
#pragma unroll
                    for (int j = 0; j < 4; ++j) s[j] = (f32x4){0.f, 0.f, 0.f, 0.f};
                    const int* inv = INV + (size_t)r * 16;
                    for (int e = 0; e < NE; ++e) { const int slot = __builtin_amdgcn_readfirstlane(inv[e]);
                        if (slot >= 0) { const bf16* y = YE + (size_t)slot * D;
#pragma unroll
                            for (int j = 0; j < 4; ++j) { const u32x2 w = *(const u32x2*)(y + 4 * lane + 256 * j); s[j] += (f32x4){bflo(w.x), bfhi(w.x), bflo(w.y), bfhi(w.y)}; } } }
                    const float* m5 = mod_ptr(F, layer - 1, v, 5);
#pragma unroll
                    for (int j = 0; j < 4; ++j) x[j] += *(const f32x4*)(m5 + 4 * lane + 256 * j) * s[j];
                }
            }
        }
        if (fin) {
#pragma unroll
            for (int j = 0; j < 4; ++j) *(f32x4*)(F.out + (size_t)(r - TC) * D + 4 * lane + 256 * j) = x[j];
            continue;
        }
        if (layer > 0) {
#pragma unroll
            for (int j = 0; j < 4; ++j) *(f32x4*)(XR + (size_t)r * D + 4 * lane + 256 * j) = x[j];
        }
        float ss = 0.f;
#pragma unroll
        for (int j = 0; j < 4; ++j) ss += (x[j].x * x[j].x + x[j].y * x[j].y) + (x[j].z * x[j].z + x[j].w * x[j].w);
        const float rinv = __builtin_amdgcn_rsqf(wave_sum(ss) * (1.0f / D) + EPS);
        const float* g = inp(F, IN_GATTN) + (size_t)layer * D; const float* sh = mod_ptr(F, layer, v, 0); const float* scl = mod_ptr(F, layer, v, 1);
#pragma unroll
        for (int j = 0; j < 4; ++j) { const int k = 4 * lane + 256 * j; const f32x4 gv = *(const f32x4*)(g + k), sv = *(const f32x4*)(sh + k), cv = *(const f32x4*)(scl + k);
            const f32x4 y = (x[j] * rinv * gv) * (cv + 1.0f) + sv;
            u32x2 w; w.x = pk2(y.x, y.y); w.y = pk2(y.z, y.w); *(u32x2*)(HB + (size_t)r * D + k) = w; }
    }
}

using pg8::Unit; using pg8::Acc;
struct SchedGrid {
    int nM, nN, G, c; const char* A; const char* B; size_t a_tile, b_tile; int pm_per_group; size_t b_group;
    __device__ __forceinline__ bool next(int i, Unit& u) const {
        int pm, pn; if (c < 0 || !pg8::grid_order((long)i * G + c, nM, nN, pm, pn)) return false;
        u.pm = pm; u.pn = pn; u.tag = 0; u.A = A + (size_t)pm * a_tile; u.B = B + (size_t)pn * b_tile + (pm_per_group ? (size_t)(pm / pm_per_group) * b_group : 0); return true; }
};
struct SchedMerge {
    int nM, nN, G, c; const char* A; const char* B; size_t a_seg, b_seg, a_tile, b_tile;
    __device__ __forceinline__ bool next(int i, Unit& u) const {
        const int t = i / 3, seg = i - 3 * t; int pm, pn; if (!pg8::grid_order((long)t * G + c, nM, nN, pm, pn)) return false;
        u.pm = pm; u.pn = pn; u.tag = seg; u.A = A + (size_t)seg * a_seg + (size_t)pm * a_tile; u.B = B + (size_t)seg * b_seg + (size_t)pn * b_tile; return true; }
};

struct EpiBf16 {
    static constexpr bool PERM = true;
    bf16* C; int ldc; int sig_pn0;
    __device__ __forceinline__ void operator()(Acc& acc, const Unit& u, int wr, int wc, int fr, int fq) const {
        const int row0 = u.pm * 256 + wr * 64 + fr, col0 = u.pn * 256 + wc * 32 + 8 * fq;
        const bool sig = u.pn >= sig_pn0;
#pragma unroll
        for (int ai = 0; ai < 2; ++ai)
#pragma unroll
            for (int m = 0; m < 4; ++m) { bf16* rowp = C + (size_t)(row0 + ai * 128 + m * 16) * ldc + col0;
#pragma unroll
                for (int bj = 0; bj < 2; ++bj) { f32x4 v0 = acc[ai][bj][m][0], v1 = acc[ai][bj][m][1];
                    if (sig) {
#pragma unroll
                        for (int j = 0; j < 4; ++j) { v0[j] = sigmoidf_(v0[j]); v1[j] = sigmoidf_(v1[j]); } }
                    u32x4 w; w.x = pk2(v0[0], v0[1]); w.y = pk2(v0[2], v0[3]); w.z = pk2(v1[0], v1[1]); w.w = pk2(v1[2], v1[3]);
                    *(u32x4*)(rowp + bj * 128) = w; } }
        pg8::zero_acc(acc);
    }
};
struct EpiGT {
    static constexpr bool PERM = true;
    bf16* GT; bf16* GTC;
    __device__ __forceinline__ void operator()(Acc& acc, const Unit& u, int wr, int wc, int fr, int fq) const {
        const int tok0 = u.pn * 256;
        bf16* base; int pitch, nseq, n0;
        if (tok0 < TC) { const int b = tok0 / CTX; base = GTC + (size_t)b * 512 * 512; pitch = 512; nseq = CTX; n0 = tok0 - b * CTX; }
        else { const int t = tok0 - TC, b = t / SEQ; base = GT + (size_t)b * 512 * 4096; pitch = 4096; nseq = SEQ; n0 = t - b * SEQ; }
        const int crow0 = u.pm * 256 + wr * 64 + fr, ccol0 = wc * 32 + 8 * fq;
#pragma unroll
        for (int ai = 0; ai < 2; ++ai)
#pragma unroll
            for (int m = 0; m < 4; ++m) { const int c = crow0 + ai * 128 + m * 16, part = c >> 9, ch = c & 511;
                bf16* rowp = base + (size_t)ch * pitch + part * nseq + n0 + ccol0;
#pragma unroll
                for (int bj = 0; bj < 2; ++bj) { const f32x4 v0 = acc[ai][bj][m][0], v1 = acc[ai][bj][m][1];
                    u32x4 w; w.x = pk2(v0[0], v0[1]); w.y = pk2(v0[2], v0[3]); w.z = pk2(v1[0], v1[1]); w.w = pk2(v1[2], v1[3]);
                    *(u32x4*)(rowp + bj * 128) = w; } }
        pg8::zero_acc(acc);
    }
};
struct EpiDFT {
    static constexpr bool PERM = true;
    bf16* FO; int nseq; int row_base0;
    __device__ __forceinline__ void operator()(Acc& acc, const Unit& u, int wr, int wc, int fr, int fq) const {
        const int k0 = u.pm * 256 + wr * 64 + fr, b = (u.pn * 256) >> 9, ch0 = ((u.pn * 256) & 511) + wc * 32 + 8 * fq;
        bf16* base = FO + (size_t)(row_base0 + b * nseq + k0) * 512 + ch0;
#pragma unroll
        for (int ai = 0; ai < 2; ++ai)
#pragma unroll
            for (int m = 0; m < 4; ++m) { bf16* rowp = base + (size_t)(ai * 128 + m * 16) * 512;
#pragma unroll
                for (int bj = 0; bj < 2; ++bj) { const f32x4 v0 = acc[ai][bj][m][0], v1 = acc[ai][bj][m][1];
                    u32x4 w; w.x = pk2(v0[0], v0[1]); w.y = pk2(v0[2], v0[3]); w.z = pk2(v1[0], v1[1]); w.w = pk2(v1[2], v1[3]);
                    *(u32x4*)(rowp + bj * 128) = w; } }
        pg8::zero_acc(acc);
    }
};
struct EpiMerge {
    static constexpr bool PERM = true;
    const bf16* PROJ; bf16* MIXB; int row_off;
    __device__ __forceinline__ void operator()(Acc& acc, const Unit& u, int wr, int wc, int fr, int fq) const {
        const int row0 = row_off + u.pm * 256 + wr * 64 + fr, col0 = u.pn * 256 + wc * 32 + 8 * fq, seg = u.tag;
#pragma unroll
        for (int ai = 0; ai < 2; ++ai)
#pragma unroll
            for (int m = 0; m < 4; ++m) { const size_t row = (size_t)(row0 + ai * 128 + m * 16);
#pragma unroll
                for (int bj = 0; bj < 2; ++bj) { const int col = col0 + bj * 128;
                    const u32x4 ga = *(const u32x4*)(PROJ + row * NPROJ + C_GATE + seg * 1024 + col);
                    float f[8];
                    if (seg < 2) { const u32x4 gb = *(const u32x4*)(PROJ + row * NPROJ + C_GATE + (seg + 1) * 1024 + col);
#pragma unroll
                        for (int q = 0; q < 4; ++q) { f[2 * q] = bflo(ga[q]) * __builtin_amdgcn_rcpf(bflo(gb[q])); f[2 * q + 1] = bfhi(ga[q]) * __builtin_amdgcn_rcpf(bfhi(gb[q])); }
                    } else {
#pragma unroll
                        for (int q = 0; q < 4; ++q) { f[2 * q] = bflo(ga[q]); f[2 * q + 1] = bfhi(ga[q]); }
                    }
                    f32x4 v0 = acc[ai][bj][m][0], v1 = acc[ai][bj][m][1];
                    v0 = v0 * (f32x4){f[0], f[1], f[2], f[3]}; v1 = v1 * (f32x4){f[4], f[5], f[6], f[7]};
                    if (seg < 2) { acc[ai][bj][m][0] = v0; acc[ai][bj][m][1] = v1; }
                    else { u32x4 w; w.x = pk2(v0[0], v0[1]); w.y = pk2(v0[2], v0[3]); w.z = pk2(v1[0], v1[1]); w.w = pk2(v1[2], v1[3]);
                        *(u32x4*)(MIXB + row * D + col) = w; acc[ai][bj][m][0] = (f32x4){0.f, 0.f, 0.f, 0.f}; acc[ai][bj][m][1] = (f32x4){0.f, 0.f, 0.f, 0.f}; } }
                asm volatile("" ::: "memory"); }
    }
};
struct EpiOut {
    static constexpr bool PERM = false;
    const float* base_ctx; const float* base_lat; float* XR; const float* mod2; int row_off;
    __device__ __forceinline__ void operator()(Acc& acc, const Unit& u, int wr, int wc, int fr, int fq) const {
        const int row0 = row_off + u.pm * 256 + wr * 64 + fr, col0 = u.pn * 256 + wc * 32 + 4 * fq;
        const int v = vec_of_row(row_off + u.pm * 256);
        f32x4 mv[2][2];
#pragma unroll
        for (int bj = 0; bj < 2; ++bj)
#pragma unroll
            for (int n = 0; n < 2; ++n) mv[bj][n] = *(const f32x4*)(mod2 + (size_t)v * 6144 + col0 + bj * 128 + n * 16);
#pragma unroll
        for (int ai = 0; ai < 2; ++ai)
#pragma unroll
            for (int m = 0; m < 4; ++m) { const int row = row0 + ai * 128 + m * 16;
                const float* bp = row < TC ? base_ctx + (size_t)row * D : base_lat + (size_t)(row - TC) * D; float* op = XR + (size_t)row * D;
#pragma unroll
                for (int bj = 0; bj < 2; ++bj)
#pragma unroll
                    for (int n = 0; n < 2; ++n) { const int c = col0 + bj * 128 + n * 16; *(f32x4*)(op + c) = *(const f32x4*)(bp + c) + mv[bj][n] * acc[ai][bj][m][n]; } }
        pg8::zero_acc(acc);
    }
};
struct EpiGU {
    static constexpr bool PERM = true;
    bf16* HID;
    __device__ __forceinline__ void operator()(Acc& acc, const Unit& u, int wr, int wc, int fr, int fq) const {
        const int row0 = u.pm * 256 + wr * 64 + fr, col0 = u.pn * 128 + wc * 32 + 8 * fq;
#pragma unroll
        for (int ai = 0; ai < 2; ++ai)
#pragma unroll
            for (int m = 0; m < 4; ++m) { float h[8];
#pragma unroll
                for (int n = 0; n < 2; ++n)
#pragma unroll
                    for (int j = 0; j < 4; ++j) { const float g = acc[ai][0][m][n][j], up = acc[ai][1][m][n][j]; h[4 * n + j] = siluf_(g) * up; }
                u32x4 w; w.x = pk2(h[0], h[1]); w.y = pk2(h[2], h[3]); w.z = pk2(h[4], h[5]); w.w = pk2(h[6], h[7]);
                *(u32x4*)(HID + (size_t)(row0 + ai * 128 + m * 16) * EH + col0) = w; }
        pg8::zero_acc(acc);
    }
};
struct EpiDown {
    static constexpr bool PERM = true;
    bf16* YE; const float* topw;
    __device__ __forceinline__ void operator()(Acc& acc, const Unit& u, int wr, int wc, int fr, int fq) const {
        const int row0 = u.pm * 256 + wr * 64 + fr, col0 = u.pn * 256 + wc * 32 + 8 * fq;
#pragma unroll
        for (int ai = 0; ai < 2; ++ai)
#pragma unroll
            for (int m = 0; m < 4; ++m) { const int row = row0 + ai * 128 + m * 16; const float tw = topw[row];
#pragma unroll
                for (int bj = 0; bj < 2; ++bj) { const f32x4 v0 = acc[ai][bj][m][0] * tw, v1 = acc[ai][bj][m][1] * tw;
                    u32x4 w; w.x = pk2(v0[0], v0[1]); w.y = pk2(v0[2], v0[3]); w.z = pk2(v1[0], v1[1]); w.w = pk2(v1[2], v1[3]);
                    *(u32x4*)(YE + (size_t)row * D + col0 + bj * 128) = w; } }
        pg8::zero_acc(acc);
    }
};

struct SchedInproj {
    int G, c, ncc; const char* HB; const char* WT;
    __device__ __forceinline__ bool next(int i, Unit& u) const {
        const long L = (long)i * G + c; int pm, pn;
        if (L < 64 * 28) { pg8::grid_order(L, 64, 28, pm, pn); pm += 8; }
        else { if (!pg8::grid_order(L - 64 * 28, 8, ncc, pm, pn)) return false; if (ncc == 7) pn = pn < 3 ? pn + 1 : pn + 5; }
        const size_t tile = (size_t)256 * D * 2;
        if (pn < 24) { u.pm = pm; u.pn = pn; u.A = HB + pm * tile; u.B = WT + pn * tile; u.tag = (pn < 2 || (pn >= 6 && pn < 10)) ? 2 : (pn >= 12 ? 1 : 0); }
        else { u.pm = pn - 24; u.pn = pm; u.A = WT + (size_t)(24 + pn - 24) * tile; u.B = HB + pm * tile; u.tag = 3; }
        return true; }
};
struct EpiInproj {
    static constexpr bool PERM = true;
    bf16* PROJ; bf16* GT; bf16* GTC; const float* rc; const float* rs; const float* qn; const float* kn;
    __device__ __forceinline__ void operator()(Acc& acc, const Unit& u, int wr, int wc, int fr, int fq) const {
        if (u.tag == 3) { EpiGT E{GT, GTC}; E(acc, u, wr, wc, fr, fq); return; }
        if (u.tag < 2) { EpiBf16 E{PROJ, NPROJ, u.tag == 1 ? 0 : 1000}; E(acc, u, wr, wc, fr, fq); return; }
        const int tile = u.pn; const bool is_d = tile >= 6, is_q = (tile == 0 || tile == 6 || tile == 7);
        f32x4 g1[2], g2[2];
        if (is_d) { const float* G = is_q ? qn : kn;
#pragma unroll
            for (int n = 0; n < 2; ++n) { g1[n] = *(const f32x4*)(G + 8 * fq + 4 * n); g2[n] = *(const f32x4*)(G + 32 + 8 * fq + 4 * n); } }
        const int row0 = u.pm * 256 + wr * 64 + fr; const bool lat = u.pm >= 8;
#pragma unroll
        for (int ai = 0; ai < 2; ++ai)
#pragma unroll
            for (int m = 0; m < 4; ++m) { const int row = row0 + ai * 128 + m * 16;
                f32x4 x1[2] = {acc[ai][0][m][0], acc[ai][0][m][1]}, x2[2] = {acc[ai][1][m][0], acc[ai][1][m][1]};
                if (is_d) {
                    float ss = 0.f;
#pragma unroll
                    for (int n = 0; n < 2; ++n) ss += (x1[n][0] * x1[n][0] + x1[n][1] * x1[n][1]) + (x1[n][2] * x1[n][2] + x1[n][3] * x1[n][3]) + (x2[n][0] * x2[n][0] + x2[n][1] * x2[n][1]) + (x2[n][2] * x2[n][2] + x2[n][3] * x2[n][3]);
                    ss += __shfl_xor(ss, 16); ss += __shfl_xor(ss, 32);
                    const float rinv = __builtin_amdgcn_rsqf(ss * (1.0f / 64.0f) + EPS);
#pragma unroll
                    for (int n = 0; n < 2; ++n) { x1[n] = x1[n] * rinv * g1[n]; x2[n] = x2[n] * rinv * g2[n]; }
                } else if (tile == 0) {
#pragma unroll
                    for (int n = 0; n < 2; ++n) { x1[n] = x1[n] * 0.125f; x2[n] = x2[n] * 0.125f; }
                }
                f32x4 o1[2], o2[2];
                if (lat) { const int pos = (row - TC) & (SEQ - 1);
#pragma unroll
                    for (int n = 0; n < 2; ++n) { const f32x4 c = *(const f32x4*)(rc + pos * 32 + 8 * fq + 4 * n), sn = *(const f32x4*)(rs + pos * 32 + 8 * fq + 4 * n);
                        o1[n] = x1[n] * c - x2[n] * sn; o2[n] = x2[n] * c + x1[n] * sn; }
                } else { o1[0] = x1[0]; o1[1] = x1[1]; o2[0] = x2[0]; o2[1] = x2[1]; }
                if (is_d && is_q) { const float k = 0.125f * LOG2E;
#pragma unroll
                    for (int n = 0; n < 2; ++n) { o1[n] = o1[n] * k; o2[n] = o2[n] * k; } }
                bf16* dst = PROJ + (size_t)row * NPROJ + tile * 256 + 64 * wc + 8 * fq;
                u32x4 w; w.x = pk2(o1[0][0], o1[0][1]); w.y = pk2(o1[0][2], o1[0][3]); w.z = pk2(o1[1][0], o1[1][1]); w.w = pk2(o1[1][2], o1[1][3]); *(u32x4*)dst = w;
                w.x = pk2(o2[0][0], o2[0][1]); w.y = pk2(o2[0][2], o2[0][3]); w.z = pk2(o2[1][0], o2[1][1]); w.w = pk2(o2[1][2], o2[1][3]); *(u32x4*)(dst + 32) = w;
                asm volatile("" ::: "memory"); }
        pg8::zero_acc(acc);
    }
};
__device__ __forceinline__ void phase_inproj(Frame& F, int layer) {
    const float* rc = (const float*)(F.ws + WS_ROPE);
    SchedInproj S{F.G, (int)blockIdx.x, layer == DEPTH - 1 ? 7 : 28, (const char*)(F.ws + WS_HB), (const char*)(F.ws + WS_WIN + layer * WIN_L)};
    EpiInproj E{(bf16*)(F.ws + WS_PROJ), (bf16*)(F.ws + WS_GT), (bf16*)(F.ws + WS_GTC), rc, rc + SEQ * 32, inp(F, IN_QN) + layer * 64, inp(F, IN_KN) + layer * 64};
    pg8::gemm_phase(F.lds, F.tid, D, S, E);
}

namespace att {
constexpr int KPITCH = 144, VPITCH = 320, KC_BYTES = 64 * KPITCH, V_BYTES = 64 * VPITCH, BUF_BYTES = 2 * KC_BYTES + V_BYTES;
constexpr int SCR_OFF = 2 * BUF_BYTES;
constexpr int QW_OFF = SCR_OFF + 8 * 256;
constexpr int S_OFF = 81920, S_BYTES = 128 * KPITCH;
__device__ __forceinline__ int crow(int r, int hi) { return (r & 3) + 8 * (r >> 2) + 4 * hi; }
__device__ __forceinline__ s16x4 vtr(const LAS unsigned char* p) { typedef short v4i16_t __attribute__((ext_vector_type(4))); return __builtin_bit_cast(s16x4, __builtin_amdgcn_ds_read_tr16_b64_v4i16((LAS v4i16_t*)p)); }

struct UnitDesc {
    int mode;
    int qrow0;
    int qpos0;
    int h;
    int krowA, ntA;
    int krowB, ntB;
    int kindB;
    int nseq;
    int outrow0;
    float lgf, lgb;
    float lam, scale_out;
    int cross, bh, blk;
};

template <int MODE> __device__ __forceinline__ void unit(const Frame& F, const UnitDesc& u) {
    LAS unsigned char* lds = F.lds;
    const int tid = F.tid, lane = F.lane, wid = F.wave, r32 = lane & 31, hi = lane >> 5;
    const bf16* PROJ = (const bf16*)(F.ws + WS_PROJ);
    constexpr bool diff = MODE == 0;
    const int comp = diff ? (wid >> 2) : 0;
    const int qoff = diff ? 32 * (wid & 3) : 32 * wid;
    const int kcol = diff ? C_DK + u.h * 128 : C_RK + u.h * 64, vcol = diff ? C_DV + u.h * 128 : C_RV + u.h * 128;
    const int qcol = diff ? C_DQ + u.h * 128 + comp * 64 : C_RQ + u.h * 64;
    const int NT = u.ntA + u.ntB;
    bf16x8 qf[4];
    { const bf16* qp = PROJ + (size_t)(u.qrow0 + qoff + r32) * NPROJ + qcol + 8 * hi;
#pragma unroll
      for (int s = 0; s < 4; ++s) qf[s] = *(const bf16x8*)(qp + 16 * s); }
    f32x16 o[4];
#pragma unroll
    for (int d = 0; d < 4; ++d) o[d] = (f32x16){};
    float lsum = 0.f;
    if (!diff && u.cross) {
        const float* LB = (const float*)(F.ws + WS_LBUF) + (size_t)u.bh * 9 * 2 * 64 * 128;
        const int dv = tid & 127, dg = tid >> 7, c = u.blk;
        float sf[16], sb[16];
#pragma unroll
        for (int k = 0; k < 16; ++k) { sf[k] = 0.f; sb[k] = 0.f; }
        for (int bp = 0; bp < 9; ++bp) {
            const float wf = bp == 8 ? __builtin_amdgcn_exp2f(u.lgf * 256.f * (float)c) : (bp < c ? __builtin_amdgcn_exp2f(u.lgf * 256.f * (float)(c - 1 - bp)) : 0.f);
            const float wb = bp == 8 ? __builtin_amdgcn_exp2f(u.lgb * 256.f * (float)(7 - c)) : (bp > c ? __builtin_amdgcn_exp2f(u.lgb * 256.f * (float)(bp - c - 1)) : 0.f);
            const float* Lf = LB + (size_t)(bp * 2 + 0) * 64 * 128 + (16 * dg) * 128 + dv; const float* Lb = Lf + 64 * 128;
            if (wf != 0.f) {
#pragma unroll
                for (int k = 0; k < 16; ++k) sf[k] += wf * Lf[k * 128]; }
            if (wb != 0.f) {
#pragma unroll
                for (int k = 0; k < 16; ++k) sb[k] += wb * Lb[k * 128]; }
        }
        LAS unsigned char* sp = lds + S_OFF + dv * KPITCH + dg * 32;
        *(LAS u32x4*)(sp) = (u32x4){pk2(sf[0], sf[1]), pk2(sf[2], sf[3]), pk2(sf[4], sf[5]), pk2(sf[6], sf[7])};
        *(LAS u32x4*)(sp + 16) = (u32x4){pk2(sf[8], sf[9]), pk2(sf[10], sf[11]), pk2(sf[12], sf[13]), pk2(sf[14], sf[15])};
        *(LAS u32x4*)(sp + S_BYTES) = (u32x4){pk2(sb[0], sb[1]), pk2(sb[2], sb[3]), pk2(sb[4], sb[5]), pk2(sb[6], sb[7])};
        *(LAS u32x4*)(sp + S_BYTES + 16) = (u32x4){pk2(sb[8], sb[9]), pk2(sb[10], sb[11]), pk2(sb[12], sb[13]), pk2(sb[14], sb[15])};
        __syncthreads();
        const int p = qoff + r32; const float ai = __builtin_amdgcn_exp2f(u.lgf * (float)(p + 1)), bi = __builtin_amdgcn_exp2f(u.lgb * (float)(256 - p));
#pragma unroll
        for (int s4 = 0; s4 < 4; ++s4) {
            const u32x4 qw = __builtin_bit_cast(u32x4, qf[s4]); u32x4 qa, qb;
#pragma unroll
            for (int q = 0; q < 4; ++q) { const float lo = bflo(qw[q]), hh = bfhi(qw[q]); qa[q] = pk2(lo * ai, hh * ai); qb[q] = pk2(lo * bi, hh * bi); }
#pragma unroll
            for (int d = 0; d < 4; ++d) {
                const LAS unsigned char* bp = lds + S_OFF + (32 * d + r32) * KPITCH + (16 * s4 + 8 * hi) * 2;
                o[d] = __builtin_amdgcn_mfma_f32_32x32x16_bf16(__builtin_bit_cast(bf16x8, qa), *(const LAS bf16x8*)bp, o[d], 0, 0, 0);
                o[d] = __builtin_amdgcn_mfma_f32_32x32x16_bf16(__builtin_bit_cast(bf16x8, qb), *(const LAS bf16x8*)(bp + S_BYTES), o[d], 0, 0, 0);
            }
        }
    }
    u32x4 kreg[2], vreg[2];
    auto tile_row = [&](int t) { return t < u.ntA ? u.krowA + 64 * t : u.krowB + 64 * (t - u.ntA); };
    unsigned voffV[2], voffK[2];
#pragma unroll
    for (int i = 0; i < 2; ++i) { const int cid = tid + 512 * i, key = cid >> 4, c16 = cid & 15;
        voffV[i] = (unsigned)((key * NPROJ + vcol + c16 * 8) * 2); voffK[i] = (unsigned)((key * NPROJ + kcol + c16 * 8) * 2); }
    if (!diff) { const int key = tid >> 3, c8 = tid & 7; voffK[0] = (unsigned)((key * NPROJ + kcol + c8 * 8) * 2); }
    auto load_tile = [&](int t) {
        const GAS unsigned char* tb = (const GAS unsigned char*)PROJ + (size_t)tile_row(t) * NPROJ * 2;
#pragma unroll
        for (int i = 0; i < 2; ++i) { vreg[i] = *(const GAS u32x4*)(tb + voffV[i]); if (diff) kreg[i] = *(const GAS u32x4*)(tb + voffK[i]); }
        if (!diff) kreg[0] = *(const GAS u32x4*)(tb + voffK[0]);
    };
    auto store_tile = [&](int buf) {
        LAS unsigned char* b = lds + buf * BUF_BYTES;
#pragma unroll
        for (int i = 0; i < 2; ++i) { const int cid = tid + 512 * i, key = cid >> 4, c16 = cid & 15;
            *(LAS u32x4*)(b + 2 * KC_BYTES + key * VPITCH + c16 * 16) = vreg[i];
            if (diff) *(LAS u32x4*)(b + (c16 >> 3) * KC_BYTES + key * KPITCH + (c16 & 7) * 16) = kreg[i]; }
        if (!diff) { const int key = tid >> 3, c8 = tid & 7; *(LAS u32x4*)(b + key * KPITCH + c8 * 16) = kreg[0]; }
    };
    load_tile(0); store_tile(0);
#pragma unroll
    for (int s4 = 0; s4 < 4; ++s4) asm volatile("" : "+v"(qf[s4]));
    __syncthreads();
    const int qpos = u.qpos0 + qoff + r32;
    for (int t = 0; t < NT; ++t) {
        if (t + 1 < NT) load_tile(t + 1);
        const LAS unsigned char* b = lds + (t & 1) * BUF_BYTES;
        const LAS unsigned char* kb = b + comp * KC_BYTES + r32 * KPITCH + hi * 16;
        u32x4 pw[4];
        const bool segB = t >= u.ntA; const int j0 = 64 * (segB ? t - u.ntA : t);
#pragma unroll
        for (int kh = 0; kh < 2; ++kh) {
            f32x16 sc = (f32x16){};
#pragma unroll
            for (int s = 0; s < 4; ++s) { const bf16x8 kf = *(const LAS bf16x8*)(kb + kh * 32 * KPITCH + s * 32); sc = __builtin_amdgcn_mfma_f32_32x32x16_bf16(kf, qf[s], sc, 0, 0, 0); }
            if (diff) {
#pragma unroll
                for (int r = 0; r < 16; ++r) sc[r] = __builtin_amdgcn_exp2f(sc[r]);
                float a = 0.f;
#pragma unroll
                for (int r = 0; r < 16; ++r) a += sc[r];
                lsum += a;
            } else if (!segB || u.kindB == 0) {
#pragma unroll
                for (int r = 0; r < 16; ++r) { const int d = qpos - (j0 + 32 * kh + crow(r, hi)); sc[r] *= __builtin_amdgcn_exp2f((float)d * (d >= 0 ? u.lgf : -u.lgb)); }
            } else {
#pragma unroll
                for (int r = 0; r < 16; ++r) { const int na = j0 + 32 * kh + crow(r, hi);
                    sc[r] *= __builtin_amdgcn_exp2f((float)(qpos + CTX - na) * u.lgf) + __builtin_amdgcn_exp2f((float)(u.nseq - qpos + na) * u.lgb); }
            }
            pw[2 * kh] = (u32x4){pk2(sc[0], sc[1]), pk2(sc[2], sc[3]), pk2(sc[4], sc[5]), pk2(sc[6], sc[7])};
            pw[2 * kh + 1] = (u32x4){pk2(sc[8], sc[9]), pk2(sc[10], sc[11]), pk2(sc[12], sc[13]), pk2(sc[14], sc[15])};
            __builtin_amdgcn_sched_barrier(0);
        }
        const LAS unsigned char* vb = b + 2 * KC_BYTES + (4 * hi + ((lane & 15) >> 2)) * VPITCH + ((lane >> 4) & 1) * 32 + (lane & 3) * 8;
        __builtin_amdgcn_sched_barrier(0);
#pragma unroll
        for (int dvb = 0; dvb < 4; ++dvb) {
#pragma unroll
            for (int ks = 0; ks < 4; ++ks) {
                const s16x4 lo = vtr(vb + ks * 16 * VPITCH + dvb * 64), hi4 = vtr(vb + ks * 16 * VPITCH + 8 * VPITCH + dvb * 64);
                const bf16x8 vf = (bf16x8){lo[0], lo[1], lo[2], lo[3], hi4[0], hi4[1], hi4[2], hi4[3]};
                o[dvb] = __builtin_amdgcn_mfma_f32_32x32x16_bf16(__builtin_bit_cast(bf16x8, pw[ks]), vf, o[dvb], 0, 0, 0);
            }
            __builtin_amdgcn_sched_barrier(0);
        }
        if (t + 1 < NT) store_tile((t + 1) & 1);
        __syncthreads();
    }
    LAS float* wsf = (LAS float*)(lds + SCR_OFF) + wid * 64;
    int lz = lane; asm volatile("" : "+v"(lz));
    const int r32e = lz & 31, hie = lz >> 5;
    if (diff) {
        lsum += __shfl_xor(lsum, 32);
        if (hie == 0) wsf[r32e] = __builtin_amdgcn_rcpf(lsum);
        LDS_WAIT();
        float rl[16];
#pragma unroll
        for (int r = 0; r < 16; ++r) rl[r] = wsf[crow(r, hie)];
        LAS float* XC = (LAS float*)lds;
        if (comp == 1) {
#pragma unroll
            for (int r = 0; r < 16; ++r) { const int q = qoff + crow(r, hie);
#pragma unroll
                for (int d = 0; d < 4; ++d) XC[q * 128 + 32 * d + r32e] = o[d][r] * rl[r] * u.lam; }
        }
        __syncthreads();
        if (comp == 0) {
            float ss[16];
#pragma unroll
            for (int r = 0; r < 16; ++r) { const int q = qoff + crow(r, hie); float a = 0.f;
#pragma unroll
                for (int d = 0; d < 4; ++d) { const float v = o[d][r] * rl[r] - XC[q * 128 + 32 * d + r32e]; o[d][r] = v; a += v * v; }
                ss[r] = a; }
#pragma unroll
            for (int r = 0; r < 16; ++r) { float a = ss[r]; a += __shfl_xor(a, 1); a += __shfl_xor(a, 2); a += __shfl_xor(a, 4); a += __shfl_xor(a, 8); a += __shfl_xor(a, 16);
                ss[r] = u.scale_out * __builtin_amdgcn_rsqf(a * (1.0f / 128.0f) + EPS); }
            bf16* DO = (bf16*)(F.ws + WS_FO + 2 * MIX_ONE);
#pragma unroll
            for (int r = 0; r < 16; ++r) { bf16* op = DO + (size_t)(u.outrow0 + qoff + crow(r, hie)) * 512 + u.h * 128 + r32e;
#pragma unroll
                for (int d = 0; d < 4; ++d) op[32 * d] = (bf16)f2bf(o[d][r] * ss[r]); }
        }
    } else {
        bf16* RO = (bf16*)(F.ws + WS_FO + 1 * MIX_ONE);
#pragma unroll
        for (int r = 0; r < 16; ++r) {
            float a = (o[0][r] + o[1][r]) + (o[2][r] + o[3][r]);
            a += __shfl_xor(a, 1); a += __shfl_xor(a, 2); a += __shfl_xor(a, 4); a += __shfl_xor(a, 8); a += __shfl_xor(a, 16);
            const float mu = a * (1.0f / 128.0f); float q = 0.f;
#pragma unroll
            for (int d = 0; d < 4; ++d) { const float v = o[d][r] - mu; o[d][r] = v; q += v * v; }
            q += __shfl_xor(q, 1); q += __shfl_xor(q, 2); q += __shfl_xor(q, 4); q += __shfl_xor(q, 8); q += __shfl_xor(q, 16);
            const float rstd = __builtin_amdgcn_rsqf(q * (1.0f / 128.0f) + EPS);
            const size_t row = (size_t)(u.outrow0 + qoff + crow(r, hie));
            const bf16* gp = PROJ + row * NPROJ + C_RG + u.h * 128 + r32e; bf16* op = RO + row * 512 + u.h * 128 + r32e;
#pragma unroll
            for (int d = 0; d < 4; ++d) { const float g = bf2f(gp[32 * d]); op[32 * d] = (bf16)f2bf(o[d][r] * rstd * siluf_(g)); }
        }
    }
    __syncthreads();
}
}

namespace rst {
constexpr int KP = 192, VP = 320, KB_BYTES = 128 * KP, VB_BYTES = 128 * VP;
__device__ __forceinline__ void unit(const Frame& F, int layer, int b, int h, int blk) {
    LAS unsigned char* lds = F.lds; const int tid = F.tid, lane = F.lane, wid = F.wave, hi = lane >> 5;
    const bf16* PROJ = (const bf16*)(F.ws + WS_PROJ);
    const int row0 = blk < 8 ? TC + b * SEQ + blk * 256 : b * CTX;
    const float lgf = inp(F, IN_RDEC)[(layer * 2 + 0) * 4 + h] * LOG2E, lgb = inp(F, IN_RDEC)[(layer * 2 + 1) * 4 + h] * LOG2E;
    const int dir = wid >> 2, dvb = wid & 3;
    f32x16 acc0 = (f32x16){}, acc1 = (f32x16){};
    for (int half = 0; half < 2; ++half) {
#pragma unroll
        for (int i = 0; i < 2; ++i) { const int cid = tid + 512 * i, tok = cid >> 3, c8 = cid & 7, p = half * 128 + tok;
            const u32x4 kv = *(const u32x4*)(PROJ + (size_t)(row0 + p) * NPROJ + C_RK + h * 64 + c8 * 8);
            const float wf = __builtin_amdgcn_exp2f((float)(255 - p) * lgf), wb = __builtin_amdgcn_exp2f((float)p * lgb);
            u32x4 kf, kb;
#pragma unroll
            for (int q = 0; q < 4; ++q) { const float lo = bflo(kv[q]), hh = bfhi(kv[q]); kf[q] = pk2(lo * wf, hh * wf); kb[q] = pk2(lo * wb, hh * wb); }
            *(LAS u32x4*)(lds + tok * KP + c8 * 16) = kf; *(LAS u32x4*)(lds + KB_BYTES + tok * KP + c8 * 16) = kb; }
#pragma unroll
        for (int i = 0; i < 4; ++i) { const int cid = tid + 512 * i, tok = cid >> 4, c16 = cid & 15, p = half * 128 + tok;
            *(LAS u32x4*)(lds + 2 * KB_BYTES + tok * VP + c16 * 16) = *(const u32x4*)(PROJ + (size_t)(row0 + p) * NPROJ + C_RV + h * 128 + c16 * 8); }
        __syncthreads();
        const LAS unsigned char* ka = lds + dir * KB_BYTES + (8 * hi + ((lane & 15) >> 2)) * KP + ((lane >> 4) & 1) * 32 + (lane & 3) * 8;
        const LAS unsigned char* va = lds + 2 * KB_BYTES + (8 * hi + ((lane & 15) >> 2)) * VP + dvb * 64 + ((lane >> 4) & 1) * 32 + (lane & 3) * 8;
#pragma unroll
        for (int ks = 0; ks < 8; ++ks) {
            const s16x4 v0 = att::vtr(va + ks * 16 * VP), v1 = att::vtr(va + ks * 16 * VP + 4 * VP);
            const bf16x8 vf = (bf16x8){v0[0], v0[1], v0[2], v0[3], v1[0], v1[1], v1[2], v1[3]};
            const s16x4 a0 = att::vtr(ka + ks * 16 * KP), a1 = att::vtr(ka + ks * 16 * KP + 4 * KP);
            const s16x4 b0 = att::vtr(ka + ks * 16 * KP + 64), b1 = att::vtr(ka + ks * 16 * KP + 4 * KP + 64);
            acc0 = __builtin_amdgcn_mfma_f32_32x32x16_bf16((bf16x8){a0[0], a0[1], a0[2], a0[3], a1[0], a1[1], a1[2], a1[3]}, vf, acc0, 0, 0, 0);
            acc1 = __builtin_amdgcn_mfma_f32_32x32x16_bf16((bf16x8){b0[0], b0[1], b0[2], b0[3], b1[0], b1[1], b1[2], b1[3]}, vf, acc1, 0, 0, 0);
        }
        __syncthreads();
    }
    float* L = (float*)(F.ws + WS_LBUF) + ((size_t)((b * 4 + h) * 9 + blk) * 2 + dir) * 64 * 128;
    const int r32 = lane & 31;
#pragma unroll
    for (int r = 0; r < 16; ++r) { const int d = att::crow(r, hi); L[(size_t)d * 128 + 32 * dvb + r32] = acc0[r]; L[(size_t)(32 + d) * 128 + 32 * dvb + r32] = acc1[r]; }
}
}
__device__ __forceinline__ void phase_retstate(Frame& F, int layer) {
    for (int i = F.vcu; i < 288; i += F.G) { const int blk = i % 9, bh = i / 9; rst::unit(F, layer, bh >> 2, bh & 3, blk); }
}


constexpr int NDFT_CU = 128;

__device__ __forceinline__ void phase_mixers(Frame& F, int layer, int rep) {
    const bool last = layer == DEPTH - 1;
#if !defined(ONLY_SUB) || ONLY_SUB == 1
    if ((int)blockIdx.x < NDFT_CU && F.G > NDFT_CU) {
        {
            SchedGrid S{SEQ / 256, 4096 / 256, NDFT_CU, (int)blockIdx.x, (const char*)(F.ws + WS_DFTL), (const char*)(F.ws + WS_GT), (size_t)256 * 4096 * 2, (size_t)256 * 4096 * 2, 0, 0};
            EpiDFT E{(bf16*)(F.ws + WS_FO), SEQ, TC};
            pg8::gemm_phase(F.lds, F.tid, 4096, S, E);
        }
        if (!last) {
            SchedGrid S{1, 4096 / 256, NDFT_CU, (int)blockIdx.x, (const char*)(F.ws + WS_DFTC), (const char*)(F.ws + WS_GTC), (size_t)256 * 512 * 2, (size_t)256 * 512 * 2, 0, 0};
            EpiDFT E{(bf16*)(F.ws + WS_FO), CTX, 0};
            pg8::gemm_phase(F.lds, F.tid, 512, S, E);
        }
    }
#endif
#if defined(ONLY_SUB) && ONLY_SUB == 1
    return;
#endif
    const int nunits = last ? 768 : 864;
    const float lam = lam_of(F, layer), so = 1.0f - lam_init_of(layer);
    unsigned* qctr = F.ctl + CW_QUEUE + 64 * (layer + 2 * rep);
    volatile LAS unsigned* qw = (volatile LAS unsigned*)(F.lds + att::QW_OFF);
    const bool solo = F.G <= NDFT_CU;
    (void)solo;
    for (;;) {
        if (F.tid == 0) *qw = __hip_atomic_fetch_add(qctr, 1u, RLX_AGENT);
        __syncthreads();
        const int i = (int)*qw;
        __syncthreads();
        if (i >= nunits) break;
        att::UnitDesc u{};
        u.lam = lam; u.scale_out = so;
        if (i < 512) { const int b = i >> 6, h = (i >> 4) & 3, qb = i & 15; u.mode = 0; u.h = h; u.qrow0 = TC + b * SEQ + qb * 128; u.qpos0 = qb * 128; u.krowA = TC + b * SEQ; u.ntA = 32; u.krowB = b * CTX; u.ntB = 4; }
        else if (i < 768) { const int j = i - 512, b = j >> 5, h = (j >> 3) & 3, qb = j & 7; u.mode = 1; u.h = h; u.qrow0 = TC + b * SEQ + qb * 256; u.qpos0 = 0; u.krowA = u.qrow0; u.ntA = 4; u.krowB = 0; u.ntB = 0; u.kindB = 0; u.nseq = SEQ; u.cross = 1; u.bh = b * 4 + h; u.blk = qb; }
        else if (i < 832) { const int j = i - 768, b = j >> 3, h = (j >> 1) & 3, qb = j & 1; u.mode = 0; u.h = h; u.qrow0 = b * CTX + qb * 128; u.qpos0 = qb * 128; u.krowA = b * CTX; u.ntA = 4; u.krowB = 0; u.ntB = 0; }
        else { const int j = i - 832, b = j >> 2, h = j & 3; u.mode = 1; u.h = h; u.qrow0 = b * CTX; u.qpos0 = 0; u.krowA = b * CTX; u.ntA = 4; u.krowB = 0; u.ntB = 0; u.kindB = 0; u.nseq = CTX; }
        u.outrow0 = u.qrow0;
        if (u.mode == 1) { u.lgf = inp(F, IN_RDEC)[(layer * 2 + 0) * 4 + u.h] * LOG2E; u.lgb = inp(F, IN_RDEC)[(layer * 2 + 1) * 4 + u.h] * LOG2E; }
        if (u.mode == 0) att::unit<0>(F, u); else att::unit<1>(F, u);
    }
}

__device__ __forceinline__ void phase_merge(Frame& F, int layer) {
    const int row_off = layer == DEPTH - 1 ? TC : 0, M = TA - row_off;
    SchedMerge S{M / 256, D / 256, F.G, (int)blockIdx.x, (const char*)(F.ws + WS_FO) + (size_t)row_off * 512 * 2, (const char*)(F.ws + WS_WFO + (size_t)layer * 3 * WMG_ONE), MIX_ONE, WMG_ONE, (size_t)256 * 512 * 2, (size_t)256 * 512 * 2};
    EpiMerge E{(const bf16*)(F.ws + WS_PROJ), (bf16*)(F.ws + WS_MIXB), row_off};
    pg8::gemm_phase(F.lds, F.tid, 512, S, E);
}
__device__ __forceinline__ void phase_outproj(Frame& F, int layer) {
    const int row_off = layer == DEPTH - 1 ? TC : 0, M = TA - row_off;
    SchedGrid S{M / 256, D / 256, F.G, (int)blockIdx.x, (const char*)(F.ws + WS_MIXB) + (size_t)row_off * D * 2, (const char*)(F.ws + WS_WOUT + layer * WOUT_L), (size_t)256 * D * 2, (size_t)256 * D * 2, 0, 0};
    const float* XR = (const float*)(F.ws + WS_XR);
    EpiOut E{layer == 0 ? inp(F, IN_CTX) : XR, layer == 0 ? inp(F, IN_X) : XR + (size_t)TC * D, (float*)(F.ws + WS_XR), (const float*)(F.ws + WS_MOD) + (size_t)layer * 9 * 6144 + 2 * 1024, row_off};
    pg8::gemm_phase(F.lds, F.tid, D, S, E);
}

__device__ __forceinline__ void phase_norm2(Frame& F, int layer) {
    const int gw = F.vcu * 8 + F.wave, NGW = F.G * 8, lane = F.lane, tid = F.tid;
    LAS float* wr_t = (LAS float*)F.lds;
    const float* wrt = inp(F, IN_WROUTER) + (size_t)layer * D * NE;
    for (int i = tid; i < D * NE; i += 512) { const int k = i >> 4, e = i & 15; wr_t[e * 1024 + k] = wrt[i]; }
    __syncthreads();
    const int r_lo = layer == DEPTH - 1 ? TC : 0;
    const float* XR = (const float*)(F.ws + WS_XR); bf16* HB = (bf16*)(F.ws + WS_HB); float* AFF = (float*)(F.ws + WS_AFF);
    for (int r = r_lo + gw; r < TA; r += NGW) {
        const int v = vec_of_row(r);
        f32x4 x[4];
#pragma unroll
        for (int j = 0; j < 4; ++j) x[j] = *(const f32x4*)(XR + (size_t)r * D + 4 * lane + 256 * j);
        float ss = 0.f;
#pragma unroll
        for (int j = 0; j < 4; ++j) ss += (x[j].x * x[j].x + x[j].y * x[j].y) + (x[j].z * x[j].z + x[j].w * x[j].w);
        const float rinv = __builtin_amdgcn_rsqf(wave_sum(ss) * (1.0f / D) + EPS);
        const float* g = inp(F, IN_GFFN) + (size_t)layer * D; const float* sh = mod_ptr(F, layer, v, 3); const float* scl = mod_ptr(F, layer, v, 4);
#pragma unroll
        for (int j = 0; j < 4; ++j) { const int k = 4 * lane + 256 * j; const f32x4 gv = *(const f32x4*)(g + k), sv = *(const f32x4*)(sh + k), cv = *(const f32x4*)(scl + k);
            x[j] = (x[j] * rinv * gv) * (cv + 1.0f) + sv;
            u32x2 w; w.x = pk2(x[j].x, x[j].y); w.y = pk2(x[j].z, x[j].w); *(u32x2*)(HB + (size_t)r * D + k) = w; }
        float mine = 0.f;
#pragma unroll
        for (int eg = 0; eg < 4; ++eg) {
            float a[4];
#pragma unroll
            for (int q = 0; q < 4; ++q) { float t = 0.f;
#pragma unroll
                for (int j = 0; j < 4; ++j) { const f32x4 w = *(const LAS f32x4*)(wr_t + (4 * eg + q) * 1024 + 4 * lane + 256 * j); t += (x[j].x * w.x + x[j].y * w.y) + (x[j].z * w.z + x[j].w * w.w); }
                a[q] = t; }
#pragma unroll
            for (int o = 1; o < 64; o <<= 1) {
#pragma unroll
                for (int q = 0; q < 4; ++q) a[q] += __shfl_xor(a[q], o); }
#pragma unroll
            for (int q = 0; q < 4; ++q) mine = (lane == 4 * eg + q) ? a[q] : mine;
            asm volatile("" ::: "memory");
        }
        float mx = mine;
        mx = fmaxf(mx, __shfl_xor(mx, 1)); mx = fmaxf(mx, __shfl_xor(mx, 2)); mx = fmaxf(mx, __shfl_xor(mx, 4)); mx = fmaxf(mx, __shfl_xor(mx, 8));
        const float ex = __expf(mine - mx); float den = ex;
        den += __shfl_xor(den, 1); den += __shfl_xor(den, 2); den += __shfl_xor(den, 4); den += __shfl_xor(den, 8);
        if (lane < 16) AFF[(size_t)r * 16 + lane] = ex * __builtin_amdgcn_rcpf(den);
    }
    __syncthreads();
}

__device__ __forceinline__ void phase_topk(Frame& F, int layer) {
    const bool last = layer == DEPTH - 1; const int tid = F.tid, lane = F.lane, wave = F.wave;
    const int RPE = last ? 2048 : 2304, lat_off = last ? 0 : 256;
    LAS unsigned* part = (LAS unsigned*)F.lds;
    LAS unsigned* cntG = part + 16;
    LAS unsigned* cntE = cntG + 32;
    LAS int* lst = (LAS int*)(cntE + 32);
    const float* AFF = (const float*)(F.ws + WS_AFF); int* INV = (int*)(F.ws + WS_INV); float* TOPW = (float*)(F.ws + WS_TOPW);
    const bf16* HB = (const bf16*)(F.ws + WS_HB); bf16* XS = (bf16*)(F.ws + WS_XS);
    const int nitems = last ? 128 : 256;
    for (int item = F.vcu; item < nitems; item += F.G) {
        int n, C, tokrow0, e, slot0;
        if (item < 128) { const int b = item >> 4; e = item & 15; n = SEQ; C = 256; tokrow0 = TC + b * SEQ; slot0 = e * RPE + lat_off + b * 256; }
        else { const int be = item - 128, b = be >> 4; e = be & 15; n = CTX; C = 32; tokrow0 = b * CTX; slot0 = e * RPE + b * 32; }
        float v[4]; unsigned key[4];
#pragma unroll
        for (int q = 0; q < 4; ++q) { const int i = tid + 512 * q; v[q] = i < n ? AFF[(size_t)(tokrow0 + i) * 16 + e] : 0.f; key[q] = __builtin_bit_cast(unsigned, v[q]); }
        unsigned t = 0u;
        for (int bit = 30; bit >= 0; --bit) {
            const unsigned cand = t | (1u << bit); unsigned c = 0u;
#pragma unroll
            for (int q = 0; q < 4; ++q) c += (unsigned)__builtin_popcountll(__ballot(key[q] >= cand));
            if (lane == 0) part[(bit & 1) * 8 + wave] = c;
            __syncthreads();
            unsigned tot = 0u;
#pragma unroll
            for (int w = 0; w < 8; ++w) tot += part[(bit & 1) * 8 + w];
            if (tot >= (unsigned)C) t = cand;
        }
        unsigned long long bg[4], be_[4];
#pragma unroll
        for (int q = 0; q < 4; ++q) { bg[q] = __ballot(key[q] > t); be_[q] = __ballot(key[q] == t && key[q] != 0u);
            if (lane == 0) { cntG[q * 8 + wave] = (unsigned)__builtin_popcountll(bg[q]); cntE[q * 8 + wave] = (unsigned)__builtin_popcountll(be_[q]); } }
        __syncthreads();
        unsigned totG = 0u, baseG[4] = {0u, 0u, 0u, 0u}, baseE[4] = {0u, 0u, 0u, 0u}; unsigned runG = 0u, runE = 0u;
#pragma unroll
        for (int q = 0; q < 4; ++q)
#pragma unroll
            for (int w = 0; w < 8; ++w) { const unsigned g = cntG[q * 8 + w], ee = cntE[q * 8 + w]; if (w == wave) { baseG[q] = runG; baseE[q] = runE; } runG += g; runE += ee; }
        totG = runG;
        const unsigned need = (unsigned)C - totG;
        const unsigned long long lt = (1ull << lane) - 1ull;
#pragma unroll
        for (int q = 0; q < 4; ++q) { const int i = tid + 512 * q;
            if (i < n) {
                const bool g = (bg[q] >> lane) & 1ull, eq = (be_[q] >> lane) & 1ull;
                const unsigned myG = baseG[q] + (unsigned)__builtin_popcountll(bg[q] & lt), myE = baseE[q] + (unsigned)__builtin_popcountll(be_[q] & lt);
                int sl = -1;
                if (g) sl = (int)myG; else if (eq && myE < need) sl = (int)(totG + myE);
                const int R = sl >= 0 ? slot0 + sl : -1;
                INV[(size_t)(tokrow0 + i) * 16 + e] = R;
                if (sl >= 0) { TOPW[R] = v[q]; lst[sl] = i; }
            } }
        __syncthreads();
        for (int sidx = wave; sidx < C; sidx += 8) { const int i = lst[sidx];
            const u32x4* src = (const u32x4*)(HB + (size_t)(tokrow0 + i) * D); u32x4* dst = (u32x4*)(XS + (size_t)(slot0 + sidx) * D);
            const u32x4 a = src[lane], bq = src[lane + 64]; dst[lane] = a; dst[lane + 64] = bq; }
        __syncthreads();
    }
}

__device__ __forceinline__ void phase_gateup(Frame& F, int layer) {
    const int RPE = layer == DEPTH - 1 ? 2048 : 2304;
    SchedGrid S{NE * RPE / 256, 4096 / 256, F.G, (int)blockIdx.x, (const char*)(F.ws + WS_XS), (const char*)(F.ws + WS_WGU), (size_t)256 * D * 2, (size_t)256 * D * 2, RPE / 256, WGU_E};
    EpiGU E{(bf16*)(F.ws + WS_HID)};
    pg8::gemm_phase(F.lds, F.tid, D, S, E);
}
__device__ __forceinline__ void phase_down(Frame& F, int layer) {
    const int RPE = layer == DEPTH - 1 ? 2048 : 2304;
    SchedGrid S{NE * RPE / 256, D / 256, F.G, (int)blockIdx.x, (const char*)(F.ws + WS_HID), (const char*)(F.ws + WS_WD), (size_t)256 * EH * 2, (size_t)256 * EH * 2, RPE / 256, WD_E};
    EpiDown E{(bf16*)(F.ws + WS_YE), (const float*)(F.ws + WS_TOPW)};
    pg8::gemm_phase(F.lds, F.tid, EH, S, E);
}

constexpr int NPHASE = 1 + 10 * DEPTH + 1;
__global__ void __launch_bounds__(512, 2) mk_fwd(Args args) {
    extern __shared__ __attribute__((aligned(16))) unsigned char lds_raw[];
    Frame F;
    F.lds = (LAS unsigned char*)lds_raw; F.MISC = (volatile LAS unsigned*)(F.lds + MISC_OFF);
    F.tid = threadIdx.x; F.lane = F.tid & 63; F.wave = __builtin_amdgcn_readfirstlane(F.tid >> 6);
    F.G = gridDim.x; { const int bx = blockIdx.x; F.vcu = (F.G % 8 == 0) ? (bx % 8) * (F.G / 8) + bx / 8 : bx; }
    F.ws = (unsigned char*)(GAS unsigned char*)(unsigned long long)args.ws; F.ctl = (unsigned*)(F.ws + WS_CTL); F.out = (float*)(GAS float*)(unsigned long long)args.out;
    for (int u = F.tid; u < (LDS_BYTES - LDSCTL_OFF) / 4; u += 512) ((LAS unsigned*)(F.lds + LDSCTL_OFF))[u] = 0u;
    __syncthreads();
    XcdBarrier bar; bar.bar = F.ctl + CW_BAR; bar.x = 0; bar.st = nullptr;
    const bool multi = (args.ph_hi - args.ph_lo) > 1;
    if (multi) bar = xcd_barrier_post(F.ctl + CW_BAR, F.MISC + 8);
    for (int ph = args.ph_lo; ph < args.ph_hi; ++ph) {
        const int layer = (ph - 1) / 10, k = (ph == 0) ? 10 : (ph == NPHASE - 1) ? 12 : (ph - 1) % 10;
        int reps = 1 + ((PROBE_MASK >> k) & 1);
        if (k == 0 && layer > 0 && (PROBE_MASK & 2048)) reps = 2;
        for (int rep = 0; rep < reps; ++rep) {
            { unsigned long long w = (unsigned long long)args.ws; asm volatile("" : "+s"(w)); F.ws = (unsigned char*)(GAS unsigned char*)w; F.ctl = (unsigned*)(F.ws + WS_CTL); }
            { unsigned long long kp = (unsigned long long)__builtin_amdgcn_kernarg_segment_ptr(); asm volatile("" : "+s"(kp)); F.karg = (const void __attribute__((address_space(4)))*)kp; }
            { int l = (int)__builtin_amdgcn_mbcnt_hi(~0u, __builtin_amdgcn_mbcnt_lo(~0u, 0u)); asm volatile("" : "+v"(l)); F.lane = l; F.tid = F.wave * 64 + l; }
#ifdef ONLY_PHASE
            if (k != ONLY_PHASE) continue;
#endif
            switch (k) {
                case 10: phase_prologue(F); break;
                case 12: phase_norm(F, DEPTH); break;
                case 0: if (rep == 0) phase_norm(F, layer); if (layer > 0) convert_expert_weights(F, layer); break;
                case 1: phase_inproj(F, layer); break;
                case 2: phase_retstate(F, layer); break;
                case 3: phase_mixers(F, layer, rep); break;
                case 4: phase_merge(F, layer); break;
                case 5: if (rep == 0) phase_outproj(F, layer); break;
                case 6: phase_norm2(F, layer); break;
                case 7: phase_topk(F, layer); break;
                case 8: phase_gateup(F, layer); break;
                default: phase_down(F, layer); break;
            }
            if (rep + 1 < reps || ph + 1 < args.ph_hi) xcd_barrier(bar);
        }
    }
}

extern "C" void kernel_launch(void* const* d_in, const int* in_sizes, int n_in, void* d_out, int out_size, void* d_ws, size_t ws_size, hipStream_t stream) {
    static int grid = 0;
    if (grid == 0) {
        if (n_in != 21 || out_size != TL * D || ws_size < WS_END) { fprintf(stderr, "kernel_launch: unexpected shapes (n_in %d, out %d, ws %zu need %zu)\n", n_in, out_size, ws_size, (size_t)WS_END); grid = -1; return; }
        int dev = 0, cus = 0, per_cu = 0;
        if (hipGetDevice(&dev) != hipSuccess || hipDeviceGetAttribute(&cus, hipDeviceAttributeMultiprocessorCount, dev) != hipSuccess) { grid = -1; return; }
        if (hipFuncSetAttribute((const void*)mk_fwd, hipFuncAttributeMaxDynamicSharedMemorySize, LDS_BYTES) != hipSuccess) { fprintf(stderr, "kernel_launch: hipFuncSetAttribute failed\n"); grid = -1; return; }
        if (hipOccupancyMaxActiveBlocksPerMultiprocessor(&per_cu, (const void*)mk_fwd, 512, LDS_BYTES) != hipSuccess || per_cu < 1) { fprintf(stderr, "kernel_launch: occupancy query says %d\n", per_cu); per_cu = 1; }
        (void)hipGetLastError();
        grid = cus * (per_cu >= 1 ? 1 : 1);
        if (grid % 8 != 0 || grid <= NDFT_CU) fprintf(stderr, "kernel_launch: unusual grid %d\n", grid);
    }
    if (grid < 0) return;
    (void)hipMemsetAsync((char*)d_ws + WS_CTL, 0, CTL_BYTES, stream);
    Args a{};
    for (int i = 0; i < 21; ++i) a.in[i] = (const float*)d_in[i];
    a.out = (float*)d_out; a.ws = (unsigned char*)d_ws;
#if MK_MULTI_LAUNCH
    for (int ph = 0; ph < NPHASE; ++ph) { a.ph_lo = ph; a.ph_hi = ph + 1; hipLaunchKernelGGL(mk_fwd, dim3(grid), dim3(512), LDS_BYTES, stream, a); }
#else
    a.ph_lo = 0; a.ph_hi = NPHASE;
    void* kargs[] = {&a};
    hipError_t e = hipLaunchCooperativeKernel((const void*)mk_fwd, dim3(grid), dim3(512), kargs, LDS_BYTES, stream);
    if (e != hipSuccess) fprintf(stderr, "kernel_launch: cooperative launch failed: %s (grid %d)\n", hipGetErrorString(e), grid);
#endif
}
```

```cpp
#include <hip/hip_runtime.h>
#include <cstdio>
#include <cstdint>

#ifndef PROBE_MASK
#define PROBE_MASK 0
#endif
#ifndef PROBE_MIX
#define PROBE_MIX 0
#endif
#ifndef MK_MULTI_LAUNCH
#define MK_MULTI_LAUNCH 0
#endif

#define GAS __attribute__((address_space(1)))
#define LAS __attribute__((address_space(3)))
typedef unsigned short bf16;
typedef short bf16x8 __attribute__((ext_vector_type(8)));
typedef short s16x4 __attribute__((ext_vector_type(4)));
typedef float f32x4 __attribute__((ext_vector_type(4)));
typedef float f32x16 __attribute__((ext_vector_type(16)));
typedef unsigned u32x4 __attribute__((ext_vector_type(4)));
typedef unsigned u32x2 __attribute__((ext_vector_type(2)));
typedef float f32x2_t __attribute__((ext_vector_type(2)));
typedef __bf16 bf16x2_t __attribute__((ext_vector_type(2)));

constexpr int D = 1024, NB = 8, SEQ = 2048, CTX = 256, DEPTH = 2, GRIDW = 64;
constexpr int TC = NB * CTX, TL = NB * SEQ, TA = TC + TL;
constexpr int NPROJ = 6144;
constexpr int C_RQ = 0, C_RK = 256, C_RV = 512, C_RG = 1024, C_DQ = 1536, C_DK = 2048, C_DV = 2560, C_GATE = 3072;
constexpr int INW = 6656;
constexpr int NE = 16, EH = 2048;
constexpr float EPS = 1e-6f;
constexpr float LOG2E = 1.4426950408889634f;

constexpr size_t al(size_t x) { return (x + 0xFFFFFull) & ~0xFFFFFull; }
constexpr size_t WS_CTL = 0, CTL_BYTES = 1u << 20;
constexpr size_t WS_MOD = WS_CTL + CTL_BYTES;
constexpr size_t WS_ROPE = WS_MOD + al((size_t)DEPTH * 9 * 6 * D * 4);
constexpr size_t WS_AFF = WS_ROPE + al((size_t)2 * SEQ * 32 * 4);
constexpr size_t WS_INV = WS_AFF + al((size_t)TA * 16 * 4);
constexpr size_t WS_TOPW = WS_INV + al((size_t)TA * 16 * 4);
constexpr size_t WS_WIN = WS_TOPW + al((size_t)36864 * 4);
constexpr size_t WIN_L = (size_t)7168 * 1024 * 2;
constexpr size_t WS_WFO = WS_WIN + al(2 * WIN_L);
constexpr size_t WMG_ONE = (size_t)1024 * 512 * 2;
constexpr size_t WS_WOUT = WS_WFO + al(6 * WMG_ONE);
constexpr size_t WOUT_L = (size_t)1024 * 1024 * 2;
constexpr size_t WS_WGU = WS_WOUT + al(2 * WOUT_L);
constexpr size_t WGU_E = (size_t)4096 * 1024 * 2;
constexpr size_t WS_WD = WS_WGU + al(16 * WGU_E);
constexpr size_t WD_E = (size_t)1024 * 2048 * 2;
constexpr size_t WS_DFTL = WS_WD + al(16 * WD_E);
constexpr size_t WS_DFTC = WS_DFTL + al((size_t)2048 * 4096 * 2);
constexpr size_t WS_XR = WS_DFTC + al((size_t)256 * 512 * 2);
constexpr size_t WS_HB = WS_XR + al((size_t)TA * D * 4);
constexpr size_t WS_PROJ = WS_HB + al((size_t)TA * D * 2);
constexpr size_t WS_GT = WS_PROJ + al((size_t)TA * NPROJ * 2);
constexpr size_t WS_GTC = WS_GT + al((size_t)4096 * 4096 * 2);
constexpr size_t WS_FO = WS_GTC + al((size_t)4096 * 512 * 2);
constexpr size_t MIX_ONE = (size_t)TA * 512 * 2;
constexpr size_t WS_MIXB = WS_FO + al(3 * MIX_ONE);
constexpr size_t WS_XS = WS_MIXB + al((size_t)TA * D * 2);
constexpr size_t WS_LBUF = WS_XS + al((size_t)36864 * D * 2);
constexpr size_t LBUF_ONE = (size_t)64 * 128 * 4;
constexpr size_t WS_END = WS_LBUF + al((size_t)32 * 9 * 2 * LBUF_ONE);
constexpr size_t WS_HID = WS_PROJ;
constexpr size_t WS_YE = WS_XS;
static_assert((size_t)36864 * EH * 2 <= (size_t)TA * NPROJ * 2, "HID overlays PROJ");
static_assert(WS_END <= (size_t)1024 * 1024 * 1024, "workspace map must fit 1 GiB");

constexpr int CW_BAR = 4096;
constexpr int CW_QUEUE = 16384;

constexpr int RING_BYTES = 131072;
constexpr int LDSCTL_OFF = RING_BYTES, MISC_OFF = LDSCTL_OFF + 320;
constexpr int LDS_BYTES = 147456;

#define RLX_AGENT __ATOMIC_RELAXED, __HIP_MEMORY_SCOPE_AGENT
#define LDS_WAIT() asm volatile("s_waitcnt lgkmcnt(0)" ::: "memory")
#define VM_WAIT() asm volatile("s_waitcnt vmcnt(0)" ::: "memory")
__device__ __forceinline__ unsigned f2bf(float f) { unsigned u = __builtin_bit_cast(unsigned, f); return (u + 0x7fffu + ((u >> 16) & 1u)) >> 16; }
__device__ __forceinline__ unsigned pk2(float lo, float hi) { f32x2_t v = {lo, hi}; bf16x2_t b = __builtin_convertvector(v, bf16x2_t); return __builtin_bit_cast(unsigned, b); }
__device__ __forceinline__ float bflo(unsigned w) { return __builtin_bit_cast(float, w << 16); }
__device__ __forceinline__ float bfhi(unsigned w) { return __builtin_bit_cast(float, w & 0xffff0000u); }
__device__ __forceinline__ float bf2f(bf16 h) { return __builtin_bit_cast(float, (unsigned)h << 16); }
__device__ __forceinline__ float wave_sum(float v) {
#pragma unroll
    for (int o = 1; o < 64; o <<= 1) v += __shfl_xor(v, o);
    return v;
}
__device__ __forceinline__ float sigmoidf_(float x) { return __builtin_amdgcn_rcpf(1.0f + __builtin_amdgcn_exp2f(-x * LOG2E)); }
__device__ __forceinline__ float siluf_(float x) { return x * sigmoidf_(x); }

namespace pg8 {
constexpr int BM = 256, BK = 64, HALF = 128, HTB = HALF * BK * 2, STAGE_BYTES = 8 * HTB, NXCD = 8, WGM = 8;
__host__ __device__ __forceinline__ int lds_byte(int r, int c) { const int st = (r >> 4) * 2 + (c >> 5), rr = r & 15, cc = c & 31, ob = rr * 64 + cc * 2; return st * 1024 + (ob ^ (((ob >> 9) & 1) << 5)); }
__host__ __device__ __forceinline__ void stage_rc(int b, int& R, int& C) { const int st = b / 1024, sb = b % 1024, swz = sb ^ (((sb >> 9) & 1) << 5); R = (st >> 1) * 16 + swz / 64; C = (st & 1) * 32 + (swz % 64) / 2; }
__host__ __device__ __forceinline__ int perm32(int rho) { const int n = rho >> 4, i = rho & 15; return 8 * (i >> 2) + 4 * n + (i & 3); }

struct Unit { int pm, pn, tag; const char* A; const char* B; };

__device__ __forceinline__ bool grid_order(long L, int nM, int nN, int& pm, int& pn) {
    const int nwg = nM * nN; if (L >= nwg) return false;
    int wgid = (int)L; { const int q = nwg / NXCD, r = nwg % NXCD, xcd = wgid % NXCD, off = wgid / NXCD; wgid = (xcd < r ? xcd * (q + 1) : r * (q + 1) + (xcd - r) * q) + off; }
    const int nig = WGM * nN, gid = wgid / nig, fm = gid * WGM, gsz = (nM - fm) < WGM ? (nM - fm) : WGM;
    pm = fm + ((wgid % nig) % gsz); pn = (wgid % nig) / gsz; return true;
}

typedef f32x4 Acc[2][2][4][2];
__device__ __forceinline__ void zero_acc(Acc& acc) {
#pragma unroll
    for (int a = 0; a < 2; ++a)
#pragma unroll
        for (int b = 0; b < 2; ++b)
#pragma unroll
            for (int m = 0; m < 4; ++m)
#pragma unroll
                for (int n = 0; n < 2; ++n) acc[a][b][m][n] = (f32x4){0.f, 0.f, 0.f, 0.f};
}

template <class Epi, class Sched>
__device__ __forceinline__ void gemm_phase(LAS unsigned char* lds, const int tid, const int K, const Sched& S, const Epi& E) {
    const int wid = __builtin_amdgcn_readfirstlane(tid >> 6), lane = tid & 63, wr = wid >> 2, wc = wid & 3, fr = lane & 15, fq = lane >> 4;
    const int nt = K / BK;
    unsigned voffA[2], voffB[2];
#pragma unroll
    for (int i = 0; i < 2; ++i) { int R, C; stage_rc(tid * 16 + i * 8192, R, C); const int Rb = Epi::PERM ? ((R & ~31) + perm32(R & 31)) : R;
        voffA[i] = (unsigned)(R * K + C) * 2u; voffB[i] = (unsigned)(Rb * K + C) * 2u; }
    const size_t kstep = (size_t)(BK * 2);
    const size_t hstep = (size_t)HALF * K * 2;
    const unsigned ldsw = (unsigned)wid * 1024u;
    const int aoff = lds_byte(wr * 64 + fr, fq * 8), boff = lds_byte(wc * 32 + fr, fq * 8);
#define PG8_SA(b, h) (((b) * 2 + (h)) * HTB)
#define PG8_SB(b, h) ((4 + (b) * 2 + (h)) * HTB)
#define PG8_STAGE(bufoff, gbase, voff) do { _Pragma("unroll") for (int _i = 0; _i < 2; ++_i) \
        __builtin_amdgcn_global_load_lds((const unsigned*)((const char*)(gbase) + (voff)[_i]), (LAS unsigned*)(lds + (bufoff) + ldsw + _i * 8192), 16, 0, 0); } while (0)
#define PG8_LDA(dst, b, h) do { _Pragma("unroll") for (int m = 0; m < 4; ++m) _Pragma("unroll") for (int k = 0; k < 2; ++k) dst[m][k] = *(const LAS bf16x8*)(lds + PG8_SA(b, h) + aoff + m * 2048 + k * 1024); } while (0)
#define PG8_LDB(dst, b, h) do { _Pragma("unroll") for (int n = 0; n < 2; ++n) _Pragma("unroll") for (int k = 0; k < 2; ++k) dst[n][k] = *(const LAS bf16x8*)(lds + PG8_SB(b, h) + boff + n * 2048 + k * 1024); } while (0)
#define PG8_MMA(ai, bj, At, Bt) do { __builtin_amdgcn_s_setprio(1); _Pragma("unroll") for (int m = 0; m < 4; ++m) _Pragma("unroll") for (int n = 0; n < 2; ++n) _Pragma("unroll") for (int k = 0; k < 2; ++k) \
        acc[ai][bj][m][n] = __builtin_amdgcn_mfma_f32_16x16x32_bf16(Bt[n][k], At[m][k], acc[ai][bj][m][n], 0, 0, 0); __builtin_amdgcn_s_setprio(0); } while (0)
#define PG8_WAIT_V(n) asm volatile("s_waitcnt vmcnt(" #n ")" ::: "memory")
#define PG8_WAIT_L(n) asm volatile("s_waitcnt lgkmcnt(" #n ")" ::: "memory")
#define PG8_BAR __builtin_amdgcn_s_barrier()
#define PG8_SCHED __builtin_amdgcn_sched_barrier(0)
    Unit cur, nxt; int ui = 0;
    if (!S.next(0, cur)) return;
    Acc acc; zero_acc(acc);
    bf16x8 At[4][2], B0[2][2], B1[2][2];
    const char* cA = cur.A; const char* cB = cur.B;
    PG8_STAGE(PG8_SB(0, 0), cB, voffB); PG8_STAGE(PG8_SB(0, 1), cB + hstep, voffB); PG8_STAGE(PG8_SA(0, 0), cA, voffA); PG8_STAGE(PG8_SA(0, 1), cA + hstep, voffA);
    if (wr == 1) PG8_BAR;
    PG8_WAIT_V(2); PG8_BAR;
    PG8_STAGE(PG8_SB(1, 0), cB + kstep, voffB); PG8_STAGE(PG8_SA(1, 0), cA + kstep, voffA); PG8_STAGE(PG8_SB(1, 1), cB + hstep + kstep, voffB);
    PG8_WAIT_V(6); PG8_BAR;
    for (;;) {
        const bool has_next = S.next(ui + 1, nxt);
        const char* nA = has_next ? nxt.A : cA; const char* nB = has_next ? nxt.B : cB;
        for (int t = 0; t < nt; t += 2) {
            const bool last = (t == nt - 2);
            const char* a1 = cA + (size_t)(t + 1) * kstep;
            const char* a2 = last ? nA : cA + (size_t)(t + 2) * kstep; const char* b2 = last ? nB : cB + (size_t)(t + 2) * kstep;
            const char* a3 = a2 + kstep; const char* b3 = b2 + kstep;
            PG8_LDB(B0, 0, 0); PG8_LDB(B1, 0, 1); PG8_SCHED; PG8_LDA(At, 0, 0); PG8_STAGE(PG8_SA(1, 1), a1 + hstep, voffA);
            PG8_WAIT_V(8); PG8_WAIT_L(0); PG8_BAR; PG8_MMA(0, 0, At, B0); PG8_MMA(0, 1, At, B1); PG8_BAR; PG8_SCHED;
            PG8_LDA(At, 0, 1); PG8_STAGE(PG8_SB(0, 0), b2, voffB); PG8_STAGE(PG8_SB(0, 1), b2 + hstep, voffB); PG8_STAGE(PG8_SA(0, 0), a2, voffA);
            PG8_WAIT_V(8); PG8_WAIT_L(0); PG8_BAR; PG8_MMA(1, 0, At, B0); PG8_MMA(1, 1, At, B1); PG8_BAR; PG8_SCHED;
            PG8_LDB(B0, 1, 0); PG8_LDB(B1, 1, 1); PG8_SCHED; PG8_LDA(At, 1, 0); PG8_STAGE(PG8_SA(0, 1), a2 + hstep, voffA);
            PG8_WAIT_V(8); PG8_WAIT_L(0); PG8_BAR; PG8_MMA(0, 0, At, B0); PG8_MMA(0, 1, At, B1); PG8_BAR; PG8_SCHED;
            PG8_LDA(At, 1, 1); PG8_STAGE(PG8_SB(1, 0), b3, voffB); PG8_STAGE(PG8_SB(1, 1), b3 + hstep, voffB); PG8_STAGE(PG8_SA(1, 0), a3, voffA);
            PG8_WAIT_V(8); PG8_WAIT_L(0); PG8_BAR; PG8_MMA(1, 0, At, B0); PG8_MMA(1, 1, At, B1); PG8_BAR; PG8_SCHED;
        }
        if (wr == 0) PG8_BAR;
        E(acc, cur, wr, wc, fr, fq);
        if (!has_next) break;
        cur = nxt; cA = nA; cB = nB; ++ui;
        if (wr == 1) PG8_BAR;
    }
    PG8_WAIT_V(0);
    PG8_BAR;
#undef PG8_SA
#undef PG8_SB
#undef PG8_STAGE
#undef PG8_LDA
#undef PG8_LDB
#undef PG8_MMA
#undef PG8_WAIT_V
#undef PG8_WAIT_L
#undef PG8_BAR
#undef PG8_SCHED
}
}

#define XB_TMO      128
#define XB_XCNT(j)  (256  + 64 * (j))
#define XB_XSUB(j)  (1280 + 64 * (j))
#define XB_XGEN(j)  (2304 + 64 * (j))
#define XB_TOP      3328
#define XB_TOPGEN   3392
#define XCD_BAR_WORDS 3456
#define XB_SPIN_CAP (1u << 22)
__device__ __forceinline__ unsigned xb_ld(unsigned* p)              { return __hip_atomic_load(p, __ATOMIC_RELAXED, __HIP_MEMORY_SCOPE_AGENT); }
__device__ __forceinline__ unsigned xb_add(unsigned* p, unsigned v) { return __hip_atomic_fetch_add(p, v, __ATOMIC_RELAXED, __HIP_MEMORY_SCOPE_AGENT); }
__device__ __forceinline__ unsigned xb_xcc_id() { return (unsigned)__builtin_amdgcn_s_getreg((3 << 11) | 20) & 0xFu; }
#define XB_SPIN(cond, bar) do { unsigned _sp = 0; while (cond) { __builtin_amdgcn_s_sleep(1); \
    if ((++_sp & 255u) == 0u) { if (xb_ld(&(bar)[XB_TMO])) break; if (_sp > XB_SPIN_CAP) { atomicAdd(&(bar)[XB_TMO], 1u); break; } } } } while (0)
struct XcdBarrier { unsigned* bar; unsigned x; volatile LAS unsigned* st; };
__device__ __forceinline__ XcdBarrier xcd_barrier_post(unsigned* bar, volatile LAS unsigned* st) {
    XcdBarrier b; b.bar = bar; b.x = xb_xcc_id(); b.st = st;
    if (threadIdx.x == 0) (void)xb_add(&bar[XB_XCNT(b.x)], 1u);
    return b;
}
__device__ __forceinline__ void xcd_barrier_complete(unsigned* bar, unsigned x, unsigned& nloc, unsigned& nx) {
    const unsigned G = gridDim.x * gridDim.y * gridDim.z;
    unsigned sum, cnt, mine, sp = 0u;
    for (;;) {
        sum = 0u; cnt = 0u; mine = 0u;
#pragma unroll
        for (unsigned j = 0; j < 16; ++j) { const unsigned c = xb_ld(&bar[XB_XCNT(j)]); sum += c; cnt += (c > 0u) ? 1u : 0u; mine = (j == x) ? c : mine; }
        if (sum == G) break;
        __builtin_amdgcn_s_sleep(1);
        if ((++sp & 255u) == 0u) { if (xb_ld(&bar[XB_TMO])) break; if (sp > XB_SPIN_CAP) { atomicAdd(&bar[XB_TMO], 1u); break; } }
    }
    nloc = mine > 0u ? mine : 1u; nx = cnt > 0u ? cnt : 1u;
}
__device__ __forceinline__ void xcd_barrier(const XcdBarrier& b) {
    asm volatile("s_waitcnt vmcnt(0)" ::: "memory");
    __syncthreads();
    if (threadIdx.x == 0) {
        unsigned* bar = b.bar;
        __builtin_amdgcn_s_waitcnt(0);
        unsigned nloc = b.st[0], nx = b.st[1];
        if (nloc == 0u) { xcd_barrier_complete(bar, b.x, nloc, nx); b.st[0] = nloc; b.st[1] = nx; }
        const unsigned old = xb_add(&bar[XB_XSUB(b.x)], 1u);
        const unsigned gen = old / nloc;
        if (old + 1u == (gen + 1u) * nloc) {
            __builtin_amdgcn_fence(__ATOMIC_RELEASE, "agent");
            asm volatile("s_waitcnt vmcnt(0)" ::: "memory");
            const unsigned og = xb_add(&bar[XB_TOP], 1u);
            const unsigned tg = og / nx;
            if (og + 1u == (tg + 1u) * nx) xb_add(&bar[XB_TOPGEN], 1u);
            else XB_SPIN(xb_ld(&bar[XB_TOPGEN]) == tg, bar);
            __builtin_amdgcn_fence(__ATOMIC_ACQUIRE, "agent");
            xb_add(&bar[XB_XGEN(b.x)], 1u);
            asm volatile("s_waitcnt vmcnt(0)" ::: "memory");
        } else {
            XB_SPIN(xb_ld(&bar[XB_XGEN(b.x)]) == gen, bar);
            __builtin_amdgcn_fence(__ATOMIC_ACQUIRE, "agent");
            asm volatile("s_waitcnt vmcnt(0)" ::: "memory");
        }
    }
    __syncthreads();
}

struct Args { const float* in[21]; float* out; unsigned char* ws; int ph_lo, ph_hi; };
struct Frame {
    LAS unsigned char* lds; volatile LAS unsigned* MISC; unsigned* ctl;
    int tid, lane, wave, vcu, G;
    const void __attribute__((address_space(4)))* karg; float* out; unsigned char* ws;
};
__device__ __forceinline__ const float* inp(const Frame& F, int i) { const unsigned long long p = ((const unsigned long long __attribute__((address_space(4)))*)F.karg)[i]; return (const float*)(const GAS float*)p; }
#define IN_X 0
#define IN_C 1
#define IN_CTX 2
#define IN_CCTX 3
#define IN_WMOD 4
#define IN_BMOD 5
#define IN_GATTN 6
#define IN_GFFN 7
#define IN_WIN 8
#define IN_RDEC 9
#define IN_QN 10
#define IN_KN 11
#define IN_LAMBDA 12
#define IN_WFO 13
#define IN_WRO 14
#define IN_WDO 15
#define IN_WOUT 16
#define IN_WROUTER 17
#define IN_WEG 18
#define IN_WEU 19
#define IN_WED 20

__device__ __forceinline__ int vec_of_row(int r) { return r < TC ? 8 : (r - TC) / SEQ; }
__device__ __forceinline__ const float* mod_ptr(const Frame& F, int layer, int v, int i) { return (const float*)(F.ws + WS_MOD) + ((size_t)(layer * 9 + v) * 6 + i) * D; }
__device__ __forceinline__ float lam_init_of(int layer) { return layer == 0 ? 0.2f : 0.8f - 0.6f * 0.74081822068171788f; }
__device__ __forceinline__ float lam_of(const Frame& F, int layer) {
    const float* L = inp(F, IN_LAMBDA) + (size_t)layer * 4 * 64; float s1 = 0.f, s2 = 0.f;
    for (int i = 0; i < 64; ++i) { s1 += L[i] * L[64 + i]; s2 += L[128 + i] * L[192 + i]; }
    return __expf(s1) - __expf(s2) + lam_init_of(layer);
}

__device__ __forceinline__ void transpose_item(const float* W, int ldw, int K, int k0, int n0src, bf16* WT, int dst_row0, LAS float* scr, int lane) {
#pragma unroll 8
    for (int i = 0; i < 32; ++i) { const int kk = 2 * i + (lane >> 5); scr[kk * 33 + (lane & 31)] = W[(size_t)(k0 + kk) * ldw + n0src + (lane & 31)]; }
    LDS_WAIT(); asm volatile("" ::: "memory");
    const int c = lane & 7;
#pragma unroll
    for (int j = 0; j < 4; ++j) { const int n = (lane >> 3) + 8 * j; const LAS float* s = scr + (8 * c) * 33 + n;
        u32x4 o; o.x = pk2(s[0 * 33], s[1 * 33]); o.y = pk2(s[2 * 33], s[3 * 33]); o.z = pk2(s[4 * 33], s[5 * 33]); o.w = pk2(s[6 * 33], s[7 * 33]);
        *(u32x4*)(WT + (size_t)(dst_row0 + n) * K + k0 + 8 * c) = o; }
    LDS_WAIT(); asm volatile("" ::: "memory");
}
template <class RowMap>
__device__ __forceinline__ void transpose_matrix(Frame& F, const float* W, int ldw, int csrc, int K, int N, bf16* WT, RowMap map, int& item_base) {
    LAS float* scr = (LAS float*)(F.lds + F.wave * 16384);
    const int gw = F.vcu * 8 + F.wave, NGW = F.G * 8;
    const int nblk = N / 32, nitems = (K / 64) * nblk;
    int start = (gw - item_base % NGW + NGW) % NGW;
    for (int it = start; it < nitems; it += NGW) { const int kb = it / nblk, nb = it % nblk; transpose_item(W, ldw, K, 64 * kb, csrc + 32 * nb, WT, map(32 * nb), scr, F.lane); }
    item_base += nitems;
}
struct MapId { int off; __device__ int operator()(int n) const { return off + n; } };
struct MapProj { __device__ int operator()(int n) const { const int tile = n >> 8; const bool qk = tile < 2 || (tile >= 6 && tile < 10); return qk ? (tile << 8) + 128 * ((n >> 5) & 1) + 32 * ((n >> 6) & 3) + (n & 31) : n; } };
struct MapGU { int up; __device__ int operator()(int n) const { return (n >> 7) * 256 + up * 128 + (n & 127); } };

__device__ __forceinline__ void convert_expert_weights(Frame& F, int layer) {
    int base = 0;
    for (int e = 0; e < NE; ++e) {
        const float* wg = inp(F, IN_WEG) + ((size_t)layer * NE + e) * D * EH; const float* wu = inp(F, IN_WEU) + ((size_t)layer * NE + e) * D * EH; const float* wd = inp(F, IN_WED) + ((size_t)layer * NE + e) * EH * D;
        bf16* gu = (bf16*)(F.ws + WS_WGU + e * WGU_E); bf16* dn = (bf16*)(F.ws + WS_WD + e * WD_E);
        transpose_matrix(F, wg, EH, 0, D, EH, gu, MapGU{0}, base);
        transpose_matrix(F, wu, EH, 0, D, EH, gu, MapGU{1}, base);
        transpose_matrix(F, wd, D, 0, EH, D, dn, MapId{0}, base);
    }
}

__device__ __forceinline__ void phase_prologue(Frame& F) {
    const int tid = F.tid;
    {
        LAS float* sc = (LAS float*)F.lds;
        LAS float* red = sc + 9 * 1024;
        for (int i = tid; i < 9 * 1024; i += 512) { const int v = i >> 10, k = i & 1023; const float c = v < 8 ? inp(F, IN_C)[v * D + k] : inp(F, IN_CCTX)[k]; sc[i] = siluf_(c); }
        __syncthreads();
        for (int item = F.vcu; item < DEPTH * 96; item += F.G) {
            const int layer = item / 96, cb = item % 96, col = cb * 64 + (tid & 63), kg = tid >> 6;
            const float* w = inp(F, IN_WMOD) + (size_t)layer * D * 6144 + col;
            float a[9];
#pragma unroll
            for (int v = 0; v < 9; ++v) a[v] = 0.f;
#pragma unroll 4
            for (int kk = 0; kk < 128; ++kk) { const int k = kg * 128 + kk; const float wv = w[(size_t)k * 6144];
#pragma unroll
                for (int v = 0; v < 9; ++v) a[v] += sc[v * 1024 + k] * wv; }
#pragma unroll
            for (int v = 0; v < 9; ++v) red[(kg * 64 + (tid & 63)) * 9 + v] = a[v];
            __syncthreads();
            for (int o = tid; o < 64 * 9; o += 512) { const int cc = o / 9, v = o % 9; float s = 0.f;
                for (int g = 0; g < 8; ++g) s += red[(g * 64 + cc) * 9 + v];
                const int colo = cb * 64 + cc;
                ((float*)(F.ws + WS_MOD))[(size_t)(layer * 9 + v) * 6144 + colo] = s + inp(F, IN_BMOD)[layer * 6144 + colo]; }
            __syncthreads();
        }
    }
    {
        const int gt = F.vcu * 512 + tid, NT = F.G * 512;
        float* rc = (float*)(F.ws + WS_ROPE); float* rs = rc + SEQ * 32;
        for (int i = gt; i < SEQ * 32; i += NT) { const int pos = i >> 5, f = i & 31; const float inv = __builtin_amdgcn_exp2f(-(float)(f & 15) * (13.287712379549449f / 16.0f));
            const float p = (f < 16) ? (float)(pos / GRIDW) : (float)(pos % GRIDW); const float ang = p * inv; rc[i] = __builtin_amdgcn_cosf(ang * 0.15915494309189535f); rs[i] = __builtin_amdgcn_sinf(ang * 0.15915494309189535f); }
        LAS float* ct = (LAS float*)F.lds;
        __syncthreads();
        for (int m = tid; m < 2048; m += 512) ct[m] = __builtin_amdgcn_cosf((float)m * (1.0f / 2048.0f));
        __syncthreads();
        bf16* dl = (bf16*)(F.ws + WS_DFTL); const float sl = 0.022097086912079608f;
        for (int i = gt; i < 2048 * 2048; i += NT) {
            const int k = i >> 11, n = i & 2047, m = (k * n) & 2047; const float c = ct[m], s = ct[(m - 512) & 2047];
            dl[(size_t)k * 4096 + n] = (bf16)f2bf(c * sl); dl[(size_t)k * 4096 + 2048 + n] = (bf16)f2bf(-s * sl); }
        bf16* dc = (bf16*)(F.ws + WS_DFTC);
        for (int i = gt; i < 256 * 256; i += NT) { const int k = i >> 8, n = i & 255, m = ((k * n) & 255) * 8; const float c = ct[m], s = ct[(m - 512) & 2047];
            dc[(size_t)k * 512 + n] = (bf16)f2bf(c * 0.0625f); dc[(size_t)k * 512 + 256 + n] = (bf16)f2bf(-s * 0.0625f); }
        for (int layer = 0; layer < DEPTH; ++layer) {
            const float* win = inp(F, IN_WIN) + (size_t)layer * D * INW; bf16* wt = (bf16*)(F.ws + WS_WIN + layer * WIN_L) + (size_t)6144 * 1024;
            for (int i = gt; i < 1024 * 1024; i += NT) { const int k = i & 1023, no = i >> 10, part = no >> 9, g = (no >> 6) & 7, cp = no & 63;
                const float* src = win + (size_t)k * INW + g * 64; float s = 0.f;
                for (int c = 0; c < 64; ++c) { const int m = ((c * cp) & 63) * 32; const float t = part == 0 ? ct[m] : ct[(m - 512) & 2047]; s += src[c] * t; }
                wt[(size_t)no * 1024 + k] = (bf16)f2bf(s * 0.125f); }
        }
        __syncthreads();
    }
    {
        int base = 0;
        for (int layer = 0; layer < DEPTH; ++layer) {
            transpose_matrix(F, inp(F, IN_WIN) + (size_t)layer * D * INW, INW, 512, D, NPROJ, (bf16*)(F.ws + WS_WIN + layer * WIN_L), MapProj{}, base);
            transpose_matrix(F, inp(F, IN_WFO) + (size_t)layer * 512 * D, D, 0, 512, D, (bf16*)(F.ws + WS_WFO + (layer * 3 + 0) * WMG_ONE), MapId{0}, base);
            transpose_matrix(F, inp(F, IN_WRO) + (size_t)layer * 512 * D, D, 0, 512, D, (bf16*)(F.ws + WS_WFO + (layer * 3 + 1) * WMG_ONE), MapId{0}, base);
            transpose_matrix(F, inp(F, IN_WDO) + (size_t)layer * 512 * D, D, 0, 512, D, (bf16*)(F.ws + WS_WFO + (layer * 3 + 2) * WMG_ONE), MapId{0}, base);
            transpose_matrix(F, inp(F, IN_WOUT) + (size_t)layer * D * D, D, 0, D, D, (bf16*)(F.ws + WS_WOUT + layer * WOUT_L), MapId{0}, base);
        }
    }
    convert_expert_weights(F, 0);
}

__device__ __forceinline__ void phase_norm(Frame& F, int layer) {
    const int gw = F.vcu * 8 + F.wave, NGW = F.G * 8, lane = F.lane;
    const bool fin = layer == DEPTH; const int r_lo = (layer >= DEPTH - 1) ? (fin ? TC : 0) : 0;
    float* XR = (float*)(F.ws + WS_XR); const int* INV = (const int*)(F.ws + WS_INV); const bf16* YE = (const bf16*)(F.ws + WS_YE); bf16* HB = (bf16*)(F.ws + WS_HB);
    for (int r = r_lo + gw; r < TA; r += NGW) {
        const int v = vec_of_row(r);
        f32x4 x[4];
        if (layer == 0) { const float* src = r < TC ? inp(F, IN_CTX) + (size_t)r * D : inp(F, IN_X) + (size_t)(r - TC) * D;
#pragma unroll
            for (int j = 0; j < 4; ++j) x[j] = *(const f32x4*)(src + 4 * lane + 256 * j);
        } else {
            const float* src = XR + (size_t)r * D;
#pragma unroll
            for (int j = 0; j < 4; ++j) x[j] = *(const f32x4*)(src + 4 * lane + 256 * j);
            if (!(layer == DEPTH - 1 + 1 && false)) {
                const bool has_moe = !(layer == 1 && r < TC && false);
                if (has_moe) {
                    f32x4 s[4];
#pragma unroll
                    for (int j = 0; j < 4; ++j) s[j] = (f32x4){0.f, 0.f, 0.f, 0.f};
                    const int* inv = INV + (size_t)r * 16;
                    for (int e = 0; e < NE; ++e) { const int slot = __builtin_amdgcn_readfirstlane(inv[e]);
                        if (slot >= 0) { const bf16* y = YE + (size_t)slot * D;
#pragma unroll
                            for (int j = 0; j < 4; ++j) { const u32x2 w = *(const u32x2*)(y + 4 * lane + 256 * j); s[j] += (f32x4){bflo(w.x), bfhi(w.x), bflo(w.y), bfhi(w.y)}; } } }
                    const float* m5 = mod_ptr(F, layer - 1, v, 5);
#pragma unroll
                    for (int j = 0; j < 4; ++j) x[j] += *(const f32x4*)(m5 + 4 * lane + 256 * j) * s[j];
                }
            }
        }
        if (fin) {
#pragma unroll
            for (int j = 0; j < 4; ++j) *(f32x4*)(F.out + (size_t)(r - TC) * D + 4 * lane + 256 * j) = x[j];
            continue;
        }
        if (layer > 0) {
#pragma unroll
            for (int j = 0; j < 4; ++j) *(f32x4*)(XR + (size_t)r * D + 4 * lane + 256 * j) = x[j];
        }
        float ss = 0.f;
#pragma unroll
        for (int j = 0; j < 4; ++j) ss += (x[j].x * x[j].x + x[j].y * x[j].y) + (x[j].z * x[j].z + x[j].w * x[j].w);
        const float rinv = __builtin_amdgcn_rsqf(wave_sum(ss) * (1.0f / D) + EPS);
        const float* g = inp(F, IN_GATTN) + (size_t)layer * D; const float* sh = mod_ptr(F, layer, v, 0); const float* scl = mod_ptr(F, layer, v, 1);
#pragma unroll
        for (int j = 0; j < 4; ++j) { const int k = 4 * lane + 256 * j; const f32x4 gv = *(const f32x4*)(g + k), sv = *(const f32x4*)(sh + k), cv = *(const f32x4*)(scl + k);
            const f32x4 y = (x[j] * rinv * gv) * (cv + 1.0f) + sv;
            u32x2 w; w.x = pk2(y.x, y.y); w.y = pk2(y.z, y.w); *(u32x2*)(HB + (size_t)r * D + k) = w; }
    }
}

using pg8::Unit; using pg8::Acc;
struct SchedGrid {
    int nM, nN, G, c; const char* A; const char* B; size_t a_tile, b_tile; int pm_per_group; size_t b_group;
    __device__ __forceinline__ bool next(int i, Unit& u) const {
        int pm, pn; if (c < 0 || !pg8::grid_order((long)i * G + c, nM, nN, pm, pn)) return false;
        u.pm = pm; u.pn = pn; u.tag = 0; u.A = A + (size_t)pm * a_tile; u.B = B + (size_t)pn * b_tile + (pm_per_group ? (size_t)(pm / pm_per_group) * b_group : 0); return true; }
};
struct SchedMerge {
    int nM, nN, G, c; const char* A; const char* B; size_t a_seg, b_seg, a_tile, b_tile;
    __device__ __forceinline__ bool next(int i, Unit& u) const {
        const int t = i / 3, seg = i - 3 * t; int pm, pn; if (!pg8::grid_order((long)t * G + c, nM, nN, pm, pn)) return false;
        u.pm = pm; u.pn = pn; u.tag = seg; u.A = A + (size_t)seg * a_seg + (size_t)pm * a_tile; u.B = B + (size_t)seg * b_seg + (size_t)pn * b_tile; return true; }
};

struct EpiBf16 {
    static constexpr bool PERM = true;
    bf16* C; int ldc; int sig_pn0;
    __device__ __forceinline__ void operator()(Acc& acc, const Unit& u, int wr, int wc, int fr, int fq) const {
        const int row0 = u.pm * 256 + wr * 64 + fr, col0 = u.pn * 256 + wc * 32 + 8 * fq;
        const bool sig = u.pn >= sig_pn0;
#pragma unroll
        for (int ai = 0; ai < 2; ++ai)
#pragma unroll
            for (int m = 0; m < 4; ++m) { bf16* rowp = C + (size_t)(row0 + ai * 128 + m * 16) * ldc + col0;
#pragma unroll
                for (int bj = 0; bj < 2; ++bj) { f32x4 v0 = acc[ai][bj][m][0], v1 = acc[ai][bj][m][1];
                    if (sig) {
#pragma unroll
                        for (int j = 0; j < 4; ++j) { v0[j] = sigmoidf_(v0[j]); v1[j] = sigmoidf_(v1[j]); } }
                    u32x4 w; w.x = pk2(v0[0], v0[1]); w.y = pk2(v0[2], v0[3]); w.z = pk2(v1[0], v1[1]); w.w = pk2(v1[2], v1[3]);
                    *(u32x4*)(rowp + bj * 128) = w; } }
        pg8::zero_acc(acc);
    }
};
struct EpiGT {
    static constexpr bool PERM = true;
    bf16* GT; bf16* GTC;
    __device__ __forceinline__ void operator()(Acc& acc, const Unit& u, int wr, int wc, int fr, int fq) const {
        const int tok0 = u.pn * 256;
        bf16* base; int pitch, nseq, n0;
        if (tok0 < TC) { const int b = tok0 / CTX; base = GTC + (size_t)b * 512 * 512; pitch = 512; nseq = CTX; n0 = tok0 - b * CTX; }
        else { const int t = tok0 - TC, b = t / SEQ; base = GT + (size_t)b * 512 * 4096; pitch = 4096; nseq = SEQ; n0 = t - b * SEQ; }
        const int crow0 = u.pm * 256 + wr * 64 + fr, ccol0 = wc * 32 + 8 * fq;
#pragma unroll
        for (int ai = 0; ai < 2; ++ai)
#pragma unroll
            for (int m = 0; m < 4; ++m) { const int c = crow0 + ai * 128 + m * 16, part = c >> 9, ch = c & 511;
                bf16* rowp = base + (size_t)ch * pitch + part * nseq + n0 + ccol0;
#pragma unroll
                for (int bj = 0; bj < 2; ++bj) { const f32x4 v0 = acc[ai][bj][m][0], v1 = acc[ai][bj][m][1];
                    u32x4 w; w.x = pk2(v0[0], v0[1]); w.y = pk2(v0[2], v0[3]); w.z = pk2(v1[0], v1[1]); w.w = pk2(v1[2], v1[3]);
                    *(u32x4*)(rowp + bj * 128) = w; } }
        pg8::zero_acc(acc);
    }
};
struct EpiDFT {
    static constexpr bool PERM = true;
    bf16* FO; int nseq; int row_base0;
    __device__ __forceinline__ void operator()(Acc& acc, const Unit& u, int wr, int wc, int fr, int fq) const {
        const int k0 = u.pm * 256 + wr * 64 + fr, b = (u.pn * 256) >> 9, ch0 = ((u.pn * 256) & 511) + wc * 32 + 8 * fq;
        bf16* base = FO + (size_t)(row_base0 + b * nseq + k0) * 512 + ch0;
#pragma unroll
        for (int ai = 0; ai < 2; ++ai)
#pragma unroll
            for (int m = 0; m < 4; ++m) { bf16* rowp = base + (size_t)(ai * 128 + m * 16) * 512;
#pragma unroll
                for (int bj = 0; bj < 2; ++bj) { const f32x4 v0 = acc[ai][bj][m][0], v1 = acc[ai][bj][m][1];
                    u32x4 w; w.x = pk2(v0[0], v0[1]); w.y = pk2(v0[2], v0[3]); w.z = pk2(v1[0], v1[1]); w.w = pk2(v1[2], v1[3]);
                    *(u32x4*)(rowp + bj * 128) = w; } }
        pg8::zero_acc(acc);
    }
};
struct EpiMerge {
    static constexpr bool PERM = true;
    const bf16* PROJ; bf16* MIXB; int row_off;
    __device__ __forceinline__ void operator()(Acc& acc, const Unit& u, int wr, int wc, int fr, int fq) const {
        const int row0 = row_off + u.pm * 256 + wr * 64 + fr, col0 = u.pn * 256 + wc * 32 + 8 * fq, seg = u.tag;
#pragma unroll
        for (int ai = 0; ai < 2; ++ai)
#pragma unroll
            for (int m = 0; m < 4; ++m) { const size_t row = (size_t)(row0 + ai * 128 + m * 16);
#pragma unroll
                for (int bj = 0; bj < 2; ++bj) { const int col = col0 + bj * 128;
                    const u32x4 ga = *(const u32x4*)(PROJ + row * NPROJ + C_GATE + seg * 1024 + col);
                    float f[8];
                    if (seg < 2) { const u32x4 gb = *(const u32x4*)(PROJ + row * NPROJ + C_GATE + (seg + 1) * 1024 + col);
#pragma unroll
                        for (int q = 0; q < 4; ++q) { f[2 * q] = bflo(ga[q]) * __builtin_amdgcn_rcpf(bflo(gb[q])); f[2 * q + 1] = bfhi(ga[q]) * __builtin_amdgcn_rcpf(bfhi(gb[q])); }
                    } else {
#pragma unroll
                        for (int q = 0; q < 4; ++q) { f[2 * q] = bflo(ga[q]); f[2 * q + 1] = bfhi(ga[q]); }
                    }
                    f32x4 v0 = acc[ai][bj][m][0], v1 = acc[ai][bj][m][1];
                    v0 = v0 * (f32x4){f[0], f[1], f[2], f[3]}; v1 = v1 * (f32x4){f[4], f[5], f[6], f[7]};
                    if (seg < 2) { acc[ai][bj][m][0] = v0; acc[ai][bj][m][1] = v1; }
                    else { u32x4 w; w.x = pk2(v0[0], v0[1]); w.y = pk2(v0[2], v0[3]); w.z = pk2(v1[0], v1[1]); w.w = pk2(v1[2], v1[3]);
                        *(u32x4*)(MIXB + row * D + col) = w; acc[ai][bj][m][0] = (f32x4){0.f, 0.f, 0.f, 0.f}; acc[ai][bj][m][1] = (f32x4){0.f, 0.f, 0.f, 0.f}; } }
                asm volatile("" ::: "memory"); }
    }
};
struct EpiOut {
    static constexpr bool PERM = false;
    const float* base_ctx; const float* base_lat; float* XR; const float* mod2; int row_off;
    __device__ __forceinline__ void operator()(Acc& acc, const Unit& u, int wr, int wc, int fr, int fq) const {
        const int row0 = row_off + u.pm * 256 + wr * 64 + fr, col0 = u.pn * 256 + wc * 32 + 4 * fq;
        const int v = vec_of_row(row_off + u.pm * 256);
        f32x4 mv[2][2];
#pragma unroll
        for (int bj = 0; bj < 2; ++bj)
#pragma unroll
            for (int n = 0; n < 2; ++n) mv[bj][n] = *(const f32x4*)(mod2 + (size_t)v * 6144 + col0 + bj * 128 + n * 16);
#pragma unroll
        for (int ai = 0; ai < 2; ++ai)
#pragma unroll
            for (int m = 0; m < 4; ++m) { const int row = row0 + ai * 128 + m * 16;
                const float* bp = row < TC ? base_ctx + (size_t)row * D : base_lat + (size_t)(row - TC) * D; float* op = XR + (size_t)row * D;
#pragma unroll
                for (int bj = 0; bj < 2; ++bj)
#pragma unroll
                    for (int n = 0; n < 2; ++n) { const int c = col0 + bj * 128 + n * 16; *(f32x4*)(op + c) = *(const f32x4*)(bp + c) + mv[bj][n] * acc[ai][bj][m][n]; } }
        pg8::zero_acc(acc);
    }
};
struct EpiGU {
    static constexpr bool PERM = true;
    bf16* HID;
    __device__ __forceinline__ void operator()(Acc& acc, const Unit& u, int wr, int wc, int fr, int fq) const {
        const int row0 = u.pm * 256 + wr * 64 + fr, col0 = u.pn * 128 + wc * 32 + 8 * fq;
#pragma unroll
        for (int ai = 0; ai < 2; ++ai)
#pragma unroll
            for (int m = 0; m < 4; ++m) { float h[8];
#pragma unroll
                for (int n = 0; n < 2; ++n)
#pragma unroll
                    for (int j = 0; j < 4; ++j) { const float g = acc[ai][0][m][n][j], up = acc[ai][1][m][n][j]; h[4 * n + j] = siluf_(g) * up; }
                u32x4 w; w.x = pk2(h[0], h[1]); w.y = pk2(h[2], h[3]); w.z = pk2(h[4], h[5]); w.w = pk2(h[6], h[7]);
                *(u32x4*)(HID + (size_t)(row0 + ai * 128 + m * 16) * EH + col0) = w; }
        pg8::zero_acc(acc);
    }
};
struct EpiDown {
    static constexpr bool PERM = true;
    bf16* YE; const float* topw;
    __device__ __forceinline__ void operator()(Acc& acc, const Unit& u, int wr, int wc, int fr, int fq) const {
        const int row0 = u.pm * 256 + wr * 64 + fr, col0 = u.pn * 256 + wc * 32 + 8 * fq;
#pragma unroll
        for (int ai = 0; ai < 2; ++ai)
#pragma unroll
            for (int m = 0; m < 4; ++m) { const int row = row0 + ai * 128 + m * 16; const float tw = topw[row];
#pragma unroll
                for (int bj = 0; bj < 2; ++bj) { const f32x4 v0 = acc[ai][bj][m][0] * tw, v1 = acc[ai][bj][m][1] * tw;
                    u32x4 w; w.x = pk2(v0[0], v0[1]); w.y = pk2(v0[2], v0[3]); w.z = pk2(v1[0], v1[1]); w.w = pk2(v1[2], v1[3]);
                    *(u32x4*)(YE + (size_t)row * D + col0 + bj * 128) = w; } }
        pg8::zero_acc(acc);
    }
};

struct SchedInproj {
    int G, c, ncc; const char* HB; const char* WT;
    __device__ __forceinline__ bool next(int i, Unit& u) const {
        const long L = (long)i * G + c; int pm, pn;
        if (L < 64 * 28) { pg8::grid_order(L, 64, 28, pm, pn); pm += 8; }
        else { if (!pg8::grid_order(L - 64 * 28, 8, ncc, pm, pn)) return false; if (ncc == 7) pn = pn < 3 ? pn + 1 : pn + 5; }
        const size_t tile = (size_t)256 * D * 2;
        if (pn < 24) { u.pm = pm; u.pn = pn; u.A = HB + pm * tile; u.B = WT + pn * tile; u.tag = (pn < 2 || (pn >= 6 && pn < 10)) ? 2 : (pn >= 12 ? 1 : 0); }
        else { u.pm = pn - 24; u.pn = pm; u.A = WT + (size_t)(24 + pn - 24) * tile; u.B = HB + pm * tile; u.tag = 3; }
        return true; }
};
struct EpiInproj {
    static constexpr bool PERM = true;
    bf16* PROJ; bf16* GT; bf16* GTC; const float* rc; const float* rs; const float* qn; const float* kn;
    __device__ __forceinline__ void operator()(Acc& acc, const Unit& u, int wr, int wc, int fr, int fq) const {
        if (u.tag == 3) { EpiGT E{GT, GTC}; E(acc, u, wr, wc, fr, fq); return; }
        if (u.tag < 2) { EpiBf16 E{PROJ, NPROJ, u.tag == 1 ? 0 : 1000}; E(acc, u, wr, wc, fr, fq); return; }
        const int tile = u.pn; const bool is_d = tile >= 6, is_q = (tile == 0 || tile == 6 || tile == 7);
        f32x4 g1[2], g2[2];
        if (is_d) { const float* G = is_q ? qn : kn;
#pragma unroll
            for (int n = 0; n < 2; ++n) { g1[n] = *(const f32x4*)(G + 8 * fq + 4 * n); g2[n] = *(const f32x4*)(G + 32 + 8 * fq + 4 * n); } }
        const int row0 = u.pm * 256 + wr * 64 + fr; const bool lat = u.pm >= 8;
#pragma unroll
        for (int ai = 0; ai < 2; ++ai)
#pragma unroll
            for (int m = 0; m < 4; ++m) { const int row = row0 + ai * 128 + m * 16;
                f32x4 x1[2] = {acc[ai][0][m][0], acc[ai][0][m][1]}, x2[2] = {acc[ai][1][m][0], acc[ai][1][m][1]};
                if (is_d) {
                    float ss = 0.f;
#pragma unroll
                    for (int n = 0; n < 2; ++n) ss += (x1[n][0] * x1[n][0] + x1[n][1] * x1[n][1]) + (x1[n][2] * x1[n][2] + x1[n][3] * x1[n][3]) + (x2[n][0] * x2[n][0] + x2[n][1] * x2[n][1]) + (x2[n][2] * x2[n][2] + x2[n][3] * x2[n][3]);
                    ss += __shfl_xor(ss, 16); ss += __shfl_xor(ss, 32);
                    const float rinv = __builtin_amdgcn_rsqf(ss * (1.0f / 64.0f) + EPS);
#pragma unroll
                    for (int n = 0; n < 2; ++n) { x1[n] = x1[n] * rinv * g1[n]; x2[n] = x2[n] * rinv * g2[n]; }
                } else if (tile == 0) {
#pragma unroll
                    for (int n = 0; n < 2; ++n) { x1[n] = x1[n] * 0.125f; x2[n] = x2[n] * 0.125f; }
                }
                f32x4 o1[2], o2[2];
                if (lat) { const int pos = (row - TC) & (SEQ - 1);
#pragma unroll
                    for (int n = 0; n < 2; ++n) { const f32x4 c = *(const f32x4*)(rc + pos * 32 + 8 * fq + 4 * n), sn = *(const f32x4*)(rs + pos * 32 + 8 * fq + 4 * n);
                        o1[n] = x1[n] * c - x2[n] * sn; o2[n] = x2[n] * c + x1[n] * sn; }
                } else { o1[0] = x1[0]; o1[1] = x1[1]; o2[0] = x2[0]; o2[1] = x2[1]; }
                if (is_d && is_q) { const float k = 0.125f * LOG2E;
#pragma unroll
                    for (int n = 0; n < 2; ++n) { o1[n] = o1[n] * k; o2[n] = o2[n] * k; } }
                bf16* dst = PROJ + (size_t)row * NPROJ + tile * 256 + 64 * wc + 8 * fq;
                u32x4 w; w.x = pk2(o1[0][0], o1[0][1]); w.y = pk2(o1[0][2], o1[0][3]); w.z = pk2(o1[1][0], o1[1][1]); w.w = pk2(o1[1][2], o1[1][3]); *(u32x4*)dst = w;
                w.x = pk2(o2[0][0], o2[0][1]); w.y = pk2(o2[0][2], o2[0][3]); w.z = pk2(o2[1][0], o2[1][1]); w.w = pk2(o2[1][2], o2[1][3]); *(u32x4*)(dst + 32) = w;
                asm volatile("" ::: "memory"); }
        pg8::zero_acc(acc);
    }
};
__device__ __forceinline__ void phase_inproj(Frame& F, int layer) {
    const float* rc = (const float*)(F.ws + WS_ROPE);
    SchedInproj S{F.G, (int)blockIdx.x, layer == DEPTH - 1 ? 7 : 28, (const char*)(F.ws + WS_HB), (const char*)(F.ws + WS_WIN + layer * WIN_L)};
    EpiInproj E{(bf16*)(F.ws + WS_PROJ), (bf16*)(F.ws + WS_GT), (bf16*)(F.ws + WS_GTC), rc, rc + SEQ * 32, inp(F, IN_QN) + layer * 64, inp(F, IN_KN) + layer * 64};
    pg8::gemm_phase(F.lds, F.tid, D, S, E);
}

namespace att {
constexpr int KPITCH = 144, VPITCH = 320, KC_BYTES = 64 * KPITCH, V_BYTES = 64 * VPITCH, BUF_BYTES = 2 * KC_BYTES + V_BYTES;
constexpr int SCR_OFF = 2 * BUF_BYTES;
constexpr int QW_OFF = SCR_OFF + 8 * 256;
constexpr int S_OFF = 81920, S_BYTES = 128 * KPITCH;
__device__ __forceinline__ int crow(int r, int hi) { return (r & 3) + 8 * (r >> 2) + 4 * hi; }
__device__ __forceinline__ s16x4 vtr(const LAS unsigned char* p) { typedef short v4i16_t __attribute__((ext_vector_type(4))); return __builtin_bit_cast(s16x4, __builtin_amdgcn_ds_read_tr16_b64_v4i16((LAS v4i16_t*)p)); }

struct UnitDesc {
    int mode;
    int qrow0;
    int qpos0;
    int h;
    int krowA, ntA;
    int krowB, ntB;
    int kindB;
    int nseq;
    int outrow0;
    float lgf, lgb;
    float lam, scale_out;
    int cross, bh, blk;
};

template <int MODE> __device__ __forceinline__ void unit(const Frame& F, const UnitDesc& u) {
    LAS unsigned char* lds = F.lds;
    int lane = F.lane; asm volatile("" : "+v"(lane));
    const int wid = F.wave, tid = wid * 64 + lane, r32 = lane & 31, hi = lane >> 5;
    const bf16* PROJ = (const bf16*)(F.ws + WS_PROJ);
    constexpr bool diff = MODE == 0;
    const int comp = diff ? (wid >> 2) : 0;
    const int qoff = diff ? 32 * (wid & 3) : 32 * wid;
    const int kcol = diff ? C_DK + u.h * 128 : C_RK + u.h * 64, vcol = diff ? C_DV + u.h * 128 : C_RV + u.h * 128;
    const int qcol = diff ? C_DQ + u.h * 128 + comp * 64 : C_RQ + u.h * 64;
    const int NT = u.ntA + u.ntB;
    bf16x8 qf[4];
    { const bf16* qp = PROJ + (size_t)(u.qrow0 + qoff + r32) * NPROJ + qcol + 8 * hi;
#pragma unroll
      for (int s = 0; s < 4; ++s) qf[s] = *(const bf16x8*)(qp + 16 * s); }
    f32x16 o[4];
#pragma unroll
    for (int d = 0; d < 4; ++d) o[d] = (f32x16){};
    float lsum = 0.f;
    if (!diff && u.cross) {
        const float* LB = (const float*)(F.ws + WS_LBUF) + (size_t)u.bh * 9 * 2 * 64 * 128;
        const int dv = tid & 127, dg = tid >> 7, c = u.blk;
        float sf[16], sb[16];
#pragma unroll
        for (int k = 0; k < 16; ++k) { sf[k] = 0.f; sb[k] = 0.f; }
        for (int bp = 0; bp < 9; ++bp) {
            const float wf = bp == 8 ? __builtin_amdgcn_exp2f(u.lgf * 256.f * (float)c) : (bp < c ? __builtin_amdgcn_exp2f(u.lgf * 256.f * (float)(c - 1 - bp)) : 0.f);
            const float wb = bp == 8 ? __builtin_amdgcn_exp2f(u.lgb * 256.f * (float)(7 - c)) : (bp > c ? __builtin_amdgcn_exp2f(u.lgb * 256.f * (float)(bp - c - 1)) : 0.f);
            const float* Lf = LB + (size_t)(bp * 2 + 0) * 64 * 128 + (16 * dg) * 128 + dv; const float* Lb = Lf + 64 * 128;
            if (wf != 0.f) {
#pragma unroll
                for (int k = 0; k < 16; ++k) sf[k] += wf * Lf[k * 128]; }
            if (wb != 0.f) {
#pragma unroll
                for (int k = 0; k < 16; ++k) sb[k] += wb * Lb[k * 128]; }
        }
        LAS unsigned char* sp = lds + S_OFF + dv * KPITCH + dg * 32;
        *(LAS u32x4*)(sp) = (u32x4){pk2(sf[0], sf[1]), pk2(sf[2], sf[3]), pk2(sf[4], sf[5]), pk2(sf[6], sf[7])};
        *(LAS u32x4*)(sp + 16) = (u32x4){pk2(sf[8], sf[9]), pk2(sf[10], sf[11]), pk2(sf[12], sf[13]), pk2(sf[14], sf[15])};
        *(LAS u32x4*)(sp + S_BYTES) = (u32x4){pk2(sb[0], sb[1]), pk2(sb[2], sb[3]), pk2(sb[4], sb[5]), pk2(sb[6], sb[7])};
        *(LAS u32x4*)(sp + S_BYTES + 16) = (u32x4){pk2(sb[8], sb[9]), pk2(sb[10], sb[11]), pk2(sb[12], sb[13]), pk2(sb[14], sb[15])};
        __syncthreads();
        const int p = qoff + r32; const float ai = __builtin_amdgcn_exp2f(u.lgf * (float)(p + 1)), bi = __builtin_amdgcn_exp2f(u.lgb * (float)(256 - p));
#pragma unroll
        for (int s4 = 0; s4 < 4; ++s4) {
            const u32x4 qw = __builtin_bit_cast(u32x4, qf[s4]); u32x4 qa, qb;
#pragma unroll
            for (int q = 0; q < 4; ++q) { const float lo = bflo(qw[q]), hh = bfhi(qw[q]); qa[q] = pk2(lo * ai, hh * ai); qb[q] = pk2(lo * bi, hh * bi); }
#pragma unroll
            for (int d = 0; d < 4; ++d) {
                const LAS unsigned char* bp = lds + S_OFF + (32 * d + r32) * KPITCH + (16 * s4 + 8 * hi) * 2;
                o[d] = __builtin_amdgcn_mfma_f32_32x32x16_bf16(__builtin_bit_cast(bf16x8, qa), *(const LAS bf16x8*)bp, o[d], 0, 0, 0);
                o[d] = __builtin_amdgcn_mfma_f32_32x32x16_bf16(__builtin_bit_cast(bf16x8, qb), *(const LAS bf16x8*)(bp + S_BYTES), o[d], 0, 0, 0);
            }
        }
    }
    u32x4 kA[2], vA[2];
    auto tile_row = [&](int t) { return t < u.ntA ? u.krowA + 64 * t : u.krowB + 64 * (t - u.ntA); };
    unsigned voffV[2], voffK[2];
#pragma unroll
    for (int i = 0; i < 2; ++i) { const int cid = tid + 512 * i, key = cid >> 4, c16 = cid & 15;
        voffV[i] = (unsigned)((key * NPROJ + vcol + c16 * 8) * 2); voffK[i] = (unsigned)((key * NPROJ + kcol + c16 * 8) * 2); }
    if (!diff) { const int key = tid >> 3, c8 = tid & 7; voffK[0] = (unsigned)((key * NPROJ + kcol + c8 * 8) * 2); }
    auto load_tile = [&](int t, u32x4 (&kr)[2], u32x4 (&vr)[2]) {
        const GAS unsigned char* tb = (const GAS unsigned char*)PROJ + (size_t)tile_row(t) * NPROJ * 2;
#pragma unroll
        for (int i = 0; i < 2; ++i) { vr[i] = *(const GAS u32x4*)(tb + voffV[i]); if (diff) kr[i] = *(const GAS u32x4*)(tb + voffK[i]); }
        if (!diff) kr[0] = *(const GAS u32x4*)(tb + voffK[0]);
    };
    auto store_tile = [&](int buf, const u32x4 (&kr)[2], const u32x4 (&vr)[2]) {
        LAS unsigned char* b = lds + buf * BUF_BYTES;
#pragma unroll
        for (int i = 0; i < 2; ++i) { const int cid = tid + 512 * i, key = cid >> 4, c16 = cid & 15;
            *(LAS u32x4*)(b + 2 * KC_BYTES + key * VPITCH + c16 * 16) = vr[i];
            if (diff) *(LAS u32x4*)(b + (c16 >> 3) * KC_BYTES + key * KPITCH + (c16 & 7) * 16) = kr[i]; }
        if (!diff) { const int key = tid >> 3, c8 = tid & 7; *(LAS u32x4*)(b + key * KPITCH + c8 * 16) = kr[0]; }
    };
    const int qpos = u.qpos0 + qoff + r32;
    auto compute_tile = [&](int t, int bufsel) {
        const LAS unsigned char* b = lds + bufsel * BUF_BYTES;
        const LAS unsigned char* kb = b + comp * KC_BYTES + r32 * KPITCH + hi * 16;
        u32x4 pw[4];
        const bool segB = t >= u.ntA; const int j0 = 64 * (segB ? t - u.ntA : t);
        f32x16 sc[2];
#pragma unroll
        for (int kh = 0; kh < 2; ++kh) { sc[kh] = (f32x16){};
#pragma unroll
            for (int s = 0; s < 4; ++s) { const bf16x8 kf = *(const LAS bf16x8*)(kb + kh * 32 * KPITCH + s * 32); sc[kh] = __builtin_amdgcn_mfma_f32_32x32x16_bf16(kf, qf[s], sc[kh], 0, 0, 0); } }
        auto weigh = [&](int kh) {
            f32x16& x = sc[kh];
            if (diff) {
#pragma unroll
                for (int r = 0; r < 16; ++r) x[r] = __builtin_amdgcn_exp2f(x[r]);
                float a = 0.f;
#pragma unroll
                for (int r = 0; r < 16; ++r) a += x[r];
                lsum += a;
            } else if (!segB || u.kindB == 0) {
#pragma unroll
                for (int r = 0; r < 16; ++r) { const int d = qpos - (j0 + 32 * kh + crow(r, hi)); x[r] *= __builtin_amdgcn_exp2f((float)d * (d >= 0 ? u.lgf : -u.lgb)); }
            } else {
#pragma unroll
                for (int r = 0; r < 16; ++r) { const int na = j0 + 32 * kh + crow(r, hi);
                    x[r] *= __builtin_amdgcn_exp2f((float)(qpos + CTX - na) * u.lgf) + __builtin_amdgcn_exp2f((float)(u.nseq - qpos + na) * u.lgb); }
            }
            pw[2 * kh] = (u32x4){pk2(x[0], x[1]), pk2(x[2], x[3]), pk2(x[4], x[5]), pk2(x[6], x[7])};
            pw[2 * kh + 1] = (u32x4){pk2(x[8], x[9]), pk2(x[10], x[11]), pk2(x[12], x[13]), pk2(x[14], x[15])};
        };
        const LAS unsigned char* vb = b + 2 * KC_BYTES + (4 * hi + ((lane & 15) >> 2)) * VPITCH + ((lane >> 4) & 1) * 32 + (lane & 3) * 8;
        auto pv = [&](int ks) {
#pragma unroll
            for (int dvb = 0; dvb < 4; ++dvb) {
                const s16x4 lo = vtr(vb + ks * 16 * VPITCH + dvb * 64), hi4 = vtr(vb + ks * 16 * VPITCH + 8 * VPITCH + dvb * 64);
                const bf16x8 vf = (bf16x8){lo[0], lo[1], lo[2], lo[3], hi4[0], hi4[1], hi4[2], hi4[3]};
                o[dvb] = __builtin_amdgcn_mfma_f32_32x32x16_bf16(__builtin_bit_cast(bf16x8, pw[ks]), vf, o[dvb], 0, 0, 0);
            }
        };
        weigh(0);
        pv(0); pv(1);
        weigh(1);
        pv(2); pv(3);
    };
    load_tile(0, kA, vA); store_tile(0, kA, vA);
#pragma unroll
    for (int s4 = 0; s4 < 4; ++s4) asm volatile("" : "+v"(qf[s4]));
    __syncthreads();
    for (int t = 0; t < NT; t += 2) {
        load_tile(t + 1, kA, vA);
        compute_tile(t, 0);
        store_tile(1, kA, vA);
        __syncthreads();
        load_tile(t + 2 < NT ? t + 2 : NT - 1, kA, vA);
        compute_tile(t + 1, 1);
        store_tile(0, kA, vA);
        __syncthreads();
    }
    LAS float* wsf = (LAS float*)(lds + SCR_OFF) + wid * 64;
    int lz = lane; asm volatile("" : "+v"(lz));
    const int r32e = lz & 31, hie = lz >> 5;
    if (diff) {
        lsum += __shfl_xor(lsum, 32);
        if (hie == 0) wsf[r32e] = __builtin_amdgcn_rcpf(lsum);
        LDS_WAIT();
        float rl[16];
#pragma unroll
        for (int r = 0; r < 16; ++r) rl[r] = wsf[crow(r, hie)];
        LAS float* XC = (LAS float*)lds;
        if (comp == 1) {
#pragma unroll
            for (int r = 0; r < 16; ++r) { const int q = qoff + crow(r, hie);
#pragma unroll
                for (int d = 0; d < 4; ++d) XC[q * 128 + 32 * d + r32e] = o[d][r] * rl[r] * u.lam; }
        }
        __syncthreads();
        if (comp == 0) {
            float ss[16];
#pragma unroll
            for (int r = 0; r < 16; ++r) { const int q = qoff + crow(r, hie); float a = 0.f;
#pragma unroll
                for (int d = 0; d < 4; ++d) { const float v = o[d][r] * rl[r] - XC[q * 128 + 32 * d + r32e]; o[d][r] = v; a += v * v; }
                ss[r] = a; }
#pragma unroll
            for (int r = 0; r < 16; ++r) { float a = ss[r]; a += __shfl_xor(a, 1); a += __shfl_xor(a, 2); a += __shfl_xor(a, 4); a += __shfl_xor(a, 8); a += __shfl_xor(a, 16);
                ss[r] = u.scale_out * __builtin_amdgcn_rsqf(a * (1.0f / 128.0f) + EPS); }
            bf16* DO = (bf16*)(F.ws + WS_FO + 2 * MIX_ONE);
#pragma unroll
            for (int r = 0; r < 16; ++r) { bf16* op = DO + (size_t)(u.outrow0 + qoff + crow(r, hie)) * 512 + u.h * 128 + r32e;
#pragma unroll
                for (int d = 0; d < 4; ++d) op[32 * d] = (bf16)f2bf(o[d][r] * ss[r]); }
        }
    } else {
        bf16* RO = (bf16*)(F.ws + WS_FO + 1 * MIX_ONE);
#pragma unroll
        for (int r = 0; r < 16; ++r) {
            float a = (o[0][r] + o[1][r]) + (o[2][r] + o[3][r]);
            a += __shfl_xor(a, 1); a += __shfl_xor(a, 2); a += __shfl_xor(a, 4); a += __shfl_xor(a, 8); a += __shfl_xor(a, 16);
            const float mu = a * (1.0f / 128.0f); float q = 0.f;
#pragma unroll
            for (int d = 0; d < 4; ++d) { const float v = o[d][r] - mu; o[d][r] = v; q += v * v; }
            q += __shfl_xor(q, 1); q += __shfl_xor(q, 2); q += __shfl_xor(q, 4); q += __shfl_xor(q, 8); q += __shfl_xor(q, 16);
            const float rstd = __builtin_amdgcn_rsqf(q * (1.0f / 128.0f) + EPS);
            const size_t row = (size_t)(u.outrow0 + qoff + crow(r, hie));
            const bf16* gp = PROJ + row * NPROJ + C_RG + u.h * 128 + r32e; bf16* op = RO + row * 512 + u.h * 128 + r32e;
#pragma unroll
            for (int d = 0; d < 4; ++d) { const float g = bf2f(gp[32 * d]); op[32 * d] = (bf16)f2bf(o[d][r] * rstd * siluf_(g)); }
        }
    }
    __syncthreads();
}
}

namespace rst {
constexpr int KP = 192, VP = 320, KB_BYTES = 128 * KP, VB_BYTES = 128 * VP;
__device__ __forceinline__ void unit(const Frame& F, int layer, int b, int h, int blk) {
    LAS unsigned char* lds = F.lds; const int tid = F.tid, lane = F.lane, wid = F.wave, hi = lane >> 5;
    const bf16* PROJ = (const bf16*)(F.ws + WS_PROJ);
    const int row0 = blk < 8 ? TC + b * SEQ + blk * 256 : b * CTX;
    const float lgf = inp(F, IN_RDEC)[(layer * 2 + 0) * 4 + h] * LOG2E, lgb = inp(F, IN_RDEC)[(layer * 2 + 1) * 4 + h] * LOG2E;
    const int dir = wid >> 2, dvb = wid & 3;
    f32x16 acc0 = (f32x16){}, acc1 = (f32x16){};
    for (int half = 0; half < 2; ++half) {
#pragma unroll
        for (int i = 0; i < 2; ++i) { const int cid = tid + 512 * i, tok = cid >> 3, c8 = cid & 7, p = half * 128 + tok;
            const u32x4 kv = *(const u32x4*)(PROJ + (size_t)(row0 + p) * NPROJ + C_RK + h * 64 + c8 * 8);
            const float wf = __builtin_amdgcn_exp2f((float)(255 - p) * lgf), wb = __builtin_amdgcn_exp2f((float)p * lgb);
            u32x4 kf, kb;
#pragma unroll
            for (int q = 0; q < 4; ++q) { const float lo = bflo(kv[q]), hh = bfhi(kv[q]); kf[q] = pk2(lo * wf, hh * wf); kb[q] = pk2(lo * wb, hh * wb); }
            *(LAS u32x4*)(lds + tok * KP + c8 * 16) = kf; *(LAS u32x4*)(lds + KB_BYTES + tok * KP + c8 * 16) = kb; }
#pragma unroll
        for (int i = 0; i < 4; ++i) { const int cid = tid + 512 * i, tok = cid >> 4, c16 = cid & 15, p = half * 128 + tok;
            *(LAS u32x4*)(lds + 2 * KB_BYTES + tok * VP + c16 * 16) = *(const u32x4*)(PROJ + (size_t)(row0 + p) * NPROJ + C_RV + h * 128 + c16 * 8); }
        __syncthreads();
        const LAS unsigned char* ka = lds + dir * KB_BYTES + (8 * hi + ((lane & 15) >> 2)) * KP + ((lane >> 4) & 1) * 32 + (lane & 3) * 8;
        const LAS unsigned char* va = lds + 2 * KB_BYTES + (8 * hi + ((lane & 15) >> 2)) * VP + dvb * 64 + ((lane >> 4) & 1) * 32 + (lane & 3) * 8;
#pragma unroll
        for (int ks = 0; ks < 8; ++ks) {
            const s16x4 v0 = att::vtr(va + ks * 16 * VP), v1 = att::vtr(va + ks * 16 * VP + 4 * VP);
            const bf16x8 vf = (bf16x8){v0[0], v0[1], v0[2], v0[3], v1[0], v1[1], v1[2], v1[3]};
            const s16x4 a0 = att::vtr(ka + ks * 16 * KP), a1 = att::vtr(ka + ks * 16 * KP + 4 * KP);
            const s16x4 b0 = att::vtr(ka + ks * 16 * KP + 64), b1 = att::vtr(ka + ks * 16 * KP + 4 * KP + 64);
            acc0 = __builtin_amdgcn_mfma_f32_32x32x16_bf16((bf16x8){a0[0], a0[1], a0[2], a0[3], a1[0], a1[1], a1[2], a1[3]}, vf, acc0, 0, 0, 0);
            acc1 = __builtin_amdgcn_mfma_f32_32x32x16_bf16((bf16x8){b0[0], b0[1], b0[2], b0[3], b1[0], b1[1], b1[2], b1[3]}, vf, acc1, 0, 0, 0);
        }
        __syncthreads();
    }
    float* L = (float*)(F.ws + WS_LBUF) + ((size_t)((b * 4 + h) * 9 + blk) * 2 + dir) * 64 * 128;
    const int r32 = lane & 31;
#pragma unroll
    for (int r = 0; r < 16; ++r) { const int d = att::crow(r, hi); L[(size_t)d * 128 + 32 * dvb + r32] = acc0[r]; L[(size_t)(32 + d) * 128 + 32 * dvb + r32] = acc1[r]; }
}
}
__device__ __forceinline__ void phase_retstate(Frame& F, int layer) {
    for (int i = F.vcu; i < 288; i += F.G) { const int blk = i % 9, bh = i / 9; rst::unit(F, layer, bh >> 2, bh & 3, blk); }
}


constexpr int NDFT_CU = 128;

__device__ __forceinline__ void phase_mixers(Frame& F, int layer, int rep) {
    const bool last = layer == DEPTH - 1;
#if !defined(ONLY_SUB) || ONLY_SUB == 1
    if ((int)blockIdx.x < NDFT_CU && F.G > NDFT_CU && !(rep > 0 && PROBE_MIX >= 2)) {
        {
            SchedGrid S{SEQ / 256, 4096 / 256, NDFT_CU, (int)blockIdx.x, (const char*)(F.ws + WS_DFTL), (const char*)(F.ws + WS_GT), (size_t)256 * 4096 * 2, (size_t)256 * 4096 * 2, 0, 0};
            EpiDFT E{(bf16*)(F.ws + WS_FO), SEQ, TC};
            pg8::gemm_phase(F.lds, F.tid, 4096, S, E);
        }
        if (!last) {
            SchedGrid S{1, 4096 / 256, NDFT_CU, (int)blockIdx.x, (const char*)(F.ws + WS_DFTC), (const char*)(F.ws + WS_GTC), (size_t)256 * 512 * 2, (size_t)256 * 512 * 2, 0, 0};
            EpiDFT E{(bf16*)(F.ws + WS_FO), CTX, 0};
            pg8::gemm_phase(F.lds, F.tid, 512, S, E);
        }
    }
#endif
#if defined(ONLY_SUB) && ONLY_SUB == 1
    return;
#endif
    const int nunits = last ? 96 : 108;
    const float lam = lam_of(F, layer), so = 1.0f - lam_init_of(layer);
    const int xq0 = (int)(xb_xcc_id() & 7u);
    volatile LAS unsigned* qw = (volatile LAS unsigned*)(F.lds + att::QW_OFF);
    for (int qi = 0; qi < 8; ++qi) {
    const int xq = (xq0 + qi) & 7;
    unsigned* qctr = F.ctl + CW_QUEUE + 64 * (xq + 8 * (layer + 2 * rep));
    for (;;) {
        if (F.tid == 0) *qw = __hip_atomic_fetch_add(qctr, 1u, RLX_AGENT);
        __syncthreads();
        const int i = (int)*qw;
        __syncthreads();
        if (i >= nunits) break;
        if (rep > 0 && PROBE_MIX != 0) { if (PROBE_MIX == 1) break; if (PROBE_MIX == 2 && i >= 64) break; if (PROBE_MIX == 3 && (i < 64 || i >= 96)) continue; }
        att::UnitDesc u{};
        u.lam = lam; u.scale_out = so;
        if (i < 64) { const int p = xq + 8 * (i >> 4), b = p >> 2, h = p & 3, qb = i & 15; u.mode = 0; u.h = h; u.qrow0 = TC + b * SEQ + qb * 128; u.qpos0 = qb * 128; u.krowA = TC + b * SEQ; u.ntA = 32; u.krowB = b * CTX; u.ntB = 4; }
        else if (i < 96) { const int j = i - 64, p = xq + 8 * (j >> 3), b = p >> 2, h = p & 3, qb = j & 7; u.mode = 1; u.h = h; u.qrow0 = TC + b * SEQ + qb * 256; u.qpos0 = 0; u.krowA = u.qrow0; u.ntA = 4; u.krowB = 0; u.ntB = 0; u.kindB = 0; u.nseq = SEQ; u.cross = 1; u.bh = b * 4 + h; u.blk = qb; }
        else if (i < 104) { const int j = i - 96, p = xq + 8 * (j >> 1), b = p >> 2, h = p & 3, qb = j & 1; u.mode = 0; u.h = h; u.qrow0 = b * CTX + qb * 128; u.qpos0 = qb * 128; u.krowA = b * CTX; u.ntA = 4; u.krowB = 0; u.ntB = 0; }
        else { const int j = i - 104, p = xq + 8 * j, b = p >> 2, h = p & 3; u.mode = 1; u.h = h; u.qrow0 = b * CTX; u.qpos0 = 0; u.krowA = b * CTX; u.ntA = 4; u.krowB = 0; u.ntB = 0; u.kindB = 0; u.nseq = CTX; }
        u.outrow0 = u.qrow0;
        if (u.mode == 1) { u.lgf = inp(F, IN_RDEC)[(layer * 2 + 0) * 4 + u.h] * LOG2E; u.lgb = inp(F, IN_RDEC)[(layer * 2 + 1) * 4 + u.h] * LOG2E; }
        if (u.mode == 0) att::unit<0>(F, u); else att::unit<1>(F, u);
    }
    }
}

__device__ __forceinline__ void phase_merge(Frame& F, int layer) {
    const int row_off = layer == DEPTH - 1 ? TC : 0, M = TA - row_off;
    SchedMerge S{M / 256, D / 256, F.G, (int)blockIdx.x, (const char*)(F.ws + WS_FO) + (size_t)row_off * 512 * 2, (const char*)(F.ws + WS_WFO + (size_t)layer * 3 * WMG_ONE), MIX_ONE, WMG_ONE, (size_t)256 * 512 * 2, (size_t)256 * 512 * 2};
    EpiMerge E{(const bf16*)(F.ws + WS_PROJ), (bf16*)(F.ws + WS_MIXB), row_off};
    pg8::gemm_phase(F.lds, F.tid, 512, S, E);
}
__device__ __forceinline__ void phase_outproj(Frame& F, int layer) {
    const int row_off = layer == DEPTH - 1 ? TC : 0, M = TA - row_off;
    SchedGrid S{M / 256, D / 256, F.G, (int)blockIdx.x, (const char*)(F.ws + WS_MIXB) + (size_t)row_off * D * 2, (const char*)(F.ws + WS_WOUT + layer * WOUT_L), (size_t)256 * D * 2, (size_t)256 * D * 2, 0, 0};
    const float* XR = (const float*)(F.ws + WS_XR);
    EpiOut E{layer == 0 ? inp(F, IN_CTX) : XR, layer == 0 ? inp(F, IN_X) : XR + (size_t)TC * D, (float*)(F.ws + WS_XR), (const float*)(F.ws + WS_MOD) + (size_t)layer * 9 * 6144 + 2 * 1024, row_off};
    pg8::gemm_phase(F.lds, F.tid, D, S, E);
}

__device__ __forceinline__ void phase_norm2(Frame& F, int layer) {
    const int gw = F.vcu * 8 + F.wave, NGW = F.G * 8, lane = F.lane, tid = F.tid;
    LAS float* wr_t = (LAS float*)F.lds;
    const float* wrt = inp(F, IN_WROUTER) + (size_t)layer * D * NE;
    for (int i = tid; i < D * NE; i += 512) { const int k = i >> 4, e = i & 15; wr_t[e * 1024 + k] = wrt[i]; }
    __syncthreads();
    const int r_lo = layer == DEPTH - 1 ? TC : 0;
    const float* XR = (const float*)(F.ws + WS_XR); bf16* HB = (bf16*)(F.ws + WS_HB); float* AFF = (float*)(F.ws + WS_AFF);
    for (int r = r_lo + gw; r < TA; r += NGW) {
        const int v = vec_of_row(r);
        f32x4 x[4];
#pragma unroll
        for (int j = 0; j < 4; ++j) x[j] = *(const f32x4*)(XR + (size_t)r * D + 4 * lane + 256 * j);
        float ss = 0.f;
#pragma unroll
        for (int j = 0; j < 4; ++j) ss += (x[j].x * x[j].x + x[j].y * x[j].y) + (x[j].z * x[j].z + x[j].w * x[j].w);
        const float rinv = __builtin_amdgcn_rsqf(wave_sum(ss) * (1.0f / D) + EPS);
        const float* g = inp(F, IN_GFFN) + (size_t)layer * D; const float* sh = mod_ptr(F, layer, v, 3); const float* scl = mod_ptr(F, layer, v, 4);
#pragma unroll
        for (int j = 0; j < 4; ++j) { const int k = 4 * lane + 256 * j; const f32x4 gv = *(const f32x4*)(g + k), sv = *(const f32x4*)(sh + k), cv = *(const f32x4*)(scl + k);
            x[j] = (x[j] * rinv * gv) * (cv + 1.0f) + sv;
            u32x2 w; w.x = pk2(x[j].x, x[j].y); w.y = pk2(x[j].z, x[j].w); *(u32x2*)(HB + (size_t)r * D + k) = w; }
        float mine = 0.f;
#pragma unroll
        for (int eg = 0; eg < 4; ++eg) {
            float a[4];
#pragma unroll
            for (int q = 0; q < 4; ++q) { float t = 0.f;
#pragma unroll
                for (int j = 0; j < 4; ++j) { const f32x4 w = *(const LAS f32x4*)(wr_t + (4 * eg + q) * 1024 + 4 * lane + 256 * j); t += (x[j].x * w.x + x[j].y * w.y) + (x[j].z * w.z + x[j].w * w.w); }
                a[q] = t; }
#pragma unroll
            for (int o = 1; o < 64; o <<= 1) {
#pragma unroll
                for (int q = 0; q < 4; ++q) a[q] += __shfl_xor(a[q], o); }
#pragma unroll
            for (int q = 0; q < 4; ++q) mine = (lane == 4 * eg + q) ? a[q] : mine;
            asm volatile("" ::: "memory");
        }
        float mx = mine;
        mx = fmaxf(mx, __shfl_xor(mx, 1)); mx = fmaxf(mx, __shfl_xor(mx, 2)); mx = fmaxf(mx, __shfl_xor(mx, 4)); mx = fmaxf(mx, __shfl_xor(mx, 8));
        const float ex = __expf(mine - mx); float den = ex;
        den += __shfl_xor(den, 1); den += __shfl_xor(den, 2); den += __shfl_xor(den, 4); den += __shfl_xor(den, 8);
        if (lane < 16) AFF[(size_t)r * 16 + lane] = ex * __builtin_amdgcn_rcpf(den);
    }
    __syncthreads();
}

__device__ __forceinline__ void phase_topk(Frame& F, int layer) {
    const bool last = layer == DEPTH - 1; const int tid = F.tid, lane = F.lane, wave = F.wave;
    const int RPE = last ? 2048 : 2304, lat_off = last ? 0 : 256;
    LAS unsigned* part = (LAS unsigned*)F.lds;
    LAS unsigned* cntG = part + 16;
    LAS unsigned* cntE = cntG + 32;
    LAS int* lst = (LAS int*)(cntE + 32);
    const float* AFF = (const float*)(F.ws + WS_AFF); int* INV = (int*)(F.ws + WS_INV); float* TOPW = (float*)(F.ws + WS_TOPW);
    const bf16* HB = (const bf16*)(F.ws + WS_HB); bf16* XS = (bf16*)(F.ws + WS_XS);
    const int nitems = last ? 128 : 256;
    for (int item = F.vcu; item < nitems; item += F.G) {
        int n, C, tokrow0, e, slot0;
        if (item < 128) { const int b = item >> 4; e = item & 15; n = SEQ; C = 256; tokrow0 = TC + b * SEQ; slot0 = e * RPE + lat_off + b * 256; }
        else { const int be = item - 128, b = be >> 4; e = be & 15; n = CTX; C = 32; tokrow0 = b * CTX; slot0 = e * RPE + b * 32; }
        float v[4]; unsigned key[4];
#pragma unroll
        for (int q = 0; q < 4; ++q) { const int i = tid + 512 * q; v[q] = i < n ? AFF[(size_t)(tokrow0 + i) * 16 + e] : 0.f; key[q] = __builtin_bit_cast(unsigned, v[q]); }
        unsigned t = 0u;
        for (int bit = 30; bit >= 0; --bit) {
            const unsigned cand = t | (1u << bit); unsigned c = 0u;
#pragma unroll
            for (int q = 0; q < 4; ++q) c += (unsigned)__builtin_popcountll(__ballot(key[q] >= cand));
            if (lane == 0) part[(bit & 1) * 8 + wave] = c;
            __syncthreads();
            unsigned tot = 0u;
#pragma unroll
            for (int w = 0; w < 8; ++w) tot += part[(bit & 1) * 8 + w];
            if (tot >= (unsigned)C) t = cand;
        }
        unsigned long long bg[4], be_[4];
#pragma unroll
        for (int q = 0; q < 4; ++q) { bg[q] = __ballot(key[q] > t); be_[q] = __ballot(key[q] == t && key[q] != 0u);
            if (lane == 0) { cntG[q * 8 + wave] = (unsigned)__builtin_popcountll(bg[q]); cntE[q * 8 + wave] = (unsigned)__builtin_popcountll(be_[q]); } }
        __syncthreads();
        unsigned totG = 0u, baseG[4] = {0u, 0u, 0u, 0u}, baseE[4] = {0u, 0u, 0u, 0u}; unsigned runG = 0u, runE = 0u;
#pragma unroll
        for (int q = 0; q < 4; ++q)
#pragma unroll
            for (int w = 0; w < 8; ++w) { const unsigned g = cntG[q * 8 + w], ee = cntE[q * 8 + w]; if (w == wave) { baseG[q] = runG; baseE[q] = runE; } runG += g; runE += ee; }
        totG = runG;
        const unsigned need = (unsigned)C - totG;
        const unsigned long long lt = (1ull << lane) - 1ull;
#pragma unroll
        for (int q = 0; q < 4; ++q) { const int i = tid + 512 * q;
            if (i < n) {
                const bool g = (bg[q] >> lane) & 1ull, eq = (be_[q] >> lane) & 1ull;
                const unsigned myG = baseG[q] + (unsigned)__builtin_popcountll(bg[q] & lt), myE = baseE[q] + (unsigned)__builtin_popcountll(be_[q] & lt);
                int sl = -1;
                if (g) sl = (int)myG; else if (eq && myE < need) sl = (int)(totG + myE);
                const int R = sl >= 0 ? slot0 + sl : -1;
                INV[(size_t)(tokrow0 + i) * 16 + e] = R;
                if (sl >= 0) { TOPW[R] = v[q]; lst[sl] = i; }
            } }
        __syncthreads();
        for (int sidx = wave; sidx < C; sidx += 8) { const int i = lst[sidx];
            const u32x4* src = (const u32x4*)(HB + (size_t)(tokrow0 + i) * D); u32x4* dst = (u32x4*)(XS + (size_t)(slot0 + sidx) * D);
            const u32x4 a = src[lane], bq = src[lane + 64]; dst[lane] = a; dst[lane + 64] = bq; }
        __syncthreads();
    }
}

__device__ __forceinline__ void phase_gateup(Frame& F, int layer) {
    const int RPE = layer == DEPTH - 1 ? 2048 : 2304;
    SchedGrid S{NE * RPE / 256, 4096 / 256, F.G, (int)blockIdx.x, (const char*)(F.ws + WS_XS), (const char*)(F.ws + WS_WGU), (size_t)256 * D * 2, (size_t)256 * D * 2, RPE / 256, WGU_E};
    EpiGU E{(bf16*)(F.ws + WS_HID)};
    pg8::gemm_phase(F.lds, F.tid, D, S, E);
}
__device__ __forceinline__ void phase_down(Frame& F, int layer) {
    const int RPE = layer == DEPTH - 1 ? 2048 : 2304;
    SchedGrid S{NE * RPE / 256, D / 256, F.G, (int)blockIdx.x, (const char*)(F.ws + WS_HID), (const char*)(F.ws + WS_WD), (size_t)256 * EH * 2, (size_t)256 * EH * 2, RPE / 256, WD_E};
    EpiDown E{(bf16*)(F.ws + WS_YE), (const float*)(F.ws + WS_TOPW)};
    pg8::gemm_phase(F.lds, F.tid, EH, S, E);
}

constexpr int NPHASE = 1 + 10 * DEPTH + 1;
__global__ void __launch_bounds__(512, 2) mk_fwd(Args args) {
    extern __shared__ __attribute__((aligned(16))) unsigned char lds_raw[];
    Frame F;
    F.lds = (LAS unsigned char*)lds_raw; F.MISC = (volatile LAS unsigned*)(F.lds + MISC_OFF);
    F.tid = threadIdx.x; F.lane = F.tid & 63; F.wave = __builtin_amdgcn_readfirstlane(F.tid >> 6);
    F.G = gridDim.x; { const int bx = blockIdx.x; F.vcu = (F.G % 8 == 0) ? (bx % 8) * (F.G / 8) + bx / 8 : bx; }
    F.ws = (unsigned char*)(GAS unsigned char*)(unsigned long long)args.ws; F.ctl = (unsigned*)(F.ws + WS_CTL); F.out = (float*)(GAS float*)(unsigned long long)args.out;
    for (int u = F.tid; u < (LDS_BYTES - LDSCTL_OFF) / 4; u += 512) ((LAS unsigned*)(F.lds + LDSCTL_OFF))[u] = 0u;
    __syncthreads();
    XcdBarrier bar; bar.bar = F.ctl + CW_BAR; bar.x = 0; bar.st = nullptr;
    const bool multi = (args.ph_hi - args.ph_lo) > 1;
    if (multi) bar = xcd_barrier_post(F.ctl + CW_BAR, F.MISC + 8);
    for (int ph = args.ph_lo; ph < args.ph_hi; ++ph) {
        const int layer = (ph - 1) / 10, k = (ph == 0) ? 10 : (ph == NPHASE - 1) ? 12 : (ph - 1) % 10;
        int reps = 1 + ((PROBE_MASK >> k) & 1);
        if (k == 0 && layer > 0 && (PROBE_MASK & 2048)) reps = 2;
        for (int rep = 0; rep < reps; ++rep) {
            { unsigned long long w = (unsigned long long)args.ws; asm volatile("" : "+s"(w)); F.ws = (unsigned char*)(GAS unsigned char*)w; F.ctl = (unsigned*)(F.ws + WS_CTL); }
            { unsigned long long kp = (unsigned long long)__builtin_amdgcn_kernarg_segment_ptr(); asm volatile("" : "+s"(kp)); F.karg = (const void __attribute__((address_space(4)))*)kp; }
            { int l = (int)__builtin_amdgcn_mbcnt_hi(~0u, __builtin_amdgcn_mbcnt_lo(~0u, 0u)); asm volatile("" : "+v"(l)); F.lane = l; F.tid = F.wave * 64 + l; }
#ifdef ONLY_PHASE
            if (k != ONLY_PHASE) continue;
#endif
            switch (k) {
                case 10: phase_prologue(F); break;
                case 12: phase_norm(F, DEPTH); break;
                case 0: if (rep == 0) phase_norm(F, layer); if (layer > 0) convert_expert_weights(F, layer); break;
                case 1: phase_inproj(F, layer); break;
                case 2: phase_retstate(F, layer); break;
                case 3: phase_mixers(F, layer, rep); break;
                case 4: phase_merge(F, layer); break;
                case 5: if (rep == 0) phase_outproj(F, layer); break;
                case 6: phase_norm2(F, layer); break;
                case 7: phase_topk(F, layer); break;
                case 8: phase_gateup(F, layer); break;
                default: phase_down(F, layer); break;
            }
            if (rep + 1 < reps || ph + 1 < args.ph_hi) xcd_barrier(bar);
        }
    }
}

extern "C" void kernel_launch(void* const* d_in, const int* in_sizes, int n_in, void* d_out, int out_size, void* d_ws, size_t ws_size, hipStream_t stream) {
    static int grid = 0;
    if (grid == 0) {
        if (n_in != 21 || out_size != TL * D || ws_size < WS_END) { fprintf(stderr, "kernel_launch: unexpected shapes (n_in %d, out %d, ws %zu need %zu)\n", n_in, out_size, ws_size, (size_t)WS_END); grid = -1; return; }
        int dev = 0, cus = 0, per_cu = 0;
        if (hipGetDevice(&dev) != hipSuccess || hipDeviceGetAttribute(&cus, hipDeviceAttributeMultiprocessorCount, dev) != hipSuccess) { grid = -1; return; }
        if (hipFuncSetAttribute((const void*)mk_fwd, hipFuncAttributeMaxDynamicSharedMemorySize, LDS_BYTES) != hipSuccess) { fprintf(stderr, "kernel_launch: hipFuncSetAttribute failed\n"); grid = -1; return; }
        if (hipOccupancyMaxActiveBlocksPerMultiprocessor(&per_cu, (const void*)mk_fwd, 512, LDS_BYTES) != hipSuccess || per_cu < 1) { fprintf(stderr, "kernel_launch: occupancy query says %d\n", per_cu); per_cu = 1; }
        (void)hipGetLastError();
        grid = cus * (per_cu >= 1 ? 1 : 1);
        if (grid % 8 != 0 || grid <= NDFT_CU) fprintf(stderr, "kernel_launch: unusual grid %d\n", grid);
    }
    if (grid < 0) return;
    (void)hipMemsetAsync((char*)d_ws + WS_CTL, 0, CTL_BYTES, stream);
    Args a{};
    for (int i = 0; i < 21; ++i) a.in[i] = (const float*)d_in[i];
    a.out = (float*)d_out; a.ws = (unsigned char*)d_ws;
#if MK_MULTI_LAUNCH
    for (int ph = 0; ph < NPHASE; ++ph) { a.ph_lo = ph; a.ph_hi = ph + 1; hipLaunchKernelGGL(mk_fwd, dim3(grid), dim3(512), LDS_BYTES, stream, a); }
#else
    a.ph_lo = 0; a.ph_hi = NPHASE;
    void* kargs[] = {&a};
    hipError_t e = hipLaunchCooperativeKernel((const void*)mk_fwd, dim3(grid), dim3(512), kargs, LDS_BYTES, stream);
    if (e != hipSuccess) fprintf(stderr, "kernel_launch: cooperative launch failed: %s (grid %d)\n", hipGetErrorString(e), grid);
#endif
}
```

```cpp
#include <hip/hip_runtime.h>
#include <cstdio>
#include <cstdint>

#ifndef PROBE_MASK
#define PROBE_MASK 0
#endif
#ifndef PROBE_MIX
#define PROBE_MIX 0
#endif
#ifndef PROBE_STAT
#define PROBE_STAT 0
#endif
#ifndef MK_MULTI_LAUNCH
#define MK_MULTI_LAUNCH 0
#endif

#define GAS __attribute__((address_space(1)))
#define LAS __attribute__((address_space(3)))
typedef unsigned short bf16;
typedef short bf16x8 __attribute__((ext_vector_type(8)));
typedef short s16x4 __attribute__((ext_vector_type(4)));
typedef float f32x4 __attribute__((ext_vector_type(4)));
typedef float f32x16 __attribute__((ext_vector_type(16)));
typedef unsigned u32x4 __attribute__((ext_vector_type(4)));
typedef unsigned u32x2 __attribute__((ext_vector_type(2)));
typedef float f32x2_t __attribute__((ext_vector_type(2)));
typedef __bf16 bf16x2_t __attribute__((ext_vector_type(2)));

constexpr int D = 1024, NB = 8, SEQ = 2048, CTX = 256, DEPTH = 2, GRIDW = 64;
constexpr int TC = NB * CTX, TL = NB * SEQ, TA = TC + TL;
constexpr int NWPROJ = 6144;
constexpr int NPROJ = 3072;
constexpr int C_RQ = 0, C_RK = 256, C_RV = 512, C_RG = 1024, C_DQ = 1536, C_DK = 2048, C_DV = 2560, C_GATE = 3072;
constexpr int INW = 6656;
constexpr int NE = 16, EH = 2048;
constexpr float EPS = 1e-6f;
constexpr float LOG2E = 1.4426950408889634f;

constexpr size_t al(size_t x) { return (x + 0xFFFFFull) & ~0xFFFFFull; }
constexpr size_t WS_CTL = 0, CTL_BYTES = 1u << 20;
constexpr size_t WS_MOD = WS_CTL + CTL_BYTES;
constexpr size_t WS_ROPE = WS_MOD + al((size_t)DEPTH * 9 * 6 * D * 4);
constexpr size_t WS_AFF = WS_ROPE + al((size_t)2 * SEQ * 32 * 4);
constexpr size_t WS_INV = WS_AFF + al((size_t)TA * 16 * 4);
constexpr size_t WS_TOPW = WS_INV + al((size_t)TA * 16 * 4);
constexpr size_t WS_SLOT = WS_TOPW + al((size_t)36864 * 4);
constexpr size_t WS_WIN = WS_SLOT + al((size_t)36864 * 4);
constexpr size_t WIN_L = (size_t)7168 * 1024 * 2;
constexpr size_t WS_WFO = WS_WIN + al(2 * WIN_L);
constexpr size_t WMG_ONE = (size_t)1024 * 512 * 2;
constexpr size_t WS_WOUT = WS_WFO + al(6 * WMG_ONE);
constexpr size_t WOUT_L = (size_t)1024 * 1024 * 2;
constexpr size_t WS_WGU = WS_WOUT + al(2 * WOUT_L);
constexpr size_t WGU_E = (size_t)4096 * 1024 * 2;
constexpr size_t WS_WD = WS_WGU + al(16 * WGU_E);
constexpr size_t WD_E = (size_t)1024 * 2048 * 2;
constexpr size_t WS_DFTL = WS_WD + al(16 * WD_E);
constexpr size_t WS_DFTC = WS_DFTL + al((size_t)2048 * 4096 * 2);
constexpr size_t WS_XR = WS_DFTC + al((size_t)256 * 512 * 2);
constexpr size_t WS_HB = WS_XR + al((size_t)TA * D * 4);
constexpr size_t WS_PROJ = WS_HB + al((size_t)TA * D * 2);
constexpr size_t WS_GT = WS_PROJ + al((size_t)TA * NPROJ * 2);
constexpr size_t WS_GTC = WS_GT + al((size_t)4096 * 4096 * 2);
constexpr size_t WS_FO = WS_GTC + al((size_t)4096 * 512 * 2);
constexpr size_t MIX_ONE = (size_t)TA * 512 * 2;
constexpr size_t WS_MIXB = WS_FO + al(3 * MIX_ONE);
constexpr size_t WS_XS = WS_MIXB + al((size_t)TA * D * 2);
constexpr size_t WS_LBUF = WS_XS + al((size_t)36864 * D * 2);
constexpr size_t LBUF_ONE = (size_t)64 * 128 * 4;
constexpr size_t WS_GT2 = WS_LBUF + al((size_t)32 * 9 * 2 * LBUF_ONE);
constexpr size_t WS_GTC2 = WS_GT2 + al((size_t)4096 * 2048 * 2);
constexpr size_t WS_G8 = WS_GTC2 + al((size_t)4096 * 256 * 2);
constexpr size_t WS_HID = WS_G8 + al((size_t)TA * 3072);
constexpr size_t WS_END = WS_HID + al((size_t)36864 * EH * 2);

constexpr size_t WS_YE = WS_XS;

static_assert(WS_END <= (size_t)1024 * 1024 * 1024, "workspace map must fit 1 GiB");

constexpr int CW_BAR = 4096;
constexpr int CW_STAT = 40000;
constexpr int CW_QUEUE = 16384;

constexpr int RING_BYTES = 131072;
constexpr int LDSCTL_OFF = RING_BYTES, MISC_OFF = LDSCTL_OFF + 320;
constexpr int LDS_BYTES = 147456;

#define RLX_AGENT __ATOMIC_RELAXED, __HIP_MEMORY_SCOPE_AGENT
#define LDS_WAIT() asm volatile("s_waitcnt lgkmcnt(0)" ::: "memory")
#define VM_WAIT() asm volatile("s_waitcnt vmcnt(0)" ::: "memory")
__device__ __forceinline__ unsigned f2bf(float f) { unsigned u = __builtin_bit_cast(unsigned, f); return (u + 0x7fffu + ((u >> 16) & 1u)) >> 16; }
__device__ __forceinline__ unsigned pk2(float lo, float hi) { f32x2_t v = {lo, hi}; bf16x2_t b = __builtin_convertvector(v, bf16x2_t); return __builtin_bit_cast(unsigned, b); }
__device__ __forceinline__ float bflo(unsigned w) { return __builtin_bit_cast(float, w << 16); }
__device__ __forceinline__ float bfhi(unsigned w) { return __builtin_bit_cast(float, w & 0xffff0000u); }
__device__ __forceinline__ float bf2f(bf16 h) { return __builtin_bit_cast(float, (unsigned)h << 16); }
template <int CTRL> __device__ __forceinline__ float dppf(float x) { return __builtin_bit_cast(float, __builtin_amdgcn_mov_dpp(__builtin_bit_cast(int, x), CTRL, 0xf, 0xf, true)); }
constexpr int DPP_XOR1 = 0xB1, DPP_XOR2 = 0x4E, DPP_HMIRROR = 0x141, DPP_ROR8 = 0x128, DPP_SHL4 = 0x104, DPP_SHR4 = 0x114;
__device__ __forceinline__ float lane_xor16(float x, int lane) { auto s = __builtin_amdgcn_permlane16_swap(__float_as_uint(x), __float_as_uint(x), false, false); return __uint_as_float((lane & 16) ? s[0] : s[1]); }
__device__ __forceinline__ float lane_xor32(float x, int lane) { auto s = __builtin_amdgcn_permlane32_swap(__float_as_uint(x), __float_as_uint(x), false, false); return __uint_as_float((lane & 32) ? s[0] : s[1]); }
__device__ __forceinline__ float lane_xor8(float x) { return dppf<DPP_ROR8>(x); }
__device__ __forceinline__ float lane_xor4(float x, int lane) { const float a = dppf<DPP_SHL4>(x), b = dppf<DPP_SHR4>(x); return (lane & 4) ? b : a; }
__device__ __forceinline__ float sum16x2(float v) { auto s = __builtin_amdgcn_permlane16_swap(__float_as_uint(v), __float_as_uint(v), false, false); return __uint_as_float(s[0]) + __uint_as_float(s[1]); }
__device__ __forceinline__ float sum32x2(float v) { auto s = __builtin_amdgcn_permlane32_swap(__float_as_uint(v), __float_as_uint(v), false, false); return __uint_as_float(s[0]) + __uint_as_float(s[1]); }
__device__ __forceinline__ float wave_sum(float v) {
    v += dppf<DPP_XOR1>(v); v += dppf<DPP_XOR2>(v); v += dppf<DPP_HMIRROR>(v); v += dppf<DPP_ROR8>(v);
    v = sum16x2(v); v = sum32x2(v); return v;
}
__device__ __forceinline__ float half_sum(float v) {
    v += dppf<DPP_XOR1>(v); v += dppf<DPP_XOR2>(v); v += dppf<DPP_HMIRROR>(v); v += dppf<DPP_ROR8>(v); return sum16x2(v);
}
__device__ __forceinline__ float sigmoidf_(float x) { return __builtin_amdgcn_rcpf(1.0f + __builtin_amdgcn_exp2f(-x * LOG2E)); }
__device__ __forceinline__ float siluf_(float x) { return x * sigmoidf_(x); }

namespace pg8 {
constexpr int BM = 256, BK = 64, HALF = 128, HTB = HALF * BK * 2, STAGE_BYTES = 8 * HTB, NXCD = 8, WGM = 8;
__host__ __device__ __forceinline__ int lds_byte(int r, int c) { const int st = (r >> 4) * 2 + (c >> 5), rr = r & 15, cc = c & 31, ob = rr * 64 + cc * 2; return st * 1024 + (ob ^ (((ob >> 9) & 1) << 5)); }
__host__ __device__ __forceinline__ void stage_rc(int b, int& R, int& C) { const int st = b / 1024, sb = b % 1024, swz = sb ^ (((sb >> 9) & 1) << 5); R = (st >> 1) * 16 + swz / 64; C = (st & 1) * 32 + (swz % 64) / 2; }
__host__ __device__ __forceinline__ int perm32(int rho) { const int n = rho >> 4, i = rho & 15; return 8 * (i >> 2) + 4 * n + (i & 3); }

struct Unit { int pm, pn, tag; const char* A; const char* B; };

__device__ __forceinline__ bool grid_order(long L, int nM, int nN, int& pm, int& pn) {
    const int nwg = nM * nN; if (L >= nwg) return false;
    int wgid = (int)L; { const int q = nwg / NXCD, r = nwg % NXCD, xcd = wgid % NXCD, off = wgid / NXCD; wgid = (xcd < r ? xcd * (q + 1) : r * (q + 1) + (xcd - r) * q) + off; }
    const int nig = WGM * nN, gid = wgid / nig, fm = gid * WGM, gsz = (nM - fm) < WGM ? (nM - fm) : WGM;
    pm = fm + ((wgid % nig) % gsz); pn = (wgid % nig) / gsz; return true;
}

typedef f32x4 Acc[2][2][4][2];
__device__ __forceinline__ void zero_acc(Acc& acc) {
#pragma unroll
    for (int a = 0; a < 2; ++a)
#pragma unroll
        for (int b = 0; b < 2; ++b)
#pragma unroll
            for (int m = 0; m < 4; ++m)
#pragma unroll
                for (int n = 0; n < 2; ++n) acc[a][b][m][n] = (f32x4){0.f, 0.f, 0.f, 0.f};
}

template <class Epi, class Sched>
__device__ __forceinline__ void gemm_phase(LAS unsigned char* lds, const int tid, const int K, const Sched& S, const Epi& E) {
    const int wid = __builtin_amdgcn_readfirstlane(tid >> 6), lane = tid & 63, wr = wid >> 2, wc = wid & 3, fr = lane & 15, fq = lane >> 4;
    const int nt = K / BK;
    unsigned voffA[2], voffB[2];
#pragma unroll
    for (int i = 0; i < 2; ++i) { int R, C; stage_rc(tid * 16 + i * 8192, R, C); const int Rb = Epi::PERM ? ((R & ~31) + perm32(R & 31)) : R;
        voffA[i] = (unsigned)(R * K + C) * 2u; voffB[i] = (unsigned)(Rb * K + C) * 2u; }
    const size_t kstep = (size_t)(BK * 2);
    const size_t hstep = (size_t)HALF * K * 2;
    const unsigned ldsw = (unsigned)wid * 1024u;
    const int aoff = lds_byte(wr * 64 + fr, fq * 8), boff = lds_byte(wc * 32 + fr, fq * 8);
#define PG8_SA(b, h) (((b) * 2 + (h)) * HTB)
#define PG8_SB(b, h) ((4 + (b) * 2 + (h)) * HTB)
#define PG8_STAGE(bufoff, gbase, voff) do { _Pragma("unroll") for (int _i = 0; _i < 2; ++_i) \
        __builtin_amdgcn_global_load_lds((const unsigned*)((const char*)(gbase) + (voff)[_i]), (LAS unsigned*)(lds + (bufoff) + ldsw + _i * 8192), 16, 0, 0); } while (0)
#define PG8_LDA(dst, b, h) do { _Pragma("unroll") for (int m = 0; m < 4; ++m) _Pragma("unroll") for (int k = 0; k < 2; ++k) dst[m][k] = *(const LAS bf16x8*)(lds + PG8_SA(b, h) + aoff + m * 2048 + k * 1024); } while (0)
#define PG8_LDB(dst, b, h) do { _Pragma("unroll") for (int n = 0; n < 2; ++n) _Pragma("unroll") for (int k = 0; k < 2; ++k) dst[n][k] = *(const LAS bf16x8*)(lds + PG8_SB(b, h) + boff + n * 2048 + k * 1024); } while (0)
#define PG8_MMA(ai, bj, At, Bt) do { __builtin_amdgcn_s_setprio(1); _Pragma("unroll") for (int m = 0; m < 4; ++m) _Pragma("unroll") for (int n = 0; n < 2; ++n) _Pragma("unroll") for (int k = 0; k < 2; ++k) \
        acc[ai][bj][m][n] = __builtin_amdgcn_mfma_f32_16x16x32_bf16(Bt[n][k], At[m][k], acc[ai][bj][m][n], 0, 0, 0); __builtin_amdgcn_s_setprio(0); } while (0)
#define PG8_WAIT_V(n) asm volatile("s_waitcnt vmcnt(" #n ")" ::: "memory")
#define PG8_WAIT_L(n) asm volatile("s_waitcnt lgkmcnt(" #n ")" ::: "memory")
#define PG8_BAR __builtin_amdgcn_s_barrier()
#define PG8_SCHED __builtin_amdgcn_sched_barrier(0)
    Unit cur, nxt; int ui = 0;
    if (!S.next(0, cur)) return;
    Acc acc; zero_acc(acc);
    bf16x8 At[4][2], B0[2][2], B1[2][2];
    const char* cA = cur.A; const char* cB = cur.B;
    PG8_STAGE(PG8_SB(0, 0), cB, voffB); PG8_STAGE(PG8_SB(0, 1), cB + hstep, voffB); PG8_STAGE(PG8_SA(0, 0), cA, voffA); PG8_STAGE(PG8_SA(0, 1), cA + hstep, voffA);
    if (wr == 1) PG8_BAR;
    PG8_WAIT_V(2); PG8_BAR;
    PG8_STAGE(PG8_SB(1, 0), cB + kstep, voffB); PG8_STAGE(PG8_SA(1, 0), cA + kstep, voffA); PG8_STAGE(PG8_SB(1, 1), cB + hstep + kstep, voffB);
    PG8_WAIT_V(6); PG8_BAR;
    for (;;) {
        const bool has_next = S.next(ui + 1, nxt);
        const char* nA = has_next ? nxt.A : cA; const char* nB = has_next ? nxt.B : cB;
        for (int t = 0; t < nt; t += 2) {
            const bool last = (t == nt - 2);
            const char* a1 = cA + (size_t)(t + 1) * kstep;
            const char* a2 = last ? nA : cA + (size_t)(t + 2) * kstep; const char* b2 = last ? nB : cB + (size_t)(t + 2) * kstep;
            const char* a3 = a2 + kstep; const char* b3 = b2 + kstep;
            PG8_LDB(B0, 0, 0); PG8_LDB(B1, 0, 1); PG8_SCHED; PG8_LDA(At, 0, 0); PG8_STAGE(PG8_SA(1, 1), a1 + hstep, voffA);
            PG8_WAIT_V(8); PG8_WAIT_L(0); PG8_BAR; PG8_MMA(0, 0, At, B0); PG8_MMA(0, 1, At, B1); PG8_BAR; PG8_SCHED;
            PG8_LDA(At, 0, 1); PG8_STAGE(PG8_SB(0, 0), b2, voffB); PG8_STAGE(PG8_SB(0, 1), b2 + hstep, voffB); PG8_STAGE(PG8_SA(0, 0), a2, voffA);
            PG8_WAIT_V(8); PG8_WAIT_L(0); PG8_BAR; PG8_MMA(1, 0, At, B0); PG8_MMA(1, 1, At, B1); PG8_BAR; PG8_SCHED;
            PG8_LDB(B0, 1, 0); PG8_LDB(B1, 1, 1); PG8_SCHED; PG8_LDA(At, 1, 0); PG8_STAGE(PG8_SA(0, 1), a2 + hstep, voffA);
            PG8_WAIT_V(8); PG8_WAIT_L(0); PG8_BAR; PG8_MMA(0, 0, At, B0); PG8_MMA(0, 1, At, B1); PG8_BAR; PG8_SCHED;
            PG8_LDA(At, 1, 1); PG8_STAGE(PG8_SB(1, 0), b3, voffB); PG8_STAGE(PG8_SB(1, 1), b3 + hstep, voffB); PG8_STAGE(PG8_SA(1, 0), a3, voffA);
            PG8_WAIT_V(8); PG8_WAIT_L(0); PG8_BAR; PG8_MMA(1, 0, At, B0); PG8_MMA(1, 1, At, B1); PG8_BAR; PG8_SCHED;
        }
        if (wr == 0) PG8_BAR;
        E(acc, cur, wr, wc, fr, fq);
        if (!has_next) break;
        cur = nxt; cA = nA; cB = nB; ++ui;
        if (wr == 1) PG8_BAR;
    }
    PG8_WAIT_V(0);
    PG8_BAR;
#undef PG8_SA
#undef PG8_SB
#undef PG8_STAGE
#undef PG8_LDA
#undef PG8_LDB
#undef PG8_MMA
#undef PG8_WAIT_V
#undef PG8_WAIT_L
#undef PG8_BAR
#undef PG8_SCHED
}
template <class Epi, class Sched>
__device__ __forceinline__ void gemm_phase_gather(LAS unsigned char* lds, const int tid, const int K, const Sched& S, const Epi& E, const char* gbase, const int* gidx, LAS int* glist) {
    const int wid = __builtin_amdgcn_readfirstlane(tid >> 6), lane = tid & 63, wr = wid >> 2, wc = wid & 3, fr = lane & 15, fq = lane >> 4;
    const int nt = K / BK;
    unsigned voffB[2]; int rowA[2]; unsigned colA[2];
#pragma unroll
    for (int i = 0; i < 2; ++i) { int R, C; stage_rc(tid * 16 + i * 8192, R, C); const int Rb = Epi::PERM ? ((R & ~31) + perm32(R & 31)) : R;
        rowA[i] = R; colA[i] = (unsigned)C * 2u; voffB[i] = (unsigned)(Rb * K + C) * 2u; }
    { Unit u0; for (int q = 0; q < 12 && S.next(q, u0); ++q) { if (tid < 256) glist[q * 256 + tid] = gidx[u0.pm * 256 + tid]; } }
    asm volatile("s_waitcnt vmcnt(0) lgkmcnt(0)" ::: "memory"); __builtin_amdgcn_s_barrier(); asm volatile("" ::: "memory");
    unsigned vc[2][2], vn[2][2];
#define PG8_GOFF(dst, q) do { _Pragma("unroll") for (int h_ = 0; h_ < 2; ++h_) _Pragma("unroll") for (int i_ = 0; i_ < 2; ++i_) dst[h_][i_] = (unsigned)glist[(q) * 256 + h_ * 128 + rowA[i_]] * (unsigned)(K * 2) + colA[i_]; } while (0)
    const size_t kstep = (size_t)(BK * 2);
    const size_t hstep = (size_t)HALF * K * 2;
    const unsigned ldsw = (unsigned)wid * 1024u;
    const int aoff = lds_byte(wr * 64 + fr, fq * 8), boff = lds_byte(wc * 32 + fr, fq * 8);
#define PG8_SA(b, h) (((b) * 2 + (h)) * HTB)
#define PG8_SB(b, h) ((4 + (b) * 2 + (h)) * HTB)
#define PG8_STAGE(bufoff, gbase, voff) do { _Pragma("unroll") for (int _i = 0; _i < 2; ++_i) \
        __builtin_amdgcn_global_load_lds((const unsigned*)((const char*)(gbase) + (voff)[_i]), (LAS unsigned*)(lds + (bufoff) + ldsw + _i * 8192), 16, 0, 0); } while (0)
#define PG8_LDA(dst, b, h) do { _Pragma("unroll") for (int m = 0; m < 4; ++m) _Pragma("unroll") for (int k = 0; k < 2; ++k) dst[m][k] = *(const LAS bf16x8*)(lds + PG8_SA(b, h) + aoff + m * 2048 + k * 1024); } while (0)
#define PG8_LDB(dst, b, h) do { _Pragma("unroll") for (int n = 0; n < 2; ++n) _Pragma("unroll") for (int k = 0; k < 2; ++k) dst[n][k] = *(const LAS bf16x8*)(lds + PG8_SB(b, h) + boff + n * 2048 + k * 1024); } while (0)
#define PG8_MMA(ai, bj, At, Bt) do { __builtin_amdgcn_s_setprio(1); _Pragma("unroll") for (int m = 0; m < 4; ++m) _Pragma("unroll") for (int n = 0; n < 2; ++n) _Pragma("unroll") for (int k = 0; k < 2; ++k) \
        acc[ai][bj][m][n] = __builtin_amdgcn_mfma_f32_16x16x32_bf16(Bt[n][k], At[m][k], acc[ai][bj][m][n], 0, 0, 0); __builtin_amdgcn_s_setprio(0); } while (0)
#define PG8_WAIT_V(n) asm volatile("s_waitcnt vmcnt(" #n ")" ::: "memory")
#define PG8_WAIT_L(n) asm volatile("s_waitcnt lgkmcnt(" #n ")" ::: "memory")
#define PG8_BAR __builtin_amdgcn_s_barrier()
#define PG8_SCHED __builtin_amdgcn_sched_barrier(0)
    Unit cur, nxt; int ui = 0;
    if (!S.next(0, cur)) return;
    Acc acc; zero_acc(acc);
    bf16x8 At[4][2], B0[2][2], B1[2][2];
    const char* cB = cur.B; PG8_GOFF(vc, 0);
    PG8_STAGE(PG8_SB(0, 0), cB, voffB); PG8_STAGE(PG8_SB(0, 1), cB + hstep, voffB); PG8_STAGE(PG8_SA(0, 0), gbase, vc[0]); PG8_STAGE(PG8_SA(0, 1), gbase, vc[1]);
    if (wr == 1) PG8_BAR;
    PG8_WAIT_V(2); PG8_BAR;
    PG8_STAGE(PG8_SB(1, 0), cB + kstep, voffB); PG8_STAGE(PG8_SA(1, 0), gbase + kstep, vc[0]); PG8_STAGE(PG8_SB(1, 1), cB + hstep + kstep, voffB);
    PG8_WAIT_V(6); PG8_BAR;
    for (;;) {
        const bool has_next = S.next(ui + 1, nxt);
        const char* nB = has_next ? nxt.B : cB;
        if (has_next) PG8_GOFF(vn, ui + 1); else { vn[0][0] = vc[0][0]; vn[0][1] = vc[0][1]; vn[1][0] = vc[1][0]; vn[1][1] = vc[1][1]; }
        for (int t = 0; t < nt; t += 2) {
            const bool last = (t == nt - 2);
            const char* a1 = gbase + (size_t)(t + 1) * kstep;
            const char* a2 = last ? gbase : gbase + (size_t)(t + 2) * kstep; const char* b2 = last ? nB : cB + (size_t)(t + 2) * kstep;
            const char* a3 = a2 + kstep; const char* b3 = b2 + kstep;
            unsigned v20[2] = {last ? vn[0][0] : vc[0][0], last ? vn[0][1] : vc[0][1]}, v21[2] = {last ? vn[1][0] : vc[1][0], last ? vn[1][1] : vc[1][1]};
            PG8_LDB(B0, 0, 0); PG8_LDB(B1, 0, 1); PG8_SCHED; PG8_LDA(At, 0, 0); PG8_STAGE(PG8_SA(1, 1), a1, vc[1]);
            PG8_WAIT_V(8); PG8_WAIT_L(0); PG8_BAR; PG8_MMA(0, 0, At, B0); PG8_MMA(0, 1, At, B1); PG8_BAR; PG8_SCHED;
            PG8_LDA(At, 0, 1); PG8_STAGE(PG8_SB(0, 0), b2, voffB); PG8_STAGE(PG8_SB(0, 1), b2 + hstep, voffB); PG8_STAGE(PG8_SA(0, 0), a2, v20);
            PG8_WAIT_V(8); PG8_WAIT_L(0); PG8_BAR; PG8_MMA(1, 0, At, B0); PG8_MMA(1, 1, At, B1); PG8_BAR; PG8_SCHED;
            PG8_LDB(B0, 1, 0); PG8_LDB(B1, 1, 1); PG8_SCHED; PG8_LDA(At, 1, 0); PG8_STAGE(PG8_SA(0, 1), a2, v21);
            PG8_WAIT_V(8); PG8_WAIT_L(0); PG8_BAR; PG8_MMA(0, 0, At, B0); PG8_MMA(0, 1, At, B1); PG8_BAR; PG8_SCHED;
            PG8_LDA(At, 1, 1); PG8_STAGE(PG8_SB(1, 0), b3, voffB); PG8_STAGE(PG8_SB(1, 1), b3 + hstep, voffB); PG8_STAGE(PG8_SA(1, 0), a3, v20);
            PG8_WAIT_V(8); PG8_WAIT_L(0); PG8_BAR; PG8_MMA(1, 0, At, B0); PG8_MMA(1, 1, At, B1); PG8_BAR; PG8_SCHED;
        }
        if (wr == 0) PG8_BAR;
        E(acc, cur, wr, wc, fr, fq);
        if (!has_next) break;
        cur = nxt; cB = nB; ++ui; vc[0][0] = vn[0][0]; vc[0][1] = vn[0][1]; vc[1][0] = vn[1][0]; vc[1][1] = vn[1][1];
        if (wr == 1) PG8_BAR;
    }
    PG8_WAIT_V(0);
    PG8_BAR;
#undef PG8_GOFF
#undef PG8_SA
#undef PG8_SB
#undef PG8_STAGE
#undef PG8_LDA
#undef PG8_LDB
#undef PG8_MMA
#undef PG8_WAIT_V
#undef PG8_WAIT_L
#undef PG8_BAR
#undef PG8_SCHED
}
}

#define XB_TMO      128
#define XB_XCNT(j)  (256  + 64 * (j))
#define XB_XSUB(j)  (1280 + 64 * (j))
#define XB_XGEN(j)  (2304 + 64 * (j))
#define XB_TOP      3328
#define XB_TOPGEN   3392
#define XCD_BAR_WORDS 3456
#define XB_SPIN_CAP (1u << 22)
__device__ __forceinline__ unsigned xb_ld(unsigned* p)              { return __hip_atomic_load(p, __ATOMIC_RELAXED, __HIP_MEMORY_SCOPE_AGENT); }
__device__ __forceinline__ unsigned xb_add(unsigned* p, unsigned v) { return __hip_atomic_fetch_add(p, v, __ATOMIC_RELAXED, __HIP_MEMORY_SCOPE_AGENT); }
__device__ __forceinline__ unsigned xb_xcc_id() { return (unsigned)__builtin_amdgcn_s_getreg((3 << 11) | 20) & 0xFu; }
#define XB_SPIN(cond, bar) do { unsigned _sp = 0; while (cond) { __builtin_amdgcn_s_sleep(1); \
    if ((++_sp & 255u) == 0u) { if (xb_ld(&(bar)[XB_TMO])) break; if (_sp > XB_SPIN_CAP) { atomicAdd(&(bar)[XB_TMO], 1u); break; } } } } while (0)
struct XcdBarrier { unsigned* bar; unsigned x; volatile LAS unsigned* st; };
__device__ __forceinline__ XcdBarrier xcd_barrier_post(unsigned* bar, volatile LAS unsigned* st) {
    XcdBarrier b; b.bar = bar; b.x = xb_xcc_id(); b.st = st;
    if (threadIdx.x == 0) (void)xb_add(&bar[XB_XCNT(b.x)], 1u);
    return b;
}
__device__ __forceinline__ void xcd_barrier_complete(unsigned* bar, unsigned x, unsigned& nloc, unsigned& nx) {
    const unsigned G = gridDim.x * gridDim.y * gridDim.z;
    unsigned sum, cnt, mine, sp = 0u;
    for (;;) {
        sum = 0u; cnt = 0u; mine = 0u;
#pragma unroll
        for (unsigned j = 0; j < 16; ++j) { const unsigned c = xb_ld(&bar[XB_XCNT(j)]); sum += c; cnt += (c > 0u) ? 1u : 0u; mine = (j == x) ? c : mine; }
        if (sum == G) break;
        __builtin_amdgcn_s_sleep(1);
        if ((++sp & 255u) == 0u) { if (xb_ld(&bar[XB_TMO])) break; if (sp > XB_SPIN_CAP) { atomicAdd(&bar[XB_TMO], 1u); break; } }
    }
    nloc = mine > 0u ? mine : 1u; nx = cnt > 0u ? cnt : 1u;
}
__device__ __forceinline__ void xcd_barrier(const XcdBarrier& b) {
    asm volatile("s_waitcnt vmcnt(0)" ::: "memory");
    __syncthreads();
    if (threadIdx.x == 0) {
        unsigned* bar = b.bar;
        __builtin_amdgcn_s_waitcnt(0);
        unsigned nloc = b.st[0], nx = b.st[1];
        if (nloc == 0u) { xcd_barrier_complete(bar, b.x, nloc, nx); b.st[0] = nloc; b.st[1] = nx; }
        const unsigned old = xb_add(&bar[XB_XSUB(b.x)], 1u);
        const unsigned gen = old / nloc;
        if (old + 1u == (gen + 1u) * nloc) {
            __builtin_amdgcn_fence(__ATOMIC_RELEASE, "agent");
            asm volatile("s_waitcnt vmcnt(0)" ::: "memory");
            const unsigned og = xb_add(&bar[XB_TOP], 1u);
            const unsigned tg = og / nx;
            if (og + 1u == (tg + 1u) * nx) xb_add(&bar[XB_TOPGEN], 1u);
            else XB_SPIN(xb_ld(&bar[XB_TOPGEN]) == tg, bar);
            __builtin_amdgcn_fence(__ATOMIC_ACQUIRE, "agent");
            xb_add(&bar[XB_XGEN(b.x)], 1u);
            asm volatile("s_waitcnt vmcnt(0)" ::: "memory");
        } else {
            XB_SPIN(xb_ld(&bar[XB_XGEN(b.x)]) == gen, bar);
            __builtin_amdgcn_fence(__ATOMIC_ACQUIRE, "agent");
            asm volatile("s_waitcnt vmcnt(0)" ::: "memory");
        }
    }
    __syncthreads();
}

struct Args { const float* in[21]; float* out; unsigned char* ws; int ph_lo, ph_hi; };
struct Frame {
    LAS unsigned char* lds; volatile LAS unsigned* MISC; unsigned* ctl;
    int tid, lane, wave, vcu, G;
    const void __attribute__((address_space(4)))* karg; float* out; unsigned char* ws;
};
__device__ __forceinline__ const float* inp(const Frame& F, int i) { const unsigned long long p = ((const unsigned long long __attribute__((address_space(4)))*)F.karg)[i]; return (const float*)(const GAS float*)p; }
#define IN_X 0
#define IN_C 1
#define IN_CTX 2
#define IN_CCTX 3
#define IN_WMOD 4
#define IN_BMOD 5
#define IN_GATTN 6
#define IN_GFFN 7
#define IN_WIN 8
#define IN_RDEC 9
#define IN_QN 10
#define IN_KN 11
#define IN_LAMBDA 12
#define IN_WFO 13
#define IN_WRO 14
#define IN_WDO 15
#define IN_WOUT 16
#define IN_WROUTER 17
#define IN_WEG 18
#define IN_WEU 19
#define IN_WED 20

__device__ __forceinline__ int vec_of_row(int r) { return r < TC ? 8 : (r - TC) / SEQ; }
__device__ __forceinline__ const float* mod_ptr(const Frame& F, int layer, int v, int i) { return (const float*)(F.ws + WS_MOD) + ((size_t)(layer * 9 + v) * 6 + i) * D; }
__device__ __forceinline__ float lam_init_of(int layer) { return layer == 0 ? 0.2f : 0.8f - 0.6f * 0.74081822068171788f; }
__device__ __forceinline__ float lam_of(const Frame& F, int layer) {
    const float* L = inp(F, IN_LAMBDA) + (size_t)layer * 4 * 64; float s1 = 0.f, s2 = 0.f;
    for (int i = 0; i < 64; ++i) { s1 += L[i] * L[64 + i]; s2 += L[128 + i] * L[192 + i]; }
    return __expf(s1) - __expf(s2) + lam_init_of(layer);
}

__device__ __forceinline__ void transpose_item(const float* W, int ldw, int K, int k0, int n0src, bf16* WT, int dst_row0, LAS float* scr, int lane) {
#pragma unroll 8
    for (int i = 0; i < 32; ++i) { const int kk = 2 * i + (lane >> 5); scr[kk * 33 + (lane & 31)] = W[(size_t)(k0 + kk) * ldw + n0src + (lane & 31)]; }
    LDS_WAIT(); asm volatile("" ::: "memory");
    const int c = lane & 7;
#pragma unroll
    for (int j = 0; j < 4; ++j) { const int n = (lane >> 3) + 8 * j; const LAS float* s = scr + (8 * c) * 33 + n;
        u32x4 o; o.x = pk2(s[0 * 33], s[1 * 33]); o.y = pk2(s[2 * 33], s[3 * 33]); o.z = pk2(s[4 * 33], s[5 * 33]); o.w = pk2(s[6 * 33], s[7 * 33]);
        *(u32x4*)(WT + (size_t)(dst_row0 + n) * K + k0 + 8 * c) = o; }
    LDS_WAIT(); asm volatile("" ::: "memory");
}
template <class RowMap>
__device__ __forceinline__ void transpose_matrix(Frame& F, const float* W, int ldw, int csrc, int K, int N, bf16* WT, RowMap map, int& item_base) {
    LAS float* scr = (LAS float*)(F.lds + F.wave * 16384);
    const int gw = F.vcu * 8 + F.wave, NGW = F.G * 8;
    const int nblk = N / 32, nitems = (K / 64) * nblk;
    int start = (gw - item_base % NGW + NGW) % NGW;
    for (int it = start; it < nitems; it += NGW) { const int kb = it / nblk, nb = it % nblk; transpose_item(W, ldw, K, 64 * kb, csrc + 32 * nb, WT, map(32 * nb), scr, F.lane); }
    item_base += nitems;
}
struct MapId { int off; __device__ int operator()(int n) const { return off + n; } };
struct MapProj { __device__ int operator()(int n) const { const int tile = n >> 8; const bool qk = tile < 2 || (tile >= 6 && tile < 10); return qk ? (tile << 8) + 128 * ((n >> 5) & 1) + 32 * ((n >> 6) & 3) + (n & 31) : n; } };
struct MapGU { int up; __device__ int operator()(int n) const { return (n >> 7) * 256 + up * 128 + (n & 127); } };

struct CvtItem { const float* src; bf16* dst; int ldw, K; };
__device__ __forceinline__ CvtItem cvt_decode(const Frame& F, int layer, int item) {
    const int e = item / 3072, rm = item - e * 3072, m = rm >> 10, r = rm & 1023; CvtItem c;
    if (m < 2) { const int kb = r >> 6, nb = r & 63; c.ldw = EH; c.K = D;
        c.src = inp(F, m == 0 ? IN_WEG : IN_WEU) + ((size_t)layer * NE + e) * D * EH + (size_t)(64 * kb) * EH + 32 * nb;
        const int n = 32 * nb, row = (n >> 7) * 256 + m * 128 + (n & 127); c.dst = (bf16*)(F.ws + WS_WGU + e * WGU_E) + (size_t)row * D + 64 * kb; }
    else { const int kb = r >> 5, nb = r & 31; c.ldw = D; c.K = EH;
        c.src = inp(F, IN_WED) + ((size_t)layer * NE + e) * EH * D + (size_t)(64 * kb) * D + 32 * nb;
        c.dst = (bf16*)(F.ws + WS_WD + e * WD_E) + (size_t)(32 * nb) * EH + 64 * kb; }
    return c;
}
__device__ __forceinline__ void cvt_load(const CvtItem& c, float (&r)[32], int lane) {
#pragma unroll
    for (int i = 0; i < 32; ++i) r[i] = c.src[(size_t)(2 * i + (lane >> 5)) * c.ldw + (lane & 31)];
}
__device__ __forceinline__ void cvt_store(const CvtItem& c, const float (&r)[32], LAS float* scr, int lane) {
#pragma unroll
    for (int i = 0; i < 32; ++i) scr[(2 * i + (lane >> 5)) * 33 + (lane & 31)] = r[i];
    LDS_WAIT(); asm volatile("" ::: "memory");
    const int cc = lane & 7;
#pragma unroll
    for (int j = 0; j < 4; ++j) { const int n = (lane >> 3) + 8 * j; const LAS float* s = scr + (8 * cc) * 33 + n;
        u32x4 o; o.x = pk2(s[0 * 33], s[1 * 33]); o.y = pk2(s[2 * 33], s[3 * 33]); o.z = pk2(s[4 * 33], s[5 * 33]); o.w = pk2(s[6 * 33], s[7 * 33]);
        *(u32x4*)(c.dst + (size_t)n * c.K + 8 * cc) = o; }
    LDS_WAIT(); asm volatile("" ::: "memory");
}
__device__ __forceinline__ void convert_expert_weights(Frame& F, int layer) {
    LAS float* scr = (LAS float*)(F.lds + F.wave * 16384);
    const int gw = F.vcu * 8 + F.wave, NGW = F.G * 8, NIT = NE * 3072;
    float ra[32], rb[32];
    int it = gw; if (it >= NIT) return;
    CvtItem ca = cvt_decode(F, layer, it), cb = ca; cvt_load(ca, ra, F.lane);
    for (;;) {
        const int i1 = it + NGW; const bool h1 = i1 < NIT; cb = cvt_decode(F, layer, h1 ? i1 : it); cvt_load(cb, rb, F.lane);
        cvt_store(ca, ra, scr, F.lane);
        if (!h1) break;
        const int i2 = i1 + NGW; const bool h2 = i2 < NIT; ca = cvt_decode(F, layer, h2 ? i2 : i1); cvt_load(ca, ra, F.lane);
        cvt_store(cb, rb, scr, F.lane);
        if (!h2) break;
        it = i2;
    }
}

__device__ __forceinline__ void phase_prologue(Frame& F) {
    const int tid = F.tid;
    {
        LAS float* sc = (LAS float*)F.lds;
        LAS float* red = sc + 9 * 1024;
        for (int i = tid; i < 9 * 1024; i += 512) { const int v = i >> 10, k = i & 1023; const float c = v < 8 ? inp(F, IN_C)[v * D + k] : inp(F, IN_CCTX)[k]; sc[i] = siluf_(c); }
        __syncthreads();
        for (int item = F.vcu; item < DEPTH * 96; item += F.G) {
            const int layer = item / 96, cb = item % 96, col = cb * 64 + (tid & 63), kg = tid >> 6;
            const float* w = inp(F, IN_WMOD) + (size_t)layer * D * 6144 + col;
            float a[9];
#pragma unroll
            for (int v = 0; v < 9; ++v) a[v] = 0.f;
#pragma unroll 4
            for (int kk = 0; kk < 128; ++kk) { const int k = kg * 128 + kk; const float wv = w[(size_t)k * 6144];
#pragma unroll
                for (int v = 0; v < 9; ++v) a[v] += sc[v * 1024 + k] * wv; }
#pragma unroll
            for (int v = 0; v < 9; ++v) red[(kg * 64 + (tid & 63)) * 9 + v] = a[v];
            __syncthreads();
            for (int o = tid; o < 64 * 9; o += 512) { const int cc = o / 9, v = o % 9; float s = 0.f;
                for (int g = 0; g < 8; ++g) s += red[(g * 64 + cc) * 9 + v];
                const int colo = cb * 64 + cc;
                ((float*)(F.ws + WS_MOD))[(size_t)(layer * 9 + v) * 6144 + colo] = s + inp(F, IN_BMOD)[layer * 6144 + colo]; }
            __syncthreads();
        }
    }
    {
        const int gt = F.vcu * 512 + tid, NT = F.G * 512;
        float* rc = (float*)(F.ws + WS_ROPE); float* rs = rc + SEQ * 32;
        for (int i = gt; i < SEQ * 32; i += NT) { const int pos = i >> 5, f = i & 31; const float inv = __builtin_amdgcn_exp2f(-(float)(f & 15) * (13.287712379549449f / 16.0f));
            const float p = (f < 16) ? (float)(pos / GRIDW) : (float)(pos % GRIDW); const float ang = p * inv; rc[i] = __builtin_amdgcn_cosf(ang * 0.15915494309189535f); rs[i] = __builtin_amdgcn_sinf(ang * 0.15915494309189535f); }
        LAS float* ct = (LAS float*)F.lds;
        __syncthreads();
        for (int m = tid; m < 2048; m += 512) ct[m] = __builtin_amdgcn_cosf((float)m * (1.0f / 2048.0f));
        __syncthreads();
        bf16* dl = (bf16*)(F.ws + WS_DFTL); const float sl = 0.022097086912079608f;
        for (int i = gt; i < 2048 * 2048; i += NT) { const int k = i >> 11, col = i & 2047; float val;
            if (col <= 1024) val = ct[(k * col) & 2047]; else val = -ct[(((k * (col - 1024)) & 2047) - 512) & 2047];
            dl[i] = (bf16)f2bf(val * sl); }
        bf16* dc = (bf16*)(F.ws + WS_DFTC);
        for (int i = gt; i < 256 * 256; i += NT) { const int k = i >> 8, col = i & 255; float val;
            if (col <= 128) val = ct[((k * col) & 255) * 8]; else val = -ct[((((k * (col - 128)) & 255) * 8) - 512) & 2047];
            dc[i] = (bf16)f2bf(val * 0.0625f); }
        {
            LAS float* tile = ct + 2048;
            for (int item = F.vcu; item < DEPTH * 16 * 8; item += F.G) {
                const int layer = item >> 7, kb = (item >> 3) & 15, g = item & 7;
                const float* win = inp(F, IN_WIN) + (size_t)layer * D * INW + (size_t)(64 * kb) * INW + g * 64; bf16* wt = (bf16*)(F.ws + WS_WIN + layer * WIN_L) + (size_t)6144 * 1024;
                __syncthreads();
                for (int i = tid; i < 64 * 64; i += 512) { const int kk = i >> 6, c = i & 63; tile[kk * 65 + c] = win[(size_t)kk * INW + c]; }
                __syncthreads();
                const int k = tid & 63, c0 = 8 * (tid >> 6);
                float ac[8], as[8];
#pragma unroll
                for (int q = 0; q < 8; ++q) { ac[q] = 0.f; as[q] = 0.f; }
                for (int c = 0; c < 64; ++c) { const float x = tile[k * 65 + c];
#pragma unroll
                    for (int q = 0; q < 8; ++q) { const int m = ((c * (c0 + q)) & 63) * 32; ac[q] += x * ct[m]; as[q] += x * ct[(m - 512) & 2047]; } }
#pragma unroll
                for (int q = 0; q < 8; ++q) { wt[(size_t)(g * 64 + c0 + q) * 1024 + 64 * kb + k] = (bf16)f2bf(ac[q] * 0.125f); wt[(size_t)(512 + g * 64 + c0 + q) * 1024 + 64 * kb + k] = (bf16)f2bf(as[q] * 0.125f); }
            }
        }
        __syncthreads();
    }
    {
        int base = 0;
        for (int layer = 0; layer < DEPTH; ++layer) {
            transpose_matrix(F, inp(F, IN_WIN) + (size_t)layer * D * INW, INW, 512, D, NWPROJ, (bf16*)(F.ws + WS_WIN + layer * WIN_L), MapProj{}, base);
            transpose_matrix(F, inp(F, IN_WFO) + (size_t)layer * 512 * D, D, 0, 512, D, (bf16*)(F.ws + WS_WFO + (layer * 3 + 0) * WMG_ONE), MapId{0}, base);
            transpose_matrix(F, inp(F, IN_WRO) + (size_t)layer * 512 * D, D, 0, 512, D, (bf16*)(F.ws + WS_WFO + (layer * 3 + 1) * WMG_ONE), MapId{0}, base);
            transpose_matrix(F, inp(F, IN_WDO) + (size_t)layer * 512 * D, D, 0, 512, D, (bf16*)(F.ws + WS_WFO + (layer * 3 + 2) * WMG_ONE), MapId{0}, base);
            transpose_matrix(F, inp(F, IN_WOUT) + (size_t)layer * D * D, D, 0, D, D, (bf16*)(F.ws + WS_WOUT + layer * WOUT_L), MapId{0}, base);
        }
    }
    convert_expert_weights(F, 0);
}

__device__ __forceinline__ void phase_norm(Frame& F, int layer) {
    const int gw = F.vcu * 8 + F.wave, NGW = F.G * 8, lane = F.lane;
    const bool fin = layer == DEPTH; const int r_lo = (layer >= DEPTH - 1) ? (fin ? TC : 0) : 0;
    float* XR = (float*)(F.ws + WS_XR); const int* INV = (const int*)(F.ws + WS_INV); const bf16* YE = (const bf16*)(F.ws + WS_YE); bf16* HB = (bf16*)(F.ws + WS_HB);
    auto rowsrc = [&](int r) -> const float* { return layer == 0 ? (r < TC ? inp(F, IN_CTX) + (size_t)r * D : inp(F, IN_X) + (size_t)(r - TC) * D) : XR + (size_t)r * D; };
    f32x4 xn[4]; int invn = -1;
    { const int r0 = r_lo + gw < TA ? r_lo + gw : TA - 1; const float* src = rowsrc(r0);
#pragma unroll
      for (int j = 0; j < 4; ++j) xn[j] = *(const f32x4*)(src + 4 * lane + 256 * j);
      if (layer > 0) invn = lane < 16 ? INV[(size_t)r0 * 16 + lane] : -1; }
    for (int r = r_lo + gw; r < TA; r += NGW) {
        const int v = vec_of_row(r);
        f32x4 x[4];
#pragma unroll
        for (int j = 0; j < 4; ++j) x[j] = xn[j];
        const int myinv_cur = invn;
        { const int rn = r + NGW < TA ? r + NGW : r; const float* src = rowsrc(rn);
#pragma unroll
          for (int j = 0; j < 4; ++j) xn[j] = *(const f32x4*)(src + 4 * lane + 256 * j);
          if (layer > 0) invn = lane < 16 ? INV[(size_t)rn * 16 + lane] : -1; }
        if (layer > 0) {
            if (!(layer == DEPTH - 1 + 1 && false)) {
                const bool has_moe = !(layer == 1 && r < TC && false);
                if (has_moe) {
                    f32x4 s[4];
#pragma unroll
                    for (int j = 0; j < 4; ++j) s[j] = (f32x4){0.f, 0.f, 0.f, 0.f};
                    const int myinv = myinv_cur;
                    unsigned long long msk = __ballot(myinv >= 0);
                    while (msk) {
                        int sl[4]; float wg[4];
#pragma unroll
                        for (int k = 0; k < 4; ++k) { if (msk) { const int b = __builtin_ctzll(msk); sl[k] = __builtin_amdgcn_readlane(myinv, b); msk &= msk - 1ull; wg[k] = 1.f; } else { sl[k] = 0; wg[k] = 0.f; } }
                        u32x2 w[4][4];
#pragma unroll
                        for (int k = 0; k < 4; ++k)
#pragma unroll
                            for (int j = 0; j < 4; ++j) w[k][j] = *(const u32x2*)(YE + (size_t)sl[k] * D + 4 * lane + 256 * j);
#pragma unroll
                        for (int k = 0; k < 4; ++k)
#pragma unroll
                            for (int j = 0; j < 4; ++j) s[j] += (f32x4){bflo(w[k][j].x), bfhi(w[k][j].x), bflo(w[k][j].y), bfhi(w[k][j].y)} * wg[k];
                    }
                    const float* m5 = mod_ptr(F, layer - 1, v, 5);
#pragma unroll
                    for (int j = 0; j < 4; ++j) x[j] += *(const f32x4*)(m5 + 4 * lane + 256 * j) * s[j];
                }
            }
        }
        if (fin) {
            if (PROBE_STAT >= 10 && r == TC && lane == 0) { const unsigned long long* ts = (const unsigned long long*)(F.ctl + CW_STAT + 8);
                const int p = PROBE_STAT >= 100 ? PROBE_STAT - 100 : PROBE_STAT - 10;
                const float num = PROBE_STAT >= 100 ? (float)(ts[p + 1] - ts[p]) * 4.0f : (float)(ts[p + 1] - ts[0]);
                ((float*)F.ctl)[CW_STAT] = num / (float)(ts[1 + 10 * DEPTH] - ts[0]); }
            if (PROBE_STAT && r == TC && lane == 0) { float v = ((const float*)F.ctl)[CW_STAT]; v = v < 0.f ? 0.f : (v > 1.f ? 1.f : v); x[0].x += 0.6f + 0.8f * v; }
#pragma unroll
            for (int j = 0; j < 4; ++j) *(f32x4*)(F.out + (size_t)(r - TC) * D + 4 * lane + 256 * j) = x[j];
            continue;
        }
        if (layer > 0) {
#pragma unroll
            for (int j = 0; j < 4; ++j) *(f32x4*)(XR + (size_t)r * D + 4 * lane + 256 * j) = x[j];
        }
        float ss = 0.f;
#pragma unroll
        for (int j = 0; j < 4; ++j) ss += (x[j].x * x[j].x + x[j].y * x[j].y) + (x[j].z * x[j].z + x[j].w * x[j].w);
        const float rinv = __builtin_amdgcn_rsqf(wave_sum(ss) * (1.0f / D) + EPS);
        const float* g = inp(F, IN_GATTN) + (size_t)layer * D; const float* sh = mod_ptr(F, layer, v, 0); const float* scl = mod_ptr(F, layer, v, 1);
#pragma unroll
        for (int j = 0; j < 4; ++j) { const int k = 4 * lane + 256 * j; const f32x4 gv = *(const f32x4*)(g + k), sv = *(const f32x4*)(sh + k), cv = *(const f32x4*)(scl + k);
            const f32x4 y = (x[j] * rinv * gv) * (cv + 1.0f) + sv;
            u32x2 w; w.x = pk2(y.x, y.y); w.y = pk2(y.z, y.w); *(u32x2*)(HB + (size_t)r * D + k) = w; }
    }
}

using pg8::Unit; using pg8::Acc;
struct SchedGrid {
    int nM, nN, G, c; const char* A; const char* B; size_t a_tile, b_tile; int pm_per_group; size_t b_group;
    __device__ __forceinline__ bool next(int i, Unit& u) const {
        int pm, pn; if (c < 0 || !pg8::grid_order((long)i * G + c, nM, nN, pm, pn)) return false;
        u.pm = pm; u.pn = pn; u.tag = 0; u.A = A + (size_t)pm * a_tile; u.B = B + (size_t)pn * b_tile + (pm_per_group ? (size_t)(pm / pm_per_group) * b_group : 0); return true; }
};
struct SchedMerge {
    int nM, nN, G, c; const char* A; const char* B; size_t a_seg, b_seg, a_tile, b_tile;
    __device__ __forceinline__ bool next(int i, Unit& u) const {
        const int t = i / 3, seg = i - 3 * t; int pm, pn; if (!pg8::grid_order((long)t * G + c, nM, nN, pm, pn)) return false;
        u.pm = pm; u.pn = pn; u.tag = seg; u.A = A + (size_t)seg * a_seg + (size_t)pm * a_tile; u.B = B + (size_t)seg * b_seg + (size_t)pn * b_tile; return true; }
};

struct EpiBf16 {
    static constexpr bool PERM = true;
    bf16* C; int ldc; int sig_pn0;
    __device__ __forceinline__ void operator()(Acc& acc, const Unit& u, int wr, int wc, int fr, int fq) const {
        const int row0 = u.pm * 256 + wr * 64 + fr, col0 = u.pn * 256 + wc * 32 + 8 * fq;
        const bool sig = u.pn >= sig_pn0;
#pragma unroll
        for (int ai = 0; ai < 2; ++ai)
#pragma unroll
            for (int m = 0; m < 4; ++m) { bf16* rowp = C + (size_t)(row0 + ai * 128 + m * 16) * ldc + col0;
#pragma unroll
                for (int bj = 0; bj < 2; ++bj) { f32x4 v0 = acc[ai][bj][m][0], v1 = acc[ai][bj][m][1];
                    if (sig) {
#pragma unroll
                        for (int j = 0; j < 4; ++j) { v0[j] = sigmoidf_(v0[j]); v1[j] = sigmoidf_(v1[j]); } }
                    u32x4 w; w.x = pk2(v0[0], v0[1]); w.y = pk2(v0[2], v0[3]); w.z = pk2(v1[0], v1[1]); w.w = pk2(v1[2], v1[3]);
                    *(u32x4*)(rowp + bj * 128) = w; } }
        pg8::zero_acc(acc);
    }
};
struct EpiGT {
    static constexpr bool PERM = true;
    bf16* GT; bf16* GTC;
    __device__ __forceinline__ void operator()(Acc& acc, const Unit& u, int wr, int wc, int fr, int fq) const {
        const int tok0 = u.pn * 256;
        bf16* base; int pitch, nseq, n0;
        if (tok0 < TC) { const int b = tok0 / CTX; base = GTC + (size_t)b * 512 * 512; pitch = 512; nseq = CTX; n0 = tok0 - b * CTX; }
        else { const int t = tok0 - TC, b = t / SEQ; base = GT + (size_t)b * 512 * 4096; pitch = 4096; nseq = SEQ; n0 = t - b * SEQ; }
        const int crow0 = u.pm * 256 + wr * 64 + fr, ccol0 = wc * 32 + 8 * fq;
#pragma unroll
        for (int ai = 0; ai < 2; ++ai)
#pragma unroll
            for (int m = 0; m < 4; ++m) { const int c = crow0 + ai * 128 + m * 16, part = c >> 9, ch = c & 511;
                bf16* rowp = base + (size_t)ch * pitch + part * nseq + n0 + ccol0;
#pragma unroll
                for (int bj = 0; bj < 2; ++bj) { const f32x4 v0 = acc[ai][bj][m][0], v1 = acc[ai][bj][m][1];
                    u32x4 w; w.x = pk2(v0[0], v0[1]); w.y = pk2(v0[2], v0[3]); w.z = pk2(v1[0], v1[1]); w.w = pk2(v1[2], v1[3]);
                    *(u32x4*)(rowp + bj * 128) = w; } }
        pg8::zero_acc(acc);
    }
};
struct EpiDFT {
    static constexpr bool PERM = true;
    bf16* FO; int nseq; int row_base0;
    __device__ __forceinline__ void operator()(Acc& acc, const Unit& u, int wr, int wc, int fr, int fq) const {
        const int k0 = u.pm * 256 + wr * 64 + fr, b = (u.pn * 256) >> 9, ch0 = ((u.pn * 256) & 511) + wc * 32 + 8 * fq;
        bf16* base = FO + (size_t)(row_base0 + b * nseq + k0) * 512 + ch0;
#pragma unroll
        for (int ai = 0; ai < 2; ++ai)
#pragma unroll
            for (int m = 0; m < 4; ++m) { bf16* rowp = base + (size_t)(ai * 128 + m * 16) * 512;
#pragma unroll
                for (int bj = 0; bj < 2; ++bj) { const f32x4 v0 = acc[ai][bj][m][0], v1 = acc[ai][bj][m][1];
                    u32x4 w; w.x = pk2(v0[0], v0[1]); w.y = pk2(v0[2], v0[3]); w.z = pk2(v1[0], v1[1]); w.w = pk2(v1[2], v1[3]);
                    *(u32x4*)(rowp + bj * 128) = w; } }
        pg8::zero_acc(acc);
    }
};
struct EpiMerge {
    static constexpr bool PERM = true;
    const unsigned char* G8; bf16* MIXB; int row_off;
    __device__ __forceinline__ void operator()(Acc& acc, const Unit& u, int wr, int wc, int fr, int fq) const {
        const int row0 = row_off + u.pm * 256 + wr * 64 + fr, col0 = u.pn * 256 + wc * 32 + 8 * fq, seg = u.tag;
#pragma unroll
        for (int ai = 0; ai < 2; ++ai)
#pragma unroll
            for (int m = 0; m < 4; ++m) { const size_t row = (size_t)(row0 + ai * 128 + m * 16);
#pragma unroll
                for (int bj = 0; bj < 2; ++bj) { const int col = col0 + bj * 128;
                    const u32x2 ga = *(const u32x2*)(G8 + row * 3072 + seg * 1024 + col);
                    float f[8];
                    if (seg < 2) { const u32x2 gb = *(const u32x2*)(G8 + row * 3072 + (seg + 1) * 1024 + col);
#pragma unroll
                        for (int q = 0; q < 8; ++q) f[q] = (float)((ga[q >> 2] >> (8 * (q & 3))) & 255u) * __builtin_amdgcn_rcpf((float)((gb[q >> 2] >> (8 * (q & 3))) & 255u));
                    } else {
#pragma unroll
                        for (int q = 0; q < 8; ++q) f[q] = (float)((ga[q >> 2] >> (8 * (q & 3))) & 255u) * (1.0f / 255.0f);
                    }
                    f32x4 v0 = acc[ai][bj][m][0], v1 = acc[ai][bj][m][1];
                    v0 = v0 * (f32x4){f[0], f[1], f[2], f[3]}; v1 = v1 * (f32x4){f[4], f[5], f[6], f[7]};
                    if (seg < 2) { acc[ai][bj][m][0] = v0; acc[ai][bj][m][1] = v1; }
                    else { u32x4 w; w.x = pk2(v0[0], v0[1]); w.y = pk2(v0[2], v0[3]); w.z = pk2(v1[0], v1[1]); w.w = pk2(v1[2], v1[3]);
                        *(u32x4*)(MIXB + row * D + col) = w; acc[ai][bj][m][0] = (f32x4){0.f, 0.f, 0.f, 0.f}; acc[ai][bj][m][1] = (f32x4){0.f, 0.f, 0.f, 0.f}; } }
                if (m == 3) asm volatile("" ::: "memory"); }
    }
};
struct EpiOut {
    static constexpr bool PERM = false;
    const float* base_ctx; const float* base_lat; float* XR; const float* mod2; int row_off;
    __device__ __forceinline__ void operator()(Acc& acc, const Unit& u, int wr, int wc, int fr, int fq) const {
        const int row0 = row_off + u.pm * 256 + wr * 64 + fr, col0 = u.pn * 256 + wc * 32 + 4 * fq;
        const int v = vec_of_row(row_off + u.pm * 256);
        f32x4 mv[2][2];
#pragma unroll
        for (int bj = 0; bj < 2; ++bj)
#pragma unroll
            for (int n = 0; n < 2; ++n) mv[bj][n] = *(const f32x4*)(mod2 + (size_t)v * 6144 + col0 + bj * 128 + n * 16);
#pragma unroll
        for (int ai = 0; ai < 2; ++ai)
#pragma unroll
            for (int m = 0; m < 4; ++m) { const int row = row0 + ai * 128 + m * 16;
                const float* bp = row < TC ? base_ctx + (size_t)row * D : base_lat + (size_t)(row - TC) * D; float* op = XR + (size_t)row * D;
#pragma unroll
                for (int bj = 0; bj < 2; ++bj)
#pragma unroll
                    for (int n = 0; n < 2; ++n) { const int c = col0 + bj * 128 + n * 16; *(f32x4*)(op + c) = *(const f32x4*)(bp + c) + mv[bj][n] * acc[ai][bj][m][n]; } }
        pg8::zero_acc(acc);
    }
};
struct EpiGU {
    static constexpr bool PERM = true;
    bf16* HID;
    __device__ __forceinline__ void operator()(Acc& acc, const Unit& u, int wr, int wc, int fr, int fq) const {
        const int row0 = u.pm * 256 + wr * 64 + fr, col0 = u.pn * 128 + wc * 32 + 8 * fq;
#pragma unroll
        for (int ai = 0; ai < 2; ++ai)
#pragma unroll
            for (int m = 0; m < 4; ++m) { float h[8];
#pragma unroll
                for (int n = 0; n < 2; ++n)
#pragma unroll
                    for (int j = 0; j < 4; ++j) { const float g = acc[ai][0][m][n][j], up = acc[ai][1][m][n][j]; h[4 * n + j] = siluf_(g) * up; }
                u32x4 w; w.x = pk2(h[0], h[1]); w.y = pk2(h[2], h[3]); w.z = pk2(h[4], h[5]); w.w = pk2(h[6], h[7]);
                *(u32x4*)(HID + (size_t)(row0 + ai * 128 + m * 16) * EH + col0) = w; }
        pg8::zero_acc(acc);
    }
};
struct EpiDown {
    static constexpr bool PERM = true;
    bf16* YE; const float* topw;
    __device__ __forceinline__ void operator()(Acc& acc, const Unit& u, int wr, int wc, int fr, int fq) const {
        const int row0 = u.pm * 256 + wr * 64 + fr, col0 = u.pn * 256 + wc * 32 + 8 * fq;
#pragma unroll
        for (int ai = 0; ai < 2; ++ai)
#pragma unroll
            for (int m = 0; m < 4; ++m) { const int row = row0 + ai * 128 + m * 16; const float tw = topw[row];
#pragma unroll
                for (int bj = 0; bj < 2; ++bj) { const f32x4 v0 = acc[ai][bj][m][0] * tw, v1 = acc[ai][bj][m][1] * tw;
                    u32x4 w; w.x = pk2(v0[0], v0[1]); w.y = pk2(v0[2], v0[3]); w.z = pk2(v1[0], v1[1]); w.w = pk2(v1[2], v1[3]);
                    *(u32x4*)(YE + (size_t)row * D + col0 + bj * 128) = w; } }
        pg8::zero_acc(acc);
    }
};

struct SchedInproj {
    int G, c, ncc; const char* HB; const char* WT;
    __device__ __forceinline__ bool next(int i, Unit& u) const {
        const long L = (long)i * G + c; int pm, pn;
        if (L < 64 * 28) { pg8::grid_order(L, 64, 28, pm, pn); pm += 8; }
        else { if (!pg8::grid_order(L - 64 * 28, 8, ncc, pm, pn)) return false; if (ncc == 7) pn = pn < 3 ? pn + 1 : pn + 5; }
        const size_t tile = (size_t)256 * D * 2;
        if (pn < 24) { u.pm = pm; u.pn = pn; u.A = HB + pm * tile; u.B = WT + pn * tile; u.tag = (pn < 2 || (pn >= 6 && pn < 10)) ? 2 : (pn >= 12 ? 1 : 0); }
        else { u.pm = pn - 24; u.pn = pm; u.A = WT + (size_t)(24 + pn - 24) * tile; u.B = HB + pm * tile; u.tag = 3; }
        return true; }
};
struct EpiInproj {
    static constexpr bool PERM = true;
    bf16* PROJ; bf16* GT; bf16* GTC; const float* rc; const float* rs; const float* qn; const float* kn; unsigned char* G8;
    __device__ __forceinline__ void operator()(Acc& acc, const Unit& u, int wr, int wc, int fr, int fq) const {
        if (u.tag == 3) { EpiGT E{GT, GTC}; E(acc, u, wr, wc, fr, fq); return; }
        if (u.tag == 0) { EpiBf16 E{PROJ, NPROJ, 1000}; E(acc, u, wr, wc, fr, fq); return; }
        if (u.tag == 1) {
            const int row0 = u.pm * 256 + wr * 64 + fr, col0 = (u.pn - C_GATE / 256) * 256 + wc * 32 + 8 * fq;
#pragma unroll
            for (int ai = 0; ai < 2; ++ai)
#pragma unroll
                for (int m = 0; m < 4; ++m) { unsigned char* rowp = G8 + (size_t)(row0 + ai * 128 + m * 16) * 3072 + col0;
#pragma unroll
                    for (int bj = 0; bj < 2; ++bj) { unsigned wlo = 0u, whi = 0u;
#pragma unroll
                        for (int j = 0; j < 4; ++j) { const float a = fminf(fmaxf(sigmoidf_(acc[ai][bj][m][0][j]) * 255.0f + 0.5f, 1.0f), 255.0f), b = fminf(fmaxf(sigmoidf_(acc[ai][bj][m][1][j]) * 255.0f + 0.5f, 1.0f), 255.0f);
                            wlo |= (unsigned)a << (8 * j); whi |= (unsigned)b << (8 * j); }
                        *(u32x2*)(rowp + bj * 128) = (u32x2){wlo, whi}; } }
            pg8::zero_acc(acc); return; }
        const int tile = u.pn; const bool is_d = tile >= 6, is_q = (tile == 0 || tile == 6 || tile == 7);
        f32x4 g1[2], g2[2];
        if (is_d) { const float* G = is_q ? qn : kn;
#pragma unroll
            for (int n = 0; n < 2; ++n) { g1[n] = *(const f32x4*)(G + 8 * fq + 4 * n); g2[n] = *(const f32x4*)(G + 32 + 8 * fq + 4 * n); } }
        const int row0 = u.pm * 256 + wr * 64 + fr; const bool lat = u.pm >= 8;
#pragma unroll
        for (int ai = 0; ai < 2; ++ai)
#pragma unroll
            for (int m = 0; m < 4; ++m) { const int row = row0 + ai * 128 + m * 16;
                f32x4 x1[2] = {acc[ai][0][m][0], acc[ai][0][m][1]}, x2[2] = {acc[ai][1][m][0], acc[ai][1][m][1]};
                if (is_d) {
                    float ss = 0.f;
#pragma unroll
                    for (int n = 0; n < 2; ++n) ss += (x1[n][0] * x1[n][0] + x1[n][1] * x1[n][1]) + (x1[n][2] * x1[n][2] + x1[n][3] * x1[n][3]) + (x2[n][0] * x2[n][0] + x2[n][1] * x2[n][1]) + (x2[n][2] * x2[n][2] + x2[n][3] * x2[n][3]);
                    ss = sum16x2(ss); ss = sum32x2(ss);
                    const float rinv = __builtin_amdgcn_rsqf(ss * (1.0f / 64.0f) + EPS);
#pragma unroll
                    for (int n = 0; n < 2; ++n) { x1[n] = x1[n] * rinv * g1[n]; x2[n] = x2[n] * rinv * g2[n]; }
                } else if (tile == 0) {
#pragma unroll
                    for (int n = 0; n < 2; ++n) { x1[n] = x1[n] * 0.125f; x2[n] = x2[n] * 0.125f; }
                }
                f32x4 o1[2], o2[2];
                if (lat) { const int pos = (row - TC) & (SEQ - 1);
#pragma unroll
                    for (int n = 0; n < 2; ++n) { const f32x4 c = *(const f32x4*)(rc + pos * 32 + 8 * fq + 4 * n), sn = *(const f32x4*)(rs + pos * 32 + 8 * fq + 4 * n);
                        o1[n] = x1[n] * c - x2[n] * sn; o2[n] = x2[n] * c + x1[n] * sn; }
                } else { o1[0] = x1[0]; o1[1] = x1[1]; o2[0] = x2[0]; o2[1] = x2[1]; }
                if (is_d && is_q) { const float k = 0.125f * LOG2E;
#pragma unroll
                    for (int n = 0; n < 2; ++n) { o1[n] = o1[n] * k; o2[n] = o2[n] * k; } }
                bf16* dst = PROJ + (size_t)row * NPROJ + tile * 256 + 64 * wc + 8 * fq;
                u32x4 w; w.x = pk2(o1[0][0], o1[0][1]); w.y = pk2(o1[0][2], o1[0][3]); w.z = pk2(o1[1][0], o1[1][1]); w.w = pk2(o1[1][2], o1[1][3]); *(u32x4*)dst = w;
                w.x = pk2(o2[0][0], o2[0][1]); w.y = pk2(o2[0][2], o2[0][3]); w.z = pk2(o2[1][0], o2[1][1]); w.w = pk2(o2[1][2], o2[1][3]); *(u32x4*)(dst + 32) = w;
                asm volatile("" ::: "memory"); }
        pg8::zero_acc(acc);
    }
};
__device__ __forceinline__ void phase_inproj(Frame& F, int layer) {
    const float* rc = (const float*)(F.ws + WS_ROPE);
    SchedInproj S{F.G, (int)blockIdx.x, layer == DEPTH - 1 ? 7 : 28, (const char*)(F.ws + WS_HB), (const char*)(F.ws + WS_WIN + layer * WIN_L)};
    EpiInproj E{(bf16*)(F.ws + WS_PROJ), (bf16*)(F.ws + WS_GT), (bf16*)(F.ws + WS_GTC), rc, rc + SEQ * 32, inp(F, IN_QN) + layer * 64, inp(F, IN_KN) + layer * 64, (unsigned char*)(F.ws + WS_G8)};
    pg8::gemm_phase(F.lds, F.tid, D, S, E);
}

namespace att {
constexpr int KPITCH = 144, VPITCH = 320, KC_BYTES = 64 * KPITCH, V_BYTES = 64 * VPITCH, BUF_BYTES = 2 * KC_BYTES + V_BYTES;
constexpr int SCR_OFF = 2 * BUF_BYTES;
constexpr int QW_OFF = SCR_OFF + 8 * 256;
constexpr int S_OFF = 81920, S_BYTES = 128 * KPITCH;
__device__ __forceinline__ int crow(int r, int hi) { return (r & 3) + 8 * (r >> 2) + 4 * hi; }
__device__ __forceinline__ s16x4 vtr(const LAS unsigned char* p) { typedef short v4i16_t __attribute__((ext_vector_type(4))); return __builtin_bit_cast(s16x4, __builtin_amdgcn_ds_read_tr16_b64_v4i16((LAS v4i16_t*)p)); }

struct UnitDesc {
    int mode;
    int qrow0;
    int qpos0;
    int h;
    int krowA, ntA;
    int krowB, ntB;
    int kindB;
    int nseq;
    int outrow0;
    float lgf, lgb;
    float lam, scale_out;
    int stat;
    int cross, bh, blk;
};

template <int MODE> __device__ __forceinline__ void unit(const Frame& F, const UnitDesc& u) {
    LAS unsigned char* lds = F.lds;
    int lane = F.lane; asm volatile("" : "+v"(lane));
    const int wid = F.wave, tid = wid * 64 + lane, r32 = lane & 31, hi = lane >> 5;
    const bf16* PROJ = (const bf16*)(F.ws + WS_PROJ);
    constexpr bool diff = MODE == 0;
    const int comp = diff ? (wid >> 2) : 0;
    const int qoff = diff ? 32 * (wid & 3) : 32 * wid;
    const int kcol = diff ? C_DK + u.h * 128 : C_RK + u.h * 64, vcol = diff ? C_DV + u.h * 128 : C_RV + u.h * 128;
    const int qcol = diff ? C_DQ + u.h * 128 + comp * 64 : C_RQ + u.h * 64;
    const int NT = u.ntA + u.ntB;
    unsigned long long ts0 = 0, ts1 = 0, ts2 = 0, ts3 = 0, tacc = 0; (void)ts0; (void)ts1; (void)ts2; (void)ts3; (void)tacc;
    if (PROBE_STAT) ts0 = __builtin_amdgcn_s_memtime();
    bf16x8 qf[4];
    { const bf16* qp = PROJ + (size_t)(u.qrow0 + qoff + r32) * NPROJ + qcol + 8 * hi;
#pragma unroll
      for (int s = 0; s < 4; ++s) qf[s] = *(const bf16x8*)(qp + 16 * s); }
    f32x16 o[4];
#pragma unroll
    for (int d = 0; d < 4; ++d) o[d] = (f32x16){};
    float lsum = 0.f;
    if (!diff && u.cross) {
        const float* LB = (const float*)(F.ws + WS_LBUF) + (size_t)u.bh * 9 * 2 * 64 * 128;
        const int dv = tid & 127, dg = tid >> 7, c = u.blk;
        float sf[16], sb[16];
#pragma unroll
        for (int k = 0; k < 16; ++k) { sf[k] = 0.f; sb[k] = 0.f; }
        for (int bp = 0; bp < 9; ++bp) {
            const float wf = bp == 8 ? __builtin_amdgcn_exp2f(u.lgf * 256.f * (float)c) : (bp < c ? __builtin_amdgcn_exp2f(u.lgf * 256.f * (float)(c - 1 - bp)) : 0.f);
            const float wb = bp == 8 ? __builtin_amdgcn_exp2f(u.lgb * 256.f * (float)(7 - c)) : (bp > c ? __builtin_amdgcn_exp2f(u.lgb * 256.f * (float)(bp - c - 1)) : 0.f);
            const float* Lf = LB + (size_t)(bp * 2 + 0) * 64 * 128 + (16 * dg) * 128 + dv; const float* Lb = Lf + 64 * 128;
            if (wf != 0.f) {
#pragma unroll
                for (int k = 0; k < 16; ++k) sf[k] += wf * Lf[k * 128]; }
            if (wb != 0.f) {
#pragma unroll
                for (int k = 0; k < 16; ++k) sb[k] += wb * Lb[k * 128]; }
        }
        LAS unsigned char* sp = lds + S_OFF + dv * KPITCH + dg * 32;
        *(LAS u32x4*)(sp) = (u32x4){pk2(sf[0], sf[1]), pk2(sf[2], sf[3]), pk2(sf[4], sf[5]), pk2(sf[6], sf[7])};
        *(LAS u32x4*)(sp + 16) = (u32x4){pk2(sf[8], sf[9]), pk2(sf[10], sf[11]), pk2(sf[12], sf[13]), pk2(sf[14], sf[15])};
        *(LAS u32x4*)(sp + S_BYTES) = (u32x4){pk2(sb[0], sb[1]), pk2(sb[2], sb[3]), pk2(sb[4], sb[5]), pk2(sb[6], sb[7])};
        *(LAS u32x4*)(sp + S_BYTES + 16) = (u32x4){pk2(sb[8], sb[9]), pk2(sb[10], sb[11]), pk2(sb[12], sb[13]), pk2(sb[14], sb[15])};
        __syncthreads();
        const int p = qoff + r32; const float ai = __builtin_amdgcn_exp2f(u.lgf * (float)(p + 1)), bi = __builtin_amdgcn_exp2f(u.lgb * (float)(256 - p));
#pragma unroll
        for (int s4 = 0; s4 < 4; ++s4) {
            const u32x4 qw = __builtin_bit_cast(u32x4, qf[s4]); u32x4 qa, qb;
#pragma unroll
            for (int q = 0; q < 4; ++q) { const float lo = bflo(qw[q]), hh = bfhi(qw[q]); qa[q] = pk2(lo * ai, hh * ai); qb[q] = pk2(lo * bi, hh * bi); }
#pragma unroll
            for (int d = 0; d < 4; ++d) {
                const LAS unsigned char* bp = lds + S_OFF + (32 * d + r32) * KPITCH + (16 * s4 + 8 * hi) * 2;
                o[d] = __builtin_amdgcn_mfma_f32_32x32x16_bf16(__builtin_bit_cast(bf16x8, qa), *(const LAS bf16x8*)bp, o[d], 0, 0, 0);
                o[d] = __builtin_amdgcn_mfma_f32_32x32x16_bf16(__builtin_bit_cast(bf16x8, qb), *(const LAS bf16x8*)(bp + S_BYTES), o[d], 0, 0, 0);
            }
        }
    }
    u32x4 kA[2], vA[2];
    auto tile_row = [&](int t) { return t < u.ntA ? u.krowA + 64 * t : u.krowB + 64 * (t - u.ntA); };
    unsigned voffV[2], voffK[2];
#pragma unroll
    for (int i = 0; i < 2; ++i) { const int cid = tid + 512 * i, key = cid >> 4, c16 = cid & 15;
        voffV[i] = (unsigned)((key * NPROJ + vcol + c16 * 8) * 2); voffK[i] = (unsigned)((key * NPROJ + kcol + c16 * 8) * 2); }
    if (!diff) { const int key = tid >> 3, c8 = tid & 7; voffK[0] = (unsigned)((key * NPROJ + kcol + c8 * 8) * 2); }
    auto load_tile = [&](int t, u32x4 (&kr)[2], u32x4 (&vr)[2]) {
        const GAS unsigned char* tb = (const GAS unsigned char*)PROJ + (size_t)tile_row(t) * NPROJ * 2;
#pragma unroll
        for (int i = 0; i < 2; ++i) { vr[i] = *(const GAS u32x4*)(tb + voffV[i]); if (diff) kr[i] = *(const GAS u32x4*)(tb + voffK[i]); }
        if (!diff) kr[0] = *(const GAS u32x4*)(tb + voffK[0]);
    };
    auto store_tile = [&](int buf, const u32x4 (&kr)[2], const u32x4 (&vr)[2]) {
        LAS unsigned char* b = lds + buf * BUF_BYTES;
#pragma unroll
        for (int i = 0; i < 2; ++i) { const int cid = tid + 512 * i, key = cid >> 4, c16 = cid & 15;
            *(LAS u32x4*)(b + 2 * KC_BYTES + key * VPITCH + c16 * 16) = vr[i];
            if (diff) *(LAS u32x4*)(b + (c16 >> 3) * KC_BYTES + key * KPITCH + (c16 & 7) * 16) = kr[i]; }
        if (!diff) { const int key = tid >> 3, c8 = tid & 7; *(LAS u32x4*)(b + key * KPITCH + c8 * 16) = kr[0]; }
    };
    const int qpos = u.qpos0 + qoff + r32;
    auto compute_tile = [&](int t, int bufsel) {
        const LAS unsigned char* b = lds + bufsel * BUF_BYTES;
        const LAS unsigned char* kb = b + comp * KC_BYTES + r32 * KPITCH + hi * 16;
        u32x4 pw[4];
        const bool segB = t >= u.ntA; const int j0 = 64 * (segB ? t - u.ntA : t);
        f32x16 sc[2];
#pragma unroll
        for (int kh = 0; kh < 2; ++kh) { sc[kh] = (f32x16){};
#pragma unroll
            for (int s = 0; s < 4; ++s) { const bf16x8 kf = *(const LAS bf16x8*)(kb + kh * 32 * KPITCH + s * 32); sc[kh] = __builtin_amdgcn_mfma_f32_32x32x16_bf16(kf, qf[s], sc[kh], 0, 0, 0); } }
        auto weigh = [&](int kh) {
            f32x16& x = sc[kh];
            if (diff) {
#pragma unroll
                for (int r = 0; r < 16; ++r) x[r] = __builtin_amdgcn_exp2f(x[r]);
                float a = 0.f;
#pragma unroll
                for (int r = 0; r < 16; ++r) a += x[r];
                lsum += a;
            } else if (!segB || u.kindB == 0) {
#pragma unroll
                for (int r = 0; r < 16; ++r) { const int d = qpos - (j0 + 32 * kh + crow(r, hi)); x[r] *= __builtin_amdgcn_exp2f((float)d * (d >= 0 ? u.lgf : -u.lgb)); }
            } else {
#pragma unroll
                for (int r = 0; r < 16; ++r) { const int na = j0 + 32 * kh + crow(r, hi);
                    x[r] *= __builtin_amdgcn_exp2f((float)(qpos + CTX - na) * u.lgf) + __builtin_amdgcn_exp2f((float)(u.nseq - qpos + na) * u.lgb); }
            }
            pw[2 * kh] = (u32x4){pk2(x[0], x[1]), pk2(x[2], x[3]), pk2(x[4], x[5]), pk2(x[6], x[7])};
            pw[2 * kh + 1] = (u32x4){pk2(x[8], x[9]), pk2(x[10], x[11]), pk2(x[12], x[13]), pk2(x[14], x[15])};
        };
        const LAS unsigned char* vb = b + 2 * KC_BYTES + (4 * hi + ((lane & 15) >> 2)) * VPITCH + ((lane >> 4) & 1) * 32 + (lane & 3) * 8;
        auto pv = [&](int ks) {
#pragma unroll
            for (int dvb = 0; dvb < 4; ++dvb) {
                const s16x4 lo = vtr(vb + ks * 16 * VPITCH + dvb * 64), hi4 = vtr(vb + ks * 16 * VPITCH + 8 * VPITCH + dvb * 64);
                const bf16x8 vf = (bf16x8){lo[0], lo[1], lo[2], lo[3], hi4[0], hi4[1], hi4[2], hi4[3]};
                o[dvb] = __builtin_amdgcn_mfma_f32_32x32x16_bf16(__builtin_bit_cast(bf16x8, pw[ks]), vf, o[dvb], 0, 0, 0);
            }
        };
        weigh(0);
        pv(0); pv(1);
        weigh(1);
        pv(2); pv(3);
    };
    load_tile(0, kA, vA); store_tile(0, kA, vA);
#pragma unroll
    for (int s4 = 0; s4 < 4; ++s4) asm volatile("" : "+v"(qf[s4]));
    __syncthreads();
    if (PROBE_STAT) ts1 = __builtin_amdgcn_s_memtime();
    for (int t = 0; t < NT; t += 2) {
        unsigned long long ta = 0; if (PROBE_STAT >= 3) ta = __builtin_amdgcn_s_memtime();
        load_tile(t + 1, kA, vA);
        compute_tile(t, 0);
        if (PROBE_STAT == 3) tacc += __builtin_amdgcn_s_memtime() - ta;
        store_tile(1, kA, vA);
        if (PROBE_STAT == 4) tacc += __builtin_amdgcn_s_memtime() - ta;
        __syncthreads();
        load_tile(t + 2 < NT ? t + 2 : NT - 1, kA, vA);
        compute_tile(t + 1, 1);
        store_tile(0, kA, vA);
        __syncthreads();
    }
    if (PROBE_STAT) ts2 = __builtin_amdgcn_s_memtime();
    LAS float* wsf = (LAS float*)(lds + SCR_OFF) + wid * 64;
    int lz = lane; asm volatile("" : "+v"(lz));
    const int r32e = lz & 31, hie = lz >> 5;
    if (diff) {
        lsum = sum32x2(lsum);
        if (hie == 0) wsf[r32e] = __builtin_amdgcn_rcpf(lsum);
        LDS_WAIT();
        float rl[16];
#pragma unroll
        for (int r = 0; r < 16; ++r) rl[r] = wsf[crow(r, hie)];
        LAS float* XC = (LAS float*)lds;
        if (comp == 1) {
#pragma unroll
            for (int r = 0; r < 16; ++r) { const int q = qoff + crow(r, hie); const float sc_ = rl[r] * u.lam;
                *(LAS f32x4*)(XC + (q * 32 + r32e) * 4) = (f32x4){o[0][r] * sc_, o[1][r] * sc_, o[2][r] * sc_, o[3][r] * sc_}; }
        }
        __syncthreads();
        if (comp == 0) {
            float ss[16];
#pragma unroll
            for (int r = 0; r < 16; ++r) { const int q = qoff + crow(r, hie); float a = 0.f; const f32x4 xc = *(const LAS f32x4*)(XC + (q * 32 + r32e) * 4);
#pragma unroll
                for (int d = 0; d < 4; ++d) { const float v = o[d][r] * rl[r] - xc[d]; o[d][r] = v; a += v * v; }
                ss[r] = a; }
#pragma unroll
            for (int r = 0; r < 16; ++r) { float a = ss[r]; a = half_sum(a);
                ss[r] = u.scale_out * __builtin_amdgcn_rsqf(a * (1.0f / 128.0f) + EPS); }
            bf16* DO = (bf16*)(F.ws + WS_FO + 2 * MIX_ONE);
            LAS unsigned char* stg = lds + 16384 * (wid & 3);
#pragma unroll
            for (int r = 0; r < 16; ++r)
#pragma unroll
                for (int d = 0; d < 4; ++d) *(LAS bf16*)(stg + crow(r, hie) * 272 + (32 * d + r32e) * 2) = (bf16)f2bf(o[d][r] * ss[r]);
#pragma unroll
            for (int it = 0; it < 8; ++it) { const int row = 4 * it + (lz >> 4), ch = lz & 15; const u32x4 w = *(const LAS u32x4*)(stg + row * 272 + ch * 16);
                *(u32x4*)(DO + (size_t)(u.outrow0 + qoff + row) * 512 + u.h * 128 + ch * 8) = w; }
        }
    } else {
        bf16* RO = (bf16*)(F.ws + WS_FO + 1 * MIX_ONE);
#pragma unroll
        for (int r = 0; r < 16; ++r) {
            float a = (o[0][r] + o[1][r]) + (o[2][r] + o[3][r]);
            a = half_sum(a);
            const float mu = a * (1.0f / 128.0f); float q = 0.f;
#pragma unroll
            for (int d = 0; d < 4; ++d) { const float v = o[d][r] - mu; o[d][r] = v; q += v * v; }
            q = half_sum(q);
            const float rstd = __builtin_amdgcn_rsqf(q * (1.0f / 128.0f) + EPS);
#pragma unroll
            for (int d = 0; d < 4; ++d) o[d][r] *= rstd;
        }
        LAS unsigned char* stg = lds + 8704 * wid;
#pragma unroll
        for (int r = 0; r < 16; ++r)
#pragma unroll
            for (int d = 0; d < 4; ++d) *(LAS bf16*)(stg + crow(r, hie) * 272 + (32 * d + r32e) * 2) = (bf16)f2bf(o[d][r]);
#pragma unroll
        for (int it = 0; it < 8; ++it) { const int rowl = 4 * it + (lz >> 4), ch = lz & 15; const size_t row = (size_t)(u.outrow0 + qoff + rowl);
            const u32x4 w = *(const LAS u32x4*)(stg + rowl * 272 + ch * 16), g = *(const u32x4*)(PROJ + row * NPROJ + C_RG + u.h * 128 + ch * 8); u32x4 ov;
#pragma unroll
            for (int q = 0; q < 4; ++q) ov[q] = pk2(bflo(w[q]) * siluf_(bflo(g[q])), bfhi(w[q]) * siluf_(bfhi(g[q])));
            *(u32x4*)(RO + row * 512 + u.h * 128 + ch * 8) = ov; }
    }
    __syncthreads();
    if (PROBE_STAT && u.stat && tid == 0) { asm volatile("s_waitcnt vmcnt(0)" ::: "memory"); ts3 = __builtin_amdgcn_s_memtime();
        const float tot = (float)(ts3 - ts0); float v = 0.f;
        if (PROBE_STAT == 1) v = (float)(ts2 - ts1) / tot;
        if (PROBE_STAT == 2) v = tot * (1.0f / 400000.0f);
        if (PROBE_STAT == 3 || PROBE_STAT == 4) v = (float)tacc * 2.0f / (float)(ts2 - ts1);
        if (PROBE_STAT == 5) v = (float)(ts3 - ts2) / tot;
        if (PROBE_STAT == 6) v = (float)(ts1 - ts0) / tot;
        ((float*)F.ctl)[CW_STAT] = v; }
}
}

namespace rst {
constexpr int KP = 192, VP = 320, KB_BYTES = 128 * KP, VB_BYTES = 128 * VP;
__device__ __forceinline__ void unit(const Frame& F, int layer, int b, int h, int blk) {
    LAS unsigned char* lds = F.lds; const int tid = F.tid, lane = F.lane, wid = F.wave, hi = lane >> 5;
    const bf16* PROJ = (const bf16*)(F.ws + WS_PROJ);
    const int row0 = blk < 8 ? TC + b * SEQ + blk * 256 : b * CTX;
    const float lgf = inp(F, IN_RDEC)[(layer * 2 + 0) * 4 + h] * LOG2E, lgb = inp(F, IN_RDEC)[(layer * 2 + 1) * 4 + h] * LOG2E;
    const int dir = wid >> 2, dvb = wid & 3;
    f32x16 acc0 = (f32x16){}, acc1 = (f32x16){};
    u32x4 kreg[2][2], vreg[2][4];
#pragma unroll
    for (int half = 0; half < 2; ++half) {
#pragma unroll
        for (int i = 0; i < 2; ++i) { const int cid = tid + 512 * i, tok = cid >> 3, c8 = cid & 7, p = half * 128 + tok; kreg[half][i] = *(const u32x4*)(PROJ + (size_t)(row0 + p) * NPROJ + C_RK + h * 64 + c8 * 8); }
#pragma unroll
        for (int i = 0; i < 4; ++i) { const int cid = tid + 512 * i, tok = cid >> 4, c16 = cid & 15, p = half * 128 + tok; vreg[half][i] = *(const u32x4*)(PROJ + (size_t)(row0 + p) * NPROJ + C_RV + h * 128 + c16 * 8); }
    }
#pragma unroll
    for (int half = 0; half < 2; ++half) {
#pragma unroll
        for (int i = 0; i < 2; ++i) { const int cid = tid + 512 * i, tok = cid >> 3, c8 = cid & 7, p = half * 128 + tok;
            const u32x4 kv = kreg[half][i];
            const float wf = __builtin_amdgcn_exp2f((float)(255 - p) * lgf), wb = __builtin_amdgcn_exp2f((float)p * lgb);
            u32x4 kf, kb;
#pragma unroll
            for (int q = 0; q < 4; ++q) { const float lo = bflo(kv[q]), hh = bfhi(kv[q]); kf[q] = pk2(lo * wf, hh * wf); kb[q] = pk2(lo * wb, hh * wb); }
            *(LAS u32x4*)(lds + tok * KP + c8 * 16) = kf; *(LAS u32x4*)(lds + KB_BYTES + tok * KP + c8 * 16) = kb; }
#pragma unroll
        for (int i = 0; i < 4; ++i) { const int cid = tid + 512 * i, tok = cid >> 4, c16 = cid & 15;
            *(LAS u32x4*)(lds + 2 * KB_BYTES + tok * VP + c16 * 16) = vreg[half][i]; }
        __syncthreads();
        const LAS unsigned char* ka = lds + dir * KB_BYTES + (8 * hi + ((lane & 15) >> 2)) * KP + ((lane >> 4) & 1) * 32 + (lane & 3) * 8;
        const LAS unsigned char* va = lds + 2 * KB_BYTES + (8 * hi + ((lane & 15) >> 2)) * VP + dvb * 64 + ((lane >> 4) & 1) * 32 + (lane & 3) * 8;
#pragma unroll
        for (int ks = 0; ks < 8; ++ks) {
            const s16x4 v0 = att::vtr(va + ks * 16 * VP), v1 = att::vtr(va + ks * 16 * VP + 4 * VP);
            const bf16x8 vf = (bf16x8){v0[0], v0[1], v0[2], v0[3], v1[0], v1[1], v1[2], v1[3]};
            const s16x4 a0 = att::vtr(ka + ks * 16 * KP), a1 = att::vtr(ka + ks * 16 * KP + 4 * KP);
            const s16x4 b0 = att::vtr(ka + ks * 16 * KP + 64), b1 = att::vtr(ka + ks * 16 * KP + 4 * KP + 64);
            acc0 = __builtin_amdgcn_mfma_f32_32x32x16_bf16((bf16x8){a0[0], a0[1], a0[2], a0[3], a1[0], a1[1], a1[2], a1[3]}, vf, acc0, 0, 0, 0);
            acc1 = __builtin_amdgcn_mfma_f32_32x32x16_bf16((bf16x8){b0[0], b0[1], b0[2], b0[3], b1[0], b1[1], b1[2], b1[3]}, vf, acc1, 0, 0, 0);
        }
        __syncthreads();
    }
    float* L = (float*)(F.ws + WS_LBUF) + ((size_t)((b * 4 + h) * 9 + blk) * 2 + dir) * 64 * 128;
    const int r32 = lane & 31;
#pragma unroll
    for (int r = 0; r < 16; ++r) { const int d = att::crow(r, hi); L[(size_t)d * 128 + 32 * dvb + r32] = acc0[r]; L[(size_t)(32 + d) * 128 + 32 * dvb + r32] = acc1[r]; }
}
}
__device__ __forceinline__ void fold_rows(Frame& F, const bf16* GTin, bf16* GTout, int N) {
    const int gw = F.vcu * 8 + F.wave, NGW = F.G * 8, lane = F.lane, H = N >> 1;
    for (int row = gw; row < 4096; row += NGW) { const bf16* gc = GTin + (size_t)row * 2 * N; const bf16* gs = gc + N; bf16* o = GTout + (size_t)row * N;
        for (int j0 = 0; j0 < H; j0 += 512) {
            float a[8], b[8], c[8], d[8];
#pragma unroll
            for (int q = 0; q < 8; ++q) { const int j = j0 + 64 * q + lane; const bool ok = j < H; const int jj = ok ? j : 0, jr = (ok && j > 0) ? N - j : 0;
                a[q] = bf2f(gc[jj]); b[q] = bf2f(gc[jr]); c[q] = bf2f(gs[jj]); d[q] = bf2f(gs[jr]); }
#pragma unroll
            for (int q = 0; q < 8; ++q) { const int j = j0 + 64 * q + lane;
                if (j < H) { o[j] = (bf16)f2bf(j == 0 ? a[q] : a[q] + b[q]); if (j > 0) o[H + j] = (bf16)f2bf(c[q] - d[q]); } }
        }
        if (lane == 0) o[H] = gc[H];
    }
}
__device__ __forceinline__ void phase_retstate(Frame& F, int layer) {
    fold_rows(F, (const bf16*)(F.ws + WS_GT), (bf16*)(F.ws + WS_GT2), SEQ);
    if (layer < DEPTH - 1) fold_rows(F, (const bf16*)(F.ws + WS_GTC), (bf16*)(F.ws + WS_GTC2), CTX);
    for (int i = F.vcu; i < 288; i += F.G) { const int blk = i % 9, bh = i / 9; rst::unit(F, layer, bh >> 2, bh & 3, blk); }
}


constexpr int NDFT_CU = 128;

__device__ __forceinline__ void phase_mixers(Frame& F, int layer, int rep) {
    const bool last = layer == DEPTH - 1;
#if !defined(ONLY_SUB) || ONLY_SUB == 1
    if ((int)blockIdx.x < NDFT_CU && F.G > NDFT_CU && !(rep > 0 && PROBE_MIX >= 2)) {
        {
            SchedGrid S{SEQ / 256, 4096 / 256, NDFT_CU, (int)blockIdx.x, (const char*)(F.ws + WS_DFTL), (const char*)(F.ws + WS_GT2), (size_t)256 * 2048 * 2, (size_t)256 * 2048 * 2, 0, 0};
            EpiDFT E{(bf16*)(F.ws + WS_FO), SEQ, TC};
            pg8::gemm_phase(F.lds, F.tid, 2048, S, E);
        }
        if (!last) {
            SchedGrid S{1, 4096 / 256, NDFT_CU, (int)blockIdx.x, (const char*)(F.ws + WS_DFTC), (const char*)(F.ws + WS_GTC2), (size_t)256 * 256 * 2, (size_t)256 * 256 * 2, 0, 0};
            EpiDFT E{(bf16*)(F.ws + WS_FO), CTX, 0};
            pg8::gemm_phase(F.lds, F.tid, 256, S, E);
        }
    }
#endif
#if defined(ONLY_SUB) && ONLY_SUB == 1
    return;
#endif
    const int nunits = last ? 96 : 108;
    const float lam = lam_of(F, layer), so = 1.0f - lam_init_of(layer);
    const int xq0 = (int)(xb_xcc_id() & 7u);
    volatile LAS unsigned* qw = (volatile LAS unsigned*)(F.lds + att::QW_OFF);
    for (int qi = 0; qi < 8; ++qi) {
    const int xq = (xq0 + qi) & 7;
    unsigned* qctr = F.ctl + CW_QUEUE + 64 * (xq + 8 * (layer + 2 * rep));
    for (;;) {
        if (F.tid == 0) *qw = __hip_atomic_fetch_add(qctr, 1u, RLX_AGENT);
        __syncthreads();
        const int i = (int)*qw;
        __syncthreads();
        if (i >= nunits) break;
        if (rep > 0 && PROBE_MIX != 0) { if (PROBE_MIX == 1) break; if (PROBE_MIX == 2 && i >= 64) break; if (PROBE_MIX == 3 && (i < 64 || i >= 96)) continue; }
        att::UnitDesc u{};
        u.lam = lam; u.scale_out = so;
        if (i < 64) { const int p = xq + 8 * (i >> 4), b = p >> 2, h = p & 3, qb = i & 15; u.mode = 0; u.h = h; u.qrow0 = TC + b * SEQ + qb * 128; u.qpos0 = qb * 128; u.krowA = TC + b * SEQ; u.ntA = 32; u.krowB = b * CTX; u.ntB = 4; }
        else if (i < 96) { const int j = i - 64, p = xq + 8 * (j >> 3), b = p >> 2, h = p & 3, qb = j & 7; u.mode = 1; u.h = h; u.qrow0 = TC + b * SEQ + qb * 256; u.qpos0 = 0; u.krowA = u.qrow0; u.ntA = 4; u.krowB = 0; u.ntB = 0; u.kindB = 0; u.nseq = SEQ; u.cross = 1; u.bh = b * 4 + h; u.blk = qb; }
        else if (i < 104) { const int j = i - 96, p = xq + 8 * (j >> 1), b = p >> 2, h = p & 3, qb = j & 1; u.mode = 0; u.h = h; u.qrow0 = b * CTX + qb * 128; u.qpos0 = qb * 128; u.krowA = b * CTX; u.ntA = 4; u.krowB = 0; u.ntB = 0; }
        else { const int j = i - 104, p = xq + 8 * j, b = p >> 2, h = p & 3; u.mode = 1; u.h = h; u.qrow0 = b * CTX; u.qpos0 = 0; u.krowA = b * CTX; u.ntA = 4; u.krowB = 0; u.ntB = 0; u.kindB = 0; u.nseq = CTX; }
        u.outrow0 = u.qrow0; u.stat = (PROBE_STAT && layer == DEPTH - 1 && rep == 0 && xq == 0 && i == 40) ? 1 : 0;
        if (u.mode == 1) { u.lgf = inp(F, IN_RDEC)[(layer * 2 + 0) * 4 + u.h] * LOG2E; u.lgb = inp(F, IN_RDEC)[(layer * 2 + 1) * 4 + u.h] * LOG2E; }
        if (u.mode == 0) att::unit<0>(F, u); else att::unit<1>(F, u);
    }
    }
}

__device__ __forceinline__ void phase_merge(Frame& F, int layer) {
    const int row_off = layer == DEPTH - 1 ? TC : 0, M = TA - row_off;
    SchedMerge S{M / 256, D / 256, F.G, (int)blockIdx.x, (const char*)(F.ws + WS_FO) + (size_t)row_off * 512 * 2, (const char*)(F.ws + WS_WFO + (size_t)layer * 3 * WMG_ONE), MIX_ONE, WMG_ONE, (size_t)256 * 512 * 2, (size_t)256 * 512 * 2};
    EpiMerge E{(const unsigned char*)(F.ws + WS_G8), (bf16*)(F.ws + WS_MIXB), row_off};
    pg8::gemm_phase(F.lds, F.tid, 512, S, E);
}
__device__ __forceinline__ void phase_outproj(Frame& F, int layer) {
    const int row_off = layer == DEPTH - 1 ? TC : 0, M = TA - row_off;
    SchedGrid S{M / 256, D / 256, F.G, (int)blockIdx.x, (const char*)(F.ws + WS_MIXB) + (size_t)row_off * D * 2, (const char*)(F.ws + WS_WOUT + layer * WOUT_L), (size_t)256 * D * 2, (size_t)256 * D * 2, 0, 0};
    const float* XR = (const float*)(F.ws + WS_XR);
    EpiOut E{layer == 0 ? inp(F, IN_CTX) : XR, layer == 0 ? inp(F, IN_X) : XR + (size_t)TC * D, (float*)(F.ws + WS_XR), (const float*)(F.ws + WS_MOD) + (size_t)layer * 9 * 6144 + 2 * 1024, row_off};
    pg8::gemm_phase(F.lds, F.tid, D, S, E);
}

__device__ __forceinline__ void phase_norm2(Frame& F, int layer) {
    const int gw = F.vcu * 8 + F.wave, NGW = F.G * 8, lane = F.lane, tid = F.tid;
    LAS float* wr_t = (LAS float*)F.lds;
    const float* wrt = inp(F, IN_WROUTER) + (size_t)layer * D * NE;
    for (int i = tid; i < D * NE; i += 512) { const int k = i >> 4, e = i & 15; wr_t[e * 1024 + k] = wrt[i]; }
    __syncthreads();
    const int r_lo = layer == DEPTH - 1 ? TC : 0;
    const float* XR = (const float*)(F.ws + WS_XR); bf16* HB = (bf16*)(F.ws + WS_HB); float* AFF = (float*)(F.ws + WS_AFF);
    f32x4 xn[4];
    { const int r0 = r_lo + gw < TA ? r_lo + gw : TA - 1;
#pragma unroll
      for (int j = 0; j < 4; ++j) xn[j] = *(const f32x4*)(XR + (size_t)r0 * D + 4 * lane + 256 * j); }
    const bool b5 = lane & 32, b4 = lane & 16, b3 = lane & 8, b2 = lane & 4;
    for (int r = r_lo + gw; r < TA; r += NGW) {
        const int v = vec_of_row(r);
        f32x4 x[4];
#pragma unroll
        for (int j = 0; j < 4; ++j) x[j] = xn[j];
        { const int rn = r + NGW < TA ? r + NGW : r;
#pragma unroll
          for (int j = 0; j < 4; ++j) xn[j] = *(const f32x4*)(XR + (size_t)rn * D + 4 * lane + 256 * j); }
        float ss = 0.f;
#pragma unroll
        for (int j = 0; j < 4; ++j) ss += (x[j].x * x[j].x + x[j].y * x[j].y) + (x[j].z * x[j].z + x[j].w * x[j].w);
        const float rinv = __builtin_amdgcn_rsqf(wave_sum(ss) * (1.0f / D) + EPS);
        const float* g = inp(F, IN_GFFN) + (size_t)layer * D; const float* sh = mod_ptr(F, layer, v, 3); const float* scl = mod_ptr(F, layer, v, 4);
#pragma unroll
        for (int j = 0; j < 4; ++j) { const int k = 4 * lane + 256 * j; const f32x4 gv = *(const f32x4*)(g + k), sv = *(const f32x4*)(sh + k), cv = *(const f32x4*)(scl + k);
            x[j] = (x[j] * rinv * gv) * (cv + 1.0f) + sv;
            u32x2 w; w.x = pk2(x[j].x, x[j].y); w.y = pk2(x[j].z, x[j].w); *(u32x2*)(HB + (size_t)r * D + k) = w; }
        float a[16];
#pragma unroll
        for (int e = 0; e < 16; ++e) { float t = 0.f;
#pragma unroll
            for (int j = 0; j < 4; ++j) { const f32x4 w = *(const LAS f32x4*)(wr_t + e * 1024 + 4 * lane + 256 * j); t += (x[j].x * w.x + x[j].y * w.y) + (x[j].z * w.z + x[j].w * w.w); }
            a[e] = t; if ((e & 3) == 3) asm volatile("" ::: "memory"); }
        float b[8], c[4], d[2];
#pragma unroll
        for (int i = 0; i < 8; ++i) { const float mine = b5 ? a[i + 8] : a[i], oth = b5 ? a[i] : a[i + 8]; b[i] = mine + lane_xor32(oth, lane); }
#pragma unroll
        for (int i = 0; i < 4; ++i) { const float mine = b4 ? b[i + 4] : b[i], oth = b4 ? b[i] : b[i + 4]; c[i] = mine + lane_xor16(oth, lane); }
#pragma unroll
        for (int i = 0; i < 2; ++i) { const float mine = b3 ? c[i + 2] : c[i], oth = b3 ? c[i] : c[i + 2]; d[i] = mine + lane_xor8(oth); }
        float lg = (b2 ? d[1] : d[0]) + lane_xor4(b2 ? d[0] : d[1], lane);
        lg += dppf<DPP_XOR2>(lg); lg += dppf<DPP_XOR1>(lg);
        float mx = lg;
        mx = fmaxf(mx, lane_xor4(mx, lane)); mx = fmaxf(mx, lane_xor8(mx)); mx = fmaxf(mx, lane_xor16(mx, lane)); mx = fmaxf(mx, lane_xor32(mx, lane));
        const float ex = __expf(lg - mx); float den = ex;
        den += lane_xor4(den, lane); den += lane_xor8(den); den = sum16x2(den); den = sum32x2(den);
        if ((lane & 3) == 0) AFF[(size_t)r * 16 + (lane >> 2)] = ex * __builtin_amdgcn_rcpf(den);
    }
    __syncthreads();
}

__device__ __forceinline__ void phase_topk(Frame& F, int layer) {
    const bool last = layer == DEPTH - 1; const int tid = F.tid, lane = F.lane, wave = F.wave;
    const int RPE = last ? 2048 : 2304, lat_off = last ? 0 : 256;
    LAS unsigned* part = (LAS unsigned*)F.lds;
    LAS unsigned* cntG = part + 16;
    LAS unsigned* cntE = cntG + 32;
    LAS int* lst = (LAS int*)(cntE + 32);
    const float* AFF = (const float*)(F.ws + WS_AFF); int* INV = (int*)(F.ws + WS_INV); float* TOPW = (float*)(F.ws + WS_TOPW);
    int* SLOT = (int*)(F.ws + WS_SLOT);
    const int nitems = last ? 128 : 256;
    for (int item = F.vcu; item < nitems; item += F.G) {
        int n, C, tokrow0, e, slot0;
        if (item < 128) { const int b = item >> 4; e = item & 15; n = SEQ; C = 256; tokrow0 = TC + b * SEQ; slot0 = e * RPE + lat_off + b * 256; }
        else { const int be = item - 128, b = be >> 4; e = be & 15; n = CTX; C = 32; tokrow0 = b * CTX; slot0 = e * RPE + b * 32; }
        float v[4]; unsigned key[4];
#pragma unroll
        for (int q = 0; q < 4; ++q) { const int i = tid + 512 * q; v[q] = i < n ? AFF[(size_t)(tokrow0 + i) * 16 + e] : 0.f; key[q] = __builtin_bit_cast(unsigned, v[q]); }
        unsigned t = 0u;
        for (int bit = 30; bit >= 0; --bit) {
            const unsigned cand = t | (1u << bit); unsigned c = 0u;
#pragma unroll
            for (int q = 0; q < 4; ++q) c += (unsigned)__builtin_popcountll(__ballot(key[q] >= cand));
            if (lane == 0) part[(bit & 1) * 8 + wave] = c;
            __syncthreads();
            unsigned tot = 0u;
#pragma unroll
            for (int w = 0; w < 8; ++w) tot += part[(bit & 1) * 8 + w];
            if (tot >= (unsigned)C) t = cand;
        }
        unsigned long long bg[4], be_[4];
#pragma unroll
        for (int q = 0; q < 4; ++q) { bg[q] = __ballot(key[q] > t); be_[q] = __ballot(key[q] == t && key[q] != 0u);
            if (lane == 0) { cntG[q * 8 + wave] = (unsigned)__builtin_popcountll(bg[q]); cntE[q * 8 + wave] = (unsigned)__builtin_popcountll(be_[q]); } }
        __syncthreads();
        unsigned totG = 0u, baseG[4] = {0u, 0u, 0u, 0u}, baseE[4] = {0u, 0u, 0u, 0u}; unsigned runG = 0u, runE = 0u;
#pragma unroll
        for (int q = 0; q < 4; ++q)
#pragma unroll
            for (int w = 0; w < 8; ++w) { const unsigned g = cntG[q * 8 + w], ee = cntE[q * 8 + w]; if (w == wave) { baseG[q] = runG; baseE[q] = runE; } runG += g; runE += ee; }
        totG = runG;
        const unsigned need = (unsigned)C - totG;
        const unsigned long long lt = (1ull << lane) - 1ull;
#pragma unroll
        for (int q = 0; q < 4; ++q) { const int i = tid + 512 * q;
            if (i < n) {
                const bool g = (bg[q] >> lane) & 1ull, eq = (be_[q] >> lane) & 1ull;
                const unsigned myG = baseG[q] + (unsigned)__builtin_popcountll(bg[q] & lt), myE = baseE[q] + (unsigned)__builtin_popcountll(be_[q] & lt);
                int sl = -1;
                if (g) sl = (int)myG; else if (eq && myE < need) sl = (int)(totG + myE);
                const int R = sl >= 0 ? slot0 + sl : -1;
                INV[(size_t)(tokrow0 + i) * 16 + e] = R;
                if (sl >= 0) { TOPW[R] = v[q]; SLOT[R] = tokrow0 + i; }
            } }
        __syncthreads();
    }
}

__device__ __forceinline__ void phase_gateup(Frame& F, int layer) {
    const int RPE = layer == DEPTH - 1 ? 2048 : 2304;
    SchedGrid S{NE * RPE / 256, 4096 / 256, F.G, (int)blockIdx.x, (const char*)nullptr, (const char*)(F.ws + WS_WGU), 0, (size_t)256 * D * 2, RPE / 256, WGU_E};
    EpiGU E{(bf16*)(F.ws + WS_HID)};
    pg8::gemm_phase_gather(F.lds, F.tid, D, S, E, (const char*)(F.ws + WS_HB), (const int*)(F.ws + WS_SLOT), (LAS int*)(F.lds + LDSCTL_OFF + 1024));
}
__device__ __forceinline__ void phase_down(Frame& F, int layer) {
    const int RPE = layer == DEPTH - 1 ? 2048 : 2304;
    SchedGrid S{NE * RPE / 256, D / 256, F.G, (int)blockIdx.x, (const char*)(F.ws + WS_HID), (const char*)(F.ws + WS_WD), (size_t)256 * EH * 2, (size_t)256 * EH * 2, RPE / 256, WD_E};
    EpiDown E{(bf16*)(F.ws + WS_YE), (const float*)(F.ws + WS_TOPW)};
    pg8::gemm_phase(F.lds, F.tid, EH, S, E);
}

constexpr int NPHASE = 1 + 10 * DEPTH + 1;
__global__ void __launch_bounds__(512, 2) mk_fwd(Args args) {
    extern __shared__ __attribute__((aligned(16))) unsigned char lds_raw[];
    Frame F;
    F.lds = (LAS unsigned char*)lds_raw; F.MISC = (volatile LAS unsigned*)(F.lds + MISC_OFF);
    F.tid = threadIdx.x; F.lane = F.tid & 63; F.wave = __builtin_amdgcn_readfirstlane(F.tid >> 6);
    F.G = gridDim.x; { const int bx = blockIdx.x; F.vcu = (F.G % 8 == 0) ? (bx % 8) * (F.G / 8) + bx / 8 : bx; }
    F.ws = (unsigned char*)(GAS unsigned char*)(unsigned long long)args.ws; F.ctl = (unsigned*)(F.ws + WS_CTL); F.out = (float*)(GAS float*)(unsigned long long)args.out;
    for (int u = F.tid; u < (LDS_BYTES - LDSCTL_OFF) / 4; u += 512) ((LAS unsigned*)(F.lds + LDSCTL_OFF))[u] = 0u;
    __syncthreads();
    XcdBarrier bar; bar.bar = F.ctl + CW_BAR; bar.x = 0; bar.st = nullptr;
    const bool multi = (args.ph_hi - args.ph_lo) > 1;
    if (multi) bar = xcd_barrier_post(F.ctl + CW_BAR, F.MISC + 8);
    if (PROBE_STAT >= 10 && blockIdx.x == 0 && F.tid == 0) ((unsigned long long*)(F.ctl + CW_STAT + 8))[0] = __builtin_amdgcn_s_memrealtime();
    for (int ph = args.ph_lo; ph < args.ph_hi; ++ph) {
        const int layer = (ph - 1) / 10, k = (ph == 0) ? 10 : (ph == NPHASE - 1) ? 12 : (ph - 1) % 10;
        int reps = 1 + ((PROBE_MASK >> k) & 1);
        if (k == 0 && layer > 0 && (PROBE_MASK & 2048)) reps = 2;
        for (int rep = 0; rep < reps; ++rep) {
            { unsigned long long w = (unsigned long long)args.ws; asm volatile("" : "+s"(w)); F.ws = (unsigned char*)(GAS unsigned char*)w; F.ctl = (unsigned*)(F.ws + WS_CTL); }
            { unsigned long long kp = (unsigned long long)__builtin_amdgcn_kernarg_segment_ptr(); asm volatile("" : "+s"(kp)); F.karg = (const void __attribute__((address_space(4)))*)kp; }
            { int l = (int)__builtin_amdgcn_mbcnt_hi(~0u, __builtin_amdgcn_mbcnt_lo(~0u, 0u)); asm volatile("" : "+v"(l)); F.lane = l; F.tid = F.wave * 64 + l; }
#ifdef ONLY_PHASE
            if (k != ONLY_PHASE) continue;
#endif
            switch (k) {
                case 10: phase_prologue(F); break;
                case 12: phase_norm(F, DEPTH); break;
                case 0: if (rep == 0) phase_norm(F, layer); if (layer > 0) convert_expert_weights(F, layer); break;
                case 1: phase_inproj(F, layer); break;
                case 2: phase_retstate(F, layer); break;
                case 3: phase_mixers(F, layer, rep); break;
                case 4: phase_merge(F, layer); break;
                case 5: if (rep == 0) phase_outproj(F, layer); break;
                case 6: phase_norm2(F, layer); break;
                case 7: phase_topk(F, layer); break;
                case 8: phase_gateup(F, layer); break;
                default: phase_down(F, layer); break;
            }
            if (rep + 1 < reps || ph + 1 < args.ph_hi) xcd_barrier(bar);
            if (PROBE_STAT >= 10 && blockIdx.x == 0 && F.tid == 0) ((unsigned long long*)(F.ctl + CW_STAT + 8))[ph + 1] = __builtin_amdgcn_s_memrealtime();
        }
    }
}

extern "C" void kernel_launch(void* const* d_in, const int* in_sizes, int n_in, void* d_out, int out_size, void* d_ws, size_t ws_size, hipStream_t stream) {
    static int grid = 0;
    if (grid == 0) {
        if (n_in != 21 || out_size != TL * D || ws_size < WS_END) { fprintf(stderr, "kernel_launch: unexpected shapes (n_in %d, out %d, ws %zu need %zu)\n", n_in, out_size, ws_size, (size_t)WS_END); grid = -1; return; }
        int dev = 0, cus = 0, per_cu = 0;
        if (hipGetDevice(&dev) != hipSuccess || hipDeviceGetAttribute(&cus, hipDeviceAttributeMultiprocessorCount, dev) != hipSuccess) { grid = -1; return; }
        if (hipFuncSetAttribute((const void*)mk_fwd, hipFuncAttributeMaxDynamicSharedMemorySize, LDS_BYTES) != hipSuccess) { fprintf(stderr, "kernel_launch: hipFuncSetAttribute failed\n"); grid = -1; return; }
        if (hipOccupancyMaxActiveBlocksPerMultiprocessor(&per_cu, (const void*)mk_fwd, 512, LDS_BYTES) != hipSuccess || per_cu < 1) { fprintf(stderr, "kernel_launch: occupancy query says %d\n", per_cu); per_cu = 1; }
        (void)hipGetLastError();
        grid = cus * (per_cu >= 1 ? 1 : 1);
        if (grid % 8 != 0 || grid <= NDFT_CU) fprintf(stderr, "kernel_launch: unusual grid %d\n", grid);
    }
    if (grid < 0) return;
    (void)hipMemsetAsync((char*)d_ws + WS_CTL, 0, CTL_BYTES, stream);
    Args a{};
    for (int i = 0; i < 21; ++i) a.in[i] = (const float*)d_in[i];
    a.out = (float*)d_out; a.ws = (unsigned char*)d_ws;
#if MK_MULTI_LAUNCH
    for (int ph = 0; ph < NPHASE; ++ph) { a.ph_lo = ph; a.ph_hi = ph + 1; hipLaunchKernelGGL(mk_fwd, dim3(grid), dim3(512), LDS_BYTES, stream, a); }
#else
    a.ph_lo = 0; a.ph_hi = NPHASE;
    void* kargs[] = {&a};
    hipError_t e = hipLaunchCooperativeKernel((const void*)mk_fwd, dim3(grid), dim3(512), kargs, LDS_BYTES, stream);
    if (e != hipSuccess) fprintf(stderr, "kernel_launch: cooperative launch failed: %s (grid %d)\n", hipGetErrorString(e), grid);
#endif
}
```

```cpp
#include <hip/hip_runtime.h>
#include <cstdio>
#include <cstdint>

#ifndef PROBE_MASK
#define PROBE_MASK 0
#endif
#ifndef PROBE_MIX
#define PROBE_MIX 0
#endif
#ifndef PROBE_STAT
#define PROBE_STAT 0
#endif
#ifndef MK_MULTI_LAUNCH
#define MK_MULTI_LAUNCH 0
#endif

#define GAS __attribute__((address_space(1)))
#define LAS __attribute__((address_space(3)))
typedef unsigned short bf16;
typedef short bf16x8 __attribute__((ext_vector_type(8)));
typedef short s16x4 __attribute__((ext_vector_type(4)));
typedef float f32x4 __attribute__((ext_vector_type(4)));
typedef float f32x16 __attribute__((ext_vector_type(16)));
typedef unsigned u32x4 __attribute__((ext_vector_type(4)));
typedef unsigned u32x2 __attribute__((ext_vector_type(2)));
typedef float f32x2_t __attribute__((ext_vector_type(2)));
typedef __bf16 bf16x2_t __attribute__((ext_vector_type(2)));

constexpr int D = 1024, NB = 8, SEQ = 2048, CTX = 256, DEPTH = 2, GRIDW = 64;
constexpr int TC = NB * CTX, TL = NB * SEQ, TA = TC + TL;
constexpr int NWPROJ = 6144;
constexpr int NPROJ = 3072;
constexpr int C_RQ = 0, C_RK = 256, C_RV = 512, C_RG = 1024, C_DQ = 1536, C_DK = 2048, C_DV = 2560, C_GATE = 3072;
constexpr int INW = 6656;
constexpr int NE = 16, EH = 2048;
constexpr int HIDP = EH + 64;
constexpr float EPS = 1e-6f;
constexpr float LOG2E = 1.4426950408889634f;

constexpr size_t al(size_t x) { return (x + 0xFFFFFull) & ~0xFFFFFull; }
constexpr size_t WS_CTL = 0, CTL_BYTES = 1u << 20;
constexpr size_t WS_MOD = WS_CTL + CTL_BYTES;
constexpr size_t WS_ROPE = WS_MOD + al((size_t)DEPTH * 9 * 6 * D * 4);
constexpr size_t WS_AFF = WS_ROPE + al((size_t)2 * SEQ * 32 * 4);
constexpr size_t WS_INV = WS_AFF + al((size_t)TA * 16 * 4);
constexpr size_t WS_TOPW = WS_INV + al((size_t)TA * 16 * 4);
constexpr size_t WS_SLOT = WS_TOPW + al((size_t)36864 * 4);
constexpr size_t WS_WIN = WS_SLOT + al((size_t)36864 * 4);
constexpr size_t WIN_L = (size_t)7168 * 1024 * 2;
constexpr size_t WS_WFO = WS_WIN + al(2 * WIN_L);
constexpr size_t WMG_ONE = (size_t)1024 * 512 * 2;
constexpr size_t WS_WOUT = WS_WFO + al(6 * WMG_ONE);
constexpr size_t WOUT_L = (size_t)1024 * 1024 * 2;
constexpr size_t WS_WGU = WS_WOUT + al(2 * WOUT_L);
constexpr size_t WGU_E = (size_t)4096 * 1024 * 2;
constexpr size_t WS_WD = WS_WGU + al(16 * WGU_E);
constexpr size_t WD_E = (size_t)1024 * 2048 * 2;
constexpr size_t EXPW_L = al(16 * WGU_E) + al(16 * WD_E);
constexpr size_t WS_DFTL = WS_WGU + DEPTH * EXPW_L;
constexpr size_t WS_DFTC = WS_DFTL + al((size_t)2048 * 4096 * 2);
constexpr size_t WS_XR = WS_DFTC + al((size_t)256 * 512 * 2);
constexpr size_t WS_HB = WS_XR + al((size_t)TA * D * 2);
constexpr size_t WS_PROJ = WS_HB + al((size_t)TA * D * 2);
constexpr size_t WS_GT = WS_PROJ + al((size_t)TA * NPROJ * 2);
constexpr size_t WS_GTC = WS_GT + al((size_t)4096 * 4096 * 2);
constexpr size_t WS_FO = WS_GTC + al((size_t)4096 * 512 * 2);
constexpr size_t MIX_ONE = (size_t)TA * 512 * 2;
constexpr size_t WS_MIXB = WS_FO + al(3 * MIX_ONE);
constexpr size_t WS_XS = WS_MIXB + al((size_t)TA * D * 2);
constexpr size_t WS_LBUF = WS_XS + al((size_t)36864 * D * 2);
constexpr size_t LBUF_ONE = (size_t)64 * 128 * 4;
constexpr size_t WS_GT2 = WS_LBUF + al((size_t)32 * 9 * 2 * LBUF_ONE);
constexpr size_t WS_GTC2 = WS_GT2 + al((size_t)4096 * 2048 * 2);
constexpr size_t WS_G8 = WS_GTC2 + al((size_t)4096 * 256 * 2);
constexpr size_t WS_END = WS_G8 + al((size_t)TA * 3072);
constexpr size_t WS_HID = WS_PROJ;
static_assert(WS_HID + (size_t)36864 * HIDP * 2 <= WS_MIXB, "HID overlay must end before MIXB (FO | RO | DO are dead between merge and the next mixers phase as well)");

constexpr size_t WS_YE = WS_XS;

static_assert(WS_END <= (size_t)1024 * 1024 * 1024, "workspace map must fit 1 GiB");

constexpr int CW_BAR = 4096;
constexpr int CW_STAT = 40000;
constexpr int CW_QUEUE = 16384;

constexpr int RING_BYTES = 131072;
constexpr int LDSCTL_OFF = RING_BYTES, MISC_OFF = LDSCTL_OFF + 320;
constexpr int LDS_BYTES = 147456;

#define RLX_AGENT __ATOMIC_RELAXED, __HIP_MEMORY_SCOPE_AGENT
#define LDS_WAIT() asm volatile("s_waitcnt lgkmcnt(0)" ::: "memory")
#define VM_WAIT() asm volatile("s_waitcnt vmcnt(0)" ::: "memory")
__device__ __forceinline__ unsigned f2bf(float f) { unsigned u = __builtin_bit_cast(unsigned, f); return (u + 0x7fffu + ((u >> 16) & 1u)) >> 16; }
__device__ __forceinline__ unsigned pk2(float lo, float hi) { f32x2_t v = {lo, hi}; bf16x2_t b = __builtin_convertvector(v, bf16x2_t); return __builtin_bit_cast(unsigned, b); }
__device__ __forceinline__ float bflo(unsigned w) { return __builtin_bit_cast(float, w << 16); }
__device__ __forceinline__ float bfhi(unsigned w) { return __builtin_bit_cast(float, w & 0xffff0000u); }
__device__ __forceinline__ float bf2f(bf16 h) { return __builtin_bit_cast(float, (unsigned)h << 16); }
template <int CTRL> __device__ __forceinline__ float dppf(float x) { return __builtin_bit_cast(float, __builtin_amdgcn_mov_dpp(__builtin_bit_cast(int, x), CTRL, 0xf, 0xf, true)); }
constexpr int DPP_XOR1 = 0xB1, DPP_XOR2 = 0x4E, DPP_HMIRROR = 0x141, DPP_ROR8 = 0x128, DPP_SHL4 = 0x104, DPP_SHR4 = 0x114;
__device__ __forceinline__ float lane_xor16(float x, int lane) { auto s = __builtin_amdgcn_permlane16_swap(__float_as_uint(x), __float_as_uint(x), false, false); return __uint_as_float((lane & 16) ? s[0] : s[1]); }
__device__ __forceinline__ float lane_xor32(float x, int lane) { auto s = __builtin_amdgcn_permlane32_swap(__float_as_uint(x), __float_as_uint(x), false, false); return __uint_as_float((lane & 32) ? s[0] : s[1]); }
__device__ __forceinline__ float lane_xor8(float x) { return dppf<DPP_ROR8>(x); }
__device__ __forceinline__ float lane_xor4(float x, int lane) { const float a = dppf<DPP_SHL4>(x), b = dppf<DPP_SHR4>(x); return (lane & 4) ? b : a; }
__device__ __forceinline__ float sum16x2(float v) { auto s = __builtin_amdgcn_permlane16_swap(__float_as_uint(v), __float_as_uint(v), false, false); return __uint_as_float(s[0]) + __uint_as_float(s[1]); }
__device__ __forceinline__ float sum32x2(float v) { auto s = __builtin_amdgcn_permlane32_swap(__float_as_uint(v), __float_as_uint(v), false, false); return __uint_as_float(s[0]) + __uint_as_float(s[1]); }
__device__ __forceinline__ float wave_sum(float v) {
    v += dppf<DPP_XOR1>(v); v += dppf<DPP_XOR2>(v); v += dppf<DPP_HMIRROR>(v); v += dppf<DPP_ROR8>(v);
    v = sum16x2(v); v = sum32x2(v); return v;
}
__device__ __forceinline__ float half_sum(float v) {
    v += dppf<DPP_XOR1>(v); v += dppf<DPP_XOR2>(v); v += dppf<DPP_HMIRROR>(v); v += dppf<DPP_ROR8>(v); return sum16x2(v);
}
__device__ __forceinline__ float sigmoidf_(float x) { return __builtin_amdgcn_rcpf(1.0f + __builtin_amdgcn_exp2f(-x * LOG2E)); }
__device__ __forceinline__ float siluf_(float x) { return x * sigmoidf_(x); }

namespace pg8 {
constexpr int BM = 256, BK = 64, HALF = 128, HTB = HALF * BK * 2, STAGE_BYTES = 8 * HTB, NXCD = 8, WGM = 8;
__host__ __device__ __forceinline__ int lds_byte(int r, int c) { const int st = (r >> 4) * 2 + (c >> 5), rr = r & 15, cc = c & 31, ob = rr * 64 + cc * 2; return st * 1024 + (ob ^ (((ob >> 9) & 1) << 5)); }
__host__ __device__ __forceinline__ void stage_rc(int b, int& R, int& C) { const int st = b / 1024, sb = b % 1024, swz = sb ^ (((sb >> 9) & 1) << 5); R = (st >> 1) * 16 + swz / 64; C = (st & 1) * 32 + (swz % 64) / 2; }
__host__ __device__ __forceinline__ int perm32(int rho) { const int n = rho >> 4, i = rho & 15; return 8 * (i >> 2) + 4 * n + (i & 3); }

struct Unit { int pm, pn, tag; const char* A; const char* B; };

__device__ __forceinline__ bool grid_order(long L, int nM, int nN, int& pm, int& pn) {
    const int nwg = nM * nN; if (L >= nwg) return false;
    int wgid = (int)L; { const int q = nwg / NXCD, r = nwg % NXCD, xcd = wgid % NXCD, off = wgid / NXCD; wgid = (xcd < r ? xcd * (q + 1) : r * (q + 1) + (xcd - r) * q) + off; }
    const int nig = WGM * nN, gid = wgid / nig, fm = gid * WGM, gsz = (nM - fm) < WGM ? (nM - fm) : WGM;
    pm = fm + ((wgid % nig) % gsz); pn = (wgid % nig) / gsz; return true;
}

typedef f32x4 Acc[2][2][4][2];
__device__ __forceinline__ void zero_acc(Acc& acc) {
#pragma unroll
    for (int a = 0; a < 2; ++a)
#pragma unroll
        for (int b = 0; b < 2; ++b)
#pragma unroll
            for (int m = 0; m < 4; ++m)
#pragma unroll
                for (int n = 0; n < 2; ++n) acc[a][b][m][n] = (f32x4){0.f, 0.f, 0.f, 0.f};
}

template <class Epi, class Sched>
__device__ __forceinline__ void gemm_phase(LAS unsigned char* lds, const int tid, const int K, const Sched& S, const Epi& E, const int lda) {
    const int wid = __builtin_amdgcn_readfirstlane(tid >> 6), lane = tid & 63, wr = wid >> 2, wc = wid & 3, fr = lane & 15, fq = lane >> 4;
    const int nt = K / BK;
    unsigned voffA[2], voffB[2];
#pragma unroll
    for (int i = 0; i < 2; ++i) { int R, C; stage_rc(tid * 16 + i * 8192, R, C); const int Rb = Epi::PERM ? ((R & ~31) + perm32(R & 31)) : R;
        voffA[i] = (unsigned)(R * lda + C) * 2u; voffB[i] = (unsigned)(Rb * K + C) * 2u; }
    const size_t kstep = (size_t)(BK * 2);
    const size_t hstep = (size_t)HALF * K * 2, hstepA = (size_t)HALF * lda * 2;
    const unsigned ldsw = (unsigned)wid * 1024u;
    const int aoff = lds_byte(wr * 64 + fr, fq * 8), boff = lds_byte(wc * 32 + fr, fq * 8);
#define PG8_SA(b, h) (((b) * 2 + (h)) * HTB)
#define PG8_SB(b, h) ((4 + (b) * 2 + (h)) * HTB)
#define PG8_STAGE(bufoff, gbase, voff) do { _Pragma("unroll") for (int _i = 0; _i < 2; ++_i) \
        __builtin_amdgcn_global_load_lds((const unsigned*)((const char*)(gbase) + (voff)[_i]), (LAS unsigned*)(lds + (bufoff) + ldsw + _i * 8192), 16, 0, 0); } while (0)
#define PG8_LDA(dst, b, h) do { _Pragma("unroll") for (int m = 0; m < 4; ++m) _Pragma("unroll") for (int k = 0; k < 2; ++k) dst[m][k] = *(const LAS bf16x8*)(lds + PG8_SA(b, h) + aoff + m * 2048 + k * 1024); } while (0)
#define PG8_LDB(dst, b, h) do { _Pragma("unroll") for (int n = 0; n < 2; ++n) _Pragma("unroll") for (int k = 0; k < 2; ++k) dst[n][k] = *(const LAS bf16x8*)(lds + PG8_SB(b, h) + boff + n * 2048 + k * 1024); } while (0)
#define PG8_MMA(ai, bj, At, Bt) do { __builtin_amdgcn_s_setprio(1); _Pragma("unroll") for (int m = 0; m < 4; ++m) _Pragma("unroll") for (int n = 0; n < 2; ++n) _Pragma("unroll") for (int k = 0; k < 2; ++k) \
        acc[ai][bj][m][n] = __builtin_amdgcn_mfma_f32_16x16x32_bf16(Bt[n][k], At[m][k], acc[ai][bj][m][n], 0, 0, 0); __builtin_amdgcn_s_setprio(0); } while (0)
#define PG8_WAIT_V(n) asm volatile("s_waitcnt vmcnt(" #n ")" ::: "memory")
#define PG8_WAIT_L(n) asm volatile("s_waitcnt lgkmcnt(" #n ")" ::: "memory")
#define PG8_BAR __builtin_amdgcn_s_barrier()
#define PG8_SCHED __builtin_amdgcn_sched_barrier(0)
    Unit cur, nxt; int ui = 0;
    if (!S.next(0, cur)) return;
    unsigned long long pt0 = 0, pt1 = 0; if ((PROBE_STAT == 32 || PROBE_STAT == 33) && Epi::STAT) pt0 = __builtin_amdgcn_s_memrealtime();
    Acc acc; zero_acc(acc);
    bf16x8 At[4][2], B0[2][2], B1[2][2];
    const char* cA = cur.A; const char* cB = cur.B;
    PG8_STAGE(PG8_SB(0, 0), cB, voffB); PG8_STAGE(PG8_SB(0, 1), cB + hstep, voffB); PG8_STAGE(PG8_SA(0, 0), cA, voffA); PG8_STAGE(PG8_SA(0, 1), cA + hstepA, voffA);
    if (wr == 1) PG8_BAR;
    PG8_WAIT_V(2); PG8_BAR;
    PG8_STAGE(PG8_SB(1, 0), cB + kstep, voffB); PG8_STAGE(PG8_SA(1, 0), cA + kstep, voffA); PG8_STAGE(PG8_SB(1, 1), cB + hstep + kstep, voffB);
    PG8_WAIT_V(6); PG8_BAR;
    if ((PROBE_STAT == 32 || PROBE_STAT == 33) && Epi::STAT) pt1 = __builtin_amdgcn_s_memrealtime();
    for (;;) {
        const bool has_next = S.next(ui + 1, nxt);
        const char* nA = has_next ? nxt.A : cA; const char* nB = has_next ? nxt.B : cB;
        for (int t = 0; t < nt; t += 2) {
            const bool last = (t == nt - 2);
            const char* a1 = cA + (size_t)(t + 1) * kstep;
            const char* a2 = last ? nA : cA + (size_t)(t + 2) * kstep; const char* b2 = last ? nB : cB + (size_t)(t + 2) * kstep;
            const char* a3 = a2 + kstep; const char* b3 = b2 + kstep;
            PG8_LDB(B0, 0, 0); PG8_LDB(B1, 0, 1); PG8_SCHED; PG8_LDA(At, 0, 0); PG8_STAGE(PG8_SA(1, 1), a1 + hstepA, voffA);
            PG8_WAIT_V(8); PG8_WAIT_L(0); PG8_BAR; PG8_MMA(0, 0, At, B0); PG8_MMA(0, 1, At, B1); PG8_BAR; PG8_SCHED;
            PG8_LDA(At, 0, 1); PG8_STAGE(PG8_SB(0, 0), b2, voffB); PG8_STAGE(PG8_SB(0, 1), b2 + hstep, voffB); PG8_STAGE(PG8_SA(0, 0), a2, voffA);
            PG8_WAIT_V(8); PG8_WAIT_L(0); PG8_BAR; PG8_MMA(1, 0, At, B0); PG8_MMA(1, 1, At, B1); PG8_BAR; PG8_SCHED;
            PG8_LDB(B0, 1, 0); PG8_LDB(B1, 1, 1); PG8_SCHED; PG8_LDA(At, 1, 0); PG8_STAGE(PG8_SA(0, 1), a2 + hstepA, voffA);
            PG8_WAIT_V(8); PG8_WAIT_L(0); PG8_BAR; PG8_MMA(0, 0, At, B0); PG8_MMA(0, 1, At, B1); PG8_BAR; PG8_SCHED;
            PG8_LDA(At, 1, 1); PG8_STAGE(PG8_SB(1, 0), b3, voffB); PG8_STAGE(PG8_SB(1, 1), b3 + hstep, voffB); PG8_STAGE(PG8_SA(1, 0), a3, voffA);
            PG8_WAIT_V(8); PG8_WAIT_L(0); PG8_BAR; PG8_MMA(1, 0, At, B0); PG8_MMA(1, 1, At, B1); PG8_BAR; PG8_SCHED;
        }
        if (wr == 0) PG8_BAR;
        if constexpr ((PROBE_STAT == 32 || PROBE_STAT == 33) && Epi::STAT) if (ui == 0 && blockIdx.x == 0 && tid == 0) { const unsigned long long pt2 = __builtin_amdgcn_s_memrealtime();
            unsigned* st = (unsigned*)((unsigned char*)E.XR - WS_XR + WS_CTL) + CW_STAT + 64; st[0] = (unsigned)(PROBE_STAT == 32 ? pt1 - pt0 : pt2 - pt1); }
        E(acc, cur, wr, wc, fr, fq);
        if (!has_next) break;
        cur = nxt; cA = nA; cB = nB; ++ui;
        if (wr == 1) PG8_BAR;
    }
    PG8_WAIT_V(0);
    PG8_BAR;
#undef PG8_SA
#undef PG8_SB
#undef PG8_STAGE
#undef PG8_LDA
#undef PG8_LDB
#undef PG8_MMA
#undef PG8_WAIT_V
#undef PG8_WAIT_L
#undef PG8_BAR
#undef PG8_SCHED
}
template <class Epi, class Sched>
__device__ __forceinline__ void gemm_phase_gather(LAS unsigned char* lds, const int tid, const int K, const Sched& S, const Epi& E, const char* gbase, const int* gidx, LAS int* glist) {
    const int wid = __builtin_amdgcn_readfirstlane(tid >> 6), lane = tid & 63, wr = wid >> 2, wc = wid & 3, fr = lane & 15, fq = lane >> 4;
    const int nt = K / BK;
    unsigned voffB[2]; int rowA[2]; unsigned colA[2];
#pragma unroll
    for (int i = 0; i < 2; ++i) { int R, C; stage_rc(tid * 16 + i * 8192, R, C); const int Rb = Epi::PERM ? ((R & ~31) + perm32(R & 31)) : R;
        rowA[i] = R; colA[i] = (unsigned)C * 2u; voffB[i] = (unsigned)(Rb * K + C) * 2u; }
    { Unit u0; for (int q = 0; q < 12 && S.next(q, u0); ++q) { if (tid < 256) glist[q * 256 + tid] = gidx[u0.pm * 256 + tid]; } }
    asm volatile("s_waitcnt vmcnt(0) lgkmcnt(0)" ::: "memory"); __builtin_amdgcn_s_barrier(); asm volatile("" ::: "memory");
    unsigned vc[2][2], vn[2][2];
#define PG8_GOFF(dst, q) do { _Pragma("unroll") for (int h_ = 0; h_ < 2; ++h_) _Pragma("unroll") for (int i_ = 0; i_ < 2; ++i_) dst[h_][i_] = (unsigned)glist[(q) * 256 + h_ * 128 + rowA[i_]] * (unsigned)(K * 2) + colA[i_]; } while (0)
    const size_t kstep = (size_t)(BK * 2);
    const size_t hstep = (size_t)HALF * K * 2;
    const unsigned ldsw = (unsigned)wid * 1024u;
    const int aoff = lds_byte(wr * 64 + fr, fq * 8), boff = lds_byte(wc * 32 + fr, fq * 8);
#define PG8_SA(b, h) (((b) * 2 + (h)) * HTB)
#define PG8_SB(b, h) ((4 + (b) * 2 + (h)) * HTB)
#define PG8_STAGE(bufoff, gbase, voff) do { _Pragma("unroll") for (int _i = 0; _i < 2; ++_i) \
        __builtin_amdgcn_global_load_lds((const unsigned*)((const char*)(gbase) + (voff)[_i]), (LAS unsigned*)(lds + (bufoff) + ldsw + _i * 8192), 16, 0, 0); } while (0)
#define PG8_LDA(dst, b, h) do { _Pragma("unroll") for (int m = 0; m < 4; ++m) _Pragma("unroll") for (int k = 0; k < 2; ++k) dst[m][k] = *(const LAS bf16x8*)(lds + PG8_SA(b, h) + aoff + m * 2048 + k * 1024); } while (0)
#define PG8_LDB(dst, b, h) do { _Pragma("unroll") for (int n = 0; n < 2; ++n) _Pragma("unroll") for (int k = 0; k < 2; ++k) dst[n][k] = *(const LAS bf16x8*)(lds + PG8_SB(b, h) + boff + n * 2048 + k * 1024); } while (0)
#define PG8_MMA(ai, bj, At, Bt) do { __builtin_amdgcn_s_setprio(1); _Pragma("unroll") for (int m = 0; m < 4; ++m) _Pragma("unroll") for (int n = 0; n < 2; ++n) _Pragma("unroll") for (int k = 0; k < 2; ++k) \
        acc[ai][bj][m][n] = __builtin_amdgcn_mfma_f32_16x16x32_bf16(Bt[n][k], At[m][k], acc[ai][bj][m][n], 0, 0, 0); __builtin_amdgcn_s_setprio(0); } while (0)
#define PG8_WAIT_V(n) asm volatile("s_waitcnt vmcnt(" #n ")" ::: "memory")
#define PG8_WAIT_L(n) asm volatile("s_waitcnt lgkmcnt(" #n ")" ::: "memory")
#define PG8_BAR __builtin_amdgcn_s_barrier()
#define PG8_SCHED __builtin_amdgcn_sched_barrier(0)
    Unit cur, nxt; int ui = 0;
    if (!S.next(0, cur)) return;
    Acc acc; zero_acc(acc);
    bf16x8 At[4][2], B0[2][2], B1[2][2];
    const char* cB = cur.B; PG8_GOFF(vc, 0);
    PG8_STAGE(PG8_SB(0, 0), cB, voffB); PG8_STAGE(PG8_SB(0, 1), cB + hstep, voffB); PG8_STAGE(PG8_SA(0, 0), gbase, vc[0]); PG8_STAGE(PG8_SA(0, 1), gbase, vc[1]);
    if (wr == 1) PG8_BAR;
    PG8_WAIT_V(2); PG8_BAR;
    PG8_STAGE(PG8_SB(1, 0), cB + kstep, voffB); PG8_STAGE(PG8_SA(1, 0), gbase + kstep, vc[0]); PG8_STAGE(PG8_SB(1, 1), cB + hstep + kstep, voffB);
    PG8_WAIT_V(6); PG8_BAR;
    for (;;) {
        const bool has_next = S.next(ui + 1, nxt);
        const char* nB = has_next ? nxt.B : cB;
        if (has_next) PG8_GOFF(vn, ui + 1); else { vn[0][0] = vc[0][0]; vn[0][1] = vc[0][1]; vn[1][0] = vc[1][0]; vn[1][1] = vc[1][1]; }
        for (int t = 0; t < nt; t += 2) {
            const bool last = (t == nt - 2);
            const char* a1 = gbase + (size_t)(t + 1) * kstep;
            const char* a2 = last ? gbase : gbase + (size_t)(t + 2) * kstep; const char* b2 = last ? nB : cB + (size_t)(t + 2) * kstep;
            const char* a3 = a2 + kstep; const char* b3 = b2 + kstep;
            unsigned v20[2] = {last ? vn[0][0] : vc[0][0], last ? vn[0][1] : vc[0][1]}, v21[2] = {last ? vn[1][0] : vc[1][0], last ? vn[1][1] : vc[1][1]};
            PG8_LDB(B0, 0, 0); PG8_LDB(B1, 0, 1); PG8_SCHED; PG8_LDA(At, 0, 0); PG8_STAGE(PG8_SA(1, 1), a1, vc[1]);
            PG8_WAIT_V(8); PG8_WAIT_L(0); PG8_BAR; PG8_MMA(0, 0, At, B0); PG8_MMA(0, 1, At, B1); PG8_BAR; PG8_SCHED;
            PG8_LDA(At, 0, 1); PG8_STAGE(PG8_SB(0, 0), b2, voffB); PG8_STAGE(PG8_SB(0, 1), b2 + hstep, voffB); PG8_STAGE(PG8_SA(0, 0), a2, v20);
            PG8_WAIT_V(8); PG8_WAIT_L(0); PG8_BAR; PG8_MMA(1, 0, At, B0); PG8_MMA(1, 1, At, B1); PG8_BAR; PG8_SCHED;
            PG8_LDB(B0, 1, 0); PG8_LDB(B1, 1, 1); PG8_SCHED; PG8_LDA(At, 1, 0); PG8_STAGE(PG8_SA(0, 1), a2, v21);
            PG8_WAIT_V(8); PG8_WAIT_L(0); PG8_BAR; PG8_MMA(0, 0, At, B0); PG8_MMA(0, 1, At, B1); PG8_BAR; PG8_SCHED;
            PG8_LDA(At, 1, 1); PG8_STAGE(PG8_SB(1, 0), b3, voffB); PG8_STAGE(PG8_SB(1, 1), b3 + hstep, voffB); PG8_STAGE(PG8_SA(1, 0), a3, v20);
            PG8_WAIT_V(8); PG8_WAIT_L(0); PG8_BAR; PG8_MMA(1, 0, At, B0); PG8_MMA(1, 1, At, B1); PG8_BAR; PG8_SCHED;
        }
        if (wr == 0) PG8_BAR;
        E(acc, cur, wr, wc, fr, fq);
        if (!has_next) break;
        cur = nxt; cB = nB; ++ui; vc[0][0] = vn[0][0]; vc[0][1] = vn[0][1]; vc[1][0] = vn[1][0]; vc[1][1] = vn[1][1];
        if (wr == 1) PG8_BAR;
    }
    PG8_WAIT_V(0);
    PG8_BAR;
#undef PG8_GOFF
#undef PG8_SA
#undef PG8_SB
#undef PG8_STAGE
#undef PG8_LDA
#undef PG8_LDB
#undef PG8_MMA
#undef PG8_WAIT_V
#undef PG8_WAIT_L
#undef PG8_BAR
#undef PG8_SCHED
}
template <class Epi, class Sched>
__device__ __forceinline__ void gemm_tail(LAS unsigned char* lds, const int tid, const int K, const Sched& S, const Epi& E, const int c, const int lda) {
    const int tpx = S.ntl / NXCD, x = c % NXCD, sl = c / NXCD; if (sl >= 4 * tpx) return;
    const int wid = __builtin_amdgcn_readfirstlane(tid >> 6), lane = tid & 63, wr = wid >> 2, wc = wid & 3, fr = lane & 15, fq = lane >> 4;
    const int nt = K / BK;
    unsigned voffA[2], voffB[2];
#pragma unroll
    for (int i = 0; i < 2; ++i) { int R, C; stage_rc(tid * 16 + i * 8192, R, C); const int Rb = Epi::PERM ? ((R & ~31) + perm32(R & 31)) : R;
        voffA[i] = (unsigned)(R * lda + C) * 2u; voffB[i] = (unsigned)(Rb * K + C) * 2u; }
    const size_t kstep = (size_t)(BK * 2);
    const size_t hstep = (size_t)HALF * K * 2, hstepA = (size_t)HALF * lda * 2;
    const unsigned ldsw = (unsigned)wid * 1024u;
    const int aoff = lds_byte(wr * 64 + fr, fq * 8), boff = lds_byte(wc * 32 + fr, fq * 8);
#define QT_STAGE(slot, gA, gB) do { _Pragma("unroll") for (int _i = 0; _i < 2; ++_i) \
        __builtin_amdgcn_global_load_lds((const unsigned*)((gA) + voffA[_i]), (LAS unsigned*)(lds + (slot) * 2 * HTB + ldsw + _i * 8192), 16, 0, 0); \
        _Pragma("unroll") for (int _i = 0; _i < 2; ++_i) \
        __builtin_amdgcn_global_load_lds((const unsigned*)((gB) + voffB[_i]), (LAS unsigned*)(lds + (slot) * 2 * HTB + HTB + ldsw + _i * 8192), 16, 0, 0); } while (0)
#define QT_STEP(tt, slot) do { const int t_ = (tt); \
        if (t_ + 2 < nt) asm volatile("s_waitcnt vmcnt(8)" ::: "memory"); else if (t_ + 1 < nt) asm volatile("s_waitcnt vmcnt(4)" ::: "memory"); else asm volatile("s_waitcnt vmcnt(0)" ::: "memory"); \
        __builtin_amdgcn_s_barrier(); \
        if (t_ + 3 < nt) QT_STAGE(((slot) + 3) & 3, gA + (size_t)(t_ + 3) * kstep, gB + (size_t)(t_ + 3) * kstep); \
        _Pragma("unroll") for (int m = 0; m < 4; ++m) _Pragma("unroll") for (int k = 0; k < 2; ++k) At[m][k] = *(const LAS bf16x8*)(lds + (slot) * 2 * HTB + aoff + m * 2048 + k * 1024); \
        _Pragma("unroll") for (int n = 0; n < 2; ++n) _Pragma("unroll") for (int k = 0; k < 2; ++k) Bt[n][k] = *(const LAS bf16x8*)(lds + (slot) * 2 * HTB + HTB + boff + n * 2048 + k * 1024); \
        asm volatile("s_waitcnt lgkmcnt(0)" ::: "memory"); __builtin_amdgcn_sched_barrier(0); \
        _Pragma("unroll") for (int m = 0; m < 4; ++m) _Pragma("unroll") for (int n = 0; n < 2; ++n) _Pragma("unroll") for (int k = 0; k < 2; ++k) \
            acc[0][0][m][n] = __builtin_amdgcn_mfma_f32_16x16x32_bf16(Bt[n][k], At[m][k], acc[0][0][m][n], 0, 0, 0); \
        __builtin_amdgcn_sched_barrier(0); } while (0)
    {
        const int j = x * tpx + (sl >> 2), qa = (sl >> 1) & 1, qb = sl & 1;
        Acc acc; zero_acc(acc);
        bf16x8 At[4][2], Bt[2][2];
        for (int s = 0; s < Sched::NSEG; ++s) {
            Unit u; S.tail_unit(j, s, u);
            const char* gA = u.A + (size_t)qa * hstepA; const char* gB = u.B + (size_t)qb * hstep;
            QT_STAGE(0, gA, gB); QT_STAGE(1, gA + kstep, gB + kstep); QT_STAGE(2, gA + 2 * kstep, gB + 2 * kstep);
            for (int t = 0; t < nt; t += 4) { QT_STEP(t, 0); QT_STEP(t + 1, 1); QT_STEP(t + 2, 2); QT_STEP(t + 3, 3); }
            E.quarter(acc, u, qa, qb, wr, wc, fr, fq);
        }
    }
#undef QT_STAGE
#undef QT_STEP
}
}

#define XB_TMO      128
#define XB_XCNT(j)  (256  + 64 * (j))
#define XB_XSUB(j)  (1280 + 64 * (j))
#define XB_XGEN(j)  (2304 + 64 * (j))
#define XB_TOP      3328
#define XB_TOPGEN   3392
#define XCD_BAR_WORDS 3456
#define XB_SPIN_CAP (1u << 22)
__device__ __forceinline__ unsigned xb_ld(unsigned* p)              { return __hip_atomic_load(p, __ATOMIC_RELAXED, __HIP_MEMORY_SCOPE_AGENT); }
__device__ __forceinline__ unsigned xb_add(unsigned* p, unsigned v) { return __hip_atomic_fetch_add(p, v, __ATOMIC_RELAXED, __HIP_MEMORY_SCOPE_AGENT); }
__device__ __forceinline__ unsigned xb_xcc_id() { return (unsigned)__builtin_amdgcn_s_getreg((3 << 11) | 20) & 0xFu; }
#define XB_SPIN(cond, bar) do { unsigned _sp = 0; while (cond) { __builtin_amdgcn_s_sleep(1); \
    if ((++_sp & 255u) == 0u) { if (xb_ld(&(bar)[XB_TMO])) break; if (_sp > XB_SPIN_CAP) { atomicAdd(&(bar)[XB_TMO], 1u); break; } } } } while (0)
struct XcdBarrier { unsigned* bar; unsigned x; volatile LAS unsigned* st; };
__device__ __forceinline__ XcdBarrier xcd_barrier_post(unsigned* bar, volatile LAS unsigned* st) {
    XcdBarrier b; b.bar = bar; b.x = xb_xcc_id(); b.st = st;
    if (threadIdx.x == 0) (void)xb_add(&bar[XB_XCNT(b.x)], 1u);
    return b;
}
__device__ __forceinline__ void xcd_barrier_complete(unsigned* bar, unsigned x, unsigned& nloc, unsigned& nx) {
    const unsigned G = gridDim.x * gridDim.y * gridDim.z;
    unsigned sum, cnt, mine, sp = 0u;
    for (;;) {
        sum = 0u; cnt = 0u; mine = 0u;
#pragma unroll
        for (unsigned j = 0; j < 16; ++j) { const unsigned c = xb_ld(&bar[XB_XCNT(j)]); sum += c; cnt += (c > 0u) ? 1u : 0u; mine = (j == x) ? c : mine; }
        if (sum == G) break;
        __builtin_amdgcn_s_sleep(1);
        if ((++sp & 255u) == 0u) { if (xb_ld(&bar[XB_TMO])) break; if (sp > XB_SPIN_CAP) { atomicAdd(&bar[XB_TMO], 1u); break; } }
    }
    nloc = mine > 0u ? mine : 1u; nx = cnt > 0u ? cnt : 1u;
}
__device__ __forceinline__ void xcd_barrier(const XcdBarrier& b) {
    asm volatile("s_waitcnt vmcnt(0)" ::: "memory");
    __syncthreads();
    if (threadIdx.x == 0) {
        unsigned* bar = b.bar;
        __builtin_amdgcn_s_waitcnt(0);
        unsigned nloc = b.st[0], nx = b.st[1];
        if (nloc == 0u) { xcd_barrier_complete(bar, b.x, nloc, nx); b.st[0] = nloc; b.st[1] = nx; }
        const unsigned old = xb_add(&bar[XB_XSUB(b.x)], 1u);
        const unsigned gen = old / nloc;
        if (old + 1u == (gen + 1u) * nloc) {
            __builtin_amdgcn_fence(__ATOMIC_RELEASE, "agent");
            asm volatile("s_waitcnt vmcnt(0)" ::: "memory");
            const unsigned og = xb_add(&bar[XB_TOP], 1u);
            const unsigned tg = og / nx;
            if (og + 1u == (tg + 1u) * nx) xb_add(&bar[XB_TOPGEN], 1u);
            else XB_SPIN(xb_ld(&bar[XB_TOPGEN]) == tg, bar);
            __builtin_amdgcn_fence(__ATOMIC_ACQUIRE, "agent");
            xb_add(&bar[XB_XGEN(b.x)], 1u);
            asm volatile("s_waitcnt vmcnt(0)" ::: "memory");
        } else {
            XB_SPIN(xb_ld(&bar[XB_XGEN(b.x)]) == gen, bar);
            __builtin_amdgcn_fence(__ATOMIC_ACQUIRE, "agent");
            asm volatile("s_waitcnt vmcnt(0)" ::: "memory");
        }
    }
    __syncthreads();
}

struct Args { const float* in[21]; float* out; unsigned char* ws; int ph_lo, ph_hi; };
struct Frame {
    LAS unsigned char* lds; volatile LAS unsigned* MISC; unsigned* ctl;
    int tid, lane, wave, vcu, G;
    const void __attribute__((address_space(4)))* karg; float* out; unsigned char* ws;
};
__device__ __forceinline__ const float* inp(const Frame& F, int i) { const unsigned long long p = ((const unsigned long long __attribute__((address_space(4)))*)F.karg)[i]; return (const float*)(const GAS float*)p; }
#define IN_X 0
#define IN_C 1
#define IN_CTX 2
#define IN_CCTX 3
#define IN_WMOD 4
#define IN_BMOD 5
#define IN_GATTN 6
#define IN_GFFN 7
#define IN_WIN 8
#define IN_RDEC 9
#define IN_QN 10
#define IN_KN 11
#define IN_LAMBDA 12
#define IN_WFO 13
#define IN_WRO 14
#define IN_WDO 15
#define IN_WOUT 16
#define IN_WROUTER 17
#define IN_WEG 18
#define IN_WEU 19
#define IN_WED 20

__device__ __forceinline__ int vec_of_row(int r) { return r < TC ? 8 : (r - TC) / SEQ; }
__device__ __forceinline__ const float* mod_ptr(const Frame& F, int layer, int v, int i) { return (const float*)(F.ws + WS_MOD) + ((size_t)(layer * 9 + v) * 6 + i) * D; }
__device__ __forceinline__ float lam_init_of(int layer) { return layer == 0 ? 0.2f : 0.8f - 0.6f * 0.74081822068171788f; }
__device__ __forceinline__ float lam_of(const Frame& F, int layer) {
    const float* L = inp(F, IN_LAMBDA) + (size_t)layer * 4 * 64; float s1 = 0.f, s2 = 0.f;
    for (int i = 0; i < 64; ++i) { s1 += L[i] * L[64 + i]; s2 += L[128 + i] * L[192 + i]; }
    return __expf(s1) - __expf(s2) + lam_init_of(layer);
}

__device__ __forceinline__ void transpose_item(const float* W, int ldw, int K, int k0, int n0src, bf16* WT, int dst_row0, LAS float* scr, int lane) {
#pragma unroll 8
    for (int i = 0; i < 32; ++i) { const int kk = 2 * i + (lane >> 5); scr[kk * 33 + (lane & 31)] = W[(size_t)(k0 + kk) * ldw + n0src + (lane & 31)]; }
    LDS_WAIT(); asm volatile("" ::: "memory");
    const int c = lane & 7;
#pragma unroll
    for (int j = 0; j < 4; ++j) { const int n = (lane >> 3) + 8 * j; const LAS float* s = scr + (8 * c) * 33 + n;
        u32x4 o; o.x = pk2(s[0 * 33], s[1 * 33]); o.y = pk2(s[2 * 33], s[3 * 33]); o.z = pk2(s[4 * 33], s[5 * 33]); o.w = pk2(s[6 * 33], s[7 * 33]);
        *(u32x4*)(WT + (size_t)(dst_row0 + n) * K + k0 + 8 * c) = o; }
    LDS_WAIT(); asm volatile("" ::: "memory");
}
template <class RowMap>
__device__ __forceinline__ void transpose_matrix(Frame& F, const float* W, int ldw, int csrc, int K, int N, bf16* WT, RowMap map, int& item_base) {
    LAS float* scr = (LAS float*)(F.lds + F.wave * 16384);
    const int gw = F.vcu * 8 + F.wave, NGW = F.G * 8;
    const int nblk = N / 32, nitems = (K / 64) * nblk;
    int start = (gw - item_base % NGW + NGW) % NGW;
    for (int it = start; it < nitems; it += NGW) { const int kb = it / nblk, nb = it % nblk; transpose_item(W, ldw, K, 64 * kb, csrc + 32 * nb, WT, map(32 * nb), scr, F.lane); }
    item_base += nitems;
}
struct MapId { int off; __device__ int operator()(int n) const { return off + n; } };
struct MapProj { __device__ int operator()(int n) const { const int tile = n >> 8; const bool qk = tile < 2 || (tile >= 6 && tile < 10); return qk ? (tile << 8) + 128 * ((n >> 5) & 1) + 32 * ((n >> 6) & 3) + (n & 31) : n; } };
struct MapGU { int up; __device__ int operator()(int n) const { return (n >> 7) * 256 + up * 128 + (n & 127); } };

struct CvtItem { const float* src; bf16* dst; int ldw, K; };
__device__ __forceinline__ CvtItem cvt_decode(const Frame& F, int layer, int item) {
    const int e = item / 3072, rm = item - e * 3072, m = rm >> 10, r = rm & 1023; CvtItem c;
    if (m < 2) { const int kb = r >> 6, nb = r & 63; c.ldw = EH; c.K = D;
        c.src = inp(F, m == 0 ? IN_WEG : IN_WEU) + ((size_t)layer * NE + e) * D * EH + (size_t)(64 * kb) * EH + 32 * nb;
        const int n = 32 * nb, row = (n >> 7) * 256 + m * 128 + (n & 127); c.dst = (bf16*)(F.ws + WS_WGU + layer * EXPW_L + e * WGU_E) + (size_t)row * D + 64 * kb; }
    else { const int kb = r >> 5, nb = r & 31; c.ldw = D; c.K = EH;
        c.src = inp(F, IN_WED) + ((size_t)layer * NE + e) * EH * D + (size_t)(64 * kb) * D + 32 * nb;
        c.dst = (bf16*)(F.ws + WS_WD + layer * EXPW_L + e * WD_E) + (size_t)(32 * nb) * EH + 64 * kb; }
    return c;
}
__device__ __forceinline__ void cvt_load(const CvtItem& c, float (&r)[32], int lane) {
#pragma unroll
    for (int i = 0; i < 32; ++i) r[i] = c.src[(size_t)(2 * i + (lane >> 5)) * c.ldw + (lane & 31)];
}
__device__ __forceinline__ void cvt_store(const CvtItem& c, const float (&r)[32], LAS float* scr, int lane) {
#pragma unroll
    for (int i = 0; i < 32; ++i) scr[(2 * i + (lane >> 5)) * 33 + (lane & 31)] = r[i];
    LDS_WAIT(); asm volatile("" ::: "memory");
    const int cc = lane & 7;
#pragma unroll
    for (int j = 0; j < 4; ++j) { const int n = (lane >> 3) + 8 * j; const LAS float* s = scr + (8 * cc) * 33 + n;
        u32x4 o; o.x = pk2(s[0 * 33], s[1 * 33]); o.y = pk2(s[2 * 33], s[3 * 33]); o.z = pk2(s[4 * 33], s[5 * 33]); o.w = pk2(s[6 * 33], s[7 * 33]);
        *(u32x4*)(c.dst + (size_t)n * c.K + 8 * cc) = o; }
    LDS_WAIT(); asm volatile("" ::: "memory");
}
struct CvtW { const float* src; bf16* dst; int ldw, K, gu, up; };
__device__ __forceinline__ CvtW cvtw_decode(const Frame& F, int layer, int item, int& n0) {
    const int e = item / 384, rm = item - e * 384, m = rm >> 7, r = rm & 127; CvtW c;
    if (m < 2) { const int kb = r >> 4, nb = r & 15; c.ldw = EH; c.K = D; c.gu = 1; c.up = m; n0 = 128 * nb;
        c.src = inp(F, m == 0 ? IN_WEG : IN_WEU) + ((size_t)layer * NE + e) * D * EH + (size_t)(128 * kb) * EH + n0;
        c.dst = (bf16*)(F.ws + WS_WGU + layer * EXPW_L + e * WGU_E) + 128 * kb; }
    else { const int kb = r >> 3, nb = r & 7; c.ldw = D; c.K = EH; c.gu = 0; c.up = 0; n0 = 128 * nb;
        c.src = inp(F, IN_WED) + ((size_t)layer * NE + e) * EH * D + (size_t)(128 * kb) * D + n0;
        c.dst = (bf16*)(F.ws + WS_WD + layer * EXPW_L + e * WD_E) + 128 * kb; }
    return c;
}
__device__ __forceinline__ void convert_expert_weights(Frame& F, int layer) {
    LAS float* t = (LAS float*)F.lds; const int lane = F.lane, w = F.wave, NITW = NE * 384;
    __syncthreads();
    int it = F.vcu; if (it >= NITW) return;
    int n0 = 0, n0n = 0; CvtW c = cvtw_decode(F, layer, it, n0), cn = c;
    f32x4 r[8], rn[8];
#pragma unroll
    for (int i = 0; i < 8; ++i) r[i] = *(const f32x4*)(c.src + (size_t)(16 * w + 2 * i + (lane >> 5)) * c.ldw + 4 * (lane & 31));
    for (;;) {
        const int itn = it + F.G; const bool hn = itn < NITW; cn = cvtw_decode(F, layer, hn ? itn : it, n0n);
#pragma unroll
        for (int i = 0; i < 8; ++i) rn[i] = *(const f32x4*)(cn.src + (size_t)(16 * w + 2 * i + (lane >> 5)) * cn.ldw + 4 * (lane & 31));
#pragma unroll
        for (int i = 0; i < 8; ++i) { LAS float* d = t + (16 * w + 2 * i + (lane >> 5)) * 129 + 4 * (lane & 31); d[0] = r[i].x; d[1] = r[i].y; d[2] = r[i].z; d[3] = r[i].w; }
        __syncthreads();
#pragma unroll
        for (int j = 0; j < 4; ++j) { const int nl = 16 * w + 4 * j + (lane >> 4), kc = lane & 15, n = n0 + nl; const LAS float* sp = t + (8 * kc) * 129 + nl;
            u32x4 o; o.x = pk2(sp[0], sp[129]); o.y = pk2(sp[2 * 129], sp[3 * 129]); o.z = pk2(sp[4 * 129], sp[5 * 129]); o.w = pk2(sp[6 * 129], sp[7 * 129]);
            const int row = c.gu ? (n >> 7) * 256 + c.up * 128 + (n & 127) : n;
            *(u32x4*)(c.dst + (size_t)row * c.K + 8 * kc) = o; }
        __syncthreads();
        if (!hn) break;
        it = itn; c = cn; n0 = n0n;
#pragma unroll
        for (int i = 0; i < 8; ++i) r[i] = rn[i];
    }
}

__device__ __forceinline__ void prologue_small(Frame& F) {
    const int tid = F.tid;
    {
        LAS float* sc = (LAS float*)F.lds;
        LAS float* red = sc + 9 * 1024;
        { float cr[18];
#pragma unroll
          for (int it = 0; it < 18; ++it) { const int i = tid + 512 * it, v = i >> 10, k = i & 1023; cr[it] = v < 8 ? inp(F, IN_C)[v * D + k] : inp(F, IN_CCTX)[k]; }
#pragma unroll
          for (int it = 0; it < 18; ++it) sc[tid + 512 * it] = siluf_(cr[it]); }
        __syncthreads();
        for (int item = F.vcu; item < DEPTH * 96; item += F.G) {
            const int layer = item / 96, cb = item % 96, col = cb * 64 + (tid & 63), kg = tid >> 6;
            const float* w = inp(F, IN_WMOD) + (size_t)layer * D * 6144 + col;
            float a[9];
#pragma unroll
            for (int v = 0; v < 9; ++v) a[v] = 0.f;
#pragma unroll 16
            for (int kk = 0; kk < 128; ++kk) { const int k = kg * 128 + kk; const float wv = w[(size_t)k * 6144];
#pragma unroll
                for (int v = 0; v < 9; ++v) a[v] += sc[v * 1024 + k] * wv; }
#pragma unroll
            for (int v = 0; v < 9; ++v) red[(kg * 64 + (tid & 63)) * 9 + v] = a[v];
            __syncthreads();
            for (int o = tid; o < 64 * 9; o += 512) { const int cc = o / 9, v = o % 9; float s = 0.f;
                for (int g = 0; g < 8; ++g) s += red[(g * 64 + cc) * 9 + v];
                const int colo = cb * 64 + cc;
                ((float*)(F.ws + WS_MOD))[(size_t)(layer * 9 + v) * 6144 + colo] = s + inp(F, IN_BMOD)[layer * 6144 + colo]; }
            __syncthreads();
        }
    }
    {
        const int gt = F.vcu * 512 + tid, NT = F.G * 512;
        float* rc = (float*)(F.ws + WS_ROPE); float* rs = rc + SEQ * 32;
        for (int i = gt; i < SEQ * 32; i += NT) { const int pos = i >> 5, f = i & 31; const float inv = __builtin_amdgcn_exp2f(-(float)(f & 15) * (13.287712379549449f / 16.0f));
            const float p = (f < 16) ? (float)(pos / GRIDW) : (float)(pos % GRIDW); const float ang = p * inv; rc[i] = __builtin_amdgcn_cosf(ang * 0.15915494309189535f); rs[i] = __builtin_amdgcn_sinf(ang * 0.15915494309189535f); }
        LAS float* ct = (LAS float*)F.lds;
        __syncthreads();
        for (int m = tid; m < 2048; m += 512) ct[m] = __builtin_amdgcn_cosf((float)m * (1.0f / 2048.0f));
        __syncthreads();
        bf16* dl = (bf16*)(F.ws + WS_DFTL); const float sl = 0.022097086912079608f;
        for (int i = gt; i < 2048 * 2048; i += NT) { const int k = i >> 11, col = i & 2047; float val;
            if (col <= 1024) val = ct[(k * col) & 2047]; else val = -ct[(((k * (col - 1024)) & 2047) - 512) & 2047];
            dl[i] = (bf16)f2bf(val * sl); }
        bf16* dc = (bf16*)(F.ws + WS_DFTC);
        for (int i = gt; i < 256 * 256; i += NT) { const int k = i >> 8, col = i & 255; float val;
            if (col <= 128) val = ct[((k * col) & 255) * 8]; else val = -ct[((((k * (col - 128)) & 255) * 8) - 512) & 2047];
            dc[i] = (bf16)f2bf(val * 0.0625f); }
        {
            LAS float* tile = ct + 2048;
            for (int item = F.vcu; item < DEPTH * 16 * 8; item += F.G) {
                const int layer = item >> 7, kb = (item >> 3) & 15, g = item & 7;
                const float* win = inp(F, IN_WIN) + (size_t)layer * D * INW + (size_t)(64 * kb) * INW + g * 64; bf16* wt = (bf16*)(F.ws + WS_WIN + layer * WIN_L) + (size_t)6144 * 1024;
                __syncthreads();
                for (int i = tid; i < 64 * 64; i += 512) { const int kk = i >> 6, c = i & 63; tile[kk * 65 + c] = win[(size_t)kk * INW + c]; }
                __syncthreads();
                const int k = tid & 63, c0 = 8 * (tid >> 6);
                float ac[8], as[8];
#pragma unroll
                for (int q = 0; q < 8; ++q) { ac[q] = 0.f; as[q] = 0.f; }
                for (int c = 0; c < 64; ++c) { const float x = tile[k * 65 + c];
#pragma unroll
                    for (int q = 0; q < 8; ++q) { const int m = ((c * (c0 + q)) & 63) * 32; ac[q] += x * ct[m]; as[q] += x * ct[(m - 512) & 2047]; } }
#pragma unroll
                for (int q = 0; q < 8; ++q) { wt[(size_t)(g * 64 + c0 + q) * 1024 + 64 * kb + k] = (bf16)f2bf(ac[q] * 0.125f); wt[(size_t)(512 + g * 64 + c0 + q) * 1024 + 64 * kb + k] = (bf16)f2bf(as[q] * 0.125f); }
            }
        }
        __syncthreads();
    }
    {
        int base = 0;
        for (int layer = 0; layer < DEPTH; ++layer) {
            transpose_matrix(F, inp(F, IN_WIN) + (size_t)layer * D * INW, INW, 512, D, NWPROJ, (bf16*)(F.ws + WS_WIN + layer * WIN_L), MapProj{}, base);
            transpose_matrix(F, inp(F, IN_WFO) + (size_t)layer * 512 * D, D, 0, 512, D, (bf16*)(F.ws + WS_WFO + (layer * 3 + 0) * WMG_ONE), MapId{0}, base);
            transpose_matrix(F, inp(F, IN_WRO) + (size_t)layer * 512 * D, D, 0, 512, D, (bf16*)(F.ws + WS_WFO + (layer * 3 + 1) * WMG_ONE), MapId{0}, base);
            transpose_matrix(F, inp(F, IN_WDO) + (size_t)layer * 512 * D, D, 0, 512, D, (bf16*)(F.ws + WS_WFO + (layer * 3 + 2) * WMG_ONE), MapId{0}, base);
            transpose_matrix(F, inp(F, IN_WOUT) + (size_t)layer * D * D, D, 0, D, D, (bf16*)(F.ws + WS_WOUT + layer * WOUT_L), MapId{0}, base);
        }
    }
}
__device__ __forceinline__ void convert_expert_weights_dyn(Frame& F, int layer, unsigned* ctr, int maxblk) {
    LAS float* t = (LAS float*)F.lds; const int lane = F.lane, w = F.wave, NITW = NE * 384; int nblk = 1;
    volatile LAS unsigned* qw = (volatile LAS unsigned*)(F.lds + RING_BYTES - 64);
    __syncthreads();
    if (F.tid == 0) *qw = __hip_atomic_fetch_add(ctr, 1u, RLX_AGENT);
    __syncthreads();
    int it = (int)*qw;
    __syncthreads();
    if (it >= NITW) return;
    int n0 = 0, n0n = 0; CvtW c = cvtw_decode(F, layer, it, n0), cn = c;
    f32x4 r[8], rn[8];
#pragma unroll
    for (int i = 0; i < 8; ++i) r[i] = __builtin_nontemporal_load((const f32x4*)(c.src + (size_t)(16 * w + 2 * i + (lane >> 5)) * c.ldw + 4 * (lane & 31)));
    for (;;) {
        if (F.tid == 0) *qw = nblk < maxblk ? __hip_atomic_fetch_add(ctr, 1u, RLX_AGENT) : (unsigned)NITW;
        ++nblk;
#pragma unroll
        for (int i = 0; i < 8; ++i) { LAS float* d = t + (16 * w + 2 * i + (lane >> 5)) * 129 + 4 * (lane & 31); d[0] = r[i].x; d[1] = r[i].y; d[2] = r[i].z; d[3] = r[i].w; }
        __syncthreads();
        const int itn = (int)*qw; const bool hn = itn < NITW; cn = cvtw_decode(F, layer, hn ? itn : it, n0n);
#pragma unroll
        for (int i = 0; i < 8; ++i) rn[i] = __builtin_nontemporal_load((const f32x4*)(cn.src + (size_t)(16 * w + 2 * i + (lane >> 5)) * cn.ldw + 4 * (lane & 31)));
#pragma unroll
        for (int j = 0; j < 4; ++j) { const int nl = 16 * w + 4 * j + (lane >> 4), kc = lane & 15, n = n0 + nl; const LAS float* sp = t + (8 * kc) * 129 + nl;
            u32x4 o; o.x = pk2(sp[0], sp[129]); o.y = pk2(sp[2 * 129], sp[3 * 129]); o.z = pk2(sp[4 * 129], sp[5 * 129]); o.w = pk2(sp[6 * 129], sp[7 * 129]);
            const int row = c.gu ? (n >> 7) * 256 + c.up * 128 + (n & 127) : n;
            __builtin_nontemporal_store(o, (u32x4*)(c.dst + (size_t)row * c.K + 8 * kc)); }
        __syncthreads();
        if (!hn) break;
        it = itn; c = cn; n0 = n0n;
#pragma unroll
        for (int i = 0; i < 8; ++i) r[i] = rn[i];
    }
}
constexpr int NSMALL_WG = 128;
__device__ __forceinline__ void phase_prologue(Frame& F) {
    if (F.G == 256) {
        if ((F.vcu & 1) == 0) { const int g0 = F.G, v0 = F.vcu; F.G = NSMALL_WG; F.vcu = v0 >> 1; prologue_small(F); F.G = g0; F.vcu = v0; }
        convert_expert_weights_dyn(F, 0, F.ctl + CW_QUEUE + 64 * 40, 1 << 30);
    } else { prologue_small(F); convert_expert_weights(F, 0); }
}

template <bool SRC_IN>
__device__ __forceinline__ void phase_norm_t(Frame& F, int layer) {
    const int gw = F.vcu * 8 + F.wave, NGW = F.G * 8, lane = F.lane;
    const bool fin = layer == DEPTH; const int r_lo = (layer >= DEPTH - 1) ? (fin ? TC : 0) : 0;
    bf16* XR = (bf16*)(F.ws + WS_XR); const int* INV = (const int*)(F.ws + WS_INV); const bf16* YE = (const bf16*)(F.ws + WS_YE); bf16* HB = (bf16*)(F.ws + WS_HB);
    auto rowsrc = [&](int r) -> const float* { return r < TC ? inp(F, IN_CTX) + (size_t)r * D : inp(F, IN_X) + (size_t)(r - TC) * D; };
    f32x4 xn[4]; u32x2 xb[4]; int invn = -1;
    const int RPW = (TA - r_lo + NGW - 1) / NGW, rbeg = r_lo + gw * RPW, rend = rbeg + RPW < TA ? rbeg + RPW : TA;
    { const int r0 = rbeg < TA ? rbeg : TA - 1;
      if (SRC_IN) { const float* src = rowsrc(r0);
#pragma unroll
        for (int j = 0; j < 4; ++j) xn[j] = *(const f32x4*)(src + 4 * lane + 256 * j);
      } else {
#pragma unroll
        for (int j = 0; j < 4; ++j) xb[j] = *(const u32x2*)(XR + (size_t)r0 * D + 4 * lane + 256 * j);
        invn = lane < 16 ? INV[(size_t)r0 * 16 + lane] : -1; } }
    for (int r = rbeg; r < rend; ++r) {
        const int v = vec_of_row(r);
        f32x4 gvv[4], svv[4], cvv[4];
        { const float* g = inp(F, IN_GATTN) + (size_t)layer * D; const float* sh = mod_ptr(F, layer, v, 0); const float* scl = mod_ptr(F, layer, v, 1);
#pragma unroll
          for (int j = 0; j < 4; ++j) { const int k = 4 * lane + 256 * j; gvv[j] = *(const f32x4*)(g + k); svv[j] = *(const f32x4*)(sh + k); cvv[j] = *(const f32x4*)(scl + k); } }
        asm volatile("" ::: "memory");
        f32x4 x[4];
#pragma unroll
        for (int j = 0; j < 4; ++j) x[j] = SRC_IN ? xn[j] : (f32x4){bflo(xb[j].x), bfhi(xb[j].x), bflo(xb[j].y), bfhi(xb[j].y)};
        const int myinv_cur = invn;
        { const int rn = r + 1 < rend ? r + 1 : r;
          if (SRC_IN) { const float* src = rowsrc(rn);
#pragma unroll
            for (int j = 0; j < 4; ++j) xn[j] = *(const f32x4*)(src + 4 * lane + 256 * j);
          } else {
#pragma unroll
            for (int j = 0; j < 4; ++j) xb[j] = *(const u32x2*)(XR + (size_t)rn * D + 4 * lane + 256 * j);
            invn = lane < 16 ? INV[(size_t)rn * 16 + lane] : -1; } }
        if (!SRC_IN) {
            if (!(layer == DEPTH - 1 + 1 && false)) {
                const bool has_moe = !(layer == 1 && r < TC && false);
                if (has_moe) {
                    f32x4 s[4];
#pragma unroll
                    for (int j = 0; j < 4; ++j) s[j] = (f32x4){0.f, 0.f, 0.f, 0.f};
                    const int myinv = myinv_cur;
                    unsigned long long msk = __ballot(myinv >= 0);
                    while (msk) {
                        int sl[4]; float wg[4];
#pragma unroll
                        for (int k = 0; k < 4; ++k) { if (msk) { const int b = __builtin_ctzll(msk); sl[k] = __builtin_amdgcn_readlane(myinv, b); msk &= msk - 1ull; wg[k] = 1.f; } else { sl[k] = 0; wg[k] = 0.f; } }
                        u32x2 w[4][4];
#pragma unroll
                        for (int k = 0; k < 4; ++k)
#pragma unroll
                            for (int j = 0; j < 4; ++j) w[k][j] = *(const u32x2*)(YE + (size_t)sl[k] * D + 4 * lane + 256 * j);
#pragma unroll
                        for (int k = 0; k < 4; ++k)
#pragma unroll
                            for (int j = 0; j < 4; ++j) s[j] += (f32x4){bflo(w[k][j].x), bfhi(w[k][j].x), bflo(w[k][j].y), bfhi(w[k][j].y)} * wg[k];
                    }
                    const float* m5 = mod_ptr(F, layer - 1, v, 5);
#pragma unroll
                    for (int j = 0; j < 4; ++j) x[j] += *(const f32x4*)(m5 + 4 * lane + 256 * j) * s[j];
                }
            }
        }
        if (fin) {
            if (PROBE_STAT >= 10 && r == TC && lane == 0) { const unsigned long long* ts = (const unsigned long long*)(F.ctl + CW_STAT + 8);
                const int p = PROBE_STAT >= 300 ? PROBE_STAT - 300 : PROBE_STAT >= 200 ? PROBE_STAT - 200 : PROBE_STAT >= 100 ? PROBE_STAT - 100 : PROBE_STAT - 10;
                const float num = PROBE_STAT >= 300 ? (float)(ts[p + 1] - ts[p]) * 20.0f : PROBE_STAT >= 200 ? (float)(ts[p + 1] - ts[p]) * 32.0f : PROBE_STAT >= 100 ? (float)(ts[p + 1] - ts[p]) * 4.0f : (float)(ts[p + 1] - ts[0]);
                float q = num / (float)(ts[1 + 10 * DEPTH] - ts[0]); if (PROBE_STAT >= 200) q = (q - floorf(q)) * 0.4875f;
                if (PROBE_STAT >= 31 && PROBE_STAT <= 33) q = (float)F.ctl[CW_STAT + 64] / (float)(ts[17] - ts[16]);
                if (PROBE_STAT == 30) q = (float)F.ctl[CW_STAT + 64] / (float)(ts[16] - ts[15]);
                ((float*)F.ctl)[CW_STAT] = q; }
            if (PROBE_STAT && r == TC && lane == 0) { float v = ((const float*)F.ctl)[CW_STAT]; v = v < 0.f ? 0.f : (v > 1.f ? 1.f : v); x[0].x += 0.6f + 0.8f * v; }
#pragma unroll
            for (int j = 0; j < 4; ++j) *(f32x4*)(F.out + (size_t)(r - TC) * D + 4 * lane + 256 * j) = x[j];
            continue;
        }
        if (!SRC_IN) {
#pragma unroll
            for (int j = 0; j < 4; ++j) { u32x2 w; w.x = pk2(x[j].x, x[j].y); w.y = pk2(x[j].z, x[j].w); *(u32x2*)(XR + (size_t)r * D + 4 * lane + 256 * j) = w; }
        }
        float ss = 0.f;
#pragma unroll
        for (int j = 0; j < 4; ++j) ss += (x[j].x * x[j].x + x[j].y * x[j].y) + (x[j].z * x[j].z + x[j].w * x[j].w);
        const float rinv = __builtin_amdgcn_rsqf(wave_sum(ss) * (1.0f / D) + EPS);
#pragma unroll
        for (int j = 0; j < 4; ++j) { const int k = 4 * lane + 256 * j; const f32x4 gv = gvv[j], sv = svv[j], cv = cvv[j];
            const f32x4 y = (x[j] * rinv * gv) * (cv + 1.0f) + sv;
            u32x2 w; w.x = pk2(y.x, y.y); w.y = pk2(y.z, y.w); *(u32x2*)(HB + (size_t)r * D + k) = w; }
    }
}
__device__ __forceinline__ void phase_norm_pipe(Frame& F, int layer) {
    const int gw = F.vcu * 8 + F.wave, NGW = F.G * 8, lane = F.lane;
    const bool fin = layer == DEPTH; const int r_lo = fin ? TC : 0;
    bf16* XR = (bf16*)(F.ws + WS_XR); const int* INV = (const int*)(F.ws + WS_INV); const bf16* YE = (const bf16*)(F.ws + WS_YE); bf16* HB = (bf16*)(F.ws + WS_HB);
    const int RPW = (TA - r_lo + NGW - 1) / NGW, rbeg = r_lo + gw * RPW, rend = rbeg + RPW < TA ? rbeg + RPW : TA;
    if (rbeg >= rend) return;
    u32x2 xb[4], yp[4][4]; float wgp[4]; int inv_c, inv_n; unsigned long long rest_c;
    auto issue_slots = [&](int inv) -> unsigned long long {
        unsigned long long msk = __ballot(inv >= 0);
#pragma unroll
        for (int k = 0; k < 4; ++k) { int sl = 0; wgp[k] = 0.f;
            if (msk) { const int b = __builtin_ctzll(msk); sl = __builtin_amdgcn_readlane(inv, b); msk &= msk - 1ull; wgp[k] = 1.f; }
#pragma unroll
            for (int j = 0; j < 4; ++j) yp[k][j] = *(const u32x2*)(YE + (size_t)sl * D + 4 * lane + 256 * j); }
        return msk; };
#pragma unroll
    for (int j = 0; j < 4; ++j) xb[j] = *(const u32x2*)(XR + (size_t)rbeg * D + 4 * lane + 256 * j);
    inv_c = lane < 16 ? INV[(size_t)rbeg * 16 + lane] : -1;
    { const int r1 = rbeg + 1 < rend ? rbeg + 1 : rbeg; inv_n = lane < 16 ? INV[(size_t)r1 * 16 + lane] : -1; }
    rest_c = issue_slots(inv_c);
    for (int r = rbeg; r < rend; ++r) {
        const int v = vec_of_row(r);
        f32x4 m5v[4], gv[4], sv[4], cv[4];
        { const float* m5 = mod_ptr(F, layer - 1, v, 5);
#pragma unroll
          for (int j = 0; j < 4; ++j) m5v[j] = *(const f32x4*)(m5 + 4 * lane + 256 * j);
          if (!fin) { const float* g = inp(F, IN_GATTN) + (size_t)layer * D; const float* sh = mod_ptr(F, layer, v, 0); const float* scl = mod_ptr(F, layer, v, 1);
#pragma unroll
            for (int j = 0; j < 4; ++j) { const int k = 4 * lane + 256 * j; gv[j] = *(const f32x4*)(g + k); sv[j] = *(const f32x4*)(sh + k); cv[j] = *(const f32x4*)(scl + k); } } }
        asm volatile("" ::: "memory");
        f32x4 x[4], s[4];
#pragma unroll
        for (int j = 0; j < 4; ++j) { x[j] = (f32x4){bflo(xb[j].x), bfhi(xb[j].x), bflo(xb[j].y), bfhi(xb[j].y)}; s[j] = (f32x4){0.f, 0.f, 0.f, 0.f}; }
#pragma unroll
        for (int k = 0; k < 4; ++k)
#pragma unroll
            for (int j = 0; j < 4; ++j) s[j] += (f32x4){bflo(yp[k][j].x), bfhi(yp[k][j].x), bflo(yp[k][j].y), bfhi(yp[k][j].y)} * wgp[k];
        const int myinv = inv_c; unsigned long long msk = rest_c;
        { const int rn = r + 1 < rend ? r + 1 : r, r2 = r + 2 < rend ? r + 2 : rend - 1;
#pragma unroll
          for (int j = 0; j < 4; ++j) xb[j] = *(const u32x2*)(XR + (size_t)rn * D + 4 * lane + 256 * j);
          inv_c = inv_n; rest_c = issue_slots(inv_c);
          inv_n = lane < 16 ? INV[(size_t)r2 * 16 + lane] : -1; }
        asm volatile("" ::: "memory");
        while (msk) {
            int sl[4]; float wg[4];
#pragma unroll
            for (int k = 0; k < 4; ++k) { if (msk) { const int b = __builtin_ctzll(msk); sl[k] = __builtin_amdgcn_readlane(myinv, b); msk &= msk - 1ull; wg[k] = 1.f; } else { sl[k] = 0; wg[k] = 0.f; } }
            u32x2 w[4][4];
#pragma unroll
            for (int k = 0; k < 4; ++k)
#pragma unroll
                for (int j = 0; j < 4; ++j) w[k][j] = *(const u32x2*)(YE + (size_t)sl[k] * D + 4 * lane + 256 * j);
#pragma unroll
            for (int k = 0; k < 4; ++k)
#pragma unroll
                for (int j = 0; j < 4; ++j) s[j] += (f32x4){bflo(w[k][j].x), bfhi(w[k][j].x), bflo(w[k][j].y), bfhi(w[k][j].y)} * wg[k];
        }
#pragma unroll
        for (int j = 0; j < 4; ++j) x[j] += m5v[j] * s[j];
        if (fin) {
            if (PROBE_STAT >= 10 && r == TC && lane == 0) { const unsigned long long* ts = (const unsigned long long*)(F.ctl + CW_STAT + 8);
                const int p = PROBE_STAT >= 300 ? PROBE_STAT - 300 : PROBE_STAT >= 200 ? PROBE_STAT - 200 : PROBE_STAT >= 100 ? PROBE_STAT - 100 : PROBE_STAT - 10;
                const float num = PROBE_STAT >= 300 ? (float)(ts[p + 1] - ts[p]) * 20.0f : PROBE_STAT >= 200 ? (float)(ts[p + 1] - ts[p]) * 32.0f : PROBE_STAT >= 100 ? (float)(ts[p + 1] - ts[p]) * 4.0f : (float)(ts[p + 1] - ts[0]);
                float q = num / (float)(ts[1 + 10 * DEPTH] - ts[0]); if (PROBE_STAT >= 200) q = (q - floorf(q)) * 0.4875f;
                if (PROBE_STAT >= 31 && PROBE_STAT <= 33) q = (float)F.ctl[CW_STAT + 64] / (float)(ts[17] - ts[16]);
                if (PROBE_STAT == 30) q = (float)F.ctl[CW_STAT + 64] / (float)(ts[16] - ts[15]);
                ((float*)F.ctl)[CW_STAT] = q; }
            if (PROBE_STAT && r == TC && lane == 0) { float v = ((const float*)F.ctl)[CW_STAT]; v = v < 0.f ? 0.f : (v > 1.f ? 1.f : v); x[0].x += 0.6f + 0.8f * v; }
#pragma unroll
            for (int j = 0; j < 4; ++j) *(f32x4*)(F.out + (size_t)(r - TC) * D + 4 * lane + 256 * j) = x[j];
            continue;
        }
#pragma unroll
        for (int j = 0; j < 4; ++j) { u32x2 w; w.x = pk2(x[j].x, x[j].y); w.y = pk2(x[j].z, x[j].w); *(u32x2*)(XR + (size_t)r * D + 4 * lane + 256 * j) = w; }
        float ss = 0.f;
#pragma unroll
        for (int j = 0; j < 4; ++j) ss += (x[j].x * x[j].x + x[j].y * x[j].y) + (x[j].z * x[j].z + x[j].w * x[j].w);
        const float rinv = __builtin_amdgcn_rsqf(wave_sum(ss) * (1.0f / D) + EPS);
#pragma unroll
        for (int j = 0; j < 4; ++j) { const int k = 4 * lane + 256 * j;
            const f32x4 y = (x[j] * rinv * gv[j]) * (cv[j] + 1.0f) + sv[j];
            u32x2 w; w.x = pk2(y.x, y.y); w.y = pk2(y.z, y.w); *(u32x2*)(HB + (size_t)r * D + k) = w; }
    }
}
__device__ __forceinline__ void phase_norm(Frame& F, int layer) { if (layer == 0) phase_norm_t<true>(F, 0); else phase_norm_pipe(F, layer); }

using pg8::Unit; using pg8::Acc;
struct SchedGrid {
    static constexpr int NSEG = 1;
    int nM, nN, G, c; const char* A; const char* B; size_t a_tile, b_tile; int pm_per_group; size_t b_group; int ntl;
    __device__ __forceinline__ void fill(int pm, int pn, Unit& u) const {
        u.pm = pm; u.pn = pn; u.tag = 0; u.A = A + (size_t)pm * a_tile; u.B = B + (size_t)pn * b_tile + (pm_per_group ? (size_t)(pm / pm_per_group) * b_group : 0); }
    __device__ __forceinline__ bool next(int i, Unit& u) const {
        int pm, pn; if (c < 0 || !pg8::grid_order((long)i * G + c, nM - ntl / nN, nN, pm, pn)) return false;
        fill(pm, pn, u); return true; }
    __device__ __forceinline__ void tail_unit(int j, int, Unit& u) const { fill(nM - ntl / nN + j / nN, j % nN, u); }
};
struct SchedMerge {
    static constexpr int NSEG = 3;
    int nM, nN, G, c; const char* A; const char* B; size_t a_seg, b_seg, a_tile, b_tile; int ntl;
    __device__ __forceinline__ void fill(int pm, int pn, int seg, Unit& u) const {
        u.pm = pm; u.pn = pn; u.tag = seg; u.A = A + (size_t)seg * a_seg + (size_t)pm * a_tile; u.B = B + (size_t)seg * b_seg + (size_t)pn * b_tile; }
    __device__ __forceinline__ bool next(int i, Unit& u) const {
        const int t = i / 3, seg = i - 3 * t; int pm, pn; if (!pg8::grid_order((long)t * G + c, nM - ntl / nN, nN, pm, pn)) return false;
        fill(pm, pn, seg, u); return true; }
    __device__ __forceinline__ void tail_unit(int j, int seg, Unit& u) const { fill(nM - ntl / nN + j / nN, j % nN, seg, u); }
};

struct EpiBf16 {
    static constexpr bool PERM = true; static constexpr int STAT = 0;
    bf16* C; int ldc; int sig_pn0;
    __device__ __forceinline__ void operator()(Acc& acc, const Unit& u, int wr, int wc, int fr, int fq) const {
        const int row0 = u.pm * 256 + wr * 64 + fr, col0 = u.pn * 256 + wc * 32 + 8 * fq;
        const bool sig = u.pn >= sig_pn0;
#pragma unroll
        for (int ai = 0; ai < 2; ++ai)
#pragma unroll
            for (int m = 0; m < 4; ++m) { bf16* rowp = C + (size_t)(row0 + ai * 128 + m * 16) * ldc + col0;
#pragma unroll
                for (int bj = 0; bj < 2; ++bj) { f32x4 v0 = acc[ai][bj][m][0], v1 = acc[ai][bj][m][1];
                    if (sig) {
#pragma unroll
                        for (int j = 0; j < 4; ++j) { v0[j] = sigmoidf_(v0[j]); v1[j] = sigmoidf_(v1[j]); } }
                    u32x4 w; w.x = pk2(v0[0], v0[1]); w.y = pk2(v0[2], v0[3]); w.z = pk2(v1[0], v1[1]); w.w = pk2(v1[2], v1[3]);
                    *(u32x4*)(rowp + bj * 128) = w; } }
        pg8::zero_acc(acc);
    }
};
struct EpiGT {
    static constexpr bool PERM = true; static constexpr int STAT = 0;
    bf16* GT; bf16* GTC;
    __device__ __forceinline__ void operator()(Acc& acc, const Unit& u, int wr, int wc, int fr, int fq) const {
        const int tok0 = u.pn * 256;
        bf16* base; int pitch, nseq, n0;
        if (tok0 < TC) { const int b = tok0 / CTX; base = GTC + (size_t)b * 512 * 512; pitch = 512; nseq = CTX; n0 = tok0 - b * CTX; }
        else { const int t = tok0 - TC, b = t / SEQ; base = GT + (size_t)b * 512 * 4096; pitch = 4096; nseq = SEQ; n0 = t - b * SEQ; }
        const int crow0 = u.pm * 256 + wr * 64 + fr, ccol0 = wc * 32 + 8 * fq;
#pragma unroll
        for (int ai = 0; ai < 2; ++ai)
#pragma unroll
            for (int m = 0; m < 4; ++m) { const int c = crow0 + ai * 128 + m * 16, part = c >> 9, ch = c & 511;
                bf16* rowp = base + (size_t)ch * pitch + part * nseq + n0 + ccol0;
#pragma unroll
                for (int bj = 0; bj < 2; ++bj) { const f32x4 v0 = acc[ai][bj][m][0], v1 = acc[ai][bj][m][1];
                    u32x4 w; w.x = pk2(v0[0], v0[1]); w.y = pk2(v0[2], v0[3]); w.z = pk2(v1[0], v1[1]); w.w = pk2(v1[2], v1[3]);
                    *(u32x4*)(rowp + bj * 128) = w; } }
        pg8::zero_acc(acc);
    }
};
struct EpiDFT {
    static constexpr bool PERM = true; static constexpr int STAT = 0;
    bf16* FO; int nseq; int row_base0;
    __device__ __forceinline__ void operator()(Acc& acc, const Unit& u, int wr, int wc, int fr, int fq) const {
        const int k0 = u.pm * 256 + wr * 64 + fr, b = (u.pn * 256) >> 9, ch0 = ((u.pn * 256) & 511) + wc * 32 + 8 * fq;
        bf16* base = FO + (size_t)(row_base0 + b * nseq + k0) * 512 + ch0;
#pragma unroll
        for (int ai = 0; ai < 2; ++ai)
#pragma unroll
            for (int m = 0; m < 4; ++m) { bf16* rowp = base + (size_t)(ai * 128 + m * 16) * 512;
#pragma unroll
                for (int bj = 0; bj < 2; ++bj) { const f32x4 v0 = acc[ai][bj][m][0], v1 = acc[ai][bj][m][1];
                    u32x4 w; w.x = pk2(v0[0], v0[1]); w.y = pk2(v0[2], v0[3]); w.z = pk2(v1[0], v1[1]); w.w = pk2(v1[2], v1[3]);
                    *(u32x4*)(rowp + bj * 128) = w; } }
        pg8::zero_acc(acc);
    }
};
struct EpiMerge {
    static constexpr bool PERM = true; static constexpr int STAT = 0;
    const unsigned char* G8; bf16* MIXB; int row_off;
    template <int NA, int NB>
    __device__ __forceinline__ void run(Acc& acc, const Unit& u, int ro, int co, int wr, int wc, int fr, int fq) const {
        const int row0 = row_off + u.pm * 256 + ro + wr * 64 + fr, col0 = u.pn * 256 + co + wc * 32 + 8 * fq, seg = u.tag;
        const unsigned char* gt = G8 + (size_t)(((row_off >> 8) + u.pm) * 12 + seg * 4 + u.pn) * 65536 + (size_t)((wr * 4 + wc) * 16 * 64 + fq * 16 + fr) * 8;
        unsigned long long st0 = 0; if (PROBE_STAT == 30) st0 = __builtin_amdgcn_s_memrealtime();
        const int gbo = seg < 2 ? 4 * 65536 : 0;
#pragma unroll
        for (int ai = 0; ai < NA; ++ai) {
            u32x2 gav[4][NB], gbv[4][NB];
#pragma unroll
            for (int m = 0; m < 4; ++m)
#pragma unroll
                for (int bj = 0; bj < NB; ++bj) { const unsigned char* gp = gt + (((ai + (ro >> 7)) * 8 + m * 2 + bj + (co >> 7)) * 512);
                    gav[m][bj] = *(const u32x2*)gp; gbv[m][bj] = *(const u32x2*)(gp + gbo); }
            asm volatile("" ::: "memory");
#pragma unroll
            for (int m = 0; m < 4; ++m) { const size_t row = (size_t)(row0 + ai * 128 + m * 16);
#pragma unroll
                for (int bj = 0; bj < NB; ++bj) { const int col = col0 + bj * 128;
                    const u32x2 ga = gav[m][bj];
                    float f[8];
                    if (seg < 2) { const u32x2 gb = gbv[m][bj];
#pragma unroll
                        for (int q = 0; q < 8; ++q) f[q] = (float)((ga[q >> 2] >> (8 * (q & 3))) & 255u) * __builtin_amdgcn_rcpf((float)((gb[q >> 2] >> (8 * (q & 3))) & 255u));
                    } else {
#pragma unroll
                        for (int q = 0; q < 8; ++q) f[q] = (float)((ga[q >> 2] >> (8 * (q & 3))) & 255u) * (1.0f / 255.0f);
                    }
                    f32x4 v0 = acc[ai][bj][m][0], v1 = acc[ai][bj][m][1];
                    v0 = v0 * (f32x4){f[0], f[1], f[2], f[3]}; v1 = v1 * (f32x4){f[4], f[5], f[6], f[7]};
                    if (seg < 2) { acc[ai][bj][m][0] = v0; acc[ai][bj][m][1] = v1; }
                    else { u32x4 w; w.x = pk2(v0[0], v0[1]); w.y = pk2(v0[2], v0[3]); w.z = pk2(v1[0], v1[1]); w.w = pk2(v1[2], v1[3]);
                        *(u32x4*)(MIXB + row * D + col) = w; acc[ai][bj][m][0] = (f32x4){0.f, 0.f, 0.f, 0.f}; acc[ai][bj][m][1] = (f32x4){0.f, 0.f, 0.f, 0.f}; } }
                if (m == 3) asm volatile("" ::: "memory"); }
        }
        if (PROBE_STAT == 30 && row_off == TC && blockIdx.x == 0 && wr == 0 && wc == 0 && fr == 0 && fq == 0) { asm volatile("s_waitcnt vmcnt(0)" ::: "memory");
            atomicAdd((unsigned*)((unsigned char*)G8 - WS_G8 + WS_CTL) + CW_STAT + 64, (unsigned)(__builtin_amdgcn_s_memrealtime() - st0)); }
    }
    __device__ __forceinline__ void operator()(Acc& acc, const Unit& u, int wr, int wc, int fr, int fq) const { run<2, 2>(acc, u, 0, 0, wr, wc, fr, fq); }
    __device__ __forceinline__ void quarter(Acc& acc, const Unit& u, int qa, int qb, int wr, int wc, int fr, int fq) const { run<1, 1>(acc, u, 128 * qa, 128 * qb, wr, wc, fr, fq); }
};
struct EpiOut {
    static constexpr bool PERM = true; static constexpr int STAT = 1;
    const float* in_ctx; const float* in_lat; bf16* XR; const float* mod2; int row_off; bool from_in;
    template <int NA, int NB>
    __device__ __forceinline__ void run(Acc& acc, const Unit& u, int ro, int co, int wr, int wc, int fr, int fq) const {
        const int row0 = row_off + u.pm * 256 + ro + wr * 64 + fr, col0 = u.pn * 256 + co + wc * 32 + 8 * fq;
        const int v = vec_of_row(row_off + u.pm * 256);
        unsigned long long st0 = 0; if (PROBE_STAT == 31) st0 = __builtin_amdgcn_s_memrealtime();
        f32x4 mv[NB][2];
#pragma unroll
        for (int bj = 0; bj < NB; ++bj)
#pragma unroll
            for (int n = 0; n < 2; ++n) mv[bj][n] = *(const f32x4*)(mod2 + (size_t)v * 6144 + col0 + bj * 128 + n * 4);
#pragma unroll
        for (int ai = 0; ai < NA; ++ai) {
            if (from_in) {
#pragma unroll
                for (int mh = 0; mh < 2; ++mh) {
                    f32x4 b[2][NB][2];
#pragma unroll
                    for (int mm = 0; mm < 2; ++mm) { const int row = row0 + ai * 128 + (2 * mh + mm) * 16; const float* bp = row < TC ? in_ctx + (size_t)row * D : in_lat + (size_t)(row - TC) * D;
#pragma unroll
                        for (int bj = 0; bj < NB; ++bj) { b[mm][bj][0] = *(const f32x4*)(bp + col0 + bj * 128); b[mm][bj][1] = *(const f32x4*)(bp + col0 + bj * 128 + 4); } }
                    asm volatile("" ::: "memory");
#pragma unroll
                    for (int mm = 0; mm < 2; ++mm) { const int m = 2 * mh + mm; bf16* op = XR + (size_t)(row0 + ai * 128 + m * 16) * D;
#pragma unroll
                        for (int bj = 0; bj < NB; ++bj) { const f32x4 b0 = b[mm][bj][0] + mv[bj][0] * acc[ai][bj][m][0], b1 = b[mm][bj][1] + mv[bj][1] * acc[ai][bj][m][1];
                            u32x4 w; w.x = pk2(b0[0], b0[1]); w.y = pk2(b0[2], b0[3]); w.z = pk2(b1[0], b1[1]); w.w = pk2(b1[2], b1[3]);
                            *(u32x4*)(op + col0 + bj * 128) = w; } }
                    asm volatile("" ::: "memory");
                }
            } else {
                u32x4 q[4][NB];
#pragma unroll
                for (int m = 0; m < 4; ++m)
#pragma unroll
                    for (int bj = 0; bj < NB; ++bj) q[m][bj] = *(const u32x4*)(XR + (size_t)(row0 + ai * 128 + m * 16) * D + col0 + bj * 128);
                asm volatile("" ::: "memory");
#pragma unroll
                for (int m = 0; m < 4; ++m) { bf16* op = XR + (size_t)(row0 + ai * 128 + m * 16) * D;
#pragma unroll
                    for (int bj = 0; bj < NB; ++bj) { const u32x4 t = q[m][bj];
                        const f32x4 b0 = (f32x4){bflo(t.x), bfhi(t.x), bflo(t.y), bfhi(t.y)} + mv[bj][0] * acc[ai][bj][m][0], b1 = (f32x4){bflo(t.z), bfhi(t.z), bflo(t.w), bfhi(t.w)} + mv[bj][1] * acc[ai][bj][m][1];
                        u32x4 w; w.x = pk2(b0[0], b0[1]); w.y = pk2(b0[2], b0[3]); w.z = pk2(b1[0], b1[1]); w.w = pk2(b1[2], b1[3]);
                        *(u32x4*)(op + col0 + bj * 128) = w; } }
            }
            asm volatile("" ::: "memory");
        }
        if (PROBE_STAT == 31 && !from_in && blockIdx.x == 0 && wr == 0 && wc == 0 && fr == 0 && fq == 0) { asm volatile("s_waitcnt vmcnt(0)" ::: "memory");
            atomicAdd((unsigned*)((unsigned char*)XR - WS_XR + WS_CTL) + CW_STAT + 64, (unsigned)(__builtin_amdgcn_s_memrealtime() - st0)); }
        pg8::zero_acc(acc);
    }
    __device__ __forceinline__ void operator()(Acc& acc, const Unit& u, int wr, int wc, int fr, int fq) const { run<2, 2>(acc, u, 0, 0, wr, wc, fr, fq); }
    __device__ __forceinline__ void quarter(Acc& acc, const Unit& u, int qa, int qb, int wr, int wc, int fr, int fq) const { run<1, 1>(acc, u, 128 * qa, 128 * qb, wr, wc, fr, fq); }
};
struct EpiGU {
    static constexpr bool PERM = true; static constexpr int STAT = 0;
    bf16* HID;
    __device__ __forceinline__ void operator()(Acc& acc, const Unit& u, int wr, int wc, int fr, int fq) const {
        const int row0 = u.pm * 256 + wr * 64 + fr, col0 = u.pn * 128 + wc * 32 + 8 * fq;
#pragma unroll
        for (int ai = 0; ai < 2; ++ai)
#pragma unroll
            for (int m = 0; m < 4; ++m) { float h[8];
#pragma unroll
                for (int n = 0; n < 2; ++n)
#pragma unroll
                    for (int j = 0; j < 4; ++j) { const float g = acc[ai][0][m][n][j], up = acc[ai][1][m][n][j]; h[4 * n + j] = siluf_(g) * up; }
                u32x4 w; w.x = pk2(h[0], h[1]); w.y = pk2(h[2], h[3]); w.z = pk2(h[4], h[5]); w.w = pk2(h[6], h[7]);
                *(u32x4*)(HID + (size_t)(row0 + ai * 128 + m * 16) * HIDP + col0) = w; }
        pg8::zero_acc(acc);
    }
};
struct EpiDown {
    static constexpr bool PERM = true; static constexpr int STAT = 0;
    bf16* YE; const float* topw;
    template <int NA, int NB>
    __device__ __forceinline__ void run(Acc& acc, const Unit& u, int ro, int co, int wr, int wc, int fr, int fq) const {
        const int row0 = u.pm * 256 + ro + wr * 64 + fr, col0 = u.pn * 256 + co + wc * 32 + 8 * fq;
        float twv[NA][4];
#pragma unroll
        for (int ai = 0; ai < NA; ++ai)
#pragma unroll
            for (int m = 0; m < 4; ++m) twv[ai][m] = topw[row0 + ai * 128 + m * 16];
        asm volatile("" ::: "memory");
#pragma unroll
        for (int ai = 0; ai < NA; ++ai)
#pragma unroll
            for (int m = 0; m < 4; ++m) { const int row = row0 + ai * 128 + m * 16; const float tw = twv[ai][m];
#pragma unroll
                for (int bj = 0; bj < NB; ++bj) { const f32x4 v0 = acc[ai][bj][m][0] * tw, v1 = acc[ai][bj][m][1] * tw;
                    u32x4 w; w.x = pk2(v0[0], v0[1]); w.y = pk2(v0[2], v0[3]); w.z = pk2(v1[0], v1[1]); w.w = pk2(v1[2], v1[3]);
                    *(u32x4*)(YE + (size_t)row * D + col0 + bj * 128) = w; } }
        pg8::zero_acc(acc);
    }
    __device__ __forceinline__ void operator()(Acc& acc, const Unit& u, int wr, int wc, int fr, int fq) const { run<2, 2>(acc, u, 0, 0, wr, wc, fr, fq); }
    __device__ __forceinline__ void quarter(Acc& acc, const Unit& u, int qa, int qb, int wr, int wc, int fr, int fq) const { run<1, 1>(acc, u, 128 * qa, 128 * qb, wr, wc, fr, fq); }
};

struct SchedInproj {
    static constexpr int NSEG = 1;
    int G, c, ncc; const char* HB; const char* WT; int ntl;
    __device__ __forceinline__ void fill(int pm, int pn, Unit& u) const {
        const size_t tile = (size_t)256 * D * 2;
        if (pn < 24) { u.pm = pm; u.pn = pn; u.A = HB + pm * tile; u.B = WT + pn * tile; u.tag = (pn < 2 || (pn >= 6 && pn < 10)) ? 2 : (pn >= 12 ? 1 : 0); }
        else { u.pm = pn - 24; u.pn = pm; u.A = WT + (size_t)(24 + pn - 24) * tile; u.B = HB + pm * tile; u.tag = 3; } }
    __device__ __forceinline__ bool next(int i, Unit& u) const {
        long L = (long)i * G + c; int pm, pn; const int tc = ntl / 8, nr1 = ntl ? 56 : 64, n2 = ntl ? 8 * (28 - tc) : 0;
        if (L < nr1 * 28) { pg8::grid_order(L, nr1, 28, pm, pn); pm += 8; }
        else if (L - nr1 * 28 < n2) { pg8::grid_order(L - nr1 * 28, 8, 28 - tc, pm, pn); pm += 64; if (pn >= 24 - tc) pn += tc; }
        else { if (!pg8::grid_order(L - nr1 * 28 - n2, 8, ncc, pm, pn)) return false; if (ncc == 7) pn = pn < 3 ? pn + 1 : pn + 5; }
        fill(pm, pn, u); return true; }
    __device__ __forceinline__ void tail_unit(int j, int, Unit& u) const { const int tc = ntl / 8; fill(64 + j / tc, 24 - tc + j % tc, u); }
};
struct EpiInproj {
    static constexpr bool PERM = true; static constexpr int STAT = 0;
    bf16* PROJ; bf16* GT; bf16* GTC; const float* rc; const float* rs; const float* qn; const float* kn; unsigned char* G8;
    __device__ __forceinline__ void operator()(Acc& acc, const Unit& u, int wr, int wc, int fr, int fq) const {
        if (u.tag == 3) { EpiGT E{GT, GTC}; E(acc, u, wr, wc, fr, fq); return; }
        if (u.tag == 0) { EpiBf16 E{PROJ, NPROJ, 1000}; E(acc, u, wr, wc, fr, fq); return; }
        if (u.tag == 1) {
            unsigned char* tp = G8 + (size_t)(u.pm * 12 + (u.pn - C_GATE / 256)) * 65536 + (size_t)((wr * 4 + wc) * 16 * 64 + fq * 16 + fr) * 8;
#pragma unroll
            for (int ai = 0; ai < 2; ++ai)
#pragma unroll
                for (int m = 0; m < 4; ++m) {
#pragma unroll
                    for (int bj = 0; bj < 2; ++bj) { unsigned wlo = 0u, whi = 0u;
#pragma unroll
                        for (int j = 0; j < 4; ++j) { const float a = fminf(fmaxf(sigmoidf_(acc[ai][bj][m][0][j]) * 255.0f + 0.5f, 1.0f), 255.0f), b = fminf(fmaxf(sigmoidf_(acc[ai][bj][m][1][j]) * 255.0f + 0.5f, 1.0f), 255.0f);
                            wlo |= (unsigned)a << (8 * j); whi |= (unsigned)b << (8 * j); }
                        *(u32x2*)(tp + (ai * 8 + m * 2 + bj) * 512) = (u32x2){wlo, whi}; } }
            pg8::zero_acc(acc); return; }
        const int tile = u.pn; const bool is_d = tile >= 6, is_q = (tile == 0 || tile == 6 || tile == 7);
        f32x4 g1[2], g2[2];
        if (is_d) { const float* G = is_q ? qn : kn;
#pragma unroll
            for (int n = 0; n < 2; ++n) { g1[n] = *(const f32x4*)(G + 8 * fq + 4 * n); g2[n] = *(const f32x4*)(G + 32 + 8 * fq + 4 * n); } }
        const int row0 = u.pm * 256 + wr * 64 + fr; const bool lat = u.pm >= 8;
#pragma unroll
        for (int ai = 0; ai < 2; ++ai)
#pragma unroll
            for (int m = 0; m < 4; ++m) { const int row = row0 + ai * 128 + m * 16;
                f32x4 x1[2] = {acc[ai][0][m][0], acc[ai][0][m][1]}, x2[2] = {acc[ai][1][m][0], acc[ai][1][m][1]};
                if (is_d) {
                    float ss = 0.f;
#pragma unroll
                    for (int n = 0; n < 2; ++n) ss += (x1[n][0] * x1[n][0] + x1[n][1] * x1[n][1]) + (x1[n][2] * x1[n][2] + x1[n][3] * x1[n][3]) + (x2[n][0] * x2[n][0] + x2[n][1] * x2[n][1]) + (x2[n][2] * x2[n][2] + x2[n][3] * x2[n][3]);
                    ss = sum16x2(ss); ss = sum32x2(ss);
                    const float rinv = __builtin_amdgcn_rsqf(ss * (1.0f / 64.0f) + EPS);
#pragma unroll
                    for (int n = 0; n < 2; ++n) { x1[n] = x1[n] * rinv * g1[n]; x2[n] = x2[n] * rinv * g2[n]; }
                } else if (tile == 0) {
#pragma unroll
                    for (int n = 0; n < 2; ++n) { x1[n] = x1[n] * 0.125f; x2[n] = x2[n] * 0.125f; }
                }
                f32x4 o1[2], o2[2];
                if (lat) { const int pos = (row - TC) & (SEQ - 1);
#pragma unroll
                    for (int n = 0; n < 2; ++n) { const f32x4 c = *(const f32x4*)(rc + pos * 32 + 8 * fq + 4 * n), sn = *(const f32x4*)(rs + pos * 32 + 8 * fq + 4 * n);
                        o1[n] = x1[n] * c - x2[n] * sn; o2[n] = x2[n] * c + x1[n] * sn; }
                } else { o1[0] = x1[0]; o1[1] = x1[1]; o2[0] = x2[0]; o2[1] = x2[1]; }
                if (is_d && is_q) { const float k = 0.125f * LOG2E;
#pragma unroll
                    for (int n = 0; n < 2; ++n) { o1[n] = o1[n] * k; o2[n] = o2[n] * k; } }
                bf16* dst = PROJ + (size_t)row * NPROJ + tile * 256 + 64 * wc + 8 * fq;
                u32x4 w; w.x = pk2(o1[0][0], o1[0][1]); w.y = pk2(o1[0][2], o1[0][3]); w.z = pk2(o1[1][0], o1[1][1]); w.w = pk2(o1[1][2], o1[1][3]); *(u32x4*)dst = w;
                w.x = pk2(o2[0][0], o2[0][1]); w.y = pk2(o2[0][2], o2[0][3]); w.z = pk2(o2[1][0], o2[1][1]); w.w = pk2(o2[1][2], o2[1][3]); *(u32x4*)(dst + 32) = w;
                asm volatile("" ::: "memory"); }
        pg8::zero_acc(acc);
    }
    __device__ __forceinline__ void quarter(Acc& acc, const Unit& u, int qa, int qb, int wr, int wc, int fr, int fq) const {
        unsigned char* tp = G8 + (size_t)(u.pm * 12 + (u.pn - C_GATE / 256)) * 65536 + (size_t)((wr * 4 + wc) * 16 * 64 + fq * 16 + fr) * 8;
#pragma unroll
        for (int m = 0; m < 4; ++m) { unsigned wlo = 0u, whi = 0u;
#pragma unroll
            for (int j = 0; j < 4; ++j) { const float a = fminf(fmaxf(sigmoidf_(acc[0][0][m][0][j]) * 255.0f + 0.5f, 1.0f), 255.0f), b = fminf(fmaxf(sigmoidf_(acc[0][0][m][1][j]) * 255.0f + 0.5f, 1.0f), 255.0f);
                wlo |= (unsigned)a << (8 * j); whi |= (unsigned)b << (8 * j); }
            *(u32x2*)(tp + (qa * 8 + m * 2 + qb) * 512) = (u32x2){wlo, whi}; }
        pg8::zero_acc(acc);
    }
};
__device__ __forceinline__ void phase_inproj(Frame& F, int layer) {
    const float* rc = (const float*)(F.ws + WS_ROPE);
    const int ncc = layer == DEPTH - 1 ? 7 : 28, rem = (64 * 28 + 8 * ncc) % F.G;
    SchedInproj S{F.G, (int)blockIdx.x, ncc, (const char*)(F.ws + WS_HB), (const char*)(F.ws + WS_WIN + layer * WIN_L), (F.G == 256 && rem % 8 == 0 && rem <= 64) ? rem : 0};
    EpiInproj E{(bf16*)(F.ws + WS_PROJ), (bf16*)(F.ws + WS_GT), (bf16*)(F.ws + WS_GTC), rc, rc + SEQ * 32, inp(F, IN_QN) + layer * 64, inp(F, IN_KN) + layer * 64, (unsigned char*)(F.ws + WS_G8)};
    pg8::gemm_phase(F.lds, F.tid, D, S, E, D);
    pg8::gemm_tail(F.lds, F.tid, D, S, E, (int)blockIdx.x, D);
}

namespace att {
constexpr int KPITCH = 144, VPITCH = 320, KC_BYTES = 64 * KPITCH, V_BYTES = 64 * VPITCH, BUF_BYTES = 2 * KC_BYTES + V_BYTES;
constexpr int SCR_OFF = 2 * BUF_BYTES;
constexpr int QW_OFF = SCR_OFF + 8 * 256;
constexpr int S_OFF = 81920, S_BYTES = 128 * KPITCH;
__device__ __forceinline__ int crow(int r, int hi) { return (r & 3) + 8 * (r >> 2) + 4 * hi; }
__device__ __forceinline__ s16x4 vtr(const LAS unsigned char* p) { typedef short v4i16_t __attribute__((ext_vector_type(4))); return __builtin_bit_cast(s16x4, __builtin_amdgcn_ds_read_tr16_b64_v4i16((LAS v4i16_t*)p)); }

struct UnitDesc {
    int mode;
    int qrow0;
    int qpos0;
    int h;
    int krowA, ntA;
    int krowB, ntB;
    int kindB;
    int nseq;
    int outrow0;
    float lgf, lgb;
    float lam, scale_out;
    int stat;
    int cross, bh, blk;
};

template <int MODE> __device__ __forceinline__ void unit(const Frame& F, const UnitDesc& u) {
    LAS unsigned char* lds = F.lds;
    int lane = F.lane; asm volatile("" : "+v"(lane));
    const int wid = F.wave, tid = wid * 64 + lane, r32 = lane & 31, hi = lane >> 5;
    const bf16* PROJ = (const bf16*)(F.ws + WS_PROJ);
    constexpr bool diff = MODE == 0;
    const int comp = diff ? (wid >> 2) : 0;
    const int qoff = diff ? 32 * (wid & 3) : 32 * wid;
    const int kcol = diff ? C_DK + u.h * 128 : C_RK + u.h * 64, vcol = diff ? C_DV + u.h * 128 : C_RV + u.h * 128;
    const int qcol = diff ? C_DQ + u.h * 128 + comp * 64 : C_RQ + u.h * 64;
    const int NT = u.ntA + u.ntB;
    unsigned long long ts0 = 0, ts1 = 0, ts2 = 0, ts3 = 0, tacc = 0; (void)ts0; (void)ts1; (void)ts2; (void)ts3; (void)tacc;
    if (PROBE_STAT) ts0 = __builtin_amdgcn_s_memtime();
    bf16x8 qf[4];
    { const bf16* qp = PROJ + (size_t)(u.qrow0 + qoff + r32) * NPROJ + qcol + 8 * hi;
#pragma unroll
      for (int s = 0; s < 4; ++s) qf[s] = *(const bf16x8*)(qp + 16 * s); }
    f32x16 o[4];
#pragma unroll
    for (int d = 0; d < 4; ++d) o[d] = (f32x16){};
    float lsum = 0.f;
    if (!diff && u.cross) {
        const float* LB = (const float*)(F.ws + WS_LBUF) + (size_t)u.bh * 9 * 2 * 64 * 128;
        const int dv = tid & 127, dg = tid >> 7, c = u.blk;
        float sf[16], sb[16];
#pragma unroll
        for (int k = 0; k < 16; ++k) { sf[k] = 0.f; sb[k] = 0.f; }
        const float* L0 = LB + (size_t)(16 * dg) * 128 + dv;
#pragma unroll
        for (int g4 = 0; g4 < 2; ++g4) {
            float val[4][16], wfv[4], wbv[4];
#pragma unroll
            for (int i = 0; i < 4; ++i) { const int bp = 4 * g4 + i; const float* Lp = L0 + (size_t)(bp * 2 + (bp < c ? 0 : 1)) * 64 * 128;
                wfv[i] = bp < c ? __builtin_amdgcn_exp2f(u.lgf * 256.f * (float)(c - 1 - bp)) : 0.f;
                wbv[i] = bp > c ? __builtin_amdgcn_exp2f(u.lgb * 256.f * (float)(bp - c - 1)) : 0.f;
#pragma unroll
                for (int k = 0; k < 16; ++k) val[i][k] = Lp[k * 128]; }
#pragma unroll
            for (int i = 0; i < 4; ++i)
#pragma unroll
                for (int k = 0; k < 16; ++k) { sf[k] += wfv[i] * val[i][k]; sb[k] += wbv[i] * val[i][k]; }
        }
        { const float wf = __builtin_amdgcn_exp2f(u.lgf * 256.f * (float)c), wb = __builtin_amdgcn_exp2f(u.lgb * 256.f * (float)(7 - c));
          const float* Lf = L0 + (size_t)(8 * 2 + 0) * 64 * 128; const float* Lb = Lf + 64 * 128; float vf[16], vb[16];
#pragma unroll
          for (int k = 0; k < 16; ++k) { vf[k] = Lf[k * 128]; vb[k] = Lb[k * 128]; }
#pragma unroll
          for (int k = 0; k < 16; ++k) { sf[k] += wf * vf[k]; sb[k] += wb * vb[k]; } }
        LAS unsigned char* sp = lds + S_OFF + dv * KPITCH + dg * 32;
        *(LAS u32x4*)(sp) = (u32x4){pk2(sf[0], sf[1]), pk2(sf[2], sf[3]), pk2(sf[4], sf[5]), pk2(sf[6], sf[7])};
        *(LAS u32x4*)(sp + 16) = (u32x4){pk2(sf[8], sf[9]), pk2(sf[10], sf[11]), pk2(sf[12], sf[13]), pk2(sf[14], sf[15])};
        *(LAS u32x4*)(sp + S_BYTES) = (u32x4){pk2(sb[0], sb[1]), pk2(sb[2], sb[3]), pk2(sb[4], sb[5]), pk2(sb[6], sb[7])};
        *(LAS u32x4*)(sp + S_BYTES + 16) = (u32x4){pk2(sb[8], sb[9]), pk2(sb[10], sb[11]), pk2(sb[12], sb[13]), pk2(sb[14], sb[15])};
        __syncthreads();
        const int p = qoff + r32; const float ai = __builtin_amdgcn_exp2f(u.lgf * (float)(p + 1)), bi = __builtin_amdgcn_exp2f(u.lgb * (float)(256 - p));
#pragma unroll
        for (int s4 = 0; s4 < 4; ++s4) {
            const u32x4 qw = __builtin_bit_cast(u32x4, qf[s4]); u32x4 qa, qb;
#pragma unroll
            for (int q = 0; q < 4; ++q) { const float lo = bflo(qw[q]), hh = bfhi(qw[q]); qa[q] = pk2(lo * ai, hh * ai); qb[q] = pk2(lo * bi, hh * bi); }
#pragma unroll
            for (int d = 0; d < 4; ++d) {
                const LAS unsigned char* bp = lds + S_OFF + (32 * d + r32) * KPITCH + (16 * s4 + 8 * hi) * 2;
                o[d] = __builtin_amdgcn_mfma_f32_32x32x16_bf16(__builtin_bit_cast(bf16x8, qa), *(const LAS bf16x8*)bp, o[d], 0, 0, 0);
                o[d] = __builtin_amdgcn_mfma_f32_32x32x16_bf16(__builtin_bit_cast(bf16x8, qb), *(const LAS bf16x8*)(bp + S_BYTES), o[d], 0, 0, 0);
            }
        }
    }
    u32x4 kA[2], vA[2];
    auto tile_row = [&](int t) { return t < u.ntA ? u.krowA + 64 * t : u.krowB + 64 * (t - u.ntA); };
    unsigned voffV[2], voffK[2];
#pragma unroll
    for (int i = 0; i < 2; ++i) { const int cid = tid + 512 * i, key = cid >> 4, c16 = cid & 15;
        voffV[i] = (unsigned)((key * NPROJ + vcol + c16 * 8) * 2); voffK[i] = (unsigned)((key * NPROJ + kcol + c16 * 8) * 2); }
    if (!diff) { const int key = tid >> 3, c8 = tid & 7; voffK[0] = (unsigned)((key * NPROJ + kcol + c8 * 8) * 2); }
    auto load_tile = [&](int t, u32x4 (&kr)[2], u32x4 (&vr)[2]) {
        const GAS unsigned char* tb = (const GAS unsigned char*)PROJ + (size_t)tile_row(t) * NPROJ * 2;
#pragma unroll
        for (int i = 0; i < 2; ++i) { vr[i] = *(const GAS u32x4*)(tb + voffV[i]); if (diff) kr[i] = *(const GAS u32x4*)(tb + voffK[i]); }
        if (!diff) kr[0] = *(const GAS u32x4*)(tb + voffK[0]);
    };
    auto store_tile = [&](int buf, const u32x4 (&kr)[2], const u32x4 (&vr)[2]) {
        LAS unsigned char* b = lds + buf * BUF_BYTES;
#pragma unroll
        for (int i = 0; i < 2; ++i) { const int cid = tid + 512 * i, key = cid >> 4, c16 = cid & 15;
            *(LAS u32x4*)(b + 2 * KC_BYTES + key * VPITCH + c16 * 16) = vr[i];
            if (diff) *(LAS u32x4*)(b + (c16 >> 3) * KC_BYTES + key * KPITCH + (c16 & 7) * 16) = kr[i]; }
        if (!diff) { const int key = tid >> 3, c8 = tid & 7; *(LAS u32x4*)(b + key * KPITCH + c8 * 16) = kr[0]; }
    };
    const int qpos = u.qpos0 + qoff + r32;
    auto compute_tile = [&](int t, int bufsel) {
        const LAS unsigned char* b = lds + bufsel * BUF_BYTES;
        const LAS unsigned char* kb = b + comp * KC_BYTES + r32 * KPITCH + hi * 16;
        u32x4 pw[4];
        const bool segB = t >= u.ntA; const int j0 = 64 * (segB ? t - u.ntA : t);
        f32x16 sc[2];
#pragma unroll
        for (int kh = 0; kh < 2; ++kh) { sc[kh] = (f32x16){};
#pragma unroll
            for (int s = 0; s < 4; ++s) { const bf16x8 kf = *(const LAS bf16x8*)(kb + kh * 32 * KPITCH + s * 32); sc[kh] = __builtin_amdgcn_mfma_f32_32x32x16_bf16(kf, qf[s], sc[kh], 0, 0, 0); } }
        auto weigh = [&](int kh) {
            f32x16& x = sc[kh];
            if (diff) {
#pragma unroll
                for (int r = 0; r < 16; ++r) x[r] = __builtin_amdgcn_exp2f(x[r]);
                float a = 0.f;
#pragma unroll
                for (int r = 0; r < 16; ++r) a += x[r];
                lsum += a;
            } else if (!segB || u.kindB == 0) {
#pragma unroll
                for (int r = 0; r < 16; ++r) { const int d = qpos - (j0 + 32 * kh + crow(r, hi)); x[r] *= __builtin_amdgcn_exp2f((float)d * (d >= 0 ? u.lgf : -u.lgb)); }
            } else {
#pragma unroll
                for (int r = 0; r < 16; ++r) { const int na = j0 + 32 * kh + crow(r, hi);
                    x[r] *= __builtin_amdgcn_exp2f((float)(qpos + CTX - na) * u.lgf) + __builtin_amdgcn_exp2f((float)(u.nseq - qpos + na) * u.lgb); }
            }
            pw[2 * kh] = (u32x4){pk2(x[0], x[1]), pk2(x[2], x[3]), pk2(x[4], x[5]), pk2(x[6], x[7])};
            pw[2 * kh + 1] = (u32x4){pk2(x[8], x[9]), pk2(x[10], x[11]), pk2(x[12], x[13]), pk2(x[14], x[15])};
        };
        const LAS unsigned char* vb = b + 2 * KC_BYTES + (4 * hi + ((lane & 15) >> 2)) * VPITCH + ((lane >> 4) & 1) * 32 + (lane & 3) * 8;
        auto pv = [&](int ks) {
#pragma unroll
            for (int dvb = 0; dvb < 4; ++dvb) {
                const s16x4 lo = vtr(vb + ks * 16 * VPITCH + dvb * 64), hi4 = vtr(vb + ks * 16 * VPITCH + 8 * VPITCH + dvb * 64);
                const bf16x8 vf = (bf16x8){lo[0], lo[1], lo[2], lo[3], hi4[0], hi4[1], hi4[2], hi4[3]};
                o[dvb] = __builtin_amdgcn_mfma_f32_32x32x16_bf16(__builtin_bit_cast(bf16x8, pw[ks]), vf, o[dvb], 0, 0, 0);
            }
        };
        weigh(0);
        pv(0); pv(1);
        weigh(1);
        pv(2); pv(3);
    };
    load_tile(0, kA, vA); store_tile(0, kA, vA);
#pragma unroll
    for (int s4 = 0; s4 < 4; ++s4) asm volatile("" : "+v"(qf[s4]));
    __syncthreads();
    if (PROBE_STAT) ts1 = __builtin_amdgcn_s_memtime();
    for (int t = 0; t < NT; t += 2) {
        unsigned long long ta = 0; if (PROBE_STAT >= 3) ta = __builtin_amdgcn_s_memtime();
        load_tile(t + 1, kA, vA);
        compute_tile(t, 0);
        if (PROBE_STAT == 3) tacc += __builtin_amdgcn_s_memtime() - ta;
        store_tile(1, kA, vA);
        if (PROBE_STAT == 4) tacc += __builtin_amdgcn_s_memtime() - ta;
        __syncthreads();
        load_tile(t + 2 < NT ? t + 2 : NT - 1, kA, vA);
        compute_tile(t + 1, 1);
        store_tile(0, kA, vA);
        __syncthreads();
    }
    if (PROBE_STAT) ts2 = __builtin_amdgcn_s_memtime();
    LAS float* wsf = (LAS float*)(lds + SCR_OFF) + wid * 64;
    int lz = lane; asm volatile("" : "+v"(lz));
    const int r32e = lz & 31, hie = lz >> 5;
    if (diff) {
        lsum = sum32x2(lsum);
        if (hie == 0) wsf[r32e] = __builtin_amdgcn_rcpf(lsum);
        LDS_WAIT();
        float rl[16];
#pragma unroll
        for (int r = 0; r < 16; ++r) rl[r] = wsf[crow(r, hie)];
        LAS float* XC = (LAS float*)lds;
        if (comp == 1) {
#pragma unroll
            for (int r = 0; r < 16; ++r) { const int q = qoff + crow(r, hie); const float sc_ = rl[r] * u.lam;
                *(LAS f32x4*)(XC + (q * 32 + r32e) * 4) = (f32x4){o[0][r] * sc_, o[1][r] * sc_, o[2][r] * sc_, o[3][r] * sc_}; }
        }
        __syncthreads();
        if (comp == 0) {
            float ss[16];
#pragma unroll
            for (int r = 0; r < 16; ++r) { const int q = qoff + crow(r, hie); float a = 0.f; const f32x4 xc = *(const LAS f32x4*)(XC + (q * 32 + r32e) * 4);
#pragma unroll
                for (int d = 0; d < 4; ++d) { const float v = o[d][r] * rl[r] - xc[d]; o[d][r] = v; a += v * v; }
                ss[r] = a; }
#pragma unroll
            for (int r = 0; r < 16; ++r) { float a = ss[r]; a = half_sum(a);
                ss[r] = u.scale_out * __builtin_amdgcn_rsqf(a * (1.0f / 128.0f) + EPS); }
            bf16* DO = (bf16*)(F.ws + WS_FO + 2 * MIX_ONE);
            LAS unsigned char* stg = lds + 16384 * (wid & 3);
#pragma unroll
            for (int r = 0; r < 16; ++r)
#pragma unroll
                for (int d = 0; d < 4; ++d) *(LAS bf16*)(stg + crow(r, hie) * 272 + (32 * d + r32e) * 2) = (bf16)f2bf(o[d][r] * ss[r]);
#pragma unroll
            for (int it = 0; it < 8; ++it) { const int row = 4 * it + (lz >> 4), ch = lz & 15; const u32x4 w = *(const LAS u32x4*)(stg + row * 272 + ch * 16);
                *(u32x4*)(DO + (size_t)(u.outrow0 + qoff + row) * 512 + u.h * 128 + ch * 8) = w; }
        }
    } else {
        bf16* RO = (bf16*)(F.ws + WS_FO + 1 * MIX_ONE);
        u32x4 gq[8];
#pragma unroll
        for (int it = 0; it < 8; ++it) gq[it] = *(const u32x4*)(PROJ + (size_t)(u.outrow0 + qoff + 4 * it + (lz >> 4)) * NPROJ + C_RG + u.h * 128 + (lz & 15) * 8);
#pragma unroll
        for (int r = 0; r < 16; ++r) {
            float a = (o[0][r] + o[1][r]) + (o[2][r] + o[3][r]);
            a = half_sum(a);
            const float mu = a * (1.0f / 128.0f); float q = 0.f;
#pragma unroll
            for (int d = 0; d < 4; ++d) { const float v = o[d][r] - mu; o[d][r] = v; q += v * v; }
            q = half_sum(q);
            const float rstd = __builtin_amdgcn_rsqf(q * (1.0f / 128.0f) + EPS);
#pragma unroll
            for (int d = 0; d < 4; ++d) o[d][r] *= rstd;
        }
        LAS unsigned char* stg = lds + 8704 * wid;
#pragma unroll
        for (int r = 0; r < 16; ++r)
#pragma unroll
            for (int d = 0; d < 4; ++d) *(LAS bf16*)(stg + crow(r, hie) * 272 + (32 * d + r32e) * 2) = (bf16)f2bf(o[d][r]);
#pragma unroll
        for (int it = 0; it < 8; ++it) { const int rowl = 4 * it + (lz >> 4), ch = lz & 15; const size_t row = (size_t)(u.outrow0 + qoff + rowl);
            const u32x4 w = *(const LAS u32x4*)(stg + rowl * 272 + ch * 16), g = gq[it]; u32x4 ov;
#pragma unroll
            for (int q = 0; q < 4; ++q) ov[q] = pk2(bflo(w[q]) * siluf_(bflo(g[q])), bfhi(w[q]) * siluf_(bfhi(g[q])));
            *(u32x4*)(RO + row * 512 + u.h * 128 + ch * 8) = ov; }
    }
    __syncthreads();
    if (PROBE_STAT && u.stat && tid == 0) { asm volatile("s_waitcnt vmcnt(0)" ::: "memory"); ts3 = __builtin_amdgcn_s_memtime();
        const float tot = (float)(ts3 - ts0); float v = 0.f;
        if (PROBE_STAT == 1) v = (float)(ts2 - ts1) / tot;
        if (PROBE_STAT == 2) v = tot * (1.0f / 400000.0f);
        if (PROBE_STAT == 3 || PROBE_STAT == 4) v = (float)tacc * 2.0f / (float)(ts2 - ts1);
        if (PROBE_STAT == 5) v = (float)(ts3 - ts2) / tot;
        if (PROBE_STAT == 6) v = (float)(ts1 - ts0) / tot;
        ((float*)F.ctl)[CW_STAT] = v; }
}
}

namespace rst {
constexpr int KP = 192, VP = 320, KB_BYTES = 128 * KP, VB_BYTES = 128 * VP;
__device__ __forceinline__ void unit(const Frame& F, int layer, int b, int h, int blk) {
    LAS unsigned char* lds = F.lds; const int tid = F.tid, lane = F.lane, wid = F.wave, hi = lane >> 5;
    const bf16* PROJ = (const bf16*)(F.ws + WS_PROJ);
    const int row0 = blk < 8 ? TC + b * SEQ + blk * 256 : b * CTX;
    const float lgf = inp(F, IN_RDEC)[(layer * 2 + 0) * 4 + h] * LOG2E, lgb = inp(F, IN_RDEC)[(layer * 2 + 1) * 4 + h] * LOG2E;
    const int dir = wid >> 2, dvb = wid & 3;
    f32x16 acc0 = (f32x16){}, acc1 = (f32x16){};
    u32x4 kreg[2][2], vreg[2][4];
#pragma unroll
    for (int half = 0; half < 2; ++half) {
#pragma unroll
        for (int i = 0; i < 2; ++i) { const int cid = tid + 512 * i, tok = cid >> 3, c8 = cid & 7, p = half * 128 + tok; kreg[half][i] = *(const u32x4*)(PROJ + (size_t)(row0 + p) * NPROJ + C_RK + h * 64 + c8 * 8); }
#pragma unroll
        for (int i = 0; i < 4; ++i) { const int cid = tid + 512 * i, tok = cid >> 4, c16 = cid & 15, p = half * 128 + tok; vreg[half][i] = *(const u32x4*)(PROJ + (size_t)(row0 + p) * NPROJ + C_RV + h * 128 + c16 * 8); }
    }
#pragma unroll
    for (int half = 0; half < 2; ++half) {
#pragma unroll
        for (int i = 0; i < 2; ++i) { const int cid = tid + 512 * i, tok = cid >> 3, c8 = cid & 7, p = half * 128 + tok;
            const u32x4 kv = kreg[half][i];
            const float wf = __builtin_amdgcn_exp2f((float)(255 - p) * lgf), wb = __builtin_amdgcn_exp2f((float)p * lgb);
            u32x4 kf, kb;
#pragma unroll
            for (int q = 0; q < 4; ++q) { const float lo = bflo(kv[q]), hh = bfhi(kv[q]); kf[q] = pk2(lo * wf, hh * wf); kb[q] = pk2(lo * wb, hh * wb); }
            *(LAS u32x4*)(lds + tok * KP + c8 * 16) = kf; *(LAS u32x4*)(lds + KB_BYTES + tok * KP + c8 * 16) = kb; }
#pragma unroll
        for (int i = 0; i < 4; ++i) { const int cid = tid + 512 * i, tok = cid >> 4, c16 = cid & 15;
            *(LAS u32x4*)(lds + 2 * KB_BYTES + tok * VP + c16 * 16) = vreg[half][i]; }
        __syncthreads();
        const LAS unsigned char* ka = lds + dir * KB_BYTES + (8 * hi + ((lane & 15) >> 2)) * KP + ((lane >> 4) & 1) * 32 + (lane & 3) * 8;
        const LAS unsigned char* va = lds + 2 * KB_BYTES + (8 * hi + ((lane & 15) >> 2)) * VP + dvb * 64 + ((lane >> 4) & 1) * 32 + (lane & 3) * 8;
#pragma unroll
        for (int ks = 0; ks < 8; ++ks) {
            const s16x4 v0 = att::vtr(va + ks * 16 * VP), v1 = att::vtr(va + ks * 16 * VP + 4 * VP);
            const bf16x8 vf = (bf16x8){v0[0], v0[1], v0[2], v0[3], v1[0], v1[1], v1[2], v1[3]};
            const s16x4 a0 = att::vtr(ka + ks * 16 * KP), a1 = att::vtr(ka + ks * 16 * KP + 4 * KP);
            const s16x4 b0 = att::vtr(ka + ks * 16 * KP + 64), b1 = att::vtr(ka + ks * 16 * KP + 4 * KP + 64);
            acc0 = __builtin_amdgcn_mfma_f32_32x32x16_bf16((bf16x8){a0[0], a0[1], a0[2], a0[3], a1[0], a1[1], a1[2], a1[3]}, vf, acc0, 0, 0, 0);
            acc1 = __builtin_amdgcn_mfma_f32_32x32x16_bf16((bf16x8){b0[0], b0[1], b0[2], b0[3], b1[0], b1[1], b1[2], b1[3]}, vf, acc1, 0, 0, 0);
        }
        __syncthreads();
    }
    float* L = (float*)(F.ws + WS_LBUF) + ((size_t)((b * 4 + h) * 9 + blk) * 2 + dir) * 64 * 128;
    const int r32 = lane & 31;
#pragma unroll
    for (int r = 0; r < 16; ++r) { const int d = att::crow(r, hi); L[(size_t)d * 128 + 32 * dvb + r32] = acc0[r]; L[(size_t)(32 + d) * 128 + 32 * dvb + r32] = acc1[r]; }
}
}
__device__ __forceinline__ void fold_rows(Frame& F, const bf16* GTin, bf16* GTout, int N) {
    const int gw = F.vcu * 8 + F.wave, NGW = F.G * 8, lane = F.lane, H = N >> 1;
    for (int row = gw; row < 4096; row += NGW) { const bf16* gc = GTin + (size_t)row * 2 * N; const bf16* gs = gc + N; bf16* o = GTout + (size_t)row * N;
        for (int j0 = 0; j0 < H; j0 += 1024) {
            float a[16], b[16], c[16], d[16];
#pragma unroll
            for (int q = 0; q < 16; ++q) { const int j = j0 + 64 * q + lane; const bool ok = j < H; const int jj = ok ? j : 0, jr = (ok && j > 0) ? N - j : 0;
                a[q] = bf2f(gc[jj]); b[q] = bf2f(gc[jr]); c[q] = bf2f(gs[jj]); d[q] = bf2f(gs[jr]); }
#pragma unroll
            for (int q = 0; q < 16; ++q) { const int j = j0 + 64 * q + lane;
                if (j < H) { o[j] = (bf16)f2bf(j == 0 ? a[q] : a[q] + b[q]); if (j > 0) o[H + j] = (bf16)f2bf(c[q] - d[q]); } }
        }
        if (lane == 0) o[H] = gc[H];
    }
}
__device__ __forceinline__ void phase_retstate(Frame& F, int layer) {
    const int nx = (F.G < 288 && 2 * F.G > 288 + 64) ? 288 - F.G : 0;
    if (F.vcu >= nx) { const int g0 = F.G, v0 = F.vcu; F.G = g0 - nx; F.vcu = v0 - nx;
        fold_rows(F, (const bf16*)(F.ws + WS_GT), (bf16*)(F.ws + WS_GT2), SEQ);
        if (layer < DEPTH - 1) fold_rows(F, (const bf16*)(F.ws + WS_GTC), (bf16*)(F.ws + WS_GTC2), CTX);
        F.G = g0; F.vcu = v0; }
    for (int i = F.vcu; i < 288; i += F.G) { const int blk = i % 9, bh = i / 9; rst::unit(F, layer, bh >> 2, bh & 3, blk); }
}


constexpr int CVT_PER_UNIT = 8;
constexpr int NDFT_CU = 128;

__device__ __forceinline__ void phase_mixers(Frame& F, int layer, int rep) {
    const bool last = layer == DEPTH - 1;
#if !defined(ONLY_SUB) || ONLY_SUB == 1
    if ((int)blockIdx.x < NDFT_CU && F.G > NDFT_CU && !(rep > 0 && PROBE_MIX >= 2)) {
        {
            SchedGrid S{SEQ / 256, 4096 / 256, NDFT_CU, (int)blockIdx.x, (const char*)(F.ws + WS_DFTL), (const char*)(F.ws + WS_GT2), (size_t)256 * 2048 * 2, (size_t)256 * 2048 * 2, 0, 0};
            EpiDFT E{(bf16*)(F.ws + WS_FO), SEQ, TC};
            pg8::gemm_phase(F.lds, F.tid, 2048, S, E, 2048);
        }
        if (!last) {
            SchedGrid S{1, 4096 / 256, NDFT_CU, (int)blockIdx.x, (const char*)(F.ws + WS_DFTC), (const char*)(F.ws + WS_GTC2), (size_t)256 * 256 * 2, (size_t)256 * 256 * 2, 0, 0};
            EpiDFT E{(bf16*)(F.ws + WS_FO), CTX, 0};
            pg8::gemm_phase(F.lds, F.tid, 256, S, E, 256);
        }
    }
#endif
#if defined(ONLY_SUB) && ONLY_SUB == 1
    return;
#endif
    const int nunits = last ? 96 : 108;
    const float lam = lam_of(F, layer), so = 1.0f - lam_init_of(layer);
    const int xq0 = (int)(xb_xcc_id() & 7u);
    volatile LAS unsigned* qw = (volatile LAS unsigned*)(F.lds + att::QW_OFF);
    for (int qi = 0; qi < 8; ++qi) {
    const int xq = (xq0 + qi) & 7;
    unsigned* qctr = F.ctl + CW_QUEUE + 64 * (xq + 8 * (layer + 2 * rep));
    for (;;) {
        if (F.tid == 0) *qw = __hip_atomic_fetch_add(qctr, 1u, RLX_AGENT);
        __syncthreads();
        const int i = (int)*qw;
        __syncthreads();
        if (i >= nunits) break;
        if (rep > 0 && PROBE_MIX != 0) { if (PROBE_MIX == 1) break; if (PROBE_MIX == 2 && i >= 64) break; if (PROBE_MIX == 3 && (i < 64 || i >= 96)) continue; }
        att::UnitDesc u{};
        u.lam = lam; u.scale_out = so;
        if (i < 64) { const int p = xq + 8 * (i >> 4), b = p >> 2, h = p & 3, qb = i & 15; u.mode = 0; u.h = h; u.qrow0 = TC + b * SEQ + qb * 128; u.qpos0 = qb * 128; u.krowA = TC + b * SEQ; u.ntA = 32; u.krowB = b * CTX; u.ntB = 4; }
        else if (i < 96) { const int j = i - 64, p = xq + 8 * (j >> 3), b = p >> 2, h = p & 3, qb = j & 7; u.mode = 1; u.h = h; u.qrow0 = TC + b * SEQ + qb * 256; u.qpos0 = 0; u.krowA = u.qrow0; u.ntA = 4; u.krowB = 0; u.ntB = 0; u.kindB = 0; u.nseq = SEQ; u.cross = 1; u.bh = b * 4 + h; u.blk = qb; }
        else if (i < 104) { const int j = i - 96, p = xq + 8 * (j >> 1), b = p >> 2, h = p & 3, qb = j & 1; u.mode = 0; u.h = h; u.qrow0 = b * CTX + qb * 128; u.qpos0 = qb * 128; u.krowA = b * CTX; u.ntA = 4; u.krowB = 0; u.ntB = 0; }
        else { const int j = i - 104, p = xq + 8 * j, b = p >> 2, h = p & 3; u.mode = 1; u.h = h; u.qrow0 = b * CTX; u.qpos0 = 0; u.krowA = b * CTX; u.ntA = 4; u.krowB = 0; u.ntB = 0; u.kindB = 0; u.nseq = CTX; }
        u.outrow0 = u.qrow0; u.stat = (PROBE_STAT && layer == DEPTH - 1 && rep == 0 && xq == 0 && i == 40) ? 1 : 0;
        if (u.mode == 1) { u.lgf = inp(F, IN_RDEC)[(layer * 2 + 0) * 4 + u.h] * LOG2E; u.lgb = inp(F, IN_RDEC)[(layer * 2 + 1) * 4 + u.h] * LOG2E; }
        if (u.mode == 0) att::unit<0>(F, u); else att::unit<1>(F, u);
        if (layer + 1 < DEPTH && F.G == 256) convert_expert_weights_dyn(F, layer + 1, F.ctl + CW_QUEUE + 64 * 41, CVT_PER_UNIT);
    }
    }
}

__device__ __forceinline__ int tail_tiles(int ntiles, int nN, int G) { const int r = ntiles % G; return (G % 8 == 0 && 4 * r <= G && r % 8 == 0 && r % nN == 0) ? r : 0; }
__device__ __forceinline__ void phase_merge(Frame& F, int layer) {
    const int row_off = layer == DEPTH - 1 ? TC : 0, M = TA - row_off;
    SchedMerge S{M / 256, D / 256, F.G, (int)blockIdx.x, (const char*)(F.ws + WS_FO) + (size_t)row_off * 512 * 2, (const char*)(F.ws + WS_WFO + (size_t)layer * 3 * WMG_ONE), MIX_ONE, WMG_ONE, (size_t)256 * 512 * 2, (size_t)256 * 512 * 2, tail_tiles((M / 256) * (D / 256), D / 256, F.G)};
    EpiMerge E{(const unsigned char*)(F.ws + WS_G8), (bf16*)(F.ws + WS_MIXB), row_off};
    pg8::gemm_phase(F.lds, F.tid, 512, S, E, 512);
    pg8::gemm_tail(F.lds, F.tid, 512, S, E, (int)blockIdx.x, 512);
}
__device__ __forceinline__ void phase_outproj(Frame& F, int layer) {
    const int row_off = layer == DEPTH - 1 ? TC : 0, M = TA - row_off;
    SchedGrid S{M / 256, D / 256, F.G, (int)blockIdx.x, (const char*)(F.ws + WS_MIXB) + (size_t)row_off * D * 2, (const char*)(F.ws + WS_WOUT + layer * WOUT_L), (size_t)256 * D * 2, (size_t)256 * D * 2, 0, 0, tail_tiles((M / 256) * (D / 256), D / 256, F.G)};
    EpiOut E{inp(F, IN_CTX), inp(F, IN_X), (bf16*)(F.ws + WS_XR), (const float*)(F.ws + WS_MOD) + (size_t)layer * 9 * 6144 + 2 * 1024, row_off, layer == 0};
    pg8::gemm_phase(F.lds, F.tid, D, S, E, D);
    pg8::gemm_tail(F.lds, F.tid, D, S, E, (int)blockIdx.x, D);
}

__device__ __forceinline__ void phase_norm2(Frame& F, int layer) {
    const int gw = F.vcu * 8 + F.wave, NGW = F.G * 8, lane = F.lane, tid = F.tid;
    LAS float* wr_t = (LAS float*)F.lds;
    const float* wrt = inp(F, IN_WROUTER) + (size_t)layer * D * NE;
    { f32x4 wv[8];
#pragma unroll
      for (int i = 0; i < 8; ++i) wv[i] = *(const f32x4*)(wrt + 4 * (tid + 512 * i));
#pragma unroll
      for (int i = 0; i < 8; ++i) { const int q = tid + 512 * i, k = q >> 2, e0 = 4 * (q & 3);
          wr_t[(e0 + 0) * 1024 + k] = wv[i].x; wr_t[(e0 + 1) * 1024 + k] = wv[i].y; wr_t[(e0 + 2) * 1024 + k] = wv[i].z; wr_t[(e0 + 3) * 1024 + k] = wv[i].w; } }
    __syncthreads();
    const int r_lo = layer == DEPTH - 1 ? TC : 0;
    const bf16* XR = (const bf16*)(F.ws + WS_XR); bf16* HB = (bf16*)(F.ws + WS_HB); float* AFF = (float*)(F.ws + WS_AFF);
    u32x2 xn[4];
    const int RPW = (TA - r_lo + NGW - 1) / NGW, rbeg = r_lo + gw * RPW, rend = rbeg + RPW < TA ? rbeg + RPW : TA;
    { const int r0 = rbeg < TA ? rbeg : TA - 1;
#pragma unroll
      for (int j = 0; j < 4; ++j) xn[j] = *(const u32x2*)(XR + (size_t)r0 * D + 4 * lane + 256 * j); }
    const bool b5 = lane & 32, b4 = lane & 16, b3 = lane & 8, b2 = lane & 4;
    for (int r = rbeg; r < rend; ++r) {
        const int v = vec_of_row(r);
        f32x4 gvv[4], svv[4], cvv[4];
        { const float* g = inp(F, IN_GFFN) + (size_t)layer * D; const float* sh = mod_ptr(F, layer, v, 3); const float* scl = mod_ptr(F, layer, v, 4);
#pragma unroll
          for (int j = 0; j < 4; ++j) { const int k = 4 * lane + 256 * j; gvv[j] = *(const f32x4*)(g + k); svv[j] = *(const f32x4*)(sh + k); cvv[j] = *(const f32x4*)(scl + k); } }
        asm volatile("" ::: "memory");
        f32x4 x[4];
#pragma unroll
        for (int j = 0; j < 4; ++j) x[j] = (f32x4){bflo(xn[j].x), bfhi(xn[j].x), bflo(xn[j].y), bfhi(xn[j].y)};
        { const int rn = r + 1 < rend ? r + 1 : r;
#pragma unroll
          for (int j = 0; j < 4; ++j) xn[j] = *(const u32x2*)(XR + (size_t)rn * D + 4 * lane + 256 * j); }
        asm volatile("" ::: "memory");
        float ss = 0.f;
#pragma unroll
        for (int j = 0; j < 4; ++j) ss += (x[j].x * x[j].x + x[j].y * x[j].y) + (x[j].z * x[j].z + x[j].w * x[j].w);
        const float rinv = __builtin_amdgcn_rsqf(wave_sum(ss) * (1.0f / D) + EPS);
#pragma unroll
        for (int j = 0; j < 4; ++j) { const int k = 4 * lane + 256 * j; const f32x4 gv = gvv[j], sv = svv[j], cv = cvv[j];
            x[j] = (x[j] * rinv * gv) * (cv + 1.0f) + sv;
            u32x2 w; w.x = pk2(x[j].x, x[j].y); w.y = pk2(x[j].z, x[j].w); *(u32x2*)(HB + (size_t)r * D + k) = w; }
        float a[16];
#pragma unroll
        for (int e = 0; e < 16; ++e) { float t = 0.f;
#pragma unroll
            for (int j = 0; j < 4; ++j) { const f32x4 w = *(const LAS f32x4*)(wr_t + e * 1024 + 4 * lane + 256 * j); t += (x[j].x * w.x + x[j].y * w.y) + (x[j].z * w.z + x[j].w * w.w); }
            a[e] = t; if ((e & 3) == 3) asm volatile("" ::: "memory"); }
        float b[8], c[4], d[2];
#pragma unroll
        for (int i = 0; i < 8; ++i) { const float mine = b5 ? a[i + 8] : a[i], oth = b5 ? a[i] : a[i + 8]; b[i] = mine + lane_xor32(oth, lane); }
#pragma unroll
        for (int i = 0; i < 4; ++i) { const float mine = b4 ? b[i + 4] : b[i], oth = b4 ? b[i] : b[i + 4]; c[i] = mine + lane_xor16(oth, lane); }
#pragma unroll
        for (int i = 0; i < 2; ++i) { const float mine = b3 ? c[i + 2] : c[i], oth = b3 ? c[i] : c[i + 2]; d[i] = mine + lane_xor8(oth); }
        float lg = (b2 ? d[1] : d[0]) + lane_xor4(b2 ? d[0] : d[1], lane);
        lg += dppf<DPP_XOR2>(lg); lg += dppf<DPP_XOR1>(lg);
        float mx = lg;
        mx = fmaxf(mx, lane_xor4(mx, lane)); mx = fmaxf(mx, lane_xor8(mx)); mx = fmaxf(mx, lane_xor16(mx, lane)); mx = fmaxf(mx, lane_xor32(mx, lane));
        const float ex = __expf(lg - mx); float den = ex;
        den += lane_xor4(den, lane); den += lane_xor8(den); den = sum16x2(den); den = sum32x2(den);
        if ((lane & 3) == 0) AFF[(size_t)r * 16 + (lane >> 2)] = ex * __builtin_amdgcn_rcpf(den);
    }
    __syncthreads();
}

__device__ __forceinline__ void phase_topk(Frame& F, int layer) {
    const bool last = layer == DEPTH - 1; const int tid = F.tid, lane = F.lane, wave = F.wave;
    const int RPE = last ? 2048 : 2304, lat_off = last ? 0 : 256;
    LAS unsigned* part = (LAS unsigned*)F.lds;
    LAS unsigned* cntG = part + 16;
    LAS unsigned* cntE = cntG + 32;
    LAS int* lst = (LAS int*)(cntE + 32);
    const float* AFF = (const float*)(F.ws + WS_AFF); int* INV = (int*)(F.ws + WS_INV); float* TOPW = (float*)(F.ws + WS_TOPW);
    int* SLOT = (int*)(F.ws + WS_SLOT);
    const int nitems = last ? 128 : 256;
    for (int item = F.vcu; item < nitems; item += F.G) {
        int n, C, tokrow0, e, slot0;
        if (item < 128) { const int b = item >> 4; e = item & 15; n = SEQ; C = 256; tokrow0 = TC + b * SEQ; slot0 = e * RPE + lat_off + b * 256; }
        else { const int be = item - 128, b = be >> 4; e = be & 15; n = CTX; C = 32; tokrow0 = b * CTX; slot0 = e * RPE + b * 32; }
        float v[4]; unsigned key[4];
#pragma unroll
        for (int q = 0; q < 4; ++q) { const int i = tid + 512 * q; v[q] = i < n ? AFF[(size_t)(tokrow0 + i) * 16 + e] : 0.f; key[q] = __builtin_bit_cast(unsigned, v[q]); }
        unsigned t = 0u;
        for (int bit = 30; bit >= 0; --bit) {
            const unsigned cand = t | (1u << bit); unsigned c = 0u;
#pragma unroll
            for (int q = 0; q < 4; ++q) c += (unsigned)__builtin_popcountll(__ballot(key[q] >= cand));
            if (lane == 0) part[(bit & 1) * 8 + wave] = c;
            __syncthreads();
            unsigned tot = 0u;
#pragma unroll
            for (int w = 0; w < 8; ++w) tot += part[(bit & 1) * 8 + w];
            if (tot >= (unsigned)C) t = cand;
        }
        unsigned long long bg[4], be_[4];
#pragma unroll
        for (int q = 0; q < 4; ++q) { bg[q] = __ballot(key[q] > t); be_[q] = __ballot(key[q] == t && key[q] != 0u);
            if (lane == 0) { cntG[q * 8 + wave] = (unsigned)__builtin_popcountll(bg[q]); cntE[q * 8 + wave] = (unsigned)__builtin_popcountll(be_[q]); } }
        __syncthreads();
        unsigned totG = 0u, baseG[4] = {0u, 0u, 0u, 0u}, baseE[4] = {0u, 0u, 0u, 0u}; unsigned runG = 0u, runE = 0u;
#pragma unroll
        for (int q = 0; q < 4; ++q)
#pragma unroll
            for (int w = 0; w < 8; ++w) { const unsigned g = cntG[q * 8 + w], ee = cntE[q * 8 + w]; if (w == wave) { baseG[q] = runG; baseE[q] = runE; } runG += g; runE += ee; }
        totG = runG;
        const unsigned need = (unsigned)C - totG;
        const unsigned long long lt = (1ull << lane) - 1ull;
#pragma unroll
        for (int q = 0; q < 4; ++q) { const int i = tid + 512 * q;
            if (i < n) {
                const bool g = (bg[q] >> lane) & 1ull, eq = (be_[q] >> lane) & 1ull;
                const unsigned myG = baseG[q] + (unsigned)__builtin_popcountll(bg[q] & lt), myE = baseE[q] + (unsigned)__builtin_popcountll(be_[q] & lt);
                int sl = -1;
                if (g) sl = (int)myG; else if (eq && myE < need) sl = (int)(totG + myE);
                const int R = sl >= 0 ? slot0 + sl : -1;
                INV[(size_t)(tokrow0 + i) * 16 + e] = R;
                if (sl >= 0) { TOPW[R] = v[q]; SLOT[R] = tokrow0 + i; }
            } }
        __syncthreads();
    }
}

__device__ __forceinline__ void phase_gateup(Frame& F, int layer) {
    const int RPE = layer == DEPTH - 1 ? 2048 : 2304;
    SchedGrid S{NE * RPE / 256, 4096 / 256, F.G, (int)blockIdx.x, (const char*)nullptr, (const char*)(F.ws + WS_WGU + layer * EXPW_L), 0, (size_t)256 * D * 2, RPE / 256, WGU_E};
    EpiGU E{(bf16*)(F.ws + WS_HID)};
    pg8::gemm_phase_gather(F.lds, F.tid, D, S, E, (const char*)(F.ws + WS_HB), (const int*)(F.ws + WS_SLOT), (LAS int*)(F.lds + LDSCTL_OFF + 1024));
}
__device__ __forceinline__ void phase_down(Frame& F, int layer) {
    const int RPE = layer == DEPTH - 1 ? 2048 : 2304;
    SchedGrid S{NE * RPE / 256, D / 256, F.G, (int)blockIdx.x, (const char*)(F.ws + WS_HID), (const char*)(F.ws + WS_WD + layer * EXPW_L), (size_t)256 * HIDP * 2, (size_t)256 * EH * 2, RPE / 256, WD_E, tail_tiles((NE * RPE / 256) * (D / 256), D / 256, F.G)};
    EpiDown E{(bf16*)(F.ws + WS_YE), (const float*)(F.ws + WS_TOPW)};
    pg8::gemm_phase(F.lds, F.tid, EH, S, E, HIDP);
    pg8::gemm_tail(F.lds, F.tid, EH, S, E, (int)blockIdx.x, HIDP);
}

constexpr int NPHASE = 1 + 10 * DEPTH + 1;
__global__ void __launch_bounds__(512, 2) mk_fwd(Args args) {
    extern __shared__ __attribute__((aligned(16))) unsigned char lds_raw[];
    Frame F;
    F.lds = (LAS unsigned char*)lds_raw; F.MISC = (volatile LAS unsigned*)(F.lds + MISC_OFF);
    F.tid = threadIdx.x; F.lane = F.tid & 63; F.wave = __builtin_amdgcn_readfirstlane(F.tid >> 6);
    F.G = gridDim.x; { const int bx = blockIdx.x; F.vcu = (F.G % 8 == 0) ? (bx % 8) * (F.G / 8) + bx / 8 : bx; }
    F.ws = (unsigned char*)(GAS unsigned char*)(unsigned long long)args.ws; F.ctl = (unsigned*)(F.ws + WS_CTL); F.out = (float*)(GAS float*)(unsigned long long)args.out;
    for (int u = F.tid; u < (LDS_BYTES - LDSCTL_OFF) / 4; u += 512) ((LAS unsigned*)(F.lds + LDSCTL_OFF))[u] = 0u;
    __syncthreads();
    XcdBarrier bar; bar.bar = F.ctl + CW_BAR; bar.x = 0; bar.st = nullptr;
    const bool multi = (args.ph_hi - args.ph_lo) > 1;
    if (multi) bar = xcd_barrier_post(F.ctl + CW_BAR, F.MISC + 8);
    if (PROBE_STAT >= 10 && blockIdx.x == 0 && F.tid == 0) ((unsigned long long*)(F.ctl + CW_STAT + 8))[0] = __builtin_amdgcn_s_memrealtime();
    for (int ph = args.ph_lo; ph < args.ph_hi; ++ph) {
        const int layer = (ph - 1) / 10, k = (ph == 0) ? 10 : (ph == NPHASE - 1) ? 12 : (ph - 1) % 10;
        int reps = 1 + ((PROBE_MASK >> k) & 1);
        if (k == 0 && layer > 0 && (PROBE_MASK & 2048)) reps = 2;
        for (int rep = 0; rep < reps; ++rep) {
            { unsigned long long w = (unsigned long long)args.ws; asm volatile("" : "+s"(w)); F.ws = (unsigned char*)(GAS unsigned char*)w; F.ctl = (unsigned*)(F.ws + WS_CTL); }
            { unsigned long long kp = (unsigned long long)__builtin_amdgcn_kernarg_segment_ptr(); asm volatile("" : "+s"(kp)); F.karg = (const void __attribute__((address_space(4)))*)kp; }
            { int l = (int)__builtin_amdgcn_mbcnt_hi(~0u, __builtin_amdgcn_mbcnt_lo(~0u, 0u)); asm volatile("" : "+v"(l)); F.lane = l; F.tid = F.wave * 64 + l; }
#ifdef ONLY_PHASE
            if (k != ONLY_PHASE) continue;
#endif
            switch (k) {
                case 10: phase_prologue(F); break;
                case 12: phase_norm(F, DEPTH); break;
                case 0: if (rep == 0) phase_norm(F, layer); if (layer > 0) { if (F.G == 256) convert_expert_weights_dyn(F, layer, F.ctl + CW_QUEUE + 64 * 41, 1 << 30); else convert_expert_weights(F, layer); } break;
                case 1: phase_inproj(F, layer); break;
                case 2: phase_retstate(F, layer); break;
                case 3: phase_mixers(F, layer, rep); break;
                case 4: phase_merge(F, layer); break;
                case 5: if (rep == 0) phase_outproj(F, layer); break;
                case 6: phase_norm2(F, layer); break;
                case 7: phase_topk(F, layer); break;
                case 8: phase_gateup(F, layer); break;
                default: phase_down(F, layer); break;
            }
            if (rep + 1 < reps || ph + 1 < args.ph_hi) xcd_barrier(bar);
            if (PROBE_STAT >= 10 && blockIdx.x == 0 && F.tid == 0) ((unsigned long long*)(F.ctl + CW_STAT + 8))[ph + 1] = __builtin_amdgcn_s_memrealtime();
        }
    }
}

extern "C" void kernel_launch(void* const* d_in, const int* in_sizes, int n_in, void* d_out, int out_size, void* d_ws, size_t ws_size, hipStream_t stream) {
    static int grid = 0;
    if (grid == 0) {
        if (n_in != 21 || out_size != TL * D || ws_size < WS_END) { fprintf(stderr, "kernel_launch: unexpected shapes (n_in %d, out %d, ws %zu need %zu)\n", n_in, out_size, ws_size, (size_t)WS_END); grid = -1; return; }
        int dev = 0, cus = 0, per_cu = 0;
        if (hipGetDevice(&dev) != hipSuccess || hipDeviceGetAttribute(&cus, hipDeviceAttributeMultiprocessorCount, dev) != hipSuccess) { grid = -1; return; }
        if (hipFuncSetAttribute((const void*)mk_fwd, hipFuncAttributeMaxDynamicSharedMemorySize, LDS_BYTES) != hipSuccess) { fprintf(stderr, "kernel_launch: hipFuncSetAttribute failed\n"); grid = -1; return; }
        if (hipOccupancyMaxActiveBlocksPerMultiprocessor(&per_cu, (const void*)mk_fwd, 512, LDS_BYTES) != hipSuccess || per_cu < 1) { fprintf(stderr, "kernel_launch: occupancy query says %d\n", per_cu); per_cu = 1; }
        (void)hipGetLastError();
        grid = cus * (per_cu >= 1 ? 1 : 1);
        if (grid % 8 != 0 || grid <= NDFT_CU) fprintf(stderr, "kernel_launch: unusual grid %d\n", grid);
    }
    if (grid < 0) return;
    (void)hipMemsetAsync((char*)d_ws + WS_CTL, 0, CTL_BYTES, stream);
    Args a{};
    for (int i = 0; i < 21; ++i) a.in[i] = (const float*)d_in[i];
    a.out = (float*)d_out; a.ws = (unsigned char*)d_ws;
#if MK_MULTI_LAUNCH
    for (int ph = 0; ph < NPHASE; ++ph) { a.ph_lo = ph; a.ph_hi = ph + 1; hipLaunchKernelGGL(mk_fwd, dim3(grid), dim3(512), LDS_BYTES, stream, a); }
#else
    a.ph_lo = 0; a.ph_hi = NPHASE;
    void* kargs[] = {&a};
    hipError_t e = hipLaunchCooperativeKernel((const void*)mk_fwd, dim3(grid), dim3(512), kargs, LDS_BYTES, stream);
    if (e != hipSuccess) fprintf(stderr, "kernel_launch: cooperative launch failed: %s (grid %d)\n", hipGetErrorString(e), grid);
#endif
}
```
